# Optimizing an MI355X kernel written in HIP

```python
import math
import jax, jax.numpy as jnp
from jax import lax
import numpy as np

D_MODEL = 1024
BATCH = 2
SEQ = 16384
DEPTH = 1

GRID_W = 64
CTX_LEN = 256
RET_HEADS = 4
RET_DK = 128
RET_DV = 256
RET_CHUNK = 128
ROPE_BASE = 10000.0
LRU_WIDTH = 1024
LRU_BLOCKS = 8
LRU_BW = LRU_WIDTH // LRU_BLOCKS
LRU_C = 8.0
CONV_W = 4
N_GROUPS = 4
EXPERTS_PER_GROUP = 8
N_EXPERTS = N_GROUPS * EXPERTS_PER_GROUP
EXPERT_HIDDEN = 768
TOP_K = 2
MOE_BLOCK = 128
EPS = 1e-6

Q_W = RET_HEADS * RET_DK
V_W = RET_HEADS * RET_DV
SPLITS = [Q_W, 2 * Q_W, 2 * Q_W + V_W, 2 * Q_W + 2 * V_W,
          2 * Q_W + 2 * V_W + LRU_WIDTH, 2 * Q_W + 2 * V_W + 2 * LRU_WIDTH]
IN_COLS = 2 * Q_W + 2 * V_W + 2 * LRU_WIDTH + 2 * D_MODEL

kernel_name = "hybrid_retention_rglru_hmoe_dit"


def rmsnorm(x, g):
    xf = x.astype(jnp.float32)
    y = xf * lax.rsqrt(jnp.mean(xf * xf, axis=-1, keepdims=True) + EPS)
    return y.astype(x.dtype) * g


def modulate(h, shift, scale):
    return h * (1 + scale) + shift


def adaln(cvec, w, b):
    return jax.nn.silu(cvec) @ w + b


def rope(x, ang):
    n = x.shape[-1] // 2
    x1, x2 = x[..., :n], x[..., n:]
    cos = jnp.cos(ang)[None, :, None, :]
    sin = jnp.sin(ang)[None, :, None, :]
    return jnp.concatenate([x1 * cos - x2 * sin, x1 * sin + x2 * cos], axis=-1).astype(x.dtype)


def rope2d(x, angles):
    ang_r, ang_c = angles
    half = x.shape[-1] // 2
    return jnp.concatenate([rope(x[..., :half], ang_r), rope(x[..., half:], ang_c)], axis=-1)


def retention_scan(q, k, v, log_gamma, s0, strict):
    B, L, H, DK = q.shape
    DV = v.shape[-1]
    C = RET_CHUNK
    n = L // C
    qc = q.reshape(B, n, C, H, DK)
    kc = k.reshape(B, n, C, H, DK)
    vc = v.reshape(B, n, C, H, DV)
    idx = jnp.arange(C, dtype=jnp.float32)
    diff = idx[:, None] - idx[None, :]
    mask = (diff > 0) if strict else (diff >= 0)
    decay_intra = jnp.where(mask[None], jnp.exp(log_gamma[:, None, None] * jnp.maximum(diff, 0.0)[None]), 0.0)
    scores = jnp.einsum('bnihd,bnjhd->bnhij', qc, kc) * decay_intra[None, None]
    o_intra = jnp.einsum('bnhij,bnjhe->bnihe', scores, vc)
    q_decay = jnp.exp(log_gamma[:, None] * (idx[None, :] + 1.0))
    k_decay = jnp.exp(log_gamma[:, None] * (C - 1.0 - idx)[None, :])
    chunk_kv = jnp.einsum('bnjhd,hj,bnjhe->nbhde', kc, k_decay, vc)
    gamma_c = jnp.exp(log_gamma * C)[None, :, None, None]

    def step(s, kv):
        return gamma_c * s + kv, s

    s_final, s_prev = lax.scan(step, s0, chunk_kv)
    o_inter = jnp.einsum('bnihd,hi,nbhde->bnihe', qc, q_decay, s_prev)
    o = (o_intra + o_inter).reshape(B, L, H, DV)
    return o, s_final


def retention_bidir(q, k, v, log_gf, log_gb, s0_f, s0_b):
    o_f, s_f = retention_scan(q, k, v, log_gf, s0_f, strict=False)
    fl = lambda t: jnp.flip(t, axis=1)
    o_b, s_b = retention_scan(fl(q), fl(k), fl(v), log_gb, s0_b, strict=True)
    return o_f + fl(o_b), s_f, s_b


def head_groupnorm(o, gain):
    of = o.astype(jnp.float32)
    mu = jnp.mean(of, axis=-1, keepdims=True)
    var = jnp.mean(jnp.square(of - mu), axis=-1, keepdims=True)
    y = (of - mu) * lax.rsqrt(var + EPS)
    B, L = o.shape[:2]
    return y.reshape(B, L, -1).astype(gain.dtype) * gain


def dwconv_centred(x, w, b):
    y = lax.conv_general_dilated(x, w[:, None, :], window_strides=(1,), padding=[(1, 2)],
                                 dimension_numbers=('NWC', 'WIO', 'NWC'),
                                 feature_group_count=x.shape[-1])
    return y + b


def block_linear(x, w, b):
    B, L, W = x.shape
    xb = x.reshape(B, L, LRU_BLOCKS, LRU_BW)
    return jnp.einsum('blnd,nde->blne', xb, w).reshape(B, L, W) + b


def _linear_combine(e1, e2):
    a1, b1 = e1
    a2, b2 = e2
    return a1 * a2, a2 * b1 + b2


def rglru_dir(xc, w_a, b_a, w_x, b_x, lam, h0, reverse):
    r = jax.nn.sigmoid(block_linear(xc, w_a, b_a)).astype(jnp.float32)
    i = jax.nn.sigmoid(block_linear(xc, w_x, b_x)).astype(jnp.float32)
    log_a = -LRU_C * r * jax.nn.softplus(-lam.astype(jnp.float32))
    a = jnp.exp(log_a)
    u = jnp.sqrt(-jnp.expm1(2.0 * log_a)) * (i * xc.astype(jnp.float32))
    if reverse:
        a, u = jnp.flip(a, axis=1), jnp.flip(u, axis=1)
    u = u.at[:, 0].add(a[:, 0] * h0)
    _, h = lax.associative_scan(_linear_combine, (a, u), axis=1)
    h_last = h[:, -1]
    if reverse:
        h = jnp.flip(h, axis=1)
    return h, h_last


def mixer_stream(h, p, angles, init_states, need_out):
    B, L, _ = h.shape
    z = h @ p['w_in']
    q, k, v, g, xl, gl, gate_logits = jnp.split(z, SPLITS, axis=-1)
    q = q.reshape(B, L, RET_HEADS, RET_DK)
    k = k.reshape(B, L, RET_HEADS, RET_DK)
    v = v.reshape(B, L, RET_HEADS, RET_DV)
    if angles is not None:
        q = rope2d(q, angles)
        k = rope2d(k, angles)
    k = k * (RET_DK ** -0.5)
    s_f0, s_b0, h_f0, h_b0 = init_states
    decay = p['ret_decay'].astype(jnp.float32)
    log_gf = -jax.nn.softplus(-decay[0])
    log_gb = -jax.nn.softplus(-decay[1])
    o, s_f, s_b = retention_bidir(q, k, v, log_gf, log_gb, s_f0, s_b0)
    xc = dwconv_centred(xl, p['conv_w'], p['conv_b'])
    hf, hf_last = rglru_dir(xc, p['lru_w_a'][0], p['lru_b_a'][0], p['lru_w_x'][0], p['lru_b_x'][0],
                            p['lru_lambda'][0], h_f0, reverse=False)
    hb, hb_last = rglru_dir(xc, p['lru_w_a'][1], p['lru_b_a'][1], p['lru_w_x'][1], p['lru_b_x'][1],
                            p['lru_lambda'][1], h_b0, reverse=True)
    states = (s_f, s_b, hf_last, hb_last)
    if not need_out:
        return None, states
    ret = head_groupnorm(o, p['ret_norm']).astype(h.dtype) * jax.nn.silu(g)
    lru = (hf + hb).astype(h.dtype) * jax.nn.gelu(gl)
    gates = jax.nn.sigmoid(gate_logits + p['b_gate'])
    g_ret, g_lru = jnp.split(gates, 2, axis=-1)
    merged = g_ret * (ret @ p['w_ret_proj']) + g_lru * (lru @ p['w_lru_proj'])
    return merged @ p['w_out'], states


def hier_moe(h, w_group, b_group, w_router, b_router, w_e_gate, w_e_up, w_e_down):
    B, L, D = h.shape
    T = B * L
    ht = h.reshape(T, D)
    g_logits = (ht @ w_group).astype(jnp.float32)
    g_probs = jax.nn.softmax(g_logits, axis=-1)
    g_sel = jnp.argmax(g_logits + b_group.astype(jnp.float32), axis=-1)
    e_logits = (ht @ w_router).astype(jnp.float32).reshape(T, N_GROUPS, EXPERTS_PER_GROUP)
    e_in = jnp.take_along_axis(e_logits, g_sel[:, None, None], axis=1)[:, 0]
    b_in = b_router.astype(jnp.float32).reshape(N_GROUPS, EXPERTS_PER_GROUP)[g_sel]
    _, top_idx = lax.top_k(e_in + b_in, TOP_K)
    top_w = jax.nn.softmax(jnp.take_along_axis(e_in, top_idx, axis=1), axis=-1)
    weights = jnp.take_along_axis(g_probs, g_sel[:, None], axis=1) * top_w
    expert_id = (g_sel[:, None] * EXPERTS_PER_GROUP + top_idx).astype(jnp.int32)

    A = T * TOP_K
    flat_e = expert_id.reshape(A)
    flat_tok = jnp.repeat(jnp.arange(T, dtype=jnp.int32), TOP_K)
    flat_w = weights.reshape(A)
    order = jnp.argsort(flat_e)
    se, stok, sw = flat_e[order], flat_tok[order], flat_w[order]
    counts = jax.ops.segment_sum(jnp.ones((A,), jnp.int32), flat_e, num_segments=N_EXPERTS)
    starts = jnp.cumsum(counts) - counts
    padded = ((counts + MOE_BLOCK - 1) // MOE_BLOCK) * MOE_BLOCK
    pends = jnp.cumsum(padded)
    pstarts = pends - padded
    dest = pstarts[se] + (jnp.arange(A, dtype=jnp.int32) - starts[se])
    n_blocks = -(-A // MOE_BLOCK) + N_EXPERTS
    buf_tok = jnp.full((n_blocks * MOE_BLOCK,), T, jnp.int32).at[dest].set(stok)
    buf_w = jnp.zeros((n_blocks * MOE_BLOCK,), h.dtype).at[dest].set(sw.astype(h.dtype))
    block_e = jnp.minimum(jnp.searchsorted(pends, jnp.arange(n_blocks, dtype=jnp.int32) * MOE_BLOCK,
                                           side='right'), N_EXPERTS - 1)
    ht_pad = jnp.concatenate([ht, jnp.zeros((1, D), ht.dtype)], axis=0)
    xb = ht_pad[buf_tok].reshape(n_blocks, MOE_BLOCK, D)

    def expert_block(args):
        xblk, e = args
        return (jax.nn.silu(xblk @ w_e_gate[e]) * (xblk @ w_e_up[e])) @ w_e_down[e]

    yb = lax.map(expert_block, (xb, block_e))
    y = jnp.zeros((T + 1, D), yb.dtype).at[buf_tok].add(yb.reshape(-1, D) * buf_w[:, None])
    return y[:T].reshape(B, L, D)


def setup_inputs(seed: int = 0) -> dict:
    key = jax.random.key(seed)
    ks = jax.random.split(key, 32)
    nrm = lambda k, shape, s: jax.random.normal(k, shape, jnp.float32) * s
    gam = 1.0 - 2.0 ** (-5.0 - jnp.arange(RET_HEADS, dtype=jnp.float32))
    decay_base = jnp.log(gam / (1.0 - gam))
    u = jax.random.uniform(ks[14], (DEPTH, 2, LRU_WIDTH), jnp.float32, minval=0.9, maxval=0.999)
    a0 = u ** 0.125
    return {
        'x': nrm(ks[0], (BATCH, SEQ, D_MODEL), 1.0),
        'c': nrm(ks[1], (BATCH, D_MODEL), 1.0),
        'ctx': nrm(ks[2], (BATCH, CTX_LEN, D_MODEL), 1.0),
        'c_ctx': nrm(ks[3], (D_MODEL,), 1.0),
        'w_mod': nrm(ks[4], (DEPTH, D_MODEL, 6 * D_MODEL), 0.5 * D_MODEL ** -0.5),
        'b_mod': nrm(ks[5], (DEPTH, 6 * D_MODEL), 0.02),
        'norm1': 1.0 + nrm(ks[6], (DEPTH, D_MODEL), 0.02),
        'norm2': 1.0 + nrm(ks[7], (DEPTH, D_MODEL), 0.02),
        'w_in': nrm(ks[8], (DEPTH, D_MODEL, IN_COLS), D_MODEL ** -0.5),
        'b_gate': nrm(ks[9], (DEPTH, 2 * D_MODEL), 0.02),
        'ret_decay': decay_base[None, None, :] + nrm(ks[10], (DEPTH, 2, RET_HEADS), 0.1),
        'ret_norm': 1.0 + nrm(ks[11], (DEPTH, V_W), 0.02),
        'w_ret_proj': nrm(ks[12], (DEPTH, V_W, D_MODEL), V_W ** -0.5),
        'conv_w': nrm(ks[13], (DEPTH, CONV_W, LRU_WIDTH), CONV_W ** -0.5),
        'conv_b': nrm(ks[15], (DEPTH, LRU_WIDTH), 0.02),
        'lru_w_a': nrm(ks[16], (DEPTH, 2, LRU_BLOCKS, LRU_BW, LRU_BW), LRU_BW ** -0.5),
        'lru_b_a': nrm(ks[17], (DEPTH, 2, LRU_WIDTH), 0.02),
        'lru_w_x': nrm(ks[18], (DEPTH, 2, LRU_BLOCKS, LRU_BW, LRU_BW), LRU_BW ** -0.5),
        'lru_b_x': nrm(ks[19], (DEPTH, 2, LRU_WIDTH), 0.02),
        'lru_lambda': jnp.log(a0 / (1.0 - a0)),
        'w_lru_proj': nrm(ks[20], (DEPTH, LRU_WIDTH, D_MODEL), LRU_WIDTH ** -0.5),
        'w_out': nrm(ks[21], (DEPTH, D_MODEL, D_MODEL), D_MODEL ** -0.5),
        'w_group': nrm(ks[22], (DEPTH, D_MODEL, N_GROUPS), D_MODEL ** -0.5),
        'b_group': nrm(ks[23], (DEPTH, N_GROUPS), 0.01),
        'w_router': nrm(ks[24], (DEPTH, D_MODEL, N_EXPERTS), D_MODEL ** -0.5),
        'b_router': nrm(ks[25], (DEPTH, N_EXPERTS), 0.01),
        'w_e_gate': nrm(ks[26], (DEPTH, N_EXPERTS, D_MODEL, EXPERT_HIDDEN), D_MODEL ** -0.5),
        'w_e_up': nrm(ks[27], (DEPTH, N_EXPERTS, D_MODEL, EXPERT_HIDDEN), D_MODEL ** -0.5),
        'w_e_down': nrm(ks[28], (DEPTH, N_EXPERTS, EXPERT_HIDDEN, D_MODEL), EXPERT_HIDDEN ** -0.5),
        'final_norm': 1.0 + nrm(ks[29], (D_MODEL,), 0.02),
    }


def reference(x, c, ctx, c_ctx, w_mod, b_mod, norm1, norm2, w_in, b_gate, ret_decay, ret_norm,
              w_ret_proj, conv_w, conv_b, lru_w_a, lru_b_a, lru_w_x, lru_b_x, lru_lambda,
              w_lru_proj, w_out, w_group, b_group, w_router, b_router, w_e_gate, w_e_up,
              w_e_down, final_norm):
    B, L, _ = x.shape
    rows = L // GRID_W
    pos_r = jnp.repeat(jnp.arange(rows, dtype=jnp.float32), GRID_W)
    pos_c = jnp.tile(jnp.arange(GRID_W, dtype=jnp.float32), rows)
    n_freq = RET_DK // 4
    freq = ROPE_BASE ** (-jnp.arange(n_freq, dtype=jnp.float32) / n_freq)
    angles = (pos_r[:, None] * freq[None, :], pos_c[:, None] * freq[None, :])
    Bc = ctx.shape[0]
    for l in range(DEPTH):
        last = l == DEPTH - 1
        p = {
            'w_in': w_in[l], 'b_gate': b_gate[l], 'ret_decay': ret_decay[l], 'ret_norm': ret_norm[l],
            'w_ret_proj': w_ret_proj[l], 'conv_w': conv_w[l], 'conv_b': conv_b[l],
            'lru_w_a': lru_w_a[l], 'lru_b_a': lru_b_a[l], 'lru_w_x': lru_w_x[l], 'lru_b_x': lru_b_x[l],
            'lru_lambda': lru_lambda[l], 'w_lru_proj': w_lru_proj[l], 'w_out': w_out[l],
        }
        mod_x = adaln(c, w_mod[l], b_mod[l])[:, None, :]
        mod_c = adaln(c_ctx, w_mod[l], b_mod[l])[None, None, :]
        sh1x, sc1x, g1x, sh2x, sc2x, g2x = jnp.split(mod_x, 6, axis=-1)
        sh1c, sc1c, g1c, sh2c, sc2c, g2c = jnp.split(mod_c, 6, axis=-1)
        zero_states = (jnp.zeros((Bc, RET_HEADS, RET_DK, RET_DV), jnp.float32),
                       jnp.zeros((Bc, RET_HEADS, RET_DK, RET_DV), jnp.float32),
                       jnp.zeros((Bc, LRU_WIDTH), jnp.float32),
                       jnp.zeros((Bc, LRU_WIDTH), jnp.float32))
        hc = modulate(rmsnorm(ctx, norm1[l]), sh1c, sc1c)
        yc, ctx_states = mixer_stream(hc, p, None, zero_states, need_out=not last)
        hx = modulate(rmsnorm(x, norm1[l]), sh1x, sc1x)
        yx, _ = mixer_stream(hx, p, angles, ctx_states, need_out=True)
        x = x + g1x * yx
        hx2 = modulate(rmsnorm(x, norm2[l]), sh2x, sc2x)
        x = x + g2x * hier_moe(hx2, w_group[l], b_group[l], w_router[l], b_router[l],
                               w_e_gate[l], w_e_up[l], w_e_down[l])
        if not last:
            ctx = ctx + g1c * yc
            hc2 = modulate(rmsnorm(ctx, norm2[l]), sh2c, sc2c)
            ctx = ctx + g2c * hier_moe(hc2, w_group[l], b_group[l], w_router[l], b_router[l],
                                       w_e_gate[l], w_e_up[l], w_e_down[l])
    return rmsnorm(x, final_norm)
```

```cpp
#include <hip/hip_runtime.h>
#include <cstdio>
#include <cstdint>

#ifndef N_LAUNCH_SPLIT
#define N_LAUNCH_SPLIT 1
#endif

#define DI __device__ __forceinline__
#ifdef SUB
#define SUBSEL(k) ((k) == SUB)
#else
#define SUBSEL(k) true
#endif
#define LAS __attribute__((address_space(3)))
typedef unsigned short bf16_t;
typedef short bf16x8 __attribute__((ext_vector_type(8)));
typedef short s16x4 __attribute__((ext_vector_type(4)));
typedef float f32x2 __attribute__((ext_vector_type(2)));
typedef float f32x4 __attribute__((ext_vector_type(4)));
typedef float f32x16 __attribute__((ext_vector_type(16)));
typedef unsigned u32x2 __attribute__((ext_vector_type(2)));
typedef unsigned u32x4 __attribute__((ext_vector_type(4)));

constexpr int NB_ = 2, SEQ = 16384, NT = NB_ * SEQ, DM = 1024, CTXL = 256, NTC = NB_ * CTXL;
constexpr int NH = 4, DK = 128, DV = 256, QW = 512, VW = 1024, LW = 1024;
constexpr int NCOL = 7168;
constexpr int NE = 32, EH = 768;
constexpr float EPSV = 1e-6f;
constexpr float LOG2E = 1.4426950408889634f;
constexpr int SCH = 512, NSC = SEQ / SCH;
constexpr int LT = 64, NLT = SEQ / LT, NSLOT = 320;

constexpr size_t MiB = 1u << 20;
constexpr size_t WS_CTL = 0;
constexpr size_t WS_MODP = 1 * MiB;
constexpr size_t WS_ROPE = 1 * MiB + 512 * 1024;
constexpr size_t WS_WRH = 1 * MiB + 768 * 1024;
constexpr size_t WS_LAGG = 2 * MiB;
constexpr size_t WS_LHIN = 12 * MiB;
constexpr size_t WS_CTXK = 17 * MiB;
constexpr size_t WS_CTXV = 17 * MiB + 512 * 1024;
constexpr size_t WS_CTXX = 18 * MiB + 512 * 1024;
constexpr size_t WS_CTXS = 20 * MiB;
constexpr size_t WS_ROUTE = 22 * MiB;
constexpr size_t WS_PTOK = 23 * MiB;
constexpr size_t WS_WIN = 32 * MiB;
constexpr size_t WS_WRET = 46 * MiB, WS_WLRU = 48 * MiB, WS_WOUT = 50 * MiB;
constexpr size_t WS_WLB = 52 * MiB;
constexpr size_t WS_HX = 56 * MiB;
constexpr size_t WS_ZQ = 120 * MiB, WS_ZK = 152 * MiB, WS_ZV = 184 * MiB, WS_ZG = 248 * MiB, WS_ZXL = 312 * MiB, WS_ZGL = 376 * MiB;
constexpr size_t WS_SBF = 440 * MiB;
constexpr size_t WS_WGU = 120 * MiB;
constexpr size_t WS_WDN = 440 * MiB;
constexpr size_t WS_HX2 = 248 * MiB;
constexpr size_t WS_HID = 313 * MiB;
constexpr size_t WS_YE = 56 * MiB;
constexpr size_t WS_NEED = 512 * MiB;
constexpr int CW_BAR = 4096, CW_CNT = 16384;

constexpr int LDS_SCR = 0, LDS_TOK = 131072, LDS_MISC = 131072 + 8192, LDS_BYTES = 147456;

DI int tid_fresh() { int t = threadIdx.x; asm volatile("" : "+v"(t)); return t; }
DI float bf2f(unsigned short b) { return __uint_as_float(((unsigned)b) << 16); }
DI unsigned cvt_pk_bf16(float lo, float hi) { unsigned r; asm volatile("v_cvt_pk_bf16_f32 %0, %1, %2" : "=v"(r) : "v"(lo), "v"(hi)); return r; }
DI unsigned short f2bf(float f) { return (unsigned short)(cvt_pk_bf16(f, 0.f) & 0xffffu); }
DI float ex2(float x) { return __builtin_amdgcn_exp2f(x); }
DI float rcpf_(float x) { return __builtin_amdgcn_rcpf(x); }
DI float sigm(float x) { return rcpf_(1.0f + ex2(-LOG2E * x)); }
DI float silu_(float x) { return x * sigm(x); }
DI float gelu_tanh(float x) { const float z = 0.7978845608028654f * (x + 0.044715f * x * x * x); return x * sigm(2.0f * z); }
DI float softplus_(float x) { return x > 20.f ? x : log1pf(expf(x)); }
DI int crow(int i, int h) { return (i & 3) + 8 * (i >> 2) + 4 * h; }
#define MFMA32(a, b, c) __builtin_amdgcn_mfma_f32_32x32x16_bf16((a), (b), (c), 0, 0, 0)
DI void lds_wait() { asm volatile("s_waitcnt lgkmcnt(0)" ::: "memory"); }
template <int O0, int O1> DI bf16x8 tr_frag(unsigned addr) {
    s16x4 lo, hi;
    asm volatile("ds_read_b64_tr_b16 %0, %2 offset:%3\n\tds_read_b64_tr_b16 %1, %2 offset:%4\n\ts_waitcnt lgkmcnt(0)" : "=&v"(lo), "=&v"(hi) : "v"(addr), "i"(O0), "i"(O1) : "memory");
    return __builtin_shufflevector(lo, hi, 0, 1, 2, 3, 4, 5, 6, 7);
}
template <int O, int S, int T> DI void tr_frag4(unsigned addr, bf16x8& f0, bf16x8& f1, bf16x8& f2, bf16x8& f3) {
    s16x4 a0, a1, b0, b1, c0, c1, d0, d1;
    asm volatile("ds_read_b64_tr_b16 %0, %8 offset:%9\n\tds_read_b64_tr_b16 %1, %8 offset:%10\n\t"
                 "ds_read_b64_tr_b16 %2, %8 offset:%11\n\tds_read_b64_tr_b16 %3, %8 offset:%12\n\t"
                 "ds_read_b64_tr_b16 %4, %8 offset:%13\n\tds_read_b64_tr_b16 %5, %8 offset:%14\n\t"
                 "ds_read_b64_tr_b16 %6, %8 offset:%15\n\tds_read_b64_tr_b16 %7, %8 offset:%16\n\ts_waitcnt lgkmcnt(0)"
                 : "=&v"(a0), "=&v"(a1), "=&v"(b0), "=&v"(b1), "=&v"(c0), "=&v"(c1), "=&v"(d0), "=&v"(d1)
                 : "v"(addr), "i"(O), "i"(O + T), "i"(O + S), "i"(O + S + T), "i"(O + 2 * S), "i"(O + 2 * S + T), "i"(O + 3 * S), "i"(O + 3 * S + T) : "memory");
    f0 = __builtin_shufflevector(a0, a1, 0, 1, 2, 3, 4, 5, 6, 7); f1 = __builtin_shufflevector(b0, b1, 0, 1, 2, 3, 4, 5, 6, 7);
    f2 = __builtin_shufflevector(c0, c1, 0, 1, 2, 3, 4, 5, 6, 7); f3 = __builtin_shufflevector(d0, d1, 0, 1, 2, 3, 4, 5, 6, 7);
}
DI f32x16 zero16() { f32x16 z; for (int i = 0; i < 16; ++i) z[i] = 0.f; return z; }

struct KArgs {
    const float* in[30];
    float* out;
    unsigned char* ws;
    int ph_lo, ph_hi;
};
enum { I_X = 0, I_C, I_CTX, I_CCTX, I_WMOD, I_BMOD, I_NORM1, I_NORM2, I_WIN, I_BGATE, I_RDECAY, I_RNORM, I_WRET, I_CONVW, I_CONVB, I_LWA, I_LBA, I_LWX, I_LBX, I_LLAM,
       I_WLRU, I_WOUT, I_WGRP, I_BGRP, I_WRT, I_BRT, I_WEG, I_WEU, I_WED, I_FNORM };

DI float mod_val(const KArgs& a, int v, int ch, int k) {
    const float* mp = (const float*)(a.ws + WS_MODP); const int n = ch * 1024 + k;
    return ((mp[(0 * 3 + v) * 6144 + n] + mp[(1 * 3 + v) * 6144 + n]) + (mp[(2 * 3 + v) * 6144 + n] + mp[(3 * 3 + v) * 6144 + n])) + a.in[I_BMOD][n];
}

#define XB_TMO      128
#define XB_XCNT(j)  (256  + 64 * (j))
#define XB_XSUB(j)  (1280 + 64 * (j))
#define XB_XGEN(j)  (2304 + 64 * (j))
#define XB_TOP      3328
#define XB_TOPGEN   3392
#define XCD_BAR_WORDS 3456
#define XB_SPIN_CAP (1u << 18)
__device__ __forceinline__ unsigned xb_ld(unsigned* p)              { return __hip_atomic_load(p, __ATOMIC_RELAXED, __HIP_MEMORY_SCOPE_AGENT); }
__device__ __forceinline__ unsigned xb_add(unsigned* p, unsigned v) { return __hip_atomic_fetch_add(p, v, __ATOMIC_RELAXED, __HIP_MEMORY_SCOPE_AGENT); }
__device__ __forceinline__ unsigned xb_xcc_id() { return (unsigned)__builtin_amdgcn_s_getreg((3 << 11) | 20) & 0xFu; }
#define XB_SPIN(cond, bar) do { unsigned _sp = 0; while (cond) { __builtin_amdgcn_s_sleep(1); \
    if ((++_sp & 255u) == 0u) { if (xb_ld(&(bar)[XB_TMO])) break; if (_sp > XB_SPIN_CAP) { atomicAdd(&(bar)[XB_TMO], 1u); break; } } } } while (0)
struct XcdBarrier { unsigned* bar; unsigned x; volatile LAS unsigned* st; };
__device__ __forceinline__ XcdBarrier xcd_barrier_post(unsigned* bar, volatile LAS unsigned* st) {
    XcdBarrier b; b.bar = bar; b.x = xb_xcc_id(); b.st = st;
    if (threadIdx.x == 0) (void)xb_add(&bar[XB_XCNT(b.x)], 1u);
    return b;
}
__device__ __forceinline__ void xcd_barrier_complete(unsigned* bar, unsigned x, unsigned& nloc, unsigned& nx) {
    const unsigned G = gridDim.x * gridDim.y * gridDim.z;
    unsigned sum, cnt, mine, sp = 0u;
    for (;;) {
        sum = 0u; cnt = 0u; mine = 0u;
#pragma unroll
        for (unsigned j = 0; j < 16; ++j) { const unsigned c = xb_ld(&bar[XB_XCNT(j)]); sum += c; cnt += (c > 0u) ? 1u : 0u; mine = (j == x) ? c : mine; }
        if (sum == G) break;
        __builtin_amdgcn_s_sleep(1);
        if ((++sp & 255u) == 0u) { if (xb_ld(&bar[XB_TMO])) break; if (sp > XB_SPIN_CAP) { atomicAdd(&bar[XB_TMO], 1u); break; } }
    }
    nloc = mine > 0u ? mine : 1u; nx = cnt > 0u ? cnt : 1u;
}
__device__ __forceinline__ void xcd_barrier(const XcdBarrier& b) {
    asm volatile("s_waitcnt vmcnt(0)" ::: "memory");
    __syncthreads();
    if (threadIdx.x == 0) {
        unsigned* bar = b.bar;
        __builtin_amdgcn_s_waitcnt(0);
        unsigned nloc = b.st[0], nx = b.st[1];
        if (nloc == 0u) { xcd_barrier_complete(bar, b.x, nloc, nx); b.st[0] = nloc; b.st[1] = nx; }
        const unsigned old = xb_add(&bar[XB_XSUB(b.x)], 1u);
        const unsigned gen = old / nloc;
        if (old + 1u == (gen + 1u) * nloc) {
            __builtin_amdgcn_fence(__ATOMIC_RELEASE, "agent");
            asm volatile("s_waitcnt vmcnt(0)" ::: "memory");
            const unsigned og = xb_add(&bar[XB_TOP], 1u);
            const unsigned tg = og / nx;
            if (og + 1u == (tg + 1u) * nx) xb_add(&bar[XB_TOPGEN], 1u);
            else XB_SPIN(xb_ld(&bar[XB_TOPGEN]) == tg, bar);
            __builtin_amdgcn_fence(__ATOMIC_ACQUIRE, "agent");
            xb_add(&bar[XB_XGEN(b.x)], 1u);
            asm volatile("s_waitcnt vmcnt(0)" ::: "memory");
        } else {
            XB_SPIN(xb_ld(&bar[XB_XGEN(b.x)]) == gen, bar);
            __builtin_amdgcn_fence(__ATOMIC_ACQUIRE, "agent");
            asm volatile("s_waitcnt vmcnt(0)" ::: "memory");
        }
    }
    __syncthreads();
}

namespace pg8 {
constexpr int BM = 256, BK = 64, HALF = 128, HTB = HALF * BK * 2, STAGE_BYTES = 8 * HTB, NXCD = 8, WGM = 8;
DI int lds_byte(int r, int c) { const int st = (r >> 4) * 2 + (c >> 5), rr = r & 15, cc = c & 31, ob = rr * 64 + cc * 2; return st * 1024 + (ob ^ (((ob >> 9) & 1) << 5)); }
DI void stage_rc(int b, int& R, int& C) { const int st = b / 1024, sb = b % 1024, swz = sb ^ (((sb >> 9) & 1) << 5); R = (st >> 1) * 16 + swz / 64; C = (st & 1) * 32 + (swz % 64) / 2; }
DI int perm32(int rho) { const int n = rho >> 4, i = rho & 15; return 8 * (i >> 2) + 4 * n + (i & 3); }
DI int bmap(int mode, int R) {
    if (mode == 1) return (R & ~31) + perm32(R & 31);
    if (mode == 2) { const int wc = R >> 5, n = (R >> 4) & 1, low = R & 15; return 64 * (wc >> 1) + 32 * n + 16 * (wc & 1) + low; }
    return R;
}
struct Unit { const char* A; const char* B; int pm, pn, aux, bmode; };
DI bool static_tile(int i, int G, int c, int nM, int nN, int& pm, int& pn) {
    const int nwg = nM * nN; const long L = (long)i * G + c; if (L >= nwg) return false;
    int wgid = (int)L; { const int q = nwg / NXCD, r = nwg % NXCD, xcd = wgid % NXCD, off = wgid / NXCD; wgid = (xcd < r ? xcd * (q + 1) : r * (q + 1) + (xcd - r) * q) + off; }
    const int nig = WGM * nN, gid = wgid / nig, fm = gid * WGM, gsz = (nM - fm) < WGM ? (nM - fm) : WGM;
    pm = fm + ((wgid % nig) % gsz); pn = (wgid % nig) / gsz; return true;
}

template <class Epi, class Sched>
DI void gemm_phase(LAS unsigned char* lds, const int K, const Sched& S, const Epi& E) {
    const int tid = tid_fresh(), wid = __builtin_amdgcn_readfirstlane(tid >> 6), lane = tid & 63, wr = wid >> 2, wc = wid & 3, fr = lane & 15, fq = lane >> 4;
    const int nt = K / BK;
    int Rr[2], Cc[2];
#pragma unroll
    for (int i = 0; i < 2; ++i) stage_rc(tid * 16 + i * 8192, Rr[i], Cc[i]);
    unsigned voffA[2][2], voffB[2];
    const size_t kstep = (size_t)(BK * 2);
    const size_t hstep = (size_t)HALF * K * 2;
    const unsigned ldsw = (unsigned)wid * 1024u;
    const int aoff = lds_byte(wr * 64 + fr, fq * 8), boff = lds_byte(wc * 32 + fr, fq * 8);
#define PG8_SA(b, h) (((b) * 2 + (h)) * HTB)
#define PG8_SB(b, h) ((4 + (b) * 2 + (h)) * HTB)
#define PG8_STAGE(bufoff, gbase, voff) do { _Pragma("unroll") for (int _i = 0; _i < 2; ++_i) \
        __builtin_amdgcn_global_load_lds((const unsigned*)((const char*)(gbase) + (voff)[_i]), (LAS unsigned*)(lds + (bufoff) + ldsw + _i * 8192), 16, 0, 0); } while (0)
#define PG8_LDA(dst, b, h) do { _Pragma("unroll") for (int m = 0; m < 4; ++m) _Pragma("unroll") for (int k = 0; k < 2; ++k) dst[m][k] = *(const LAS bf16x8*)(lds + PG8_SA(b, h) + aoff + m * 2048 + k * 1024); } while (0)
#define PG8_LDB(dst, b, h) do { _Pragma("unroll") for (int n = 0; n < 2; ++n) _Pragma("unroll") for (int k = 0; k < 2; ++k) dst[n][k] = *(const LAS bf16x8*)(lds + PG8_SB(b, h) + boff + n * 2048 + k * 1024); } while (0)
#define PG8_MMA(ai, bj, At, Bt) do { __builtin_amdgcn_s_setprio(1); _Pragma("unroll") for (int m = 0; m < 4; ++m) _Pragma("unroll") for (int n = 0; n < 2; ++n) _Pragma("unroll") for (int k = 0; k < 2; ++k) \
        acc[ai][bj][m][n] = __builtin_amdgcn_mfma_f32_16x16x32_bf16(Bt[n][k], At[m][k], acc[ai][bj][m][n], 0, 0, 0); __builtin_amdgcn_s_setprio(0); } while (0)
#define PG8_WAIT_V(n) asm volatile("s_waitcnt vmcnt(" #n ")" ::: "memory")
#define PG8_WAIT_L(n) asm volatile("s_waitcnt lgkmcnt(" #n ")" ::: "memory")
#define PG8_BAR __builtin_amdgcn_s_barrier()
#define PG8_SCHED __builtin_amdgcn_sched_barrier(0)
#define PG8_SETB(u) do { _Pragma("unroll") for (int _i = 0; _i < 2; ++_i) voffB[_i] = (unsigned)(bmap((u).bmode, Rr[_i]) * K + Cc[_i]) * 2u; } while (0)
    Unit cur, nxt; int ui = 0;
    if (!S.next(0, cur)) return;
    f32x4 acc[2][2][4][2];
#pragma unroll
    for (int a = 0; a < 2; ++a)
#pragma unroll
        for (int b = 0; b < 2; ++b)
#pragma unroll
            for (int m = 0; m < 4; ++m)
#pragma unroll
                for (int n = 0; n < 2; ++n) acc[a][b][m][n] = (f32x4){0.f, 0.f, 0.f, 0.f};
    bf16x8 At[4][2], B0[2][2], B1[2][2];
    const char* cA = cur.A; const char* cB = cur.B;
    S.offsA(cur, 0, Rr, Cc, voffA); PG8_SETB(cur);
    PG8_STAGE(PG8_SB(0, 0), cB, voffB); PG8_STAGE(PG8_SB(0, 1), cB + hstep, voffB); PG8_STAGE(PG8_SA(0, 0), cA, voffA[0]); PG8_STAGE(PG8_SA(0, 1), cA, voffA[1]);
    if (wr == 1) PG8_BAR;
    PG8_WAIT_V(2); PG8_BAR;
    PG8_STAGE(PG8_SB(1, 0), cB + kstep, voffB); PG8_STAGE(PG8_SA(1, 0), cA + kstep, voffA[0]); PG8_STAGE(PG8_SB(1, 1), cB + hstep + kstep, voffB);
    PG8_WAIT_V(6); PG8_BAR;
    for (;;) {
        const bool has_next = S.next(ui + 1, nxt);
        const char* nA = has_next ? nxt.A : cA; const char* nB = has_next ? nxt.B : cB;
        for (int t = 0; t < nt; t += 2) {
            const bool last = (t == nt - 2);
            const char* a1 = cA + (size_t)(t + 1) * kstep;
            const char* a2 = last ? nA : cA + (size_t)(t + 2) * kstep; const char* b2 = last ? nB : cB + (size_t)(t + 2) * kstep;
            const char* a3 = a2 + kstep; const char* b3 = b2 + kstep;
            if (last && has_next) PG8_SETB(nxt);
            PG8_LDB(B0, 0, 0); PG8_LDB(B1, 0, 1); PG8_SCHED; PG8_LDA(At, 0, 0); PG8_STAGE(PG8_SA(1, 1), a1, voffA[1]);
            PG8_WAIT_V(8); PG8_WAIT_L(0); PG8_BAR; PG8_MMA(0, 0, At, B0); PG8_MMA(0, 1, At, B1); PG8_BAR; PG8_SCHED;
            if (last && has_next) S.offsA(nxt, ui + 1, Rr, Cc, voffA);
            PG8_LDA(At, 0, 1); PG8_STAGE(PG8_SB(0, 0), b2, voffB); PG8_STAGE(PG8_SB(0, 1), b2 + hstep, voffB); PG8_STAGE(PG8_SA(0, 0), a2, voffA[0]);
            PG8_WAIT_V(8); PG8_WAIT_L(0); PG8_BAR; PG8_MMA(1, 0, At, B0); PG8_MMA(1, 1, At, B1); PG8_BAR; PG8_SCHED;
            PG8_LDB(B0, 1, 0); PG8_LDB(B1, 1, 1); PG8_SCHED; PG8_LDA(At, 1, 0); PG8_STAGE(PG8_SA(0, 1), a2, voffA[1]);
            PG8_WAIT_V(8); PG8_WAIT_L(0); PG8_BAR; PG8_MMA(0, 0, At, B0); PG8_MMA(0, 1, At, B1); PG8_BAR; PG8_SCHED;
            PG8_LDA(At, 1, 1); PG8_STAGE(PG8_SB(1, 0), b3, voffB); PG8_STAGE(PG8_SB(1, 1), b3 + hstep, voffB); PG8_STAGE(PG8_SA(1, 0), a3, voffA[0]);
            PG8_WAIT_V(8); PG8_WAIT_L(0); PG8_BAR; PG8_MMA(1, 0, At, B0); PG8_MMA(1, 1, At, B1); PG8_BAR; PG8_SCHED;
        }
        if (wr == 0) PG8_BAR;
        const bool keep = E(acc, cur, wr, wc, fr, fq);
        if (!has_next) break;
        if (!keep) {
#pragma unroll
            for (int a = 0; a < 2; ++a)
#pragma unroll
                for (int b = 0; b < 2; ++b)
#pragma unroll
                    for (int m = 0; m < 4; ++m)
#pragma unroll
                        for (int n = 0; n < 2; ++n) acc[a][b][m][n] = (f32x4){0.f, 0.f, 0.f, 0.f};
        }
        cur = nxt; cA = nA; cB = nB; ++ui;
        if (wr == 1) PG8_BAR;
    }
    PG8_WAIT_V(0);
    PG8_BAR;
#undef PG8_SA
#undef PG8_SB
#undef PG8_STAGE
#undef PG8_LDA
#undef PG8_LDB
#undef PG8_MMA
#undef PG8_WAIT_V
#undef PG8_WAIT_L
#undef PG8_BAR
#undef PG8_SCHED
#undef PG8_SETB
}
DI void dense_offs(int K, const int (&R)[2], const int (&C)[2], unsigned (&voffA)[2][2]) {
#pragma unroll
    for (int h = 0; h < 2; ++h)
#pragma unroll
        for (int i = 0; i < 2; ++i) voffA[h][i] = (unsigned)((h * HALF + R[i]) * K + C[i]) * 2u;
}
}
using pg8::Unit;

#define EPI_LOOP_ROWS for (int ai = 0; ai < 2; ++ai) _Pragma("unroll") for (int m = 0; m < 4; ++m)

DI void cvt_tile(LAS float* tile, const float* src, int ld_src, bf16_t* dst, int ld_dst, float scale) {
    const int tid = tid_fresh();
    __syncthreads();
#pragma unroll
    for (int i = 0; i < 2; ++i) { const int kr = (tid >> 4) + 32 * i, nc = (tid & 15) * 4; const f32x4 v = *(const f32x4*)(src + (size_t)kr * ld_src + nc);
        tile[kr * 65 + nc + 0] = v[0]; tile[kr * 65 + nc + 1] = v[1]; tile[kr * 65 + nc + 2] = v[2]; tile[kr * 65 + nc + 3] = v[3]; }
    __syncthreads();
    const int n = tid >> 3, kc = (tid & 7) * 8; float v[8];
#pragma unroll
    for (int j = 0; j < 8; ++j) v[j] = tile[(kc + j) * 65 + n] * scale;
    u32x4 w; w.x = cvt_pk_bf16(v[0], v[1]); w.y = cvt_pk_bf16(v[2], v[3]); w.z = cvt_pk_bf16(v[4], v[5]); w.w = cvt_pk_bf16(v[6], v[7]);
    *(u32x4*)(dst + (size_t)n * ld_dst + kc) = w;
}

DI void phase0a(const KArgs& a, LAS unsigned char* lds) {
    const int tid = tid_fresh(), G = gridDim.x;
    LAS float* fl = (LAS float*)lds;
    constexpr int NU_MOD = 192, NU_ROPE = 1, NU_ROUTW = 1, T_WIN = 16 * 112, T_PROJ = 3 * 256, T_LB = 128;
    constexpr int U0 = NU_MOD, U1 = U0 + NU_ROPE, U2 = U1 + NU_ROUTW, U3 = U2 + T_WIN, U4 = U3 + T_PROJ, U5 = U4 + T_LB;
    for (int u = blockIdx.x; u < U5; u += G) {
        if (u < U0) {
            const int ks = u / 48, cg = u % 48;
            __syncthreads();
            for (int i = tid; i < 768; i += 512) { const int v = i >> 8, k = 256 * ks + (i & 255); const float x = (v == 0) ? a.in[I_C][k] : (v == 1) ? a.in[I_C][1024 + k] : a.in[I_CCTX][k]; fl[i] = silu_(x); }
            __syncthreads();
            const int rl = tid >> 5, cl = tid & 31; float acc[3][4];
#pragma unroll
            for (int v = 0; v < 3; ++v) for (int j = 0; j < 4; ++j) acc[v][j] = 0.f;
            for (int s = 0; s < 16; ++s) { const int kk = 16 * s + rl; const f32x4 w = *(const f32x4*)(a.in[I_WMOD] + (size_t)(256 * ks + kk) * 6144 + 128 * cg + 4 * cl);
#pragma unroll
                for (int v = 0; v < 3; ++v) { const float sv = fl[v * 256 + kk]; acc[v][0] += sv * w[0]; acc[v][1] += sv * w[1]; acc[v][2] += sv * w[2]; acc[v][3] += sv * w[3]; } }
            __syncthreads();
            LAS float* red = fl + 1024;
#pragma unroll
            for (int v = 0; v < 3; ++v) for (int j = 0; j < 4; ++j) red[(rl * 3 + v) * 128 + 4 * cl + j] = acc[v][j];
            __syncthreads();
            if (tid < 384) { const int v = tid >> 7, c = tid & 127; float s = 0.f; for (int r = 0; r < 16; ++r) s += red[(r * 3 + v) * 128 + c];
                ((float*)(a.ws + WS_MODP))[(ks * 3 + v) * 6144 + 128 * cg + c] = s; }
        } else if (u < U1) {
            f32x2* tab = (f32x2*)(a.ws + WS_ROPE);
            for (int i = tid; i < 320 * 32; i += 512) { const int p = i >> 5, fi = i & 31; const float pos = (float)(p < 256 ? p : p - 256);
                const float freq = ex2(-(float)fi * (13.287712379549449f / 32.0f)); float rev = pos * freq * 0.15915494309189535f; rev -= floorf(rev);
                tab[i] = (f32x2){__builtin_amdgcn_cosf(rev), __builtin_amdgcn_sinf(rev)}; }
        } else if (u < U2) {
            bf16_t* hi = (bf16_t*)(a.ws + WS_WRH); bf16_t* lo = hi + 64 * 1024;
            for (int i = tid; i < 64 * 1024; i += 512) { const int n = i >> 10, k = i & 1023; float w = 0.f;
                if (n < 4) w = a.in[I_WGRP][k * 4 + n]; else if (n < 36) w = a.in[I_WRT][k * 32 + (n - 4)];
                const unsigned short h16 = f2bf(w); hi[i] = h16; lo[i] = f2bf(w - bf2f(h16)); }
        } else if (u < U3) {
            const int t = u - U2, kt = t / 112, nt = t % 112;
            cvt_tile(fl, a.in[I_WIN] + (size_t)(64 * kt) * NCOL + 64 * nt, NCOL, (bf16_t*)(a.ws + WS_WIN) + (size_t)(64 * nt) * 1024 + 64 * kt, 1024, 1.f);
        } else if (u < U4) {
            const int t = u - U3, w = t >> 8, kt = (t & 255) >> 4, nt = t & 15;
            const float* src = a.in[w == 0 ? I_WRET : w == 1 ? I_WLRU : I_WOUT]; bf16_t* dst = (bf16_t*)(a.ws + (w == 0 ? WS_WRET : w == 1 ? WS_WLRU : WS_WOUT));
            cvt_tile(fl, src + (size_t)(64 * kt) * 1024 + 64 * nt, 1024, dst + (size_t)(64 * nt) * 1024 + 64 * kt, 1024, 1.f);
        } else {
            const int t = u - U4, mat = t >> 5, blk = (t >> 2) & 7, kt = (t >> 1) & 1, nt = t & 1, dir = mat >> 1;
            const float* src = a.in[(mat & 1) ? I_LWX : I_LWA] + (size_t)(dir * 8 + blk) * 128 * 128;
            bf16_t* dst = (bf16_t*)(a.ws + WS_WLB) + (size_t)(mat * 8 + blk) * 128 * 128;
            cvt_tile(fl, src + (size_t)(64 * kt) * 128 + 64 * nt, 128, dst + (size_t)(64 * nt) * 128 + 64 * kt, 128, -LOG2E);
        }
    }
}

DI void phase0b(const KArgs& a, LAS unsigned char* lds) {
    const int tid = tid_fresh(), G = gridDim.x, lane = tid & 63, wid = tid >> 6;
    LAS float* gm = (LAS float*)lds;
    LAS float* sh = gm + 3072;
    __syncthreads();
    for (int i = tid; i < 3072; i += 512) { const int v = i >> 10, k = i & 1023; gm[i] = a.in[I_NORM1][k] * (1.0f + mod_val(a, v, 1, k)); sh[i] = mod_val(a, v, 0, k); }
    __syncthreads();
    for (int u = blockIdx.x; u < 160; u += G) {
        const int rt = u / 20, ct = u % 20;
        const int col0 = ct < 4 ? 512 + 128 * ct : ct < 12 ? 1024 + 128 * (ct - 4) : 3072 + 128 * (ct - 12);
        const int rb = wid >> 2, cb = wid & 3, r = lane & 31, h = lane >> 5;
        const float* xr = a.in[I_CTX] + (size_t)(64 * rt + 32 * rb + r) * 1024;
        float ss = 0.f;
        for (int s = 0; s < 64; ++s) { const f32x4 p = *(const f32x4*)(xr + 16 * s + 8 * h), q = *(const f32x4*)(xr + 16 * s + 8 * h + 4);
            ss += (p[0] * p[0] + p[1] * p[1]) + (p[2] * p[2] + p[3] * p[3]) + (q[0] * q[0] + q[1] * q[1]) + (q[2] * q[2] + q[3] * q[3]); }
        ss += __shfl_xor(ss, 32);
        const float rstd = rsqrtf(ss * (1.0f / 1024.0f) + EPSV);
        const bf16_t* wrow = (const bf16_t*)(a.ws + WS_WIN) + (size_t)(col0 + 32 * cb + r) * 1024;
        f32x16 acc = zero16();
        for (int s = 0; s < 64; ++s) { const int k0 = 16 * s + 8 * h;
            const f32x4 p = *(const f32x4*)(xr + k0), q = *(const f32x4*)(xr + k0 + 4);
            const f32x4 g0 = *(const LAS f32x4*)(gm + 2048 + k0), g1 = *(const LAS f32x4*)(gm + 2048 + k0 + 4), s0 = *(const LAS f32x4*)(sh + 2048 + k0), s1 = *(const LAS f32x4*)(sh + 2048 + k0 + 4);
            u32x4 w; w.x = cvt_pk_bf16(p[0] * rstd * g0[0] + s0[0], p[1] * rstd * g0[1] + s0[1]); w.y = cvt_pk_bf16(p[2] * rstd * g0[2] + s0[2], p[3] * rstd * g0[3] + s0[3]);
            w.z = cvt_pk_bf16(q[0] * rstd * g1[0] + s1[0], q[1] * rstd * g1[1] + s1[1]); w.w = cvt_pk_bf16(q[2] * rstd * g1[2] + s1[2], q[3] * rstd * g1[3] + s1[3]);
            const bf16x8 af = __builtin_bit_cast(bf16x8, w); const bf16x8 bfr = *(const bf16x8*)(wrow + k0);
            acc = MFMA32(af, bfr, acc); }
        const int ccol = 128 * (ct < 4 ? ct : ct < 12 ? ct - 4 : ct - 12) + 32 * cb + r;
        bf16_t* dst = (bf16_t*)(a.ws + (ct < 4 ? WS_CTXK : ct < 12 ? WS_CTXV : WS_CTXX)); const int ldd = ct < 4 ? 512 : 1024; const float sc = ct < 4 ? 0.08838834764831845f : 1.0f;
#pragma unroll
        for (int i = 0; i < 16; ++i) dst[(size_t)(64 * rt + 32 * rb + crow(i, h)) * ldd + ccol] = f2bf(acc[i] * sc);
    }
    for (int row = blockIdx.x * 8 + wid; row < NT; row += G * 8) {
        const int v = row / SEQ; const float* xr = a.in[I_X] + (size_t)row * 1024; f32x4 x[4]; float ss = 0.f;
#pragma unroll
        for (int j = 0; j < 4; ++j) { x[j] = *(const f32x4*)(xr + 4 * lane + 256 * j); ss += (x[j][0] * x[j][0] + x[j][1] * x[j][1]) + (x[j][2] * x[j][2] + x[j][3] * x[j][3]); }
#pragma unroll
        for (int o = 32; o >= 1; o >>= 1) ss += __shfl_xor(ss, o);
        const float rstd = rsqrtf(ss * (1.0f / 1024.0f) + EPSV);
        bf16_t* dst = (bf16_t*)(a.ws + WS_HX) + (size_t)row * 1024;
#pragma unroll
        for (int j = 0; j < 4; ++j) { const int k0 = 4 * lane + 256 * j; const f32x4 g = *(const LAS f32x4*)(gm + v * 1024 + k0), s = *(const LAS f32x4*)(sh + v * 1024 + k0);
            u32x2 w; w.x = cvt_pk_bf16(x[j][0] * rstd * g[0] + s[0], x[j][1] * rstd * g[1] + s[1]); w.y = cvt_pk_bf16(x[j][2] * rstd * g[2] + s[2], x[j][3] * rstd * g[3] + s[3]);
            *(u32x2*)(dst + k0) = w; }
    }
}

struct OrderIn {
    const char* A; const char* B; int G, c;
    DI bool next(int i, Unit& u) const { int pm, pn; if (!pg8::static_tile(i, G, c, NT / 256, NCOL / 256, pm, pn)) return false;
        u.pm = pm; u.pn = pn; u.A = A + (size_t)pm * 256 * 1024 * 2; u.B = B + (size_t)pn * 256 * 1024 * 2; u.aux = 0; u.bmode = pn < 4 ? 2 : 1; return true; }
    DI void offsA(const Unit&, int, const int (&R)[2], const int (&C)[2], unsigned (&v)[2][2]) const { pg8::dense_offs(1024, R, C, v); }
};
struct EpiIn {
    unsigned char* ws; bf16_t* glog; const float* bgate; const f32x2* rope;
    DI bool operator()(f32x4 (&acc)[2][2][4][2], const Unit& u, int wr, int wc, int fr, int fq) const {
        const int pn = u.pn;
        if (pn < 4) {
            bf16_t* dst = (bf16_t*)(ws + (pn < 2 ? WS_ZQ : WS_ZK)); const float sc = pn < 2 ? 1.0f : 0.08838834764831845f;
            const int half = wc >> 1, f0 = 16 * (wc & 1) + 4 * fq;
#pragma unroll
            EPI_LOOP_ROWS { const int row = u.pm * 256 + ai * 128 + wr * 64 + m * 16 + fr; const int t = row & (SEQ - 1); const int pos = half ? 256 + (t & 63) : (t >> 6);
                const f32x2* tb = rope + pos * 32 + f0; f32x2 cs[4];
#pragma unroll
                for (int j = 0; j < 4; ++j) cs[j] = tb[j];
#pragma unroll
                for (int bj = 0; bj < 2; ++bj) { const f32x4 x1 = acc[ai][bj][m][0], x2 = acc[ai][bj][m][1]; float o1[4], o2[4];
#pragma unroll
                    for (int j = 0; j < 4; ++j) { o1[j] = (x1[j] * cs[j][0] - x2[j] * cs[j][1]) * sc; o2[j] = (x1[j] * cs[j][1] + x2[j] * cs[j][0]) * sc; }
                    bf16_t* p = dst + (size_t)row * 512 + (pn & 1) * 256 + bj * 128 + 64 * half + f0;
                    u32x2 w1, w2; w1.x = cvt_pk_bf16(o1[0], o1[1]); w1.y = cvt_pk_bf16(o1[2], o1[3]); w2.x = cvt_pk_bf16(o2[0], o2[1]); w2.y = cvt_pk_bf16(o2[2], o2[3]);
                    *(u32x2*)p = w1; *(u32x2*)(p + 32) = w2; } }
            return false;
        }
        int act, ldd, cb; bf16_t* dst;
        if (pn < 8) { dst = (bf16_t*)(ws + WS_ZV); act = 0; ldd = 1024; cb = (pn - 4) * 256; }
        else if (pn < 12) { dst = (bf16_t*)(ws + WS_ZG); act = 1; ldd = 1024; cb = (pn - 8) * 256; }
        else if (pn < 16) { dst = (bf16_t*)(ws + WS_ZXL); act = 0; ldd = 1024; cb = (pn - 12) * 256; }
        else if (pn < 20) { dst = (bf16_t*)(ws + WS_ZGL); act = 2; ldd = 1024; cb = (pn - 16) * 256; }
        else { dst = glog; act = 3; ldd = 2048; cb = (pn - 20) * 256; }
#pragma unroll
        for (int bj = 0; bj < 2; ++bj) { const int col = cb + bj * 128 + wc * 32 + 8 * fq; f32x4 b0 = (f32x4){0.f, 0.f, 0.f, 0.f}, b1 = b0;
            if (act == 3) { b0 = *(const f32x4*)(bgate + col); b1 = *(const f32x4*)(bgate + col + 4); }
#pragma unroll
            EPI_LOOP_ROWS { const int row = u.pm * 256 + ai * 128 + wr * 64 + m * 16 + fr; f32x4 v0 = acc[ai][bj][m][0] + b0, v1 = acc[ai][bj][m][1] + b1;
                if (act == 1) {
#pragma unroll
                    for (int j = 0; j < 4; ++j) { v0[j] = silu_(v0[j]); v1[j] = silu_(v1[j]); } }
                if (act == 2) {
#pragma unroll
                    for (int j = 0; j < 4; ++j) { v0[j] = gelu_tanh(v0[j]); v1[j] = gelu_tanh(v1[j]); } }
                u32x4 w; w.x = cvt_pk_bf16(v0[0], v0[1]); w.y = cvt_pk_bf16(v0[2], v0[3]); w.z = cvt_pk_bf16(v1[0], v1[1]); w.w = cvt_pk_bf16(v1[2], v1[3]);
                *(u32x4*)(dst + (size_t)row * ldd + col) = w; } }
        return false;
    }
};

constexpr int R1_RSV = 576, R1_RSK = 320;
DI void r1_unit(LAS unsigned char* lds, const bf16_t* kp, int kld, const bf16_t* vp, int vld, int nrows, float lg2, int dir, float* outp) {
    const int tid = tid_fresh(), lane = tid & 63, wid = tid >> 6, h = lane >> 5;
    LAS unsigned char* Vt = lds; LAS unsigned char* Kw = lds + 64 * R1_RSV;
    const int mh = wid >> 2, nb = wid & 3;
    f32x16 acc[4];
#pragma unroll
    for (int mi = 0; mi < 4; ++mi) acc[mi] = zero16();
    const unsigned lb = (unsigned)((8 * h + ((lane & 15) >> 2))) , blk = (lane >> 4) & 1, p = lane & 3;
    const unsigned lbV = (unsigned)(size_t)Vt + lb * R1_RSV + 32 * blk + 8 * p + (128 * mh) * 2;
    const unsigned lbK = (unsigned)(size_t)Kw + lb * R1_RSK + 32 * blk + 8 * p + (32 * nb) * 2;
    for (int ch = 0; ch < nrows / 64; ++ch) {
        __syncthreads();
#pragma unroll
        for (int i = 0; i < 4; ++i) { const int pid = tid + 512 * i, row = pid >> 5, c16 = pid & 31;
            const u32x4 v = *(const u32x4*)(vp + (size_t)(64 * ch + row) * vld + c16 * 8); *(LAS u32x4*)(Vt + row * R1_RSV + c16 * 16) = v; }
#pragma unroll
        for (int i = 0; i < 2; ++i) { const int pid = tid + 512 * i, row = pid >> 4, c16 = pid & 15; const int jj = 64 * ch + row;
            const u32x4 kv = *(const u32x4*)(kp + (size_t)jj * kld + c16 * 8);
            const float w = ex2(lg2 * (float)(dir ? jj : nrows - 1 - jj));
            u32x4 o;
#pragma unroll
            for (int e = 0; e < 4; ++e) { const float lo = __uint_as_float(kv[e] << 16), hi = __uint_as_float(kv[e] & 0xffff0000u); o[e] = cvt_pk_bf16(lo * w, hi * w); }
            *(LAS u32x4*)(Kw + row * R1_RSK + c16 * 16) = o; }
        __syncthreads();
#pragma unroll
        for (int ks = 0; ks < 4; ++ks) {
            bf16x8 av[4]; tr_frag4<0, 64, 4 * R1_RSV>(lbV + ks * 16 * R1_RSV, av[0], av[1], av[2], av[3]);
            const bf16x8 bw = tr_frag<0, 4 * R1_RSK>(lbK + ks * 16 * R1_RSK);
#pragma unroll
            for (int mi = 0; mi < 4; ++mi) acc[mi] = MFMA32(av[mi], bw, acc[mi]);
        }
    }
    const int c = lane & 31;
    float* ob = outp + (size_t)(128 * mh + 4 * h) * 128 + 32 * nb + c;
#pragma unroll
    for (int mi = 0; mi < 4; ++mi)
#pragma unroll
        for (int i = 0; i < 16; ++i) ob[(32 * mi + (i & 3) + 8 * (i >> 2)) * 128] = acc[mi][i];
}

template <bool FULL, int DIR>
DI void lru_scan(const KArgs& a, f32x16 (&acc)[2][2], LAS float* hfb, int b, int tile, int t0, int nq, int gc, bool is_ctx) {
    const int lane = tid_fresh() & 63, h = lane >> 5, c = lane & 31;
    float sA[8], sU[8];
#pragma unroll
    for (int s = 0; s < 8; ++s) { const int mb = s >> 2, g = s & 3; float A = 1.f, U = 0.f;
#pragma unroll
        for (int e = 0; e < 4; ++e) { const int i = 4 * g + (DIR == 0 ? e : 3 - e); U = acc[0][mb][i] * U + acc[1][mb][i]; A *= acc[0][mb][i]; }
        sA[s] = A; sU[s] = U; }
    float pA[8], pU[8];
#pragma unroll
    for (int s = 0; s < 8; ++s) { pA[s] = __shfl_xor(sA[s], 32); pU[s] = __shfl_xor(sU[s], 32); }
    const int slot = is_ctx ? (DIR == 0 ? tile : 3 - tile) : (DIR == 0 ? 4 + tile : 4 + (NLT - 1 - tile));
    const size_t chain = ((size_t)(b * 2 + DIR) * 1024 + gc) * NSLOT + slot;
    const bool first = (h == (DIR == 0 ? 0 : 1));
    if (!FULL) {
        float A = 1.f, U = 0.f;
#pragma unroll
        for (int q = 0; q < 8; ++q) { const int s = DIR == 0 ? q : 7 - q;
            const float A1 = first ? sA[s] : pA[s], U1 = first ? sU[s] : pU[s], A2 = first ? pA[s] : sA[s], U2 = first ? pU[s] : sU[s];
            U = A1 * U + U1; A *= A1; U = A2 * U + U2; A *= A2; }
        if (h == 0) ((f32x2*)(a.ws + WS_LAGG))[chain] = (f32x2){A, U};
    } else {
        float H = ((const float*)(a.ws + WS_LHIN))[chain];
        float st[8];
#pragma unroll
        for (int q = 0; q < 8; ++q) { const int s = DIR == 0 ? q : 7 - q;
            const float A1 = first ? sA[s] : pA[s], U1 = first ? sU[s] : pU[s], A2 = first ? pA[s] : sA[s], U2 = first ? pU[s] : sU[s];
            const float Hm = A1 * H + U1; st[s] = first ? H : Hm; H = A2 * Hm + U2; }
#pragma unroll
        for (int s = 0; s < 8; ++s) { const int mb = s >> 2, g = s & 3; float hv = st[s];
#pragma unroll
            for (int e = 0; e < 4; ++e) { const int i = 4 * g + (DIR == 0 ? e : 3 - e); hv = acc[0][mb][i] * hv + acc[1][mb][i]; acc[1][mb][i] = hv; } }
        if (DIR == 0) {
#pragma unroll
            for (int mb = 0; mb < 2; ++mb)
#pragma unroll
                for (int i = 0; i < 16; ++i) hfb[(32 * mb + crow(i, h)) * 132 + 32 * nq + c] = acc[1][mb][i];
        }
    }
}

constexpr int LX_RS = 272;
template <bool FULL>
DI void lru_unit(const KArgs& a, LAS unsigned char* lds, int b, int tile, int n, bool is_ctx) {
    const int tid = tid_fresh(), lane = tid & 63, wid = __builtin_amdgcn_readfirstlane(tid >> 6), h = lane >> 5, c = lane & 31;
    LAS unsigned char* xcb = lds;
    LAS float* xc32 = (LAS float*)(lds + 64 * LX_RS);
    LAS float* hfb = xc32 + 64 * 132;
    const int Ls = is_ctx ? CTXL : SEQ, t0 = tile * LT;
    const bf16_t* xl = is_ctx ? (const bf16_t*)(a.ws + WS_CTXX) + (size_t)(b * CTXL) * 1024 + 128 * n : (const bf16_t*)(a.ws + WS_ZXL) + (size_t)(b * SEQ) * 1024 + 128 * n;
    __syncthreads();
    {
        const int row = tid >> 3, c0 = (tid & 7) * 16; float o[16];
#pragma unroll
        for (int j = 0; j < 16; ++j) o[j] = a.in[I_CONVB][128 * n + c0 + j];
#pragma unroll
        for (int k = 0; k < 4; ++k) { const int t = t0 + row + k - 1; if (t >= 0 && t < Ls) {
                const u32x4 p0 = *(const u32x4*)(xl + (size_t)t * 1024 + c0), p1 = *(const u32x4*)(xl + (size_t)t * 1024 + c0 + 8);
                const float* cw = a.in[I_CONVW] + k * 1024 + 128 * n + c0;
#pragma unroll
                for (int e = 0; e < 4; ++e) { o[2 * e] += cw[2 * e] * __uint_as_float(p0[e] << 16); o[2 * e + 1] += cw[2 * e + 1] * __uint_as_float(p0[e] & 0xffff0000u);
                    o[8 + 2 * e] += cw[8 + 2 * e] * __uint_as_float(p1[e] << 16); o[8 + 2 * e + 1] += cw[8 + 2 * e + 1] * __uint_as_float(p1[e] & 0xffff0000u); } } }
        u32x4 w0, w1;
#pragma unroll
        for (int e = 0; e < 4; ++e) { w0[e] = cvt_pk_bf16(o[2 * e], o[2 * e + 1]); w1[e] = cvt_pk_bf16(o[8 + 2 * e], o[8 + 2 * e + 1]); }
        *(LAS u32x4*)(xcb + row * LX_RS + c0 * 2) = w0; *(LAS u32x4*)(xcb + row * LX_RS + c0 * 2 + 16) = w1;
#pragma unroll
        for (int j = 0; j < 16; j += 4) *(LAS f32x4*)(xc32 + row * 132 + c0 + j) = (f32x4){o[j], o[j + 1], o[j + 2], o[j + 3]};
    }
    __syncthreads();
    const int dir = wid >> 2, nq = wid & 3, gc = 128 * n + 32 * nq + c;
    f32x16 acc[2][2];
#pragma unroll
    for (int q = 0; q < 2; ++q) for (int mb = 0; mb < 2; ++mb) acc[q][mb] = zero16();
    const bf16_t* wa = (const bf16_t*)(a.ws + WS_WLB) + (size_t)((2 * dir) * 8 + n) * 128 * 128 + (size_t)(32 * nq + c) * 128 + 8 * h;
    const bf16_t* wx = wa + (size_t)8 * 128 * 128;
#pragma unroll
    for (int ks = 0; ks < 8; ++ks) {
        const bf16x8 ba = *(const bf16x8*)(wa + 16 * ks), bx = *(const bf16x8*)(wx + 16 * ks);
        const bf16x8 a0 = *(const LAS bf16x8*)(xcb + c * LX_RS + (16 * ks + 8 * h) * 2), a1 = *(const LAS bf16x8*)(xcb + (32 + c) * LX_RS + (16 * ks + 8 * h) * 2);
        acc[0][0] = MFMA32(a0, ba, acc[0][0]); acc[0][1] = MFMA32(a1, ba, acc[0][1]); acc[1][0] = MFMA32(a0, bx, acc[1][0]); acc[1][1] = MFMA32(a1, bx, acc[1][1]);
    }
    const float ba2 = -LOG2E * a.in[I_LBA][dir * 1024 + gc], bx2 = -LOG2E * a.in[I_LBX][dir * 1024 + gc];
    const float cl = -8.0f * softplus_(-a.in[I_LLAM][dir * 1024 + gc]) * LOG2E;
#pragma unroll
    for (int mb = 0; mb < 2; ++mb)
#pragma unroll
        for (int i = 0; i < 16; ++i) { const int row = 32 * mb + crow(i, h);
            const float r = rcpf_(1.0f + ex2(acc[0][mb][i] + ba2)), ig = rcpf_(1.0f + ex2(acc[1][mb][i] + bx2));
            const float av = ex2(cl * r); const float s = sqrtf(fmaxf(1.0f - av * av, 0.f));
            acc[0][mb][i] = av; acc[1][mb][i] = s * ig * xc32[row * 132 + 32 * nq + c]; }
    if (dir == 0) lru_scan<FULL, 0>(a, acc, hfb, b, tile, t0, nq, gc, is_ctx);
    else lru_scan<FULL, 1>(a, acc, hfb, b, tile, t0, nq, gc, is_ctx);
    if (FULL) {
        __syncthreads();
        if (dir == 1) {
            bf16_t* gl = (bf16_t*)(a.ws + WS_ZGL) + (size_t)(b * SEQ + t0) * 1024 + gc;
#pragma unroll
            for (int mb = 0; mb < 2; ++mb)
#pragma unroll
                for (int i = 0; i < 16; ++i) { const int row = 32 * mb + crow(i, h); const float tot = acc[1][mb][i] + hfb[row * 132 + 32 * nq + c];
                    gl[(size_t)row * 1024] = f2bf(tot * bf2f(gl[(size_t)row * 1024])); }
        }
    }
}

DI void ret_decays(const KArgs& a, int h, float& lgf2, float& lgb2) {
    lgf2 = -softplus_(-a.in[I_RDECAY][h]) * LOG2E; lgb2 = -softplus_(-a.in[I_RDECAY][4 + h]) * LOG2E;
}

DI void phase2a(const KArgs& a, LAS unsigned char* lds) {
    const int G = gridDim.x;
    constexpr int NU_R1 = NB_ * NH * NSC * 2, NU_CK = NB_ * NH * 2, NU_LX = NB_ * NLT * 8, NU_LC = NB_ * 4 * 8;
    for (int u = blockIdx.x; u < NU_R1 + NU_CK + NU_LX + NU_LC; u += G) {
        if (SUBSEL(1) && u < NU_R1) {
            const int dir = u & 1, sc = (u >> 1) & 31, h = (u >> 6) & 3, b = u >> 8; float lgf2, lgb2; ret_decays(a, h, lgf2, lgb2);
            float* o = (float*)(a.ws + WS_HX) + (size_t)(((b * 4 + h) * 32 + sc) * 2 + dir) * 32768;
            r1_unit(lds, (const bf16_t*)(a.ws + WS_ZK) + (size_t)(b * SEQ + sc * SCH) * 512 + h * 128, 512, (const bf16_t*)(a.ws + WS_ZV) + (size_t)(b * SEQ + sc * SCH) * 1024 + h * 256, 1024, SCH, dir ? lgb2 : lgf2, dir, o);
        } else if (SUBSEL(1) && u < NU_R1 + NU_CK) {
            const int q = u - NU_R1, dir = q & 1, h = (q >> 1) & 3, b = q >> 3; float lgf2, lgb2; ret_decays(a, h, lgf2, lgb2);
            float* o = (float*)(a.ws + WS_CTXS) + (size_t)((b * 4 + h) * 2 + dir) * 32768;
            r1_unit(lds, (const bf16_t*)(a.ws + WS_CTXK) + (size_t)(b * CTXL) * 512 + h * 128, 512, (const bf16_t*)(a.ws + WS_CTXV) + (size_t)(b * CTXL) * 1024 + h * 256, 1024, CTXL, dir ? lgb2 : lgf2, dir, o);
        } else if (SUBSEL(2) && u < NU_R1 + NU_CK + NU_LX) {
            const int q = u - NU_R1 - NU_CK, b = q / (NLT * 8), tile = (q / 8) % NLT, n = q & 7;
            lru_unit<false>(a, lds, b, tile, n, false);
        } else if (SUBSEL(2)) {
            const int q = u - NU_R1 - NU_CK - NU_LX, b = q >> 5, tile = (q >> 3) & 3, n = q & 7;
            lru_unit<false>(a, lds, b, tile, n, true);
        }
    }
}

DI void phase2b(const KArgs& a) {
    const int tid = tid_fresh(), G = gridDim.x, lane = tid & 63, wid = tid >> 6;
    for (int e = blockIdx.x * 512 + tid; e < NB_ * NH * 2 * 8192; e += G * 512) {
        const int e4 = e & 8191, dir = (e >> 13) & 1, h = (e >> 14) & 3, b = e >> 16;
        float lgf2, lgb2; ret_decays(a, h, lgf2, lgb2); const float gC = ex2((dir ? lgb2 : lgf2) * (float)SCH);
        f32x4 S = *(const f32x4*)((const float*)(a.ws + WS_CTXS) + (size_t)((b * 4 + h) * 2 + dir) * 32768 + 4 * e4);
        const float* kv = (const float*)(a.ws + WS_HX) + (size_t)((b * 4 + h) * 32 * 2 + dir) * 32768 + 4 * e4;
        bf16_t* so = (bf16_t*)(a.ws + WS_SBF) + (size_t)((b * 4 + h) * 32 * 2 + dir) * 32768 + 4 * e4;
        for (int s0 = 0; s0 < NSC; s0 += 8) {
            f32x4 kvv[8];
#pragma unroll
            for (int j = 0; j < 8; ++j) { const int sc = dir ? NSC - 1 - (s0 + j) : s0 + j; kvv[j] = *(const f32x4*)(kv + (size_t)sc * 65536); }
#pragma unroll
            for (int j = 0; j < 8; ++j) { const int sc = dir ? NSC - 1 - (s0 + j) : s0 + j;
                u32x2 w; w.x = cvt_pk_bf16(S[0], S[1]); w.y = cvt_pk_bf16(S[2], S[3]); *(u32x2*)(so + (size_t)sc * 65536) = w;
                S = S * gC + kvv[j]; }
        }
    }
    for (int ch = blockIdx.x * 8 + wid; ch < NB_ * 2 * 1024; ch += G * 8) {
        const f32x2* ag = (const f32x2*)(a.ws + WS_LAGG) + (size_t)ch * NSLOT; float* hin = (float*)(a.ws + WS_LHIN) + (size_t)ch * NSLOT;
        float carry = 0.f;
        for (int rd = 0; rd < 5; ++rd) { const int slot = 64 * rd + lane;
            f32x2 v = (f32x2){1.f, 0.f}; if (slot < 4 + NLT) v = ag[slot];
            float A = v[0], U = v[1];
#pragma unroll
            for (int o = 1; o < 64; o <<= 1) { const float Ap = __shfl_up(A, o), Up = __shfl_up(U, o); if (lane >= o) { U = A * Up + U; A = A * Ap; } }
            const float incl = A * carry + U;
            float excl = __shfl_up(incl, 1); if (lane == 0) excl = carry;
            if (slot < 4 + NLT) hin[slot] = excl;
            carry = __shfl(incl, 63);
        }
    }
}

constexpr int R3_RSQ = 272, R3_RSK = 272, R3_RSV = 576, R3_RSP = 144;
DI void r3_unit(const KArgs& a, LAS unsigned char* lds, int b, int hh, int qb) {
    const int tid = tid_fresh(), lane = tid & 63, wid = tid >> 6, h = lane >> 5, c = lane & 31;
    LAS unsigned char* Qs = lds; LAS unsigned char* Ks = Qs + 128 * R3_RSQ; LAS unsigned char* Vs = Ks + 64 * R3_RSK; LAS unsigned char* Ps = Vs + 64 * R3_RSV;
    LAS float* red = (LAS float*)(Ps + 128 * R3_RSP);
    const int sc = qb >> 2, blk = qb & 3;
    float lgf2, lgb2; ret_decays(a, hh, lgf2, lgb2);
    const size_t tok0 = (size_t)b * SEQ + 128 * qb, tokS = (size_t)b * SEQ + SCH * sc;
    __syncthreads();
#pragma unroll
    for (int i = 0; i < 4; ++i) { const int pid = tid + 512 * i, row = pid >> 4, c16 = pid & 15;
        *(LAS u32x4*)(Qs + row * R3_RSQ + c16 * 16) = *(const u32x4*)((const bf16_t*)(a.ws + WS_ZQ) + (tok0 + row) * 512 + hh * 128 + c16 * 8); }
    __syncthreads();
    const int rb = wid >> 1, dvh = wid & 1;
    f32x16 O[4];
    {
#pragma unroll
        for (int nb = 0; nb < 4; ++nb) O[nb] = zero16();
#pragma unroll 1
        for (int d = 0; d < 2; ++d) {
            const bf16_t* Sg = (const bf16_t*)(a.ws + WS_SBF) + (size_t)(((b * 4 + hh) * 32 + sc) * 2 + d) * 32768 + (size_t)(128 * dvh + c) * 128 + 8 * h;
            f32x16 tmp[4];
#pragma unroll
            for (int nb = 0; nb < 4; ++nb) tmp[nb] = zero16();
#pragma unroll 2
            for (int ks = 0; ks < 8; ++ks) { const bf16x8 af = *(const LAS bf16x8*)(Qs + (32 * rb + c) * R3_RSQ + (16 * ks + 8 * h) * 2);
#pragma unroll
                for (int nb = 0; nb < 4; ++nb) { const bf16x8 bfr = *(const bf16x8*)(Sg + (size_t)(32 * nb) * 128 + 16 * ks); tmp[nb] = MFMA32(af, bfr, tmp[nb]); } }
            const float lg = d ? lgb2 : lgf2; const float e0 = d ? (float)(SCH - 128 * blk - 32 * rb - 4 * h) : (float)(128 * blk + 32 * rb + 4 * h + 1), sg = d ? -1.f : 1.f;
#pragma unroll
            for (int i = 0; i < 16; ++i) { const float dec = ex2(lg * (e0 + sg * (float)((i & 3) + 8 * (i >> 2))));
#pragma unroll
                for (int nb = 0; nb < 4; ++nb) O[nb][i] += dec * tmp[nb][i]; }
        }
    }
    const unsigned lb = (unsigned)(8 * h + ((lane & 15) >> 2)), tb = (lane >> 4) & 1, tp = lane & 3;
    const unsigned lbV = (unsigned)(size_t)Vs + lb * R3_RSV + 32 * tb + 8 * tp + (128 * dvh) * 2;
    const int jbk = wid & 1, ib = wid >> 1;
    for (int jb = 0; jb < 8; ++jb) {
        u32x4 kreg[2], vreg[4];
#pragma unroll
        for (int i = 0; i < 2; ++i) { const int pid = tid + 512 * i, row = pid >> 4, c16 = pid & 15; kreg[i] = *(const u32x4*)((const bf16_t*)(a.ws + WS_ZK) + (tokS + 64 * jb + row) * 512 + hh * 128 + c16 * 8); }
#pragma unroll
        for (int i = 0; i < 4; ++i) { const int pid = tid + 512 * i, row = pid >> 5, c16 = pid & 31; vreg[i] = *(const u32x4*)((const bf16_t*)(a.ws + WS_ZV) + (tokS + 64 * jb + row) * 1024 + hh * 256 + c16 * 8); }
        __syncthreads();
#pragma unroll
        for (int i = 0; i < 2; ++i) { const int pid = tid + 512 * i, row = pid >> 4, c16 = pid & 15; *(LAS u32x4*)(Ks + row * R3_RSK + c16 * 16) = kreg[i]; }
#pragma unroll
        for (int i = 0; i < 4; ++i) { const int pid = tid + 512 * i, row = pid >> 5, c16 = pid & 31; *(LAS u32x4*)(Vs + row * R3_RSV + c16 * 16) = vreg[i]; }
        __syncthreads();
        f32x16 st = zero16();
#pragma unroll
        for (int ks = 0; ks < 8; ++ks) { const bf16x8 kf = *(const LAS bf16x8*)(Ks + (32 * jbk + c) * R3_RSK + (16 * ks + 8 * h) * 2), qf = *(const LAS bf16x8*)(Qs + (32 * ib + c) * R3_RSQ + (16 * ks + 8 * h) * 2);
            st = MFMA32(kf, qf, st); }
        {
            const int ti = 128 * blk + 32 * ib + c;
#pragma unroll
            for (int g = 0; g < 4; ++g) { float pv[4];
#pragma unroll
                for (int e = 0; e < 4; ++e) { const int tj = 64 * jb + 32 * jbk + 8 * g + 4 * h + e; const int d = ti - tj; const float w = d >= 0 ? ex2(lgf2 * (float)d) : ex2(lgb2 * (float)(-d)); pv[e] = st[4 * g + e] * w; }
                u32x2 w2; w2.x = cvt_pk_bf16(pv[0], pv[1]); w2.y = cvt_pk_bf16(pv[2], pv[3]);
                *(LAS u32x2*)(Ps + (32 * ib + c) * R3_RSP + (32 * jbk + 8 * g + 4 * h) * 2) = w2; }
        }
        __syncthreads();
#pragma unroll
        for (int ks = 0; ks < 4; ++ks) { const bf16x8 pf = *(const LAS bf16x8*)(Ps + (32 * rb + c) * R3_RSP + (16 * ks + 8 * h) * 2);
            bf16x8 vf[4]; tr_frag4<0, 64, 4 * R3_RSV>(lbV + ks * 16 * R3_RSV, vf[0], vf[1], vf[2], vf[3]);
#pragma unroll
            for (int nb = 0; nb < 4; ++nb) O[nb] = MFMA32(pf, vf[nb], O[nb]); }
    }
    float s1[16], s2[16];
#pragma unroll
    for (int i = 0; i < 16; ++i) { float x = 0.f, y = 0.f;
#pragma unroll
        for (int nb = 0; nb < 4; ++nb) { x += O[nb][i]; y += O[nb][i] * O[nb][i]; }
#pragma unroll
        for (int o = 16; o >= 1; o >>= 1) { x += __shfl_xor(x, o); y += __shfl_xor(y, o); }
        s1[i] = x; s2[i] = y; }
    if (c == 0) {
#pragma unroll
        for (int i = 0; i < 16; ++i) { const int row = 32 * rb + crow(i, h); red[(row * 2 + dvh) * 2 + 0] = s1[i]; red[(row * 2 + dvh) * 2 + 1] = s2[i]; } }
    __syncthreads();
    bf16_t* gp = (bf16_t*)(a.ws + WS_ZG) + tok0 * 1024 + hh * 256 + 128 * dvh + c;
#pragma unroll
    for (int i = 0; i < 16; ++i) { const int row = 32 * rb + crow(i, h);
        const float sx = red[(row * 2 + 0) * 2 + 0] + red[(row * 2 + 1) * 2 + 0], sy = red[(row * 2 + 0) * 2 + 1] + red[(row * 2 + 1) * 2 + 1];
        const float mu = sx * (1.0f / 256.0f), var = fmaxf(sy * (1.0f / 256.0f) - mu * mu, 0.f), rstd = rsqrtf(var + EPSV);
#pragma unroll
        for (int nb = 0; nb < 4; ++nb) { bf16_t* p = gp + (size_t)row * 1024 + 32 * nb; const float gain = a.in[I_RNORM][hh * 256 + 128 * dvh + 32 * nb + c];
            *p = f2bf((O[nb][i] - mu) * rstd * gain * bf2f(*p)); } }
}

DI void phase2c(const KArgs& a, LAS unsigned char* lds) {
    const int G = gridDim.x;
    constexpr int NU_R3 = NB_ * NH * (SEQ / 128), NU_L3 = NB_ * NLT * 8;
    for (int u = blockIdx.x; u < NU_R3 + NU_L3; u += G) {
        if (SUBSEL(1) && u < NU_R3) { const int b = u >> 9, hh = (u >> 7) & 3, qb = u & 127; r3_unit(a, lds, b, hh, qb); }
        else if (SUBSEL(2)) { const int q = u - NU_R3, b = q / (NLT * 8), tile = (q / 8) % NLT, n = q & 7; lru_unit<true>(a, lds, b, tile, n, false); }
    }
}

DI void phase3_cvt(const KArgs& a, LAS unsigned char* lds) {
    const int G = gridDim.x; LAS float* fl = (LAS float*)lds;
    constexpr int T_GU = 32 * 2 * 16 * 12, T_DN = 32 * 12 * 16;
    for (int t = blockIdx.x; t < T_GU + T_DN; t += G) {
        if (t < T_GU) { const int e = t / 384, r = t % 384, mat = r / 192, kt = (r % 192) / 12, nn = r % 12;
            const float* src = a.in[mat ? I_WEU : I_WEG] + (size_t)e * 1024 * 768 + (size_t)(64 * kt) * 768 + 64 * nn;
            bf16_t* dst = (bf16_t*)(a.ws + WS_WGU) + ((size_t)(e * 6 + (nn >> 1)) * 256 + mat * 128 + (nn & 1) * 64) * 1024 + 64 * kt;
            cvt_tile(fl, src, 768, dst, 1024, 1.f);
        } else { const int q = t - T_GU, e = q / 192, r = q % 192, kt = r / 16, nt = r % 16;
            const float* src = a.in[I_WED] + (size_t)e * 768 * 1024 + (size_t)(64 * kt) * 1024 + 64 * nt;
            bf16_t* dst = (bf16_t*)(a.ws + WS_WDN) + ((size_t)e * 1024 + 64 * nt) * 768 + 64 * kt;
            cvt_tile(fl, src, 1024, dst, 768, 1.f);
        }
    }
    __syncthreads();
}
struct OrderMerge {
    const char* A0; const char* A1; const char* B0; const char* B1; int G, c;
    DI bool next(int i, Unit& u) const { int pm, pn; if (!pg8::static_tile(i >> 1, G, c, NT / 256, 4, pm, pn)) return false;
        const int st = i & 1; u.pm = pm; u.pn = pn; u.aux = st; u.bmode = 1; u.A = (st ? A1 : A0) + (size_t)pm * 256 * 1024 * 2; u.B = (st ? B1 : B0) + (size_t)pn * 256 * 1024 * 2; return true; }
    DI void offsA(const Unit&, int, const int (&R)[2], const int (&C)[2], unsigned (&v)[2][2]) const { pg8::dense_offs(1024, R, C, v); }
};
struct EpiMerge {
    const bf16_t* glog; bf16_t* out;
    DI bool operator()(f32x4 (&acc)[2][2][4][2], const Unit& u, int wr, int wc, int fr, int fq) const {
#pragma unroll
        for (int bj = 0; bj < 2; ++bj) { const int col = u.pn * 256 + bj * 128 + wc * 32 + 8 * fq;
#pragma unroll
            EPI_LOOP_ROWS { const int row = u.pm * 256 + ai * 128 + wr * 64 + m * 16 + fr;
                const u32x4 gl = *(const u32x4*)(glog + (size_t)row * 2048 + 1024 + col);
                if (u.aux == 0) { const u32x4 gr = *(const u32x4*)(glog + (size_t)row * 2048 + col);
#pragma unroll
                    for (int e = 0; e < 4; ++e) { const float r0 = __uint_as_float(gr[e] << 16), r1 = __uint_as_float(gr[e] & 0xffff0000u), l0 = __uint_as_float(gl[e] << 16), l1 = __uint_as_float(gl[e] & 0xffff0000u);
                        const float q0 = (1.0f + ex2(-LOG2E * l0)) * rcpf_(1.0f + ex2(-LOG2E * r0)), q1 = (1.0f + ex2(-LOG2E * l1)) * rcpf_(1.0f + ex2(-LOG2E * r1));
                        acc[ai][bj][m][e >> 1][2 * (e & 1)] *= q0; acc[ai][bj][m][e >> 1][2 * (e & 1) + 1] *= q1; }
                } else { float v[8];
#pragma unroll
                    for (int e = 0; e < 4; ++e) { const float l0 = __uint_as_float(gl[e] << 16), l1 = __uint_as_float(gl[e] & 0xffff0000u);
                        v[2 * e] = acc[ai][bj][m][e >> 1][2 * (e & 1)] * sigm(l0); v[2 * e + 1] = acc[ai][bj][m][e >> 1][2 * (e & 1) + 1] * sigm(l1); }
                    u32x4 w; w.x = cvt_pk_bf16(v[0], v[1]); w.y = cvt_pk_bf16(v[2], v[3]); w.z = cvt_pk_bf16(v[4], v[5]); w.w = cvt_pk_bf16(v[6], v[7]);
                    *(u32x4*)(out + (size_t)row * 1024 + col) = w; } } }
        return u.aux == 0;
    }
};

struct OrderOut {
    const char* A; const char* B; int G, c;
    DI bool next(int i, Unit& u) const { int pm, pn; if (!pg8::static_tile(i, G, c, NT / 256, 4, pm, pn)) return false;
        u.pm = pm; u.pn = pn; u.aux = 0; u.bmode = 0; u.A = A + (size_t)pm * 256 * 1024 * 2; u.B = B + (size_t)pn * 256 * 1024 * 2; return true; }
    DI void offsA(const Unit&, int, const int (&R)[2], const int (&C)[2], unsigned (&v)[2][2]) const { pg8::dense_offs(1024, R, C, v); }
};
struct EpiOut {
    const KArgs* a;
    DI bool operator()(f32x4 (&acc)[2][2][4][2], const Unit& u, int wr, int wc, int fr, int fq) const {
        const int b = (u.pm * 256) / SEQ;
#pragma unroll
        for (int bj = 0; bj < 2; ++bj)
#pragma unroll
            for (int n = 0; n < 2; ++n) { const int col = u.pn * 256 + bj * 128 + wc * 32 + 16 * n + 4 * fq; f32x4 g;
#pragma unroll
                for (int j = 0; j < 4; ++j) g[j] = mod_val(*a, b, 2, col + j);
#pragma unroll
                EPI_LOOP_ROWS { const size_t off = (size_t)(u.pm * 256 + ai * 128 + wr * 64 + m * 16 + fr) * 1024 + col;
                    *(f32x4*)(a->out + off) = *(const f32x4*)(a->in[I_X] + off) + g * acc[ai][bj][m][n]; } }
        return false;
    }
};

DI void phase5(const KArgs& a, LAS unsigned char* lds) {
    const int tid = tid_fresh(), G = gridDim.x, lane = tid & 63, wid = tid >> 6;
    LAS float* gm = (LAS float*)lds;
    LAS float* sh = gm + 2048;
    LAS float* lg = sh + 2048;
    LAS int* lcnt = (LAS int*)(lg + 128 * 40);
    LAS int* rinfo = lcnt + 64;
    LAS float* rw = (LAS float*)(rinfo + 512);
    __syncthreads();
    for (int i = tid; i < 2048; i += 512) { const int v = i >> 10, k = i & 1023; gm[i] = a.in[I_NORM2][k] * (1.0f + mod_val(a, v, 4, k)); sh[i] = mod_val(a, v, 3, k); }
    if (blockIdx.x == 0) for (int i = tid; i < 512; i += 512) ((unsigned*)(a.ws + WS_HX2) + (size_t)NT * 512)[i] = 0u;
    bf16_t* hx2 = (bf16_t*)(a.ws + WS_HX2);
    int* cnt = (int*)(a.ws + WS_CTL) + CW_CNT;
    for (int rt = blockIdx.x; rt < NT / 128; rt += G) {
        __syncthreads();
        if (tid < 32) lcnt[tid] = 0;
        for (int rr = 0; rr < 16; ++rr) { const int row = 128 * rt + 16 * wid + rr; const int v = row / SEQ; const float* xr = a.out + (size_t)row * 1024; f32x4 x[4]; float ss = 0.f;
#pragma unroll
            for (int j = 0; j < 4; ++j) { x[j] = *(const f32x4*)(xr + 4 * lane + 256 * j); ss += (x[j][0] * x[j][0] + x[j][1] * x[j][1]) + (x[j][2] * x[j][2] + x[j][3] * x[j][3]); }
#pragma unroll
            for (int o = 32; o >= 1; o >>= 1) ss += __shfl_xor(ss, o);
            const float rstd = rsqrtf(ss * (1.0f / 1024.0f) + EPSV);
#pragma unroll
            for (int j = 0; j < 4; ++j) { const int k0 = 4 * lane + 256 * j; const f32x4 g = *(const LAS f32x4*)(gm + v * 1024 + k0), s = *(const LAS f32x4*)(sh + v * 1024 + k0);
                u32x2 w; w.x = cvt_pk_bf16(x[j][0] * rstd * g[0] + s[0], x[j][1] * rstd * g[1] + s[1]); w.y = cvt_pk_bf16(x[j][2] * rstd * g[2] + s[2], x[j][3] * rstd * g[3] + s[3]);
                *(u32x2*)(hx2 + (size_t)row * 1024 + k0) = w; } }
        __syncthreads();
        {
            const int rb = wid >> 1, cb = wid & 1, r = lane & 31, h = lane >> 5;
            const bf16_t* ar = hx2 + (size_t)(128 * rt + 32 * rb + r) * 1024 + 8 * h;
            const bf16_t* bh = (const bf16_t*)(a.ws + WS_WRH) + (size_t)(32 * cb + r) * 1024 + 8 * h; const bf16_t* bl = bh + 64 * 1024;
            f32x16 acc = zero16();
            for (int ks = 0; ks < 64; ++ks) { const bf16x8 af = *(const bf16x8*)(ar + 16 * ks), b1 = *(const bf16x8*)(bh + 16 * ks), b2 = *(const bf16x8*)(bl + 16 * ks);
                acc = MFMA32(af, b1, acc); acc = MFMA32(af, b2, acc); }
            const int col = 32 * cb + r;
            if (col < 36) {
#pragma unroll
                for (int i = 0; i < 16; ++i) lg[(32 * rb + crow(i, h)) * 40 + col] = acc[i]; }
        }
        __syncthreads();
        if (tid < 128) { const LAS float* l = lg + tid * 40;
            int gs = 0; float best = l[0] + a.in[I_BGRP][0];
#pragma unroll
            for (int g = 1; g < 4; ++g) { const float v = l[g] + a.in[I_BGRP][g]; if (v > best) { best = v; gs = g; } }
            const float mx = fmaxf(fmaxf(l[0], l[1]), fmaxf(l[2], l[3])); float den = 0.f;
#pragma unroll
            for (int g = 0; g < 4; ++g) den += expf(l[g] - mx);
            const float pg = expf(l[gs] - mx) / den;
            int i0 = 0, i1 = -1; float v0 = -3.0e38f, v1 = -3.0e38f;
#pragma unroll
            for (int e = 0; e < 8; ++e) { const float v = l[4 + 8 * gs + e] + a.in[I_BRT][8 * gs + e];
                if (v > v0) { v1 = v0; i1 = i0; v0 = v; i0 = e; } else if (v > v1) { v1 = v; i1 = e; } }
            const float e0 = l[4 + 8 * gs + i0], e1 = l[4 + 8 * gs + i1], m2 = fmaxf(e0, e1), x0 = expf(e0 - m2), x1 = expf(e1 - m2), inv = 1.0f / (x0 + x1);
            const int ex0 = 8 * gs + i0, ex1 = 8 * gs + i1;
            rinfo[tid * 4 + 0] = ex0; rinfo[tid * 4 + 1] = atomicAdd((int*)&lcnt[ex0], 1); rinfo[tid * 4 + 2] = ex1; rinfo[tid * 4 + 3] = atomicAdd((int*)&lcnt[ex1], 1);
            rw[tid * 2 + 0] = pg * x0 * inv; rw[tid * 2 + 1] = pg * x1 * inv; }
        __syncthreads();
        if (tid < 32) lcnt[32 + tid] = lcnt[tid] ? atomicAdd(&cnt[tid], lcnt[tid]) : 0;
        __syncthreads();
        if (tid < 128) { const int tok = 128 * rt + tid; const int e0 = rinfo[tid * 4 + 0], s0 = lcnt[32 + e0] + rinfo[tid * 4 + 1], e1 = rinfo[tid * 4 + 2], s1 = lcnt[32 + e1] + rinfo[tid * 4 + 3];
            int* ptok = (int*)(a.ws + WS_PTOK); ptok[(size_t)e0 * 65536 + s0] = tok; ptok[(size_t)e1 * 65536 + s1] = tok;
            unsigned* ro = (unsigned*)(a.ws + WS_ROUTE) + (size_t)tok * 8; ro[0] = e0; ro[1] = s0; ro[2] = e1; ro[3] = s1; ro[4] = __float_as_uint(rw[tid * 2]); ro[5] = __float_as_uint(rw[tid * 2 + 1]); }
    }
}

DI void moe_tiles(const KArgs& a, LAS int* tt) {
    __syncthreads();
    if (threadIdx.x == 0) { const int* cnt = (const int*)(a.ws + WS_CTL) + CW_CNT; int s = 0; for (int e = 0; e < 32; ++e) { tt[e] = s; s += (cnt[e] + 255) >> 8; } tt[32] = s; }
    __syncthreads();
}
DI int moe_expert(const LAS int* tt, int rt) { int e = 0;
#pragma unroll
    for (int q = 16; q >= 1; q >>= 1) if (tt[e + q] <= rt) e += q;
    return e; }
struct OrderMoe1 {
    const char* A; const char* B; const LAS int* tt; const LAS int* tok; int G, c;
    DI bool next(int i, Unit& u) const { const int L = i * G + c; if (L >= tt[32] * 6) return false; const int rt = L / 6, ct = L % 6, e = moe_expert(tt, rt);
        u.pm = rt; u.pn = ct; u.aux = e; u.bmode = 1; u.A = A; u.B = B + (size_t)(e * 6 + ct) * 256 * 1024 * 2; return true; }
    DI void offsA(const Unit&, int ui, const int (&R)[2], const int (&C)[2], unsigned (&v)[2][2]) const {
#pragma unroll
        for (int h = 0; h < 2; ++h)
#pragma unroll
            for (int i = 0; i < 2; ++i) v[h][i] = (unsigned)tok[ui * 256 + h * 128 + R[i]] * 2048u + (unsigned)C[i] * 2u; }
};
struct EpiMoe1 {
    bf16_t* hid;
    DI bool operator()(f32x4 (&acc)[2][2][4][2], const Unit& u, int wr, int wc, int fr, int fq) const {
        const int col = u.pn * 128 + wc * 32 + 8 * fq;
#pragma unroll
        EPI_LOOP_ROWS { const size_t row = (size_t)u.pm * 256 + ai * 128 + wr * 64 + m * 16 + fr; float v[8];
#pragma unroll
            for (int n = 0; n < 2; ++n)
#pragma unroll
                for (int j = 0; j < 4; ++j) v[4 * n + j] = silu_(acc[ai][0][m][n][j]) * acc[ai][1][m][n][j];
            u32x4 w; w.x = cvt_pk_bf16(v[0], v[1]); w.y = cvt_pk_bf16(v[2], v[3]); w.z = cvt_pk_bf16(v[4], v[5]); w.w = cvt_pk_bf16(v[6], v[7]);
            *(u32x4*)(hid + row * 768 + col) = w; }
        return false;
    }
};
struct OrderMoe2 {
    const char* A; const char* B; const LAS int* tt; int G, c;
    DI bool next(int i, Unit& u) const { const int L = i * G + c; if (L >= tt[32] * 4) return false; const int rt = L >> 2, ct = L & 3, e = moe_expert(tt, rt);
        u.pm = rt; u.pn = ct; u.aux = e; u.bmode = 1; u.A = A + (size_t)rt * 256 * 768 * 2; u.B = B + ((size_t)e * 1024 + 256 * ct) * 768 * 2; return true; }
    DI void offsA(const Unit&, int, const int (&R)[2], const int (&C)[2], unsigned (&v)[2][2]) const { pg8::dense_offs(768, R, C, v); }
};
struct EpiMoe2 {
    bf16_t* ye;
    DI bool operator()(f32x4 (&acc)[2][2][4][2], const Unit& u, int wr, int wc, int fr, int fq) const {
#pragma unroll
        for (int bj = 0; bj < 2; ++bj) { const int col = u.pn * 256 + bj * 128 + wc * 32 + 8 * fq;
#pragma unroll
            EPI_LOOP_ROWS { const size_t row = (size_t)u.pm * 256 + ai * 128 + wr * 64 + m * 16 + fr; const f32x4 v0 = acc[ai][bj][m][0], v1 = acc[ai][bj][m][1];
                u32x4 w; w.x = cvt_pk_bf16(v0[0], v0[1]); w.y = cvt_pk_bf16(v0[2], v0[3]); w.z = cvt_pk_bf16(v1[0], v1[1]); w.w = cvt_pk_bf16(v1[2], v1[3]);
                *(u32x4*)(ye + row * 1024 + col) = w; } }
        return false;
    }
};

DI void phase8(const KArgs& a, LAS unsigned char* lds) {
    const int tid = tid_fresh(), G = gridDim.x, lane = tid & 63, wid = tid >> 6;
    LAS float* g2 = (LAS float*)lds;
    LAS int* tt = (LAS int*)(g2 + 2048);
    moe_tiles(a, tt);
    for (int i = tid; i < 2048; i += 512) g2[i] = mod_val(a, i >> 10, 5, i & 1023);
    __syncthreads();
    const bf16_t* ye = (const bf16_t*)(a.ws + WS_YE);
    for (int row = blockIdx.x * 8 + wid; row < NT; row += G * 8) {
        const int v = row / SEQ; const unsigned* ro = (const unsigned*)(a.ws + WS_ROUTE) + (size_t)row * 8;
        const size_t p0 = (size_t)tt[ro[0]] * 256 + ro[1], p1 = (size_t)tt[ro[2]] * 256 + ro[3]; const float w0 = __uint_as_float(ro[4]), w1 = __uint_as_float(ro[5]);
        float* xr = a.out + (size_t)row * 1024; f32x4 x[4]; float ss = 0.f;
#pragma unroll
        for (int j = 0; j < 4; ++j) { const int k0 = 4 * lane + 256 * j; x[j] = *(const f32x4*)(xr + k0);
            const u32x2 ya = *(const u32x2*)(ye + p0 * 1024 + k0), yb = *(const u32x2*)(ye + p1 * 1024 + k0); const f32x4 g = *(const LAS f32x4*)(g2 + v * 1024 + k0);
            x[j][0] += g[0] * (w0 * __uint_as_float(ya[0] << 16) + w1 * __uint_as_float(yb[0] << 16)); x[j][1] += g[1] * (w0 * __uint_as_float(ya[0] & 0xffff0000u) + w1 * __uint_as_float(yb[0] & 0xffff0000u));
            x[j][2] += g[2] * (w0 * __uint_as_float(ya[1] << 16) + w1 * __uint_as_float(yb[1] << 16)); x[j][3] += g[3] * (w0 * __uint_as_float(ya[1] & 0xffff0000u) + w1 * __uint_as_float(yb[1] & 0xffff0000u));
            ss += (x[j][0] * x[j][0] + x[j][1] * x[j][1]) + (x[j][2] * x[j][2] + x[j][3] * x[j][3]); }
#pragma unroll
        for (int o = 32; o >= 1; o >>= 1) ss += __shfl_xor(ss, o);
        const float rstd = rsqrtf(ss * (1.0f / 1024.0f) + EPSV);
#pragma unroll
        for (int j = 0; j < 4; ++j) { const int k0 = 4 * lane + 256 * j; const f32x4 fn = *(const f32x4*)(a.in[I_FNORM] + k0); *(f32x4*)(xr + k0) = x[j] * rstd * fn; }
    }
}

constexpr int N_PHASES = 12;
__global__ void __launch_bounds__(512, 2) fwd_kernel(KArgs a) {
    extern __shared__ __attribute__((aligned(16))) unsigned char lds_raw[];
    LAS unsigned char* lds = (LAS unsigned char*)lds_raw;
    const int tid = tid_fresh();
    volatile LAS unsigned* misc = (volatile LAS unsigned*)(lds + LDS_MISC);
    if (tid < 8) misc[tid] = 0u;
    __syncthreads();
    XcdBarrier bar; bar.bar = (unsigned*)(a.ws + WS_CTL) + CW_BAR; bar.x = 0; bar.st = misc;
    const bool one = (a.ph_hi - a.ph_lo) > 1;
    if (one) bar = xcd_barrier_post((unsigned*)(a.ws + WS_CTL) + CW_BAR, misc);
#ifdef ONLY_PHASE
#define IN(k) ((k) == ONLY_PHASE)
#else
#define IN(k) (a.ph_lo <= (k) && (k) < a.ph_hi)
#endif
#define SEAM(k) do { if (IN(k) && IN((k) + 1)) xcd_barrier(bar); } while (0)
    const int G = gridDim.x, c = blockIdx.x;
    if (IN(0)) { phase0a(a, lds); } SEAM(0);
    if (IN(1)) { phase0b(a, lds); } SEAM(1);
    if (IN(2)) { __syncthreads(); OrderIn S{(const char*)(a.ws + WS_HX), (const char*)(a.ws + WS_WIN), G, c};
        EpiIn E{a.ws, (bf16_t*)a.out, a.in[I_BGATE], (const f32x2*)(a.ws + WS_ROPE)}; pg8::gemm_phase(lds, 1024, S, E); } SEAM(2);
    if (IN(3)) { phase2a(a, lds); } SEAM(3);
    if (IN(4)) { phase2b(a); } SEAM(4);
    if (IN(5)) { phase2c(a, lds); } SEAM(5);
    if (IN(6)) { phase3_cvt(a, lds);
        OrderMerge S{(const char*)(a.ws + WS_ZG), (const char*)(a.ws + WS_ZGL), (const char*)(a.ws + WS_WRET), (const char*)(a.ws + WS_WLRU), G, c};
        EpiMerge E{(const bf16_t*)a.out, (bf16_t*)(a.ws + WS_HX)}; pg8::gemm_phase(lds, 1024, S, E); } SEAM(6);
    if (IN(7)) { __syncthreads(); OrderOut S{(const char*)(a.ws + WS_HX), (const char*)(a.ws + WS_WOUT), G, c}; EpiOut E{&a}; pg8::gemm_phase(lds, 1024, S, E); } SEAM(7);
    if (IN(8)) { phase5(a, lds); } SEAM(8);
    if (IN(9)) {
        LAS int* tt = (LAS int*)(lds + LDS_MISC + 64); LAS int* tok = (LAS int*)(lds + LDS_TOK);
        moe_tiles(a, tt);
        {
            const int* cnt = (const int*)(a.ws + WS_CTL) + CW_CNT; const int* ptok = (const int*)(a.ws + WS_PTOK);
            for (int i = 0; i < 8; ++i) { const int L = i * G + c; if (L >= tt[32] * 6) break; const int rt = L / 6, e = moe_expert(tt, rt), r0 = (rt - tt[e]) * 256;
                if (tid < 256) tok[i * 256 + tid] = (r0 + tid < cnt[e]) ? ptok[(size_t)e * 65536 + r0 + tid] : NT; }
            __syncthreads();
        }
        OrderMoe1 S{(const char*)(a.ws + WS_HX2), (const char*)(a.ws + WS_WGU), tt, tok, G, c}; EpiMoe1 E{(bf16_t*)(a.ws + WS_HID)}; pg8::gemm_phase(lds, 1024, S, E); } SEAM(9);
    if (IN(10)) { LAS int* tt = (LAS int*)(lds + LDS_MISC + 64); moe_tiles(a, tt);
        OrderMoe2 S{(const char*)(a.ws + WS_HID), (const char*)(a.ws + WS_WDN), tt, G, c}; EpiMoe2 E{(bf16_t*)(a.ws + WS_YE)}; pg8::gemm_phase(lds, 768, S, E); } SEAM(10);
    if (IN(11)) { phase8(a, lds); }
#undef IN
#undef SEAM
}

extern "C" void kernel_launch(void* const* d_in, const int* in_sizes, int n_in, void* d_out, int out_size, void* d_ws, size_t ws_size, hipStream_t stream) {
    static int grid = 0;
    if (grid == 0) {
        if (n_in != 30 || out_size != NT * DM || ws_size < WS_NEED) { fprintf(stderr, "kernel_launch: unexpected shapes (n_in %d out %d ws %zu)\n", n_in, out_size, ws_size); grid = -1; return; }
        int dev = 0, cus = 0;
        if (hipGetDevice(&dev) != hipSuccess || hipDeviceGetAttribute(&cus, hipDeviceAttributeMultiprocessorCount, dev) != hipSuccess) { grid = -1; return; }
        if (hipFuncSetAttribute((const void*)fwd_kernel, hipFuncAttributeMaxDynamicSharedMemorySize, LDS_BYTES) != hipSuccess) { fprintf(stderr, "kernel_launch: hipFuncSetAttribute failed\n"); grid = -1; return; }
        int per_cu = 0; (void)hipOccupancyMaxActiveBlocksPerMultiprocessor(&per_cu, (const void*)fwd_kernel, 512, LDS_BYTES); (void)hipGetLastError();
        grid = cus;
    }
    if (grid < 0) return;
    (void)hipMemsetAsync((char*)d_ws + WS_CTL, 0, 1 * MiB, stream);
    KArgs a{};
    for (int i = 0; i < 30; ++i) a.in[i] = (const float*)d_in[i];
    a.out = (float*)d_out; a.ws = (unsigned char*)d_ws;
#if N_LAUNCH_SPLIT
    for (int p = 0; p < N_PHASES; ++p) { a.ph_lo = p; a.ph_hi = p + 1; hipLaunchKernelGGL(fwd_kernel, dim3(grid), dim3(512), LDS_BYTES, stream, a); }
#else
    a.ph_lo = 0; a.ph_hi = N_PHASES; hipLaunchKernelGGL(fwd_kernel, dim3(grid), dim3(512), LDS_BYTES, stream, a);
#endif
}
```

```cpp
#include <hip/hip_runtime.h>
#include <cstdio>
#include <cstdint>

#ifndef N_LAUNCH_SPLIT
#define N_LAUNCH_SPLIT 0
#endif

#define DI __device__ __forceinline__
#ifdef SUB
#define SUBSEL(k) ((k) == SUB)
#else
#define SUBSEL(k) true
#endif
#define LAS __attribute__((address_space(3)))
typedef unsigned short bf16_t;
typedef short bf16x8 __attribute__((ext_vector_type(8)));
typedef short s16x4 __attribute__((ext_vector_type(4)));
typedef float f32x2 __attribute__((ext_vector_type(2)));
typedef float f32x4 __attribute__((ext_vector_type(4)));
typedef float f32x16 __attribute__((ext_vector_type(16)));
typedef unsigned u32x2 __attribute__((ext_vector_type(2)));
typedef unsigned u32x4 __attribute__((ext_vector_type(4)));

constexpr int NB_ = 2, SEQ = 16384, NT = NB_ * SEQ, DM = 1024, CTXL = 256, NTC = NB_ * CTXL;
constexpr int NH = 4, DK = 128, DV = 256, QW = 512, VW = 1024, LW = 1024;
constexpr int NCOL = 7168;
constexpr int NE = 32, EH = 768;
constexpr float EPSV = 1e-6f;
constexpr float LOG2E = 1.4426950408889634f;
constexpr int SCH = 512, NSC = SEQ / SCH;
constexpr int LT = 64, NLT = SEQ / LT, NSLOT = 320;

constexpr size_t MiB = 1u << 20;
constexpr size_t WS_CTL = 0;
constexpr size_t WS_MODP = 1 * MiB;
constexpr size_t WS_ROPE = 1 * MiB + 512 * 1024;
constexpr size_t WS_WRH = 1 * MiB + 768 * 1024;
constexpr size_t WS_LAGG = 2 * MiB;
constexpr size_t WS_LHIN = 12 * MiB;
constexpr size_t WS_CTXK = 17 * MiB;
constexpr size_t WS_CTXV = 17 * MiB + 512 * 1024;
constexpr size_t WS_CTXX = 18 * MiB + 512 * 1024;
constexpr size_t WS_CTXS = 20 * MiB;
constexpr size_t WS_ROUTE = 22 * MiB;
constexpr size_t WS_PTOK = 23 * MiB;
constexpr size_t WS_WIN = 32 * MiB;
constexpr size_t WS_WRET = 46 * MiB, WS_WLRU = 48 * MiB, WS_WOUT = 50 * MiB;
constexpr size_t WS_WLB = 52 * MiB;
constexpr size_t WS_HX = 56 * MiB;
constexpr size_t WS_ZQ = 120 * MiB, WS_ZK = 152 * MiB, WS_ZV = 184 * MiB, WS_ZG = 248 * MiB, WS_ZXL = 312 * MiB, WS_ZGL = 376 * MiB;
constexpr size_t WS_SBF = 440 * MiB;
constexpr size_t WS_WGU = 120 * MiB;
constexpr size_t WS_WDN = 440 * MiB;
constexpr size_t WS_HX2 = 248 * MiB;
constexpr size_t WS_HID = 313 * MiB;
constexpr size_t WS_YE = 56 * MiB;
constexpr size_t WS_NEED = 512 * MiB;
constexpr int CW_BAR = 4096, CW_CNT = 16384;

constexpr int LDS_SCR = 0, LDS_TOK = 131072, LDS_MISC = 131072 + 8192, LDS_BYTES = 147456;

DI int tid_fresh() { int t = threadIdx.x; asm volatile("" : "+v"(t)); return t; }
DI float bf2f(unsigned short b) { return __uint_as_float(((unsigned)b) << 16); }
DI unsigned cvt_pk_bf16(float lo, float hi) { unsigned r; asm volatile("v_cvt_pk_bf16_f32 %0, %1, %2" : "=v"(r) : "v"(lo), "v"(hi)); return r; }
DI unsigned short f2bf(float f) { return (unsigned short)(cvt_pk_bf16(f, 0.f) & 0xffffu); }
DI float ex2(float x) { return __builtin_amdgcn_exp2f(x); }
DI float rcpf_(float x) { return __builtin_amdgcn_rcpf(x); }
DI float sigm(float x) { return rcpf_(1.0f + ex2(-LOG2E * x)); }
DI float silu_(float x) { return x * sigm(x); }
DI float gelu_tanh(float x) { const float z = 0.7978845608028654f * (x + 0.044715f * x * x * x); return x * sigm(2.0f * z); }
DI float softplus_(float x) { return x > 20.f ? x : log1pf(expf(x)); }
DI int crow(int i, int h) { return (i & 3) + 8 * (i >> 2) + 4 * h; }
#define MFMA32(a, b, c) __builtin_amdgcn_mfma_f32_32x32x16_bf16((a), (b), (c), 0, 0, 0)
DI void lds_wait() { asm volatile("s_waitcnt lgkmcnt(0)" ::: "memory"); }
template <int O0, int O1> DI bf16x8 tr_frag(unsigned addr) {
    s16x4 lo, hi;
    asm volatile("ds_read_b64_tr_b16 %0, %2 offset:%3\n\tds_read_b64_tr_b16 %1, %2 offset:%4\n\ts_waitcnt lgkmcnt(0)" : "=&v"(lo), "=&v"(hi) : "v"(addr), "i"(O0), "i"(O1) : "memory");
    return __builtin_shufflevector(lo, hi, 0, 1, 2, 3, 4, 5, 6, 7);
}
template <int O, int S, int T> DI void tr_frag4(unsigned addr, bf16x8& f0, bf16x8& f1, bf16x8& f2, bf16x8& f3) {
    s16x4 a0, a1, b0, b1, c0, c1, d0, d1;
    asm volatile("ds_read_b64_tr_b16 %0, %8 offset:%9\n\tds_read_b64_tr_b16 %1, %8 offset:%10\n\t"
                 "ds_read_b64_tr_b16 %2, %8 offset:%11\n\tds_read_b64_tr_b16 %3, %8 offset:%12\n\t"
                 "ds_read_b64_tr_b16 %4, %8 offset:%13\n\tds_read_b64_tr_b16 %5, %8 offset:%14\n\t"
                 "ds_read_b64_tr_b16 %6, %8 offset:%15\n\tds_read_b64_tr_b16 %7, %8 offset:%16\n\ts_waitcnt lgkmcnt(0)"
                 : "=&v"(a0), "=&v"(a1), "=&v"(b0), "=&v"(b1), "=&v"(c0), "=&v"(c1), "=&v"(d0), "=&v"(d1)
                 : "v"(addr), "i"(O), "i"(O + T), "i"(O + S), "i"(O + S + T), "i"(O + 2 * S), "i"(O + 2 * S + T), "i"(O + 3 * S), "i"(O + 3 * S + T) : "memory");
    f0 = __builtin_shufflevector(a0, a1, 0, 1, 2, 3, 4, 5, 6, 7); f1 = __builtin_shufflevector(b0, b1, 0, 1, 2, 3, 4, 5, 6, 7);
    f2 = __builtin_shufflevector(c0, c1, 0, 1, 2, 3, 4, 5, 6, 7); f3 = __builtin_shufflevector(d0, d1, 0, 1, 2, 3, 4, 5, 6, 7);
}
DI f32x16 zero16() { f32x16 z; for (int i = 0; i < 16; ++i) z[i] = 0.f; return z; }

struct KArgs {
    const float* in[30];
    float* out;
    unsigned char* ws;
    int ph_lo, ph_hi;
};
enum { I_X = 0, I_C, I_CTX, I_CCTX, I_WMOD, I_BMOD, I_NORM1, I_NORM2, I_WIN, I_BGATE, I_RDECAY, I_RNORM, I_WRET, I_CONVW, I_CONVB, I_LWA, I_LBA, I_LWX, I_LBX, I_LLAM,
       I_WLRU, I_WOUT, I_WGRP, I_BGRP, I_WRT, I_BRT, I_WEG, I_WEU, I_WED, I_FNORM };

DI float mod_val(const KArgs& a, int v, int ch, int k) {
    const float* mp = (const float*)(a.ws + WS_MODP); const int n = ch * 1024 + k;
    return ((mp[(0 * 3 + v) * 6144 + n] + mp[(1 * 3 + v) * 6144 + n]) + (mp[(2 * 3 + v) * 6144 + n] + mp[(3 * 3 + v) * 6144 + n])) + a.in[I_BMOD][n];
}

#define XB_TMO      128
#define XB_XCNT(j)  (256  + 64 * (j))
#define XB_XSUB(j)  (1280 + 64 * (j))
#define XB_XGEN(j)  (2304 + 64 * (j))
#define XB_TOP      3328
#define XB_TOPGEN   3392
#define XCD_BAR_WORDS 3456
#define XB_SPIN_CAP (1u << 18)
__device__ __forceinline__ unsigned xb_ld(unsigned* p)              { return __hip_atomic_load(p, __ATOMIC_RELAXED, __HIP_MEMORY_SCOPE_AGENT); }
__device__ __forceinline__ unsigned xb_add(unsigned* p, unsigned v) { return __hip_atomic_fetch_add(p, v, __ATOMIC_RELAXED, __HIP_MEMORY_SCOPE_AGENT); }
__device__ __forceinline__ unsigned xb_xcc_id() { return (unsigned)__builtin_amdgcn_s_getreg((3 << 11) | 20) & 0xFu; }
#define XB_SPIN(cond, bar) do { unsigned _sp = 0; while (cond) { __builtin_amdgcn_s_sleep(1); \
    if ((++_sp & 255u) == 0u) { if (xb_ld(&(bar)[XB_TMO])) break; if (_sp > XB_SPIN_CAP) { atomicAdd(&(bar)[XB_TMO], 1u); break; } } } } while (0)
struct XcdBarrier { unsigned* bar; unsigned x; volatile LAS unsigned* st; };
__device__ __forceinline__ XcdBarrier xcd_barrier_post(unsigned* bar, volatile LAS unsigned* st) {
    XcdBarrier b; b.bar = bar; b.x = xb_xcc_id(); b.st = st;
    if (threadIdx.x == 0) (void)xb_add(&bar[XB_XCNT(b.x)], 1u);
    return b;
}
__device__ __forceinline__ void xcd_barrier_complete(unsigned* bar, unsigned x, unsigned& nloc, unsigned& nx) {
    const unsigned G = gridDim.x * gridDim.y * gridDim.z;
    unsigned sum, cnt, mine, sp = 0u;
    for (;;) {
        sum = 0u; cnt = 0u; mine = 0u;
#pragma unroll
        for (unsigned j = 0; j < 16; ++j) { const unsigned c = xb_ld(&bar[XB_XCNT(j)]); sum += c; cnt += (c > 0u) ? 1u : 0u; mine = (j == x) ? c : mine; }
        if (sum == G) break;
        __builtin_amdgcn_s_sleep(1);
        if ((++sp & 255u) == 0u) { if (xb_ld(&bar[XB_TMO])) break; if (sp > XB_SPIN_CAP) { atomicAdd(&bar[XB_TMO], 1u); break; } }
    }
    nloc = mine > 0u ? mine : 1u; nx = cnt > 0u ? cnt : 1u;
}
__device__ __forceinline__ void xcd_barrier(const XcdBarrier& b) {
    asm volatile("s_waitcnt vmcnt(0)" ::: "memory");
    __syncthreads();
    if (threadIdx.x == 0) {
        unsigned* bar = b.bar;
        __builtin_amdgcn_s_waitcnt(0);
        unsigned nloc = b.st[0], nx = b.st[1];
        if (nloc == 0u) { xcd_barrier_complete(bar, b.x, nloc, nx); b.st[0] = nloc; b.st[1] = nx; }
        const unsigned old = xb_add(&bar[XB_XSUB(b.x)], 1u);
        const unsigned gen = old / nloc;
        if (old + 1u == (gen + 1u) * nloc) {
            __builtin_amdgcn_fence(__ATOMIC_RELEASE, "agent");
            asm volatile("s_waitcnt vmcnt(0)" ::: "memory");
            const unsigned og = xb_add(&bar[XB_TOP], 1u);
            const unsigned tg = og / nx;
            if (og + 1u == (tg + 1u) * nx) xb_add(&bar[XB_TOPGEN], 1u);
            else XB_SPIN(xb_ld(&bar[XB_TOPGEN]) == tg, bar);
            __builtin_amdgcn_fence(__ATOMIC_ACQUIRE, "agent");
            xb_add(&bar[XB_XGEN(b.x)], 1u);
            asm volatile("s_waitcnt vmcnt(0)" ::: "memory");
        } else {
            XB_SPIN(xb_ld(&bar[XB_XGEN(b.x)]) == gen, bar);
            __builtin_amdgcn_fence(__ATOMIC_ACQUIRE, "agent");
            asm volatile("s_waitcnt vmcnt(0)" ::: "memory");
        }
    }
    __syncthreads();
}

namespace pg8 {
constexpr int BM = 256, BK = 64, HALF = 128, HTB = HALF * BK * 2, STAGE_BYTES = 8 * HTB, NXCD = 8, WGM = 8;
DI int lds_byte(int r, int c) { const int st = (r >> 4) * 2 + (c >> 5), rr = r & 15, cc = c & 31, ob = rr * 64 + cc * 2; return st * 1024 + (ob ^ (((ob >> 9) & 1) << 5)); }
DI void stage_rc(int b, int& R, int& C) { const int st = b / 1024, sb = b % 1024, swz = sb ^ (((sb >> 9) & 1) << 5); R = (st >> 1) * 16 + swz / 64; C = (st & 1) * 32 + (swz % 64) / 2; }
DI int perm32(int rho) { const int n = rho >> 4, i = rho & 15; return 8 * (i >> 2) + 4 * n + (i & 3); }
DI int bmap(int mode, int R) {
    if (mode == 1) return (R & ~31) + perm32(R & 31);
    if (mode == 2) { const int wc = R >> 5, n = (R >> 4) & 1, low = R & 15; return 64 * (wc >> 1) + 32 * n + 16 * (wc & 1) + low; }
    return R;
}
struct Unit { const char* A; const char* B; int pm, pn, aux, bmode; };
DI bool static_tile(int i, int G, int c, int nM, int nN, int& pm, int& pn) {
    const int nwg = nM * nN; const long L = (long)i * G + c; if (L >= nwg) return false;
    int wgid = (int)L; { const int q = nwg / NXCD, r = nwg % NXCD, xcd = wgid % NXCD, off = wgid / NXCD; wgid = (xcd < r ? xcd * (q + 1) : r * (q + 1) + (xcd - r) * q) + off; }
    const int nig = WGM * nN, gid = wgid / nig, fm = gid * WGM, gsz = (nM - fm) < WGM ? (nM - fm) : WGM;
    pm = fm + ((wgid % nig) % gsz); pn = (wgid % nig) / gsz; return true;
}

template <class Epi, class Sched>
DI void gemm_phase(LAS unsigned char* lds, const int K, const Sched& S, const Epi& E) {
    const int tid = tid_fresh(), wid = __builtin_amdgcn_readfirstlane(tid >> 6), lane = tid & 63, wr = wid >> 2, wc = wid & 3, fr = lane & 15, fq = lane >> 4;
    const int nt = K / BK;
    int Rr[2], Cc[2];
#pragma unroll
    for (int i = 0; i < 2; ++i) stage_rc(tid * 16 + i * 8192, Rr[i], Cc[i]);
    unsigned voffA[2][2], voffB[2];
    const size_t kstep = (size_t)(BK * 2);
    const size_t hstep = (size_t)HALF * K * 2;
    const unsigned ldsw = (unsigned)wid * 1024u;
    const int aoff = lds_byte(wr * 64 + fr, fq * 8), boff = lds_byte(wc * 32 + fr, fq * 8);
#define PG8_SA(b, h) (((b) * 2 + (h)) * HTB)
#define PG8_SB(b, h) ((4 + (b) * 2 + (h)) * HTB)
#define PG8_STAGE(bufoff, gbase, voff) do { _Pragma("unroll") for (int _i = 0; _i < 2; ++_i) \
        __builtin_amdgcn_global_load_lds((const unsigned*)((const char*)(gbase) + (voff)[_i]), (LAS unsigned*)(lds + (bufoff) + ldsw + _i * 8192), 16, 0, 0); } while (0)
#define PG8_LDA(dst, b, h) do { _Pragma("unroll") for (int m = 0; m < 4; ++m) _Pragma("unroll") for (int k = 0; k < 2; ++k) dst[m][k] = *(const LAS bf16x8*)(lds + PG8_SA(b, h) + aoff + m * 2048 + k * 1024); } while (0)
#define PG8_LDB(dst, b, h) do { _Pragma("unroll") for (int n = 0; n < 2; ++n) _Pragma("unroll") for (int k = 0; k < 2; ++k) dst[n][k] = *(const LAS bf16x8*)(lds + PG8_SB(b, h) + boff + n * 2048 + k * 1024); } while (0)
#define PG8_MMA(ai, bj, At, Bt) do { __builtin_amdgcn_s_setprio(1); _Pragma("unroll") for (int m = 0; m < 4; ++m) _Pragma("unroll") for (int n = 0; n < 2; ++n) _Pragma("unroll") for (int k = 0; k < 2; ++k) \
        acc[ai][bj][m][n] = __builtin_amdgcn_mfma_f32_16x16x32_bf16(Bt[n][k], At[m][k], acc[ai][bj][m][n], 0, 0, 0); __builtin_amdgcn_s_setprio(0); } while (0)
#define PG8_WAIT_V(n) asm volatile("s_waitcnt vmcnt(" #n ")" ::: "memory")
#define PG8_WAIT_L(n) asm volatile("s_waitcnt lgkmcnt(" #n ")" ::: "memory")
#define PG8_BAR __builtin_amdgcn_s_barrier()
#define PG8_SCHED __builtin_amdgcn_sched_barrier(0)
#define PG8_SETB(u) do { _Pragma("unroll") for (int _i = 0; _i < 2; ++_i) voffB[_i] = (unsigned)(bmap((u).bmode, Rr[_i]) * K + Cc[_i]) * 2u; } while (0)
    Unit cur, nxt; int ui = 0;
    if (!S.next(0, cur)) return;
    f32x4 acc[2][2][4][2];
#pragma unroll
    for (int a = 0; a < 2; ++a)
#pragma unroll
        for (int b = 0; b < 2; ++b)
#pragma unroll
            for (int m = 0; m < 4; ++m)
#pragma unroll
                for (int n = 0; n < 2; ++n) acc[a][b][m][n] = (f32x4){0.f, 0.f, 0.f, 0.f};
    bf16x8 At[4][2], B0[2][2], B1[2][2];
    const char* cA = cur.A; const char* cB = cur.B;
    S.offsA(cur, 0, Rr, Cc, voffA); PG8_SETB(cur);
    PG8_STAGE(PG8_SB(0, 0), cB, voffB); PG8_STAGE(PG8_SB(0, 1), cB + hstep, voffB); PG8_STAGE(PG8_SA(0, 0), cA, voffA[0]); PG8_STAGE(PG8_SA(0, 1), cA, voffA[1]);
    if (wr == 1) PG8_BAR;
    PG8_WAIT_V(2); PG8_BAR;
    PG8_STAGE(PG8_SB(1, 0), cB + kstep, voffB); PG8_STAGE(PG8_SA(1, 0), cA + kstep, voffA[0]); PG8_STAGE(PG8_SB(1, 1), cB + hstep + kstep, voffB);
    PG8_WAIT_V(6); PG8_BAR;
    for (;;) {
        const bool has_next = S.next(ui + 1, nxt);
        const char* nA = has_next ? nxt.A : cA; const char* nB = has_next ? nxt.B : cB;
        for (int t = 0; t < nt; t += 2) {
            const bool last = (t == nt - 2);
            const char* a1 = cA + (size_t)(t + 1) * kstep;
            const char* a2 = last ? nA : cA + (size_t)(t + 2) * kstep; const char* b2 = last ? nB : cB + (size_t)(t + 2) * kstep;
            const char* a3 = a2 + kstep; const char* b3 = b2 + kstep;
            if (last && has_next) PG8_SETB(nxt);
            PG8_LDB(B0, 0, 0); PG8_LDB(B1, 0, 1); PG8_SCHED; PG8_LDA(At, 0, 0); PG8_STAGE(PG8_SA(1, 1), a1, voffA[1]);
            PG8_WAIT_V(8); PG8_WAIT_L(0); PG8_BAR; PG8_MMA(0, 0, At, B0); PG8_MMA(0, 1, At, B1); PG8_BAR; PG8_SCHED;
            if (last && has_next) S.offsA(nxt, ui + 1, Rr, Cc, voffA);
            PG8_LDA(At, 0, 1); PG8_STAGE(PG8_SB(0, 0), b2, voffB); PG8_STAGE(PG8_SB(0, 1), b2 + hstep, voffB); PG8_STAGE(PG8_SA(0, 0), a2, voffA[0]);
            PG8_WAIT_V(8); PG8_WAIT_L(0); PG8_BAR; PG8_MMA(1, 0, At, B0); PG8_MMA(1, 1, At, B1); PG8_BAR; PG8_SCHED;
            PG8_LDB(B0, 1, 0); PG8_LDB(B1, 1, 1); PG8_SCHED; PG8_LDA(At, 1, 0); PG8_STAGE(PG8_SA(0, 1), a2, voffA[1]);
            PG8_WAIT_V(8); PG8_WAIT_L(0); PG8_BAR; PG8_MMA(0, 0, At, B0); PG8_MMA(0, 1, At, B1); PG8_BAR; PG8_SCHED;
            PG8_LDA(At, 1, 1); PG8_STAGE(PG8_SB(1, 0), b3, voffB); PG8_STAGE(PG8_SB(1, 1), b3 + hstep, voffB); PG8_STAGE(PG8_SA(1, 0), a3, voffA[0]);
            PG8_WAIT_V(8); PG8_WAIT_L(0); PG8_BAR; PG8_MMA(1, 0, At, B0); PG8_MMA(1, 1, At, B1); PG8_BAR; PG8_SCHED;
        }
        if (wr == 0) PG8_BAR;
        const bool keep = E(acc, cur, wr, wc, fr, fq);
        if (!has_next) break;
        if (!keep) {
#pragma unroll
            for (int a = 0; a < 2; ++a)
#pragma unroll
                for (int b = 0; b < 2; ++b)
#pragma unroll
                    for (int m = 0; m < 4; ++m)
#pragma unroll
                        for (int n = 0; n < 2; ++n) acc[a][b][m][n] = (f32x4){0.f, 0.f, 0.f, 0.f};
        }
        cur = nxt; cA = nA; cB = nB; ++ui;
        if (wr == 1) PG8_BAR;
    }
    PG8_WAIT_V(0);
    PG8_BAR;
#undef PG8_SA
#undef PG8_SB
#undef PG8_STAGE
#undef PG8_LDA
#undef PG8_LDB
#undef PG8_MMA
#undef PG8_WAIT_V
#undef PG8_WAIT_L
#undef PG8_BAR
#undef PG8_SCHED
#undef PG8_SETB
}
DI void dense_offs(int K, const int (&R)[2], const int (&C)[2], unsigned (&voffA)[2][2]) {
#pragma unroll
    for (int h = 0; h < 2; ++h)
#pragma unroll
        for (int i = 0; i < 2; ++i) voffA[h][i] = (unsigned)((h * HALF + R[i]) * K + C[i]) * 2u;
}
}
using pg8::Unit;

#define EPI_LOOP_ROWS for (int ai = 0; ai < 2; ++ai) _Pragma("unroll") for (int m = 0; m < 4; ++m)

DI void cvt_tile(LAS float* tile, const float* src, int ld_src, bf16_t* dst, int ld_dst, float scale) {
    const int tid = tid_fresh();
    __syncthreads();
#pragma unroll
    for (int i = 0; i < 2; ++i) { const int kr = (tid >> 4) + 32 * i, nc = (tid & 15) * 4; const f32x4 v = *(const f32x4*)(src + (size_t)kr * ld_src + nc);
        tile[kr * 65 + nc + 0] = v[0]; tile[kr * 65 + nc + 1] = v[1]; tile[kr * 65 + nc + 2] = v[2]; tile[kr * 65 + nc + 3] = v[3]; }
    __syncthreads();
    const int n = tid >> 3, kc = (tid & 7) * 8; float v[8];
#pragma unroll
    for (int j = 0; j < 8; ++j) v[j] = tile[(kc + j) * 65 + n] * scale;
    u32x4 w; w.x = cvt_pk_bf16(v[0], v[1]); w.y = cvt_pk_bf16(v[2], v[3]); w.z = cvt_pk_bf16(v[4], v[5]); w.w = cvt_pk_bf16(v[6], v[7]);
    *(u32x4*)(dst + (size_t)n * ld_dst + kc) = w;
}

DI void phase0a(const KArgs& a, LAS unsigned char* lds) {
    const int tid = tid_fresh(), G = gridDim.x;
    LAS float* fl = (LAS float*)lds;
    constexpr int NU_MOD = 192, NU_ROPE = 1, NU_ROUTW = 1, T_WIN = 16 * 112, T_PROJ = 3 * 256, T_LB = 128;
    constexpr int U0 = NU_MOD, U1 = U0 + NU_ROPE, U2 = U1 + NU_ROUTW, U3 = U2 + T_WIN, U4 = U3 + T_PROJ, U5 = U4 + T_LB;
    for (int u = blockIdx.x; u < U5; u += G) {
        if (u < U0) {
            const int ks = u / 48, cg = u % 48;
            __syncthreads();
            for (int i = tid; i < 768; i += 512) { const int v = i >> 8, k = 256 * ks + (i & 255); const float x = (v == 0) ? a.in[I_C][k] : (v == 1) ? a.in[I_C][1024 + k] : a.in[I_CCTX][k]; fl[i] = silu_(x); }
            __syncthreads();
            const int rl = tid >> 5, cl = tid & 31; float acc[3][4];
#pragma unroll
            for (int v = 0; v < 3; ++v) for (int j = 0; j < 4; ++j) acc[v][j] = 0.f;
            for (int s = 0; s < 16; ++s) { const int kk = 16 * s + rl; const f32x4 w = *(const f32x4*)(a.in[I_WMOD] + (size_t)(256 * ks + kk) * 6144 + 128 * cg + 4 * cl);
#pragma unroll
                for (int v = 0; v < 3; ++v) { const float sv = fl[v * 256 + kk]; acc[v][0] += sv * w[0]; acc[v][1] += sv * w[1]; acc[v][2] += sv * w[2]; acc[v][3] += sv * w[3]; } }
            __syncthreads();
            LAS float* red = fl + 1024;
#pragma unroll
            for (int v = 0; v < 3; ++v) for (int j = 0; j < 4; ++j) red[(rl * 3 + v) * 128 + 4 * cl + j] = acc[v][j];
            __syncthreads();
            if (tid < 384) { const int v = tid >> 7, c = tid & 127; float s = 0.f; for (int r = 0; r < 16; ++r) s += red[(r * 3 + v) * 128 + c];
                ((float*)(a.ws + WS_MODP))[(ks * 3 + v) * 6144 + 128 * cg + c] = s; }
        } else if (u < U1) {
            f32x2* tab = (f32x2*)(a.ws + WS_ROPE);
            for (int i = tid; i < 320 * 32; i += 512) { const int p = i >> 5, fi = i & 31; const float pos = (float)(p < 256 ? p : p - 256);
                const float freq = ex2(-(float)fi * (13.287712379549449f / 32.0f)); float rev = pos * freq * 0.15915494309189535f; rev -= floorf(rev);
                tab[i] = (f32x2){__builtin_amdgcn_cosf(rev), __builtin_amdgcn_sinf(rev)}; }
        } else if (u < U2) {
            bf16_t* hi = (bf16_t*)(a.ws + WS_WRH); bf16_t* lo = hi + 64 * 1024;
            for (int i = tid; i < 64 * 1024; i += 512) { const int n = i >> 10, k = i & 1023; float w = 0.f;
                if (n < 4) w = a.in[I_WGRP][k * 4 + n]; else if (n < 36) w = a.in[I_WRT][k * 32 + (n - 4)];
                const unsigned short h16 = f2bf(w); hi[i] = h16; lo[i] = f2bf(w - bf2f(h16)); }
        } else if (u < U3) {
            const int t = u - U2, kt = t / 112, nt = t % 112;
            cvt_tile(fl, a.in[I_WIN] + (size_t)(64 * kt) * NCOL + 64 * nt, NCOL, (bf16_t*)(a.ws + WS_WIN) + (size_t)(64 * nt) * 1024 + 64 * kt, 1024, 1.f);
        } else if (u < U4) {
            const int t = u - U3, w = t >> 8, kt = (t & 255) >> 4, nt = t & 15;
            const float* src = a.in[w == 0 ? I_WRET : w == 1 ? I_WLRU : I_WOUT]; bf16_t* dst = (bf16_t*)(a.ws + (w == 0 ? WS_WRET : w == 1 ? WS_WLRU : WS_WOUT));
            cvt_tile(fl, src + (size_t)(64 * kt) * 1024 + 64 * nt, 1024, dst + (size_t)(64 * nt) * 1024 + 64 * kt, 1024, 1.f);
        } else {
            const int t = u - U4, mat = t >> 5, blk = (t >> 2) & 7, kt = (t >> 1) & 1, nt = t & 1, dir = mat >> 1;
            const float* src = a.in[(mat & 1) ? I_LWX : I_LWA] + (size_t)(dir * 8 + blk) * 128 * 128;
            bf16_t* dst = (bf16_t*)(a.ws + WS_WLB) + (size_t)(mat * 8 + blk) * 128 * 128;
            cvt_tile(fl, src + (size_t)(64 * kt) * 128 + 64 * nt, 128, dst + (size_t)(64 * nt) * 128 + 64 * kt, 128, -LOG2E);
        }
    }
}

DI void phase0b(const KArgs& a, LAS unsigned char* lds) {
    const int tid = tid_fresh(), G = gridDim.x, lane = tid & 63, wid = tid >> 6;
    LAS float* gm = (LAS float*)lds;
    LAS float* sh = gm + 3072;
    __syncthreads();
    for (int i = tid; i < 3072; i += 512) { const int v = i >> 10, k = i & 1023; gm[i] = a.in[I_NORM1][k] * (1.0f + mod_val(a, v, 1, k)); sh[i] = mod_val(a, v, 0, k); }
    __syncthreads();
    for (int u = blockIdx.x; u < 160; u += G) {
        const int rt = u / 20, ct = u % 20;
        const int col0 = ct < 4 ? 512 + 128 * ct : ct < 12 ? 1024 + 128 * (ct - 4) : 3072 + 128 * (ct - 12);
        const int rb = wid >> 2, cb = wid & 3, r = lane & 31, h = lane >> 5;
        const float* xr = a.in[I_CTX] + (size_t)(64 * rt + 32 * rb + r) * 1024;
        float ss = 0.f;
        for (int s = 0; s < 64; ++s) { const f32x4 p = *(const f32x4*)(xr + 16 * s + 8 * h), q = *(const f32x4*)(xr + 16 * s + 8 * h + 4);
            ss += (p[0] * p[0] + p[1] * p[1]) + (p[2] * p[2] + p[3] * p[3]) + (q[0] * q[0] + q[1] * q[1]) + (q[2] * q[2] + q[3] * q[3]); }
        ss += __shfl_xor(ss, 32);
        const float rstd = rsqrtf(ss * (1.0f / 1024.0f) + EPSV);
        const bf16_t* wrow = (const bf16_t*)(a.ws + WS_WIN) + (size_t)(col0 + 32 * cb + r) * 1024;
        f32x16 acc = zero16();
        for (int s = 0; s < 64; ++s) { const int k0 = 16 * s + 8 * h;
            const f32x4 p = *(const f32x4*)(xr + k0), q = *(const f32x4*)(xr + k0 + 4);
            const f32x4 g0 = *(const LAS f32x4*)(gm + 2048 + k0), g1 = *(const LAS f32x4*)(gm + 2048 + k0 + 4), s0 = *(const LAS f32x4*)(sh + 2048 + k0), s1 = *(const LAS f32x4*)(sh + 2048 + k0 + 4);
            u32x4 w; w.x = cvt_pk_bf16(p[0] * rstd * g0[0] + s0[0], p[1] * rstd * g0[1] + s0[1]); w.y = cvt_pk_bf16(p[2] * rstd * g0[2] + s0[2], p[3] * rstd * g0[3] + s0[3]);
            w.z = cvt_pk_bf16(q[0] * rstd * g1[0] + s1[0], q[1] * rstd * g1[1] + s1[1]); w.w = cvt_pk_bf16(q[2] * rstd * g1[2] + s1[2], q[3] * rstd * g1[3] + s1[3]);
            const bf16x8 af = __builtin_bit_cast(bf16x8, w); const bf16x8 bfr = *(const bf16x8*)(wrow + k0);
            acc = MFMA32(af, bfr, acc); }
        const int ccol = 128 * (ct < 4 ? ct : ct < 12 ? ct - 4 : ct - 12) + 32 * cb + r;
        bf16_t* dst = (bf16_t*)(a.ws + (ct < 4 ? WS_CTXK : ct < 12 ? WS_CTXV : WS_CTXX)); const int ldd = ct < 4 ? 512 : 1024; const float sc = ct < 4 ? 0.08838834764831845f : 1.0f;
#pragma unroll
        for (int i = 0; i < 16; ++i) dst[(size_t)(64 * rt + 32 * rb + crow(i, h)) * ldd + ccol] = f2bf(acc[i] * sc);
    }
    for (int row = blockIdx.x * 8 + wid; row < NT; row += G * 8) {
        const int v = row / SEQ; const float* xr = a.in[I_X] + (size_t)row * 1024; f32x4 x[4]; float ss = 0.f;
#pragma unroll
        for (int j = 0; j < 4; ++j) { x[j] = *(const f32x4*)(xr + 4 * lane + 256 * j); ss += (x[j][0] * x[j][0] + x[j][1] * x[j][1]) + (x[j][2] * x[j][2] + x[j][3] * x[j][3]); }
#pragma unroll
        for (int o = 32; o >= 1; o >>= 1) ss += __shfl_xor(ss, o);
        const float rstd = rsqrtf(ss * (1.0f / 1024.0f) + EPSV);
        bf16_t* dst = (bf16_t*)(a.ws + WS_HX) + (size_t)row * 1024;
#pragma unroll
        for (int j = 0; j < 4; ++j) { const int k0 = 4 * lane + 256 * j; const f32x4 g = *(const LAS f32x4*)(gm + v * 1024 + k0), s = *(const LAS f32x4*)(sh + v * 1024 + k0);
            u32x2 w; w.x = cvt_pk_bf16(x[j][0] * rstd * g[0] + s[0], x[j][1] * rstd * g[1] + s[1]); w.y = cvt_pk_bf16(x[j][2] * rstd * g[2] + s[2], x[j][3] * rstd * g[3] + s[3]);
            *(u32x2*)(dst + k0) = w; }
    }
}

struct OrderIn {
    const char* A; const char* B; int G, c;
    DI bool next(int i, Unit& u) const { int pm, pn; if (!pg8::static_tile(i, G, c, NT / 256, NCOL / 256, pm, pn)) return false;
        u.pm = pm; u.pn = pn; u.A = A + (size_t)pm * 256 * 1024 * 2; u.B = B + (size_t)pn * 256 * 1024 * 2; u.aux = 0; u.bmode = pn < 4 ? 2 : 1; return true; }
    DI void offsA(const Unit&, int, const int (&R)[2], const int (&C)[2], unsigned (&v)[2][2]) const { pg8::dense_offs(1024, R, C, v); }
};
struct EpiIn {
    unsigned char* ws; bf16_t* glog; const float* bgate; const f32x2* rope;
    DI bool operator()(f32x4 (&acc)[2][2][4][2], const Unit& u, int wr, int wc, int fr, int fq) const {
        const int pn = u.pn;
        if (pn < 4) {
            bf16_t* dst = (bf16_t*)(ws + (pn < 2 ? WS_ZQ : WS_ZK)); const float sc = pn < 2 ? 1.0f : 0.08838834764831845f;
            const int half = wc >> 1, f0 = 16 * (wc & 1) + 4 * fq;
#pragma unroll
            EPI_LOOP_ROWS { const int row = u.pm * 256 + ai * 128 + wr * 64 + m * 16 + fr; const int t = row & (SEQ - 1); const int pos = half ? 256 + (t & 63) : (t >> 6);
                const f32x2* tb = rope + pos * 32 + f0; f32x2 cs[4];
#pragma unroll
                for (int j = 0; j < 4; ++j) cs[j] = tb[j];
#pragma unroll
                for (int bj = 0; bj < 2; ++bj) { const f32x4 x1 = acc[ai][bj][m][0], x2 = acc[ai][bj][m][1]; float o1[4], o2[4];
#pragma unroll
                    for (int j = 0; j < 4; ++j) { o1[j] = (x1[j] * cs[j][0] - x2[j] * cs[j][1]) * sc; o2[j] = (x1[j] * cs[j][1] + x2[j] * cs[j][0]) * sc; }
                    bf16_t* p = dst + (size_t)row * 512 + (pn & 1) * 256 + bj * 128 + 64 * half + f0;
                    u32x2 w1, w2; w1.x = cvt_pk_bf16(o1[0], o1[1]); w1.y = cvt_pk_bf16(o1[2], o1[3]); w2.x = cvt_pk_bf16(o2[0], o2[1]); w2.y = cvt_pk_bf16(o2[2], o2[3]);
                    *(u32x2*)p = w1; *(u32x2*)(p + 32) = w2; } }
            return false;
        }
        int act, ldd, cb; bf16_t* dst;
        if (pn < 8) { dst = (bf16_t*)(ws + WS_ZV); act = 0; ldd = 1024; cb = (pn - 4) * 256; }
        else if (pn < 12) { dst = (bf16_t*)(ws + WS_ZG); act = 1; ldd = 1024; cb = (pn - 8) * 256; }
        else if (pn < 16) { dst = (bf16_t*)(ws + WS_ZXL); act = 0; ldd = 1024; cb = (pn - 12) * 256; }
        else if (pn < 20) { dst = (bf16_t*)(ws + WS_ZGL); act = 2; ldd = 1024; cb = (pn - 16) * 256; }
        else { dst = glog; act = 3; ldd = 2048; cb = (pn - 20) * 256; }
#pragma unroll
        for (int bj = 0; bj < 2; ++bj) { const int col = cb + bj * 128 + wc * 32 + 8 * fq; f32x4 b0 = (f32x4){0.f, 0.f, 0.f, 0.f}, b1 = b0;
            if (act == 3) { b0 = *(const f32x4*)(bgate + col); b1 = *(const f32x4*)(bgate + col + 4); }
#pragma unroll
            EPI_LOOP_ROWS { const int row = u.pm * 256 + ai * 128 + wr * 64 + m * 16 + fr; f32x4 v0 = acc[ai][bj][m][0] + b0, v1 = acc[ai][bj][m][1] + b1;
                if (act == 1) {
#pragma unroll
                    for (int j = 0; j < 4; ++j) { v0[j] = silu_(v0[j]); v1[j] = silu_(v1[j]); } }
                if (act == 2) {
#pragma unroll
                    for (int j = 0; j < 4; ++j) { v0[j] = gelu_tanh(v0[j]); v1[j] = gelu_tanh(v1[j]); } }
                u32x4 w; w.x = cvt_pk_bf16(v0[0], v0[1]); w.y = cvt_pk_bf16(v0[2], v0[3]); w.z = cvt_pk_bf16(v1[0], v1[1]); w.w = cvt_pk_bf16(v1[2], v1[3]);
                *(u32x4*)(dst + (size_t)row * ldd + col) = w; } }
        return false;
    }
};

constexpr int R1_RSV = 576, R1_RSK = 320;
DI void r1_unit(LAS unsigned char* lds, const bf16_t* kp, int kld, const bf16_t* vp, int vld, int nrows, float lg2, int dir, float* outp) {
    const int tid = tid_fresh(), lane = tid & 63, wid = tid >> 6, h = lane >> 5;
    LAS unsigned char* Vt = lds; LAS unsigned char* Kw = lds + 64 * R1_RSV;
    const int mh = wid >> 2, nb = wid & 3;
    f32x16 acc[4];
#pragma unroll
    for (int mi = 0; mi < 4; ++mi) acc[mi] = zero16();
    const unsigned lb = (unsigned)((8 * h + ((lane & 15) >> 2))) , blk = (lane >> 4) & 1, p = lane & 3;
    const unsigned lbV = (unsigned)(size_t)Vt + lb * R1_RSV + 32 * blk + 8 * p + (128 * mh) * 2;
    const unsigned lbK = (unsigned)(size_t)Kw + lb * R1_RSK + 32 * blk + 8 * p + (32 * nb) * 2;
    for (int ch = 0; ch < nrows / 64; ++ch) {
        __syncthreads();
#pragma unroll
        for (int i = 0; i < 4; ++i) { const int pid = tid + 512 * i, row = pid >> 5, c16 = pid & 31;
            const u32x4 v = *(const u32x4*)(vp + (size_t)(64 * ch + row) * vld + c16 * 8); *(LAS u32x4*)(Vt + row * R1_RSV + c16 * 16) = v; }
#pragma unroll
        for (int i = 0; i < 2; ++i) { const int pid = tid + 512 * i, row = pid >> 4, c16 = pid & 15; const int jj = 64 * ch + row;
            const u32x4 kv = *(const u32x4*)(kp + (size_t)jj * kld + c16 * 8);
            const float w = ex2(lg2 * (float)(dir ? jj : nrows - 1 - jj));
            u32x4 o;
#pragma unroll
            for (int e = 0; e < 4; ++e) { const float lo = __uint_as_float(kv[e] << 16), hi = __uint_as_float(kv[e] & 0xffff0000u); o[e] = cvt_pk_bf16(lo * w, hi * w); }
            *(LAS u32x4*)(Kw + row * R1_RSK + c16 * 16) = o; }
        __syncthreads();
#pragma unroll
        for (int ks = 0; ks < 4; ++ks) {
            bf16x8 av[4]; tr_frag4<0, 64, 4 * R1_RSV>(lbV + ks * 16 * R1_RSV, av[0], av[1], av[2], av[3]);
            const bf16x8 bw = tr_frag<0, 4 * R1_RSK>(lbK + ks * 16 * R1_RSK);
#pragma unroll
            for (int mi = 0; mi < 4; ++mi) acc[mi] = MFMA32(av[mi], bw, acc[mi]);
        }
    }
    const int c = lane & 31;
    float* ob = outp + (size_t)(128 * mh + 4 * h) * 128 + 32 * nb + c;
#pragma unroll
    for (int mi = 0; mi < 4; ++mi)
#pragma unroll
        for (int i = 0; i < 16; ++i) ob[(32 * mi + (i & 3) + 8 * (i >> 2)) * 128] = acc[mi][i];
}

template <bool FULL, int DIR>
DI void lru_scan(const KArgs& a, f32x16 (&acc)[2][2], LAS float* hfb, int b, int tile, int t0, int nq, int gc, bool is_ctx) {
    const int lane = tid_fresh() & 63, h = lane >> 5, c = lane & 31;
    float sA[8], sU[8];
#pragma unroll
    for (int s = 0; s < 8; ++s) { const int mb = s >> 2, g = s & 3; float A = 1.f, U = 0.f;
#pragma unroll
        for (int e = 0; e < 4; ++e) { const int i = 4 * g + (DIR == 0 ? e : 3 - e); U = acc[0][mb][i] * U + acc[1][mb][i]; A *= acc[0][mb][i]; }
        sA[s] = A; sU[s] = U; }
    float pA[8], pU[8];
#pragma unroll
    for (int s = 0; s < 8; ++s) { pA[s] = __shfl_xor(sA[s], 32); pU[s] = __shfl_xor(sU[s], 32); }
    const int slot = is_ctx ? (DIR == 0 ? tile : 3 - tile) : (DIR == 0 ? 4 + tile : 4 + (NLT - 1 - tile));
    const size_t chain = ((size_t)(b * 2 + DIR) * 1024 + gc) * NSLOT + slot;
    const bool first = (h == (DIR == 0 ? 0 : 1));
    if (!FULL) {
        float A = 1.f, U = 0.f;
#pragma unroll
        for (int q = 0; q < 8; ++q) { const int s = DIR == 0 ? q : 7 - q;
            const float A1 = first ? sA[s] : pA[s], U1 = first ? sU[s] : pU[s], A2 = first ? pA[s] : sA[s], U2 = first ? pU[s] : sU[s];
            U = A1 * U + U1; A *= A1; U = A2 * U + U2; A *= A2; }
        if (h == 0) ((f32x2*)(a.ws + WS_LAGG))[chain] = (f32x2){A, U};
    } else {
        float H = ((const float*)(a.ws + WS_LHIN))[chain];
        float st[8];
#pragma unroll
        for (int q = 0; q < 8; ++q) { const int s = DIR == 0 ? q : 7 - q;
            const float A1 = first ? sA[s] : pA[s], U1 = first ? sU[s] : pU[s], A2 = first ? pA[s] : sA[s], U2 = first ? pU[s] : sU[s];
            const float Hm = A1 * H + U1; st[s] = first ? H : Hm; H = A2 * Hm + U2; }
#pragma unroll
        for (int s = 0; s < 8; ++s) { const int mb = s >> 2, g = s & 3; float hv = st[s];
#pragma unroll
            for (int e = 0; e < 4; ++e) { const int i = 4 * g + (DIR == 0 ? e : 3 - e); hv = acc[0][mb][i] * hv + acc[1][mb][i]; acc[1][mb][i] = hv; } }
        if (DIR == 0) {
#pragma unroll
            for (int mb = 0; mb < 2; ++mb)
#pragma unroll
                for (int i = 0; i < 16; ++i) hfb[(32 * mb + crow(i, h)) * 132 + 32 * nq + c] = acc[1][mb][i];
        }
    }
}

constexpr int LX_RS = 272;
template <bool FULL>
DI void lru_unit(const KArgs& a, LAS unsigned char* lds, int b, int tile, int n, bool is_ctx) {
    const int tid = tid_fresh(), lane = tid & 63, wid = __builtin_amdgcn_readfirstlane(tid >> 6), h = lane >> 5, c = lane & 31;
    LAS unsigned char* xcb = lds;
    LAS float* xc32 = (LAS float*)(lds + 64 * LX_RS);
    LAS float* hfb = xc32 + 64 * 132;
    const int Ls = is_ctx ? CTXL : SEQ, t0 = tile * LT;
    const bf16_t* xl = is_ctx ? (const bf16_t*)(a.ws + WS_CTXX) + (size_t)(b * CTXL) * 1024 + 128 * n : (const bf16_t*)(a.ws + WS_ZXL) + (size_t)(b * SEQ) * 1024 + 128 * n;
    __syncthreads();
    {
        const int row = tid >> 3, c0 = (tid & 7) * 16; float o[16];
#pragma unroll
        for (int j = 0; j < 16; ++j) o[j] = a.in[I_CONVB][128 * n + c0 + j];
#pragma unroll
        for (int k = 0; k < 4; ++k) { const int t = t0 + row + k - 1; if (t >= 0 && t < Ls) {
                const u32x4 p0 = *(const u32x4*)(xl + (size_t)t * 1024 + c0), p1 = *(const u32x4*)(xl + (size_t)t * 1024 + c0 + 8);
                const float* cw = a.in[I_CONVW] + k * 1024 + 128 * n + c0;
#pragma unroll
                for (int e = 0; e < 4; ++e) { o[2 * e] += cw[2 * e] * __uint_as_float(p0[e] << 16); o[2 * e + 1] += cw[2 * e + 1] * __uint_as_float(p0[e] & 0xffff0000u);
                    o[8 + 2 * e] += cw[8 + 2 * e] * __uint_as_float(p1[e] << 16); o[8 + 2 * e + 1] += cw[8 + 2 * e + 1] * __uint_as_float(p1[e] & 0xffff0000u); } } }
        u32x4 w0, w1;
#pragma unroll
        for (int e = 0; e < 4; ++e) { w0[e] = cvt_pk_bf16(o[2 * e], o[2 * e + 1]); w1[e] = cvt_pk_bf16(o[8 + 2 * e], o[8 + 2 * e + 1]); }
        *(LAS u32x4*)(xcb + row * LX_RS + c0 * 2) = w0; *(LAS u32x4*)(xcb + row * LX_RS + c0 * 2 + 16) = w1;
#pragma unroll
        for (int j = 0; j < 16; j += 4) *(LAS f32x4*)(xc32 + row * 132 + c0 + j) = (f32x4){o[j], o[j + 1], o[j + 2], o[j + 3]};
    }
    __syncthreads();
    const int dir = wid >> 2, nq = wid & 3, gc = 128 * n + 32 * nq + c;
    f32x16 acc[2][2];
#pragma unroll
    for (int q = 0; q < 2; ++q) for (int mb = 0; mb < 2; ++mb) acc[q][mb] = zero16();
    const bf16_t* wa = (const bf16_t*)(a.ws + WS_WLB) + (size_t)((2 * dir) * 8 + n) * 128 * 128 + (size_t)(32 * nq + c) * 128 + 8 * h;
    const bf16_t* wx = wa + (size_t)8 * 128 * 128;
#pragma unroll
    for (int ks = 0; ks < 8; ++ks) {
        const bf16x8 ba = *(const bf16x8*)(wa + 16 * ks), bx = *(const bf16x8*)(wx + 16 * ks);
        const bf16x8 a0 = *(const LAS bf16x8*)(xcb + c * LX_RS + (16 * ks + 8 * h) * 2), a1 = *(const LAS bf16x8*)(xcb + (32 + c) * LX_RS + (16 * ks + 8 * h) * 2);
        acc[0][0] = MFMA32(a0, ba, acc[0][0]); acc[0][1] = MFMA32(a1, ba, acc[0][1]); acc[1][0] = MFMA32(a0, bx, acc[1][0]); acc[1][1] = MFMA32(a1, bx, acc[1][1]);
    }
    const float ba2 = -LOG2E * a.in[I_LBA][dir * 1024 + gc], bx2 = -LOG2E * a.in[I_LBX][dir * 1024 + gc];
    const float cl = -8.0f * softplus_(-a.in[I_LLAM][dir * 1024 + gc]) * LOG2E;
#pragma unroll
    for (int mb = 0; mb < 2; ++mb)
#pragma unroll
        for (int i = 0; i < 16; ++i) { const int row = 32 * mb + crow(i, h);
            const float r = rcpf_(1.0f + ex2(acc[0][mb][i] + ba2)), ig = rcpf_(1.0f + ex2(acc[1][mb][i] + bx2));
            const float av = ex2(cl * r); const float s = sqrtf(fmaxf(1.0f - av * av, 0.f));
            acc[0][mb][i] = av; acc[1][mb][i] = s * ig * xc32[row * 132 + 32 * nq + c]; }
    if (dir == 0) lru_scan<FULL, 0>(a, acc, hfb, b, tile, t0, nq, gc, is_ctx);
    else lru_scan<FULL, 1>(a, acc, hfb, b, tile, t0, nq, gc, is_ctx);
    if (FULL) {
        __syncthreads();
        if (dir == 1) {
            bf16_t* gl = (bf16_t*)(a.ws + WS_ZGL) + (size_t)(b * SEQ + t0) * 1024 + gc;
#pragma unroll
            for (int mb = 0; mb < 2; ++mb)
#pragma unroll
                for (int i = 0; i < 16; ++i) { const int row = 32 * mb + crow(i, h); const float tot = acc[1][mb][i] + hfb[row * 132 + 32 * nq + c];
                    gl[(size_t)row * 1024] = f2bf(tot * bf2f(gl[(size_t)row * 1024])); }
        }
    }
}

DI void ret_decays(const KArgs& a, int h, float& lgf2, float& lgb2) {
    lgf2 = -softplus_(-a.in[I_RDECAY][h]) * LOG2E; lgb2 = -softplus_(-a.in[I_RDECAY][4 + h]) * LOG2E;
}

DI void phase2a(const KArgs& a, LAS unsigned char* lds) {
    const int G = gridDim.x;
    constexpr int NU_R1 = NB_ * NH * NSC * 2, NU_CK = NB_ * NH * 2, NU_LX = NB_ * NLT * 8, NU_LC = NB_ * 4 * 8;
    for (int u = blockIdx.x; u < NU_R1 + NU_CK + NU_LX + NU_LC; u += G) {
        if (SUBSEL(1) && u < NU_R1) {
            const int dir = u & 1, sc = (u >> 1) & 31, h = (u >> 6) & 3, b = u >> 8; float lgf2, lgb2; ret_decays(a, h, lgf2, lgb2);
            float* o = (float*)(a.ws + WS_HX) + (size_t)(((b * 4 + h) * 32 + sc) * 2 + dir) * 32768;
            r1_unit(lds, (const bf16_t*)(a.ws + WS_ZK) + (size_t)(b * SEQ + sc * SCH) * 512 + h * 128, 512, (const bf16_t*)(a.ws + WS_ZV) + (size_t)(b * SEQ + sc * SCH) * 1024 + h * 256, 1024, SCH, dir ? lgb2 : lgf2, dir, o);
        } else if (SUBSEL(1) && u < NU_R1 + NU_CK) {
            const int q = u - NU_R1, dir = q & 1, h = (q >> 1) & 3, b = q >> 3; float lgf2, lgb2; ret_decays(a, h, lgf2, lgb2);
            float* o = (float*)(a.ws + WS_CTXS) + (size_t)((b * 4 + h) * 2 + dir) * 32768;
            r1_unit(lds, (const bf16_t*)(a.ws + WS_CTXK) + (size_t)(b * CTXL) * 512 + h * 128, 512, (const bf16_t*)(a.ws + WS_CTXV) + (size_t)(b * CTXL) * 1024 + h * 256, 1024, CTXL, dir ? lgb2 : lgf2, dir, o);
        } else if (SUBSEL(2) && u < NU_R1 + NU_CK + NU_LX) {
            const int q = u - NU_R1 - NU_CK, b = q / (NLT * 8), tile = (q / 8) % NLT, n = q & 7;
            lru_unit<false>(a, lds, b, tile, n, false);
        } else if (SUBSEL(2)) {
            const int q = u - NU_R1 - NU_CK - NU_LX, b = q >> 5, tile = (q >> 3) & 3, n = q & 7;
            lru_unit<false>(a, lds, b, tile, n, true);
        }
    }
}

DI void phase2b(const KArgs& a) {
    const int tid = tid_fresh(), G = gridDim.x, lane = tid & 63, wid = tid >> 6;
    for (int e = blockIdx.x * 512 + tid; e < NB_ * NH * 2 * 8192; e += G * 512) {
        const int e4 = e & 8191, dir = (e >> 13) & 1, h = (e >> 14) & 3, b = e >> 16;
        float lgf2, lgb2; ret_decays(a, h, lgf2, lgb2); const float gC = ex2((dir ? lgb2 : lgf2) * (float)SCH);
        f32x4 S = *(const f32x4*)((const float*)(a.ws + WS_CTXS) + (size_t)((b * 4 + h) * 2 + dir) * 32768 + 4 * e4);
        const float* kv = (const float*)(a.ws + WS_HX) + (size_t)((b * 4 + h) * 32 * 2 + dir) * 32768 + 4 * e4;
        bf16_t* so = (bf16_t*)(a.ws + WS_SBF) + (size_t)((b * 4 + h) * 32 * 2 + dir) * 32768 + 4 * e4;
        for (int s0 = 0; s0 < NSC; s0 += 8) {
            f32x4 kvv[8];
#pragma unroll
            for (int j = 0; j < 8; ++j) { const int sc = dir ? NSC - 1 - (s0 + j) : s0 + j; kvv[j] = *(const f32x4*)(kv + (size_t)sc * 65536); }
#pragma unroll
            for (int j = 0; j < 8; ++j) { const int sc = dir ? NSC - 1 - (s0 + j) : s0 + j;
                u32x2 w; w.x = cvt_pk_bf16(S[0], S[1]); w.y = cvt_pk_bf16(S[2], S[3]); *(u32x2*)(so + (size_t)sc * 65536) = w;
                S = S * gC + kvv[j]; }
        }
    }
    for (int ch = blockIdx.x * 8 + wid; ch < NB_ * 2 * 1024; ch += G * 8) {
        const f32x2* ag = (const f32x2*)(a.ws + WS_LAGG) + (size_t)ch * NSLOT; float* hin = (float*)(a.ws + WS_LHIN) + (size_t)ch * NSLOT;
        float carry = 0.f;
        for (int rd = 0; rd < 5; ++rd) { const int slot = 64 * rd + lane;
            f32x2 v = (f32x2){1.f, 0.f}; if (slot < 4 + NLT) v = ag[slot];
            float A = v[0], U = v[1];
#pragma unroll
            for (int o = 1; o < 64; o <<= 1) { const float Ap = __shfl_up(A, o), Up = __shfl_up(U, o); if (lane >= o) { U = A * Up + U; A = A * Ap; } }
            const float incl = A * carry + U;
            float excl = __shfl_up(incl, 1); if (lane == 0) excl = carry;
            if (slot < 4 + NLT) hin[slot] = excl;
            carry = __shfl(incl, 63);
        }
    }
}

constexpr int R3_RSQ = 272, R3_RSK = 272, R3_RSV = 576, R3_RSP = 144;
DI void r3_unit(const KArgs& a, LAS unsigned char* lds, int b, int hh, int qb) {
    const int tid = tid_fresh(), lane = tid & 63, wid = tid >> 6, h = lane >> 5, c = lane & 31;
    LAS unsigned char* Qs = lds; LAS unsigned char* Ks = Qs + 128 * R3_RSQ; LAS unsigned char* Vs = Ks + 64 * R3_RSK; LAS unsigned char* Ps = Vs + 64 * R3_RSV;
    LAS float* red = (LAS float*)(Ps + 128 * R3_RSP);
    const int sc = qb >> 2, blk = qb & 3;
    float lgf2, lgb2; ret_decays(a, hh, lgf2, lgb2);
    const size_t tok0 = (size_t)b * SEQ + 128 * qb, tokS = (size_t)b * SEQ + SCH * sc;
    __syncthreads();
#pragma unroll
    for (int i = 0; i < 4; ++i) { const int pid = tid + 512 * i, row = pid >> 4, c16 = pid & 15;
        *(LAS u32x4*)(Qs + row * R3_RSQ + c16 * 16) = *(const u32x4*)((const bf16_t*)(a.ws + WS_ZQ) + (tok0 + row) * 512 + hh * 128 + c16 * 8); }
    __syncthreads();
    const int rb = wid >> 1, dvh = wid & 1;
    f32x16 O[4];
    {
#pragma unroll
        for (int nb = 0; nb < 4; ++nb) O[nb] = zero16();
#pragma unroll 1
        for (int d = 0; d < 2; ++d) {
            const bf16_t* Sg = (const bf16_t*)(a.ws + WS_SBF) + (size_t)(((b * 4 + hh) * 32 + sc) * 2 + d) * 32768 + (size_t)(128 * dvh + c) * 128 + 8 * h;
            f32x16 tmp[4];
#pragma unroll
            for (int nb = 0; nb < 4; ++nb) tmp[nb] = zero16();
#pragma unroll 2
            for (int ks = 0; ks < 8; ++ks) { const bf16x8 af = *(const LAS bf16x8*)(Qs + (32 * rb + c) * R3_RSQ + (16 * ks + 8 * h) * 2);
#pragma unroll
                for (int nb = 0; nb < 4; ++nb) { const bf16x8 bfr = *(const bf16x8*)(Sg + (size_t)(32 * nb) * 128 + 16 * ks); tmp[nb] = MFMA32(af, bfr, tmp[nb]); } }
            const float lg = d ? lgb2 : lgf2; const float e0 = d ? (float)(SCH - 128 * blk - 32 * rb - 4 * h) : (float)(128 * blk + 32 * rb + 4 * h + 1), sg = d ? -1.f : 1.f;
#pragma unroll
            for (int i = 0; i < 16; ++i) { const float dec = ex2(lg * (e0 + sg * (float)((i & 3) + 8 * (i >> 2))));
#pragma unroll
                for (int nb = 0; nb < 4; ++nb) O[nb][i] += dec * tmp[nb][i]; }
        }
    }
    const unsigned lb = (unsigned)(8 * h + ((lane & 15) >> 2)), tb = (lane >> 4) & 1, tp = lane & 3;
    const unsigned lbV = (unsigned)(size_t)Vs + lb * R3_RSV + 32 * tb + 8 * tp + (128 * dvh) * 2;
    const int jbk = wid & 1, ib = wid >> 1;
    for (int jb = 0; jb < 8; ++jb) {
        u32x4 kreg[2], vreg[4];
#pragma unroll
        for (int i = 0; i < 2; ++i) { const int pid = tid + 512 * i, row = pid >> 4, c16 = pid & 15; kreg[i] = *(const u32x4*)((const bf16_t*)(a.ws + WS_ZK) + (tokS + 64 * jb + row) * 512 + hh * 128 + c16 * 8); }
#pragma unroll
        for (int i = 0; i < 4; ++i) { const int pid = tid + 512 * i, row = pid >> 5, c16 = pid & 31; vreg[i] = *(const u32x4*)((const bf16_t*)(a.ws + WS_ZV) + (tokS + 64 * jb + row) * 1024 + hh * 256 + c16 * 8); }
        __syncthreads();
#pragma unroll
        for (int i = 0; i < 2; ++i) { const int pid = tid + 512 * i, row = pid >> 4, c16 = pid & 15; *(LAS u32x4*)(Ks + row * R3_RSK + c16 * 16) = kreg[i]; }
#pragma unroll
        for (int i = 0; i < 4; ++i) { const int pid = tid + 512 * i, row = pid >> 5, c16 = pid & 31; *(LAS u32x4*)(Vs + row * R3_RSV + c16 * 16) = vreg[i]; }
        __syncthreads();
        f32x16 st = zero16();
#pragma unroll
        for (int ks = 0; ks < 8; ++ks) { const bf16x8 kf = *(const LAS bf16x8*)(Ks + (32 * jbk + c) * R3_RSK + (16 * ks + 8 * h) * 2), qf = *(const LAS bf16x8*)(Qs + (32 * ib + c) * R3_RSQ + (16 * ks + 8 * h) * 2);
            st = MFMA32(kf, qf, st); }
        {
            const int ti = 128 * blk + 32 * ib + c;
#pragma unroll
            for (int g = 0; g < 4; ++g) { float pv[4];
#pragma unroll
                for (int e = 0; e < 4; ++e) { const int tj = 64 * jb + 32 * jbk + 8 * g + 4 * h + e; const int d = ti - tj; const float w = d >= 0 ? ex2(lgf2 * (float)d) : ex2(lgb2 * (float)(-d)); pv[e] = st[4 * g + e] * w; }
                u32x2 w2; w2.x = cvt_pk_bf16(pv[0], pv[1]); w2.y = cvt_pk_bf16(pv[2], pv[3]);
                *(LAS u32x2*)(Ps + (32 * ib + c) * R3_RSP + (32 * jbk + 8 * g + 4 * h) * 2) = w2; }
        }
        __syncthreads();
#pragma unroll
        for (int ks = 0; ks < 4; ++ks) { const bf16x8 pf = *(const LAS bf16x8*)(Ps + (32 * rb + c) * R3_RSP + (16 * ks + 8 * h) * 2);
            bf16x8 vf[4]; tr_frag4<0, 64, 4 * R3_RSV>(lbV + ks * 16 * R3_RSV, vf[0], vf[1], vf[2], vf[3]);
#pragma unroll
            for (int nb = 0; nb < 4; ++nb) O[nb] = MFMA32(pf, vf[nb], O[nb]); }
    }
    float s1[16], s2[16];
#pragma unroll
    for (int i = 0; i < 16; ++i) { float x = 0.f, y = 0.f;
#pragma unroll
        for (int nb = 0; nb < 4; ++nb) { x += O[nb][i]; y += O[nb][i] * O[nb][i]; }
#pragma unroll
        for (int o = 16; o >= 1; o >>= 1) { x += __shfl_xor(x, o); y += __shfl_xor(y, o); }
        s1[i] = x; s2[i] = y; }
    if (c == 0) {
#pragma unroll
        for (int i = 0; i < 16; ++i) { const int row = 32 * rb + crow(i, h); red[(row * 2 + dvh) * 2 + 0] = s1[i]; red[(row * 2 + dvh) * 2 + 1] = s2[i]; } }
    __syncthreads();
    bf16_t* gp = (bf16_t*)(a.ws + WS_ZG) + tok0 * 1024 + hh * 256 + 128 * dvh + c;
#pragma unroll
    for (int i = 0; i < 16; ++i) { const int row = 32 * rb + crow(i, h);
        const float sx = red[(row * 2 + 0) * 2 + 0] + red[(row * 2 + 1) * 2 + 0], sy = red[(row * 2 + 0) * 2 + 1] + red[(row * 2 + 1) * 2 + 1];
        const float mu = sx * (1.0f / 256.0f), var = fmaxf(sy * (1.0f / 256.0f) - mu * mu, 0.f), rstd = rsqrtf(var + EPSV);
#pragma unroll
        for (int nb = 0; nb < 4; ++nb) { bf16_t* p = gp + (size_t)row * 1024 + 32 * nb; const float gain = a.in[I_RNORM][hh * 256 + 128 * dvh + 32 * nb + c];
            *p = f2bf((O[nb][i] - mu) * rstd * gain * bf2f(*p)); } }
}

DI void phase2c(const KArgs& a, LAS unsigned char* lds) {
    const int G = gridDim.x;
    constexpr int NU_R3 = NB_ * NH * (SEQ / 128), NU_L3 = NB_ * NLT * 8;
    for (int u = blockIdx.x; u < NU_R3 + NU_L3; u += G) {
        if (SUBSEL(1) && u < NU_R3) { const int b = u >> 9, hh = (u >> 7) & 3, qb = u & 127; r3_unit(a, lds, b, hh, qb); }
        else if (SUBSEL(2)) { const int q = u - NU_R3, b = q / (NLT * 8), tile = (q / 8) % NLT, n = q & 7; lru_unit<true>(a, lds, b, tile, n, false); }
    }
}

DI void phase3_cvt(const KArgs& a, LAS unsigned char* lds) {
    const int G = gridDim.x; LAS float* fl = (LAS float*)lds;
    constexpr int T_GU = 32 * 2 * 16 * 12, T_DN = 32 * 12 * 16;
    for (int t = blockIdx.x; t < T_GU + T_DN; t += G) {
        if (t < T_GU) { const int e = t / 384, r = t % 384, mat = r / 192, kt = (r % 192) / 12, nn = r % 12;
            const float* src = a.in[mat ? I_WEU : I_WEG] + (size_t)e * 1024 * 768 + (size_t)(64 * kt) * 768 + 64 * nn;
            bf16_t* dst = (bf16_t*)(a.ws + WS_WGU) + ((size_t)(e * 6 + (nn >> 1)) * 256 + mat * 128 + (nn & 1) * 64) * 1024 + 64 * kt;
            cvt_tile(fl, src, 768, dst, 1024, 1.f);
        } else { const int q = t - T_GU, e = q / 192, r = q % 192, kt = r / 16, nt = r % 16;
            const float* src = a.in[I_WED] + (size_t)e * 768 * 1024 + (size_t)(64 * kt) * 1024 + 64 * nt;
            bf16_t* dst = (bf16_t*)(a.ws + WS_WDN) + ((size_t)e * 1024 + 64 * nt) * 768 + 64 * kt;
            cvt_tile(fl, src, 1024, dst, 768, 1.f);
        }
    }
    __syncthreads();
}
struct OrderMerge {
    const char* A0; const char* A1; const char* B0; const char* B1; int G, c;
    DI bool next(int i, Unit& u) const { int pm, pn; if (!pg8::static_tile(i >> 1, G, c, NT / 256, 4, pm, pn)) return false;
        const int st = i & 1; u.pm = pm; u.pn = pn; u.aux = st; u.bmode = 1; u.A = (st ? A1 : A0) + (size_t)pm * 256 * 1024 * 2; u.B = (st ? B1 : B0) + (size_t)pn * 256 * 1024 * 2; return true; }
    DI void offsA(const Unit&, int, const int (&R)[2], const int (&C)[2], unsigned (&v)[2][2]) const { pg8::dense_offs(1024, R, C, v); }
};
struct EpiMerge {
    const bf16_t* glog; bf16_t* out;
    DI bool operator()(f32x4 (&acc)[2][2][4][2], const Unit& u, int wr, int wc, int fr, int fq) const {
#pragma unroll
        for (int bj = 0; bj < 2; ++bj) { const int col = u.pn * 256 + bj * 128 + wc * 32 + 8 * fq;
#pragma unroll
            EPI_LOOP_ROWS { const int row = u.pm * 256 + ai * 128 + wr * 64 + m * 16 + fr;
                const u32x4 gl = *(const u32x4*)(glog + (size_t)row * 2048 + 1024 + col);
                if (u.aux == 0) { const u32x4 gr = *(const u32x4*)(glog + (size_t)row * 2048 + col);
#pragma unroll
                    for (int e = 0; e < 4; ++e) { const float r0 = __uint_as_float(gr[e] << 16), r1 = __uint_as_float(gr[e] & 0xffff0000u), l0 = __uint_as_float(gl[e] << 16), l1 = __uint_as_float(gl[e] & 0xffff0000u);
                        const float q0 = (1.0f + ex2(-LOG2E * l0)) * rcpf_(1.0f + ex2(-LOG2E * r0)), q1 = (1.0f + ex2(-LOG2E * l1)) * rcpf_(1.0f + ex2(-LOG2E * r1));
                        acc[ai][bj][m][e >> 1][2 * (e & 1)] *= q0; acc[ai][bj][m][e >> 1][2 * (e & 1) + 1] *= q1; }
                } else { float v[8];
#pragma unroll
                    for (int e = 0; e < 4; ++e) { const float l0 = __uint_as_float(gl[e] << 16), l1 = __uint_as_float(gl[e] & 0xffff0000u);
                        v[2 * e] = acc[ai][bj][m][e >> 1][2 * (e & 1)] * sigm(l0); v[2 * e + 1] = acc[ai][bj][m][e >> 1][2 * (e & 1) + 1] * sigm(l1); }
                    u32x4 w; w.x = cvt_pk_bf16(v[0], v[1]); w.y = cvt_pk_bf16(v[2], v[3]); w.z = cvt_pk_bf16(v[4], v[5]); w.w = cvt_pk_bf16(v[6], v[7]);
                    *(u32x4*)(out + (size_t)row * 1024 + col) = w; } } }
        return u.aux == 0;
    }
};

struct OrderOut {
    const char* A; const char* B; int G, c;
    DI bool next(int i, Unit& u) const { int pm, pn; if (!pg8::static_tile(i, G, c, NT / 256, 4, pm, pn)) return false;
        u.pm = pm; u.pn = pn; u.aux = 0; u.bmode = 0; u.A = A + (size_t)pm * 256 * 1024 * 2; u.B = B + (size_t)pn * 256 * 1024 * 2; return true; }
    DI void offsA(const Unit&, int, const int (&R)[2], const int (&C)[2], unsigned (&v)[2][2]) const { pg8::dense_offs(1024, R, C, v); }
};
struct EpiOut {
    const KArgs* a;
    DI bool operator()(f32x4 (&acc)[2][2][4][2], const Unit& u, int wr, int wc, int fr, int fq) const {
        const int b = (u.pm * 256) / SEQ;
#pragma unroll
        for (int bj = 0; bj < 2; ++bj)
#pragma unroll
            for (int n = 0; n < 2; ++n) { const int col = u.pn * 256 + bj * 128 + wc * 32 + 16 * n + 4 * fq; f32x4 g;
#pragma unroll
                for (int j = 0; j < 4; ++j) g[j] = mod_val(*a, b, 2, col + j);
#pragma unroll
                EPI_LOOP_ROWS { const size_t off = (size_t)(u.pm * 256 + ai * 128 + wr * 64 + m * 16 + fr) * 1024 + col;
                    *(f32x4*)(a->out + off) = *(const f32x4*)(a->in[I_X] + off) + g * acc[ai][bj][m][n]; } }
        return false;
    }
};

DI void phase5(const KArgs& a, LAS unsigned char* lds) {
    const int tid = tid_fresh(), G = gridDim.x, lane = tid & 63, wid = tid >> 6;
    LAS float* gm = (LAS float*)lds;
    LAS float* sh = gm + 2048;
    LAS float* lg = sh + 2048;
    LAS int* lcnt = (LAS int*)(lg + 128 * 40);
    LAS int* rinfo = lcnt + 64;
    LAS float* rw = (LAS float*)(rinfo + 512);
    __syncthreads();
    for (int i = tid; i < 2048; i += 512) { const int v = i >> 10, k = i & 1023; gm[i] = a.in[I_NORM2][k] * (1.0f + mod_val(a, v, 4, k)); sh[i] = mod_val(a, v, 3, k); }
    if (blockIdx.x == 0) for (int i = tid; i < 512; i += 512) ((unsigned*)(a.ws + WS_HX2) + (size_t)NT * 512)[i] = 0u;
    bf16_t* hx2 = (bf16_t*)(a.ws + WS_HX2);
    int* cnt = (int*)(a.ws + WS_CTL) + CW_CNT;
    for (int rt = blockIdx.x; rt < NT / 128; rt += G) {
        __syncthreads();
        if (tid < 32) lcnt[tid] = 0;
        for (int rr = 0; rr < 16; ++rr) { const int row = 128 * rt + 16 * wid + rr; const int v = row / SEQ; const float* xr = a.out + (size_t)row * 1024; f32x4 x[4]; float ss = 0.f;
#pragma unroll
            for (int j = 0; j < 4; ++j) { x[j] = *(const f32x4*)(xr + 4 * lane + 256 * j); ss += (x[j][0] * x[j][0] + x[j][1] * x[j][1]) + (x[j][2] * x[j][2] + x[j][3] * x[j][3]); }
#pragma unroll
            for (int o = 32; o >= 1; o >>= 1) ss += __shfl_xor(ss, o);
            const float rstd = rsqrtf(ss * (1.0f / 1024.0f) + EPSV);
#pragma unroll
            for (int j = 0; j < 4; ++j) { const int k0 = 4 * lane + 256 * j; const f32x4 g = *(const LAS f32x4*)(gm + v * 1024 + k0), s = *(const LAS f32x4*)(sh + v * 1024 + k0);
                u32x2 w; w.x = cvt_pk_bf16(x[j][0] * rstd * g[0] + s[0], x[j][1] * rstd * g[1] + s[1]); w.y = cvt_pk_bf16(x[j][2] * rstd * g[2] + s[2], x[j][3] * rstd * g[3] + s[3]);
                *(u32x2*)(hx2 + (size_t)row * 1024 + k0) = w; } }
        __syncthreads();
        {
            const int rb = wid >> 1, cb = wid & 1, r = lane & 31, h = lane >> 5;
            const bf16_t* ar = hx2 + (size_t)(128 * rt + 32 * rb + r) * 1024 + 8 * h;
            const bf16_t* bh = (const bf16_t*)(a.ws + WS_WRH) + (size_t)(32 * cb + r) * 1024 + 8 * h; const bf16_t* bl = bh + 64 * 1024;
            f32x16 acc = zero16();
            for (int ks = 0; ks < 64; ++ks) { const bf16x8 af = *(const bf16x8*)(ar + 16 * ks), b1 = *(const bf16x8*)(bh + 16 * ks), b2 = *(const bf16x8*)(bl + 16 * ks);
                acc = MFMA32(af, b1, acc); acc = MFMA32(af, b2, acc); }
            const int col = 32 * cb + r;
            if (col < 36) {
#pragma unroll
                for (int i = 0; i < 16; ++i) lg[(32 * rb + crow(i, h)) * 40 + col] = acc[i]; }
        }
        __syncthreads();
        if (tid < 128) { const LAS float* l = lg + tid * 40;
            int gs = 0; float best = l[0] + a.in[I_BGRP][0];
#pragma unroll
            for (int g = 1; g < 4; ++g) { const float v = l[g] + a.in[I_BGRP][g]; if (v > best) { best = v; gs = g; } }
            const float mx = fmaxf(fmaxf(l[0], l[1]), fmaxf(l[2], l[3])); float den = 0.f;
#pragma unroll
            for (int g = 0; g < 4; ++g) den += expf(l[g] - mx);
            const float pg = expf(l[gs] - mx) / den;
            int i0 = 0, i1 = -1; float v0 = -3.0e38f, v1 = -3.0e38f;
#pragma unroll
            for (int e = 0; e < 8; ++e) { const float v = l[4 + 8 * gs + e] + a.in[I_BRT][8 * gs + e];
                if (v > v0) { v1 = v0; i1 = i0; v0 = v; i0 = e; } else if (v > v1) { v1 = v; i1 = e; } }
            const float e0 = l[4 + 8 * gs + i0], e1 = l[4 + 8 * gs + i1], m2 = fmaxf(e0, e1), x0 = expf(e0 - m2), x1 = expf(e1 - m2), inv = 1.0f / (x0 + x1);
            const int ex0 = 8 * gs + i0, ex1 = 8 * gs + i1;
            rinfo[tid * 4 + 0] = ex0; rinfo[tid * 4 + 1] = atomicAdd((int*)&lcnt[ex0], 1); rinfo[tid * 4 + 2] = ex1; rinfo[tid * 4 + 3] = atomicAdd((int*)&lcnt[ex1], 1);
            rw[tid * 2 + 0] = pg * x0 * inv; rw[tid * 2 + 1] = pg * x1 * inv; }
        __syncthreads();
        if (tid < 32) lcnt[32 + tid] = lcnt[tid] ? atomicAdd(&cnt[tid], lcnt[tid]) : 0;
        __syncthreads();
        if (tid < 128) { const int tok = 128 * rt + tid; const int e0 = rinfo[tid * 4 + 0], s0 = lcnt[32 + e0] + rinfo[tid * 4 + 1], e1 = rinfo[tid * 4 + 2], s1 = lcnt[32 + e1] + rinfo[tid * 4 + 3];
            int* ptok = (int*)(a.ws + WS_PTOK); ptok[(size_t)e0 * 65536 + s0] = tok; ptok[(size_t)e1 * 65536 + s1] = tok;
            unsigned* ro = (unsigned*)(a.ws + WS_ROUTE) + (size_t)tok * 8; ro[0] = e0; ro[1] = s0; ro[2] = e1; ro[3] = s1; ro[4] = __float_as_uint(rw[tid * 2]); ro[5] = __float_as_uint(rw[tid * 2 + 1]); }
    }
}

DI void moe_tiles(const KArgs& a, LAS int* tt) {
    __syncthreads();
    if (threadIdx.x == 0) { const int* cnt = (const int*)(a.ws + WS_CTL) + CW_CNT; int s = 0; for (int e = 0; e < 32; ++e) { tt[e] = s; s += (cnt[e] + 255) >> 8; } tt[32] = s; }
    __syncthreads();
}
DI int moe_expert(const LAS int* tt, int rt) { int e = 0;
#pragma unroll
    for (int q = 16; q >= 1; q >>= 1) if (tt[e + q] <= rt) e += q;
    return e; }
struct OrderMoe1 {
    const char* A; const char* B; const LAS int* tt; const LAS int* tok; int G, c;
    DI bool next(int i, Unit& u) const { const int L = i * G + c; if (L >= tt[32] * 6) return false; const int rt = L / 6, ct = L % 6, e = moe_expert(tt, rt);
        u.pm = rt; u.pn = ct; u.aux = e; u.bmode = 1; u.A = A; u.B = B + (size_t)(e * 6 + ct) * 256 * 1024 * 2; return true; }
    DI void offsA(const Unit&, int ui, const int (&R)[2], const int (&C)[2], unsigned (&v)[2][2]) const {
#pragma unroll
        for (int h = 0; h < 2; ++h)
#pragma unroll
            for (int i = 0; i < 2; ++i) v[h][i] = (unsigned)tok[ui * 256 + h * 128 + R[i]] * 2048u + (unsigned)C[i] * 2u; }
};
struct EpiMoe1 {
    bf16_t* hid;
    DI bool operator()(f32x4 (&acc)[2][2][4][2], const Unit& u, int wr, int wc, int fr, int fq) const {
        const int col = u.pn * 128 + wc * 32 + 8 * fq;
#pragma unroll
        EPI_LOOP_ROWS { const size_t row = (size_t)u.pm * 256 + ai * 128 + wr * 64 + m * 16 + fr; float v[8];
#pragma unroll
            for (int n = 0; n < 2; ++n)
#pragma unroll
                for (int j = 0; j < 4; ++j) v[4 * n + j] = silu_(acc[ai][0][m][n][j]) * acc[ai][1][m][n][j];
            u32x4 w; w.x = cvt_pk_bf16(v[0], v[1]); w.y = cvt_pk_bf16(v[2], v[3]); w.z = cvt_pk_bf16(v[4], v[5]); w.w = cvt_pk_bf16(v[6], v[7]);
            *(u32x4*)(hid + row * 768 + col) = w; }
        return false;
    }
};
struct OrderMoe2 {
    const char* A; const char* B; const LAS int* tt; int G, c;
    DI bool next(int i, Unit& u) const { const int L = i * G + c; if (L >= tt[32] * 4) return false; const int rt = L >> 2, ct = L & 3, e = moe_expert(tt, rt);
        u.pm = rt; u.pn = ct; u.aux = e; u.bmode = 1; u.A = A + (size_t)rt * 256 * 768 * 2; u.B = B + ((size_t)e * 1024 + 256 * ct) * 768 * 2; return true; }
    DI void offsA(const Unit&, int, const int (&R)[2], const int (&C)[2], unsigned (&v)[2][2]) const { pg8::dense_offs(768, R, C, v); }
};
struct EpiMoe2 {
    bf16_t* ye;
    DI bool operator()(f32x4 (&acc)[2][2][4][2], const Unit& u, int wr, int wc, int fr, int fq) const {
#pragma unroll
        for (int bj = 0; bj < 2; ++bj) { const int col = u.pn * 256 + bj * 128 + wc * 32 + 8 * fq;
#pragma unroll
            EPI_LOOP_ROWS { const size_t row = (size_t)u.pm * 256 + ai * 128 + wr * 64 + m * 16 + fr; const f32x4 v0 = acc[ai][bj][m][0], v1 = acc[ai][bj][m][1];
                u32x4 w; w.x = cvt_pk_bf16(v0[0], v0[1]); w.y = cvt_pk_bf16(v0[2], v0[3]); w.z = cvt_pk_bf16(v1[0], v1[1]); w.w = cvt_pk_bf16(v1[2], v1[3]);
                *(u32x4*)(ye + row * 1024 + col) = w; } }
        return false;
    }
};

DI void phase8(const KArgs& a, LAS unsigned char* lds) {
    const int tid = tid_fresh(), G = gridDim.x, lane = tid & 63, wid = tid >> 6;
    LAS float* g2 = (LAS float*)lds;
    LAS int* tt = (LAS int*)(g2 + 2048);
    moe_tiles(a, tt);
    for (int i = tid; i < 2048; i += 512) g2[i] = mod_val(a, i >> 10, 5, i & 1023);
    __syncthreads();
    const bf16_t* ye = (const bf16_t*)(a.ws + WS_YE);
    for (int row = blockIdx.x * 8 + wid; row < NT; row += G * 8) {
        const int v = row / SEQ; const unsigned* ro = (const unsigned*)(a.ws + WS_ROUTE) + (size_t)row * 8;
        const size_t p0 = (size_t)tt[ro[0]] * 256 + ro[1], p1 = (size_t)tt[ro[2]] * 256 + ro[3]; const float w0 = __uint_as_float(ro[4]), w1 = __uint_as_float(ro[5]);
        float* xr = a.out + (size_t)row * 1024; f32x4 x[4]; float ss = 0.f;
#pragma unroll
        for (int j = 0; j < 4; ++j) { const int k0 = 4 * lane + 256 * j; x[j] = *(const f32x4*)(xr + k0);
            const u32x2 ya = *(const u32x2*)(ye + p0 * 1024 + k0), yb = *(const u32x2*)(ye + p1 * 1024 + k0); const f32x4 g = *(const LAS f32x4*)(g2 + v * 1024 + k0);
            x[j][0] += g[0] * (w0 * __uint_as_float(ya[0] << 16) + w1 * __uint_as_float(yb[0] << 16)); x[j][1] += g[1] * (w0 * __uint_as_float(ya[0] & 0xffff0000u) + w1 * __uint_as_float(yb[0] & 0xffff0000u));
            x[j][2] += g[2] * (w0 * __uint_as_float(ya[1] << 16) + w1 * __uint_as_float(yb[1] << 16)); x[j][3] += g[3] * (w0 * __uint_as_float(ya[1] & 0xffff0000u) + w1 * __uint_as_float(yb[1] & 0xffff0000u));
            ss += (x[j][0] * x[j][0] + x[j][1] * x[j][1]) + (x[j][2] * x[j][2] + x[j][3] * x[j][3]); }
#pragma unroll
        for (int o = 32; o >= 1; o >>= 1) ss += __shfl_xor(ss, o);
        const float rstd = rsqrtf(ss * (1.0f / 1024.0f) + EPSV);
#pragma unroll
        for (int j = 0; j < 4; ++j) { const int k0 = 4 * lane + 256 * j; const f32x4 fn = *(const f32x4*)(a.in[I_FNORM] + k0); *(f32x4*)(xr + k0) = x[j] * rstd * fn; }
    }
}

constexpr int N_PHASES = 12;
__global__ void __launch_bounds__(512, 2) fwd_kernel(KArgs a) {
    extern __shared__ __attribute__((aligned(16))) unsigned char lds_raw[];
    LAS unsigned char* lds = (LAS unsigned char*)lds_raw;
    const int tid = tid_fresh();
    volatile LAS unsigned* misc = (volatile LAS unsigned*)(lds + LDS_MISC);
    if (tid < 8) misc[tid] = 0u;
    __syncthreads();
    XcdBarrier bar; bar.bar = (unsigned*)(a.ws + WS_CTL) + CW_BAR; bar.x = 0; bar.st = misc;
    const bool one = (a.ph_hi - a.ph_lo) > 1;
    if (one) bar = xcd_barrier_post((unsigned*)(a.ws + WS_CTL) + CW_BAR, misc);
#ifdef ONLY_PHASE
#define IN(k) ((k) == ONLY_PHASE)
#else
#define IN(k) (a.ph_lo <= (k) && (k) < a.ph_hi)
#endif
#define SEAM(k) do { if (IN(k) && IN((k) + 1)) xcd_barrier(bar); } while (0)
    const int G = gridDim.x, c = blockIdx.x;
    if (IN(0)) { phase0a(a, lds); } SEAM(0);
    if (IN(1)) { phase0b(a, lds); } SEAM(1);
    if (IN(2)) { __syncthreads(); OrderIn S{(const char*)(a.ws + WS_HX), (const char*)(a.ws + WS_WIN), G, c};
        EpiIn E{a.ws, (bf16_t*)a.out, a.in[I_BGATE], (const f32x2*)(a.ws + WS_ROPE)}; pg8::gemm_phase(lds, 1024, S, E); } SEAM(2);
    if (IN(3)) { phase2a(a, lds); } SEAM(3);
    if (IN(4)) { phase2b(a); } SEAM(4);
    if (IN(5)) { phase2c(a, lds); } SEAM(5);
    if (IN(6)) { phase3_cvt(a, lds);
        OrderMerge S{(const char*)(a.ws + WS_ZG), (const char*)(a.ws + WS_ZGL), (const char*)(a.ws + WS_WRET), (const char*)(a.ws + WS_WLRU), G, c};
        EpiMerge E{(const bf16_t*)a.out, (bf16_t*)(a.ws + WS_HX)}; pg8::gemm_phase(lds, 1024, S, E); } SEAM(6);
    if (IN(7)) { __syncthreads(); OrderOut S{(const char*)(a.ws + WS_HX), (const char*)(a.ws + WS_WOUT), G, c}; EpiOut E{&a}; pg8::gemm_phase(lds, 1024, S, E); } SEAM(7);
    if (IN(8)) { phase5(a, lds); } SEAM(8);
    if (IN(9)) {
        LAS int* tt = (LAS int*)(lds + LDS_MISC + 64); LAS int* tok = (LAS int*)(lds + LDS_TOK);
        moe_tiles(a, tt);
        {
            const int* cnt = (const int*)(a.ws + WS_CTL) + CW_CNT; const int* ptok = (const int*)(a.ws + WS_PTOK);
            for (int i = 0; i < 8; ++i) { const int L = i * G + c; if (L >= tt[32] * 6) break; const int rt = L / 6, e = moe_expert(tt, rt), r0 = (rt - tt[e]) * 256;
                if (tid < 256) tok[i * 256 + tid] = (r0 + tid < cnt[e]) ? ptok[(size_t)e * 65536 + r0 + tid] : NT; }
            __syncthreads();
        }
        OrderMoe1 S{(const char*)(a.ws + WS_HX2), (const char*)(a.ws + WS_WGU), tt, tok, G, c}; EpiMoe1 E{(bf16_t*)(a.ws + WS_HID)}; pg8::gemm_phase(lds, 1024, S, E); } SEAM(9);
    if (IN(10)) { LAS int* tt = (LAS int*)(lds + LDS_MISC + 64); moe_tiles(a, tt);
        OrderMoe2 S{(const char*)(a.ws + WS_HID), (const char*)(a.ws + WS_WDN), tt, G, c}; EpiMoe2 E{(bf16_t*)(a.ws + WS_YE)}; pg8::gemm_phase(lds, 768, S, E); } SEAM(10);
    if (IN(11)) { phase8(a, lds); }
#undef IN
#undef SEAM
}

extern "C" void kernel_launch(void* const* d_in, const int* in_sizes, int n_in, void* d_out, int out_size, void* d_ws, size_t ws_size, hipStream_t stream) {
    static int grid = 0;
    if (grid == 0) {
        if (n_in != 30 || out_size != NT * DM || ws_size < WS_NEED) { fprintf(stderr, "kernel_launch: unexpected shapes (n_in %d out %d ws %zu)\n", n_in, out_size, ws_size); grid = -1; return; }
        int dev = 0, cus = 0;
        if (hipGetDevice(&dev) != hipSuccess || hipDeviceGetAttribute(&cus, hipDeviceAttributeMultiprocessorCount, dev) != hipSuccess) { grid = -1; return; }
        if (hipFuncSetAttribute((const void*)fwd_kernel, hipFuncAttributeMaxDynamicSharedMemorySize, LDS_BYTES) != hipSuccess) { fprintf(stderr, "kernel_launch: hipFuncSetAttribute failed\n"); grid = -1; return; }
        int per_cu = 0; (void)hipOccupancyMaxActiveBlocksPerMultiprocessor(&per_cu, (const void*)fwd_kernel, 512, LDS_BYTES); (void)hipGetLastError();
        grid = cus;
    }
    if (grid < 0) return;
    (void)hipMemsetAsync((char*)d_ws + WS_CTL, 0, 1 * MiB, stream);
    KArgs a{};
    for (int i = 0; i < 30; ++i) a.in[i] = (const float*)d_in[i];
    a.out = (float*)d_out; a.ws = (unsigned char*)d_ws;
#if N_LAUNCH_SPLIT
    for (int p = 0; p < N_PHASES; ++p) { a.ph_lo = p; a.ph_hi = p + 1; hipLaunchKernelGGL(fwd_kernel, dim3(grid), dim3(512), LDS_BYTES, stream, a); }
#else
    a.ph_lo = 0; a.ph_hi = N_PHASES; hipLaunchKernelGGL(fwd_kernel, dim3(grid), dim3(512), LDS_BYTES, stream, a);
#endif
}
```

```cpp
#include <hip/hip_runtime.h>
#include <cstdio>
#include <cstdint>

#ifndef N_LAUNCH_SPLIT
#define N_LAUNCH_SPLIT 0
#endif

#define DI __device__ __forceinline__
#ifdef SUB
#define SUBSEL(k) ((k) == SUB)
#else
#define SUBSEL(k) true
#endif
#define LAS __attribute__((address_space(3)))
typedef unsigned short bf16_t;
typedef short bf16x8 __attribute__((ext_vector_type(8)));
typedef short s16x4 __attribute__((ext_vector_type(4)));
typedef float f32x2 __attribute__((ext_vector_type(2)));
typedef float f32x4 __attribute__((ext_vector_type(4)));
typedef float f32x16 __attribute__((ext_vector_type(16)));
typedef unsigned u32x2 __attribute__((ext_vector_type(2)));
typedef unsigned u32x4 __attribute__((ext_vector_type(4)));

constexpr int NB_ = 2, SEQ = 16384, NT = NB_ * SEQ, DM = 1024, CTXL = 256, NTC = NB_ * CTXL;
constexpr int NH = 4, DK = 128, DV = 256, QW = 512, VW = 1024, LW = 1024;
constexpr int NCOL = 7168;
constexpr int NE = 32, EH = 768;
constexpr float EPSV = 1e-6f;
constexpr float LOG2E = 1.4426950408889634f;
constexpr int SCH = 512, NSC = SEQ / SCH;
constexpr int LT = 64, NLT = SEQ / LT, NSLOT = 320;

constexpr size_t MiB = 1u << 20;
constexpr size_t WS_CTL = 0;
constexpr size_t WS_MODP = 1 * MiB;
constexpr size_t WS_MODT = 1 * MiB + 384 * 1024;
constexpr size_t WS_ROPE = 1 * MiB + 512 * 1024;
constexpr size_t WS_WRH = 1 * MiB + 768 * 1024;
constexpr size_t WS_LAGG = 2 * MiB;
constexpr size_t WS_LHIN = 12 * MiB;
constexpr size_t WS_CTXK = 17 * MiB;
constexpr size_t WS_CTXV = 17 * MiB + 512 * 1024;
constexpr size_t WS_CTXX = 18 * MiB + 512 * 1024;
constexpr size_t WS_CTXS = 20 * MiB;
constexpr size_t WS_ROUTE = 22 * MiB;
constexpr size_t WS_PTOK = 23 * MiB;
constexpr size_t WS_WIN = 32 * MiB;
constexpr size_t WS_WRET = 46 * MiB, WS_WLRU = 48 * MiB, WS_WOUT = 50 * MiB;
constexpr size_t WS_WLB = 52 * MiB;
constexpr size_t WS_HX = 56 * MiB;
constexpr size_t WS_ZQ = 120 * MiB, WS_ZK = 152 * MiB, WS_ZV = 184 * MiB, WS_ZG = 248 * MiB, WS_ZXL = 312 * MiB, WS_ZGL = 376 * MiB;
constexpr size_t WS_SBF = 440 * MiB;
constexpr size_t WS_WGU = 120 * MiB;
constexpr size_t WS_WDN = 440 * MiB;
constexpr size_t WS_HX2 = 248 * MiB;
constexpr size_t WS_HID = 313 * MiB;
constexpr size_t WS_YE = 56 * MiB;
constexpr size_t WS_NEED = 512 * MiB;
constexpr int CW_BAR = 4096, CW_CNT = 16384;

constexpr int LDS_SCR = 0, LDS_TOK = 131072, LDS_MISC = 131072 + 8192, LDS_BYTES = 147456;

DI int tid_fresh() { int t = threadIdx.x; asm volatile("" : "+v"(t)); return t; }
#ifdef PROBE_ID
DI volatile LAS unsigned long long* probe_words() { extern __shared__ __attribute__((aligned(16))) unsigned char lds_raw[]; return (volatile LAS unsigned long long*)((LAS unsigned char*)lds_raw + 131072 + 8192 + 1024); }
#define PB(id) do { if ((id) == PROBE_ID && threadIdx.x == 0) probe_words()[0] = wall_clock64(); } while (0)
#define PE(id) do { if ((id) == PROBE_ID && threadIdx.x == 0) probe_words()[1] += wall_clock64() - probe_words()[0]; } while (0)
#else
#define PB(id) do {} while (0)
#define PE(id) do {} while (0)
#endif
DI float bf2f(unsigned short b) { return __uint_as_float(((unsigned)b) << 16); }
DI unsigned cvt_pk_bf16(float lo, float hi) { unsigned r; asm volatile("v_cvt_pk_bf16_f32 %0, %1, %2" : "=v"(r) : "v"(lo), "v"(hi)); return r; }
DI unsigned short f2bf(float f) { return (unsigned short)(cvt_pk_bf16(f, 0.f) & 0xffffu); }
DI float ex2(float x) { return __builtin_amdgcn_exp2f(x); }
DI float rcpf_(float x) { return __builtin_amdgcn_rcpf(x); }
DI float sigm(float x) { return rcpf_(1.0f + ex2(-LOG2E * x)); }
DI float silu_(float x) { return x * sigm(x); }
DI float gelu_tanh(float x) { const float z = 0.7978845608028654f * (x + 0.044715f * x * x * x); return x * sigm(2.0f * z); }
DI float softplus_(float x) { return x > 20.f ? x : log1pf(expf(x)); }
DI int crow(int i, int h) { return (i & 3) + 8 * (i >> 2) + 4 * h; }
#define MFMA32(a, b, c) __builtin_amdgcn_mfma_f32_32x32x16_bf16((a), (b), (c), 0, 0, 0)
DI void lds_wait() { asm volatile("s_waitcnt lgkmcnt(0)" ::: "memory"); }
template <int O0, int O1> DI bf16x8 tr_frag(unsigned addr) {
    s16x4 lo, hi;
    asm volatile("ds_read_b64_tr_b16 %0, %2 offset:%3\n\tds_read_b64_tr_b16 %1, %2 offset:%4\n\ts_waitcnt lgkmcnt(0)" : "=&v"(lo), "=&v"(hi) : "v"(addr), "i"(O0), "i"(O1) : "memory");
    return __builtin_shufflevector(lo, hi, 0, 1, 2, 3, 4, 5, 6, 7);
}
template <int O, int S, int T> DI void tr_frag4(unsigned addr, bf16x8& f0, bf16x8& f1, bf16x8& f2, bf16x8& f3) {
    s16x4 a0, a1, b0, b1, c0, c1, d0, d1;
    asm volatile("ds_read_b64_tr_b16 %0, %8 offset:%9\n\tds_read_b64_tr_b16 %1, %8 offset:%10\n\t"
                 "ds_read_b64_tr_b16 %2, %8 offset:%11\n\tds_read_b64_tr_b16 %3, %8 offset:%12\n\t"
                 "ds_read_b64_tr_b16 %4, %8 offset:%13\n\tds_read_b64_tr_b16 %5, %8 offset:%14\n\t"
                 "ds_read_b64_tr_b16 %6, %8 offset:%15\n\tds_read_b64_tr_b16 %7, %8 offset:%16\n\ts_waitcnt lgkmcnt(0)"
                 : "=&v"(a0), "=&v"(a1), "=&v"(b0), "=&v"(b1), "=&v"(c0), "=&v"(c1), "=&v"(d0), "=&v"(d1)
                 : "v"(addr), "i"(O), "i"(O + T), "i"(O + S), "i"(O + S + T), "i"(O + 2 * S), "i"(O + 2 * S + T), "i"(O + 3 * S), "i"(O + 3 * S + T) : "memory");
    f0 = __builtin_shufflevector(a0, a1, 0, 1, 2, 3, 4, 5, 6, 7); f1 = __builtin_shufflevector(b0, b1, 0, 1, 2, 3, 4, 5, 6, 7);
    f2 = __builtin_shufflevector(c0, c1, 0, 1, 2, 3, 4, 5, 6, 7); f3 = __builtin_shufflevector(d0, d1, 0, 1, 2, 3, 4, 5, 6, 7);
}
DI void lds_barrier() { asm volatile("s_waitcnt lgkmcnt(0)" ::: "memory"); __builtin_amdgcn_s_barrier(); asm volatile("" ::: "memory"); }
DI f32x16 zero16() { f32x16 z; for (int i = 0; i < 16; ++i) z[i] = 0.f; return z; }

struct KArgs {
    const float* in[30];
    float* out;
    unsigned char* ws;
    int ph_lo, ph_hi;
};
enum { I_X = 0, I_C, I_CTX, I_CCTX, I_WMOD, I_BMOD, I_NORM1, I_NORM2, I_WIN, I_BGATE, I_RDECAY, I_RNORM, I_WRET, I_CONVW, I_CONVB, I_LWA, I_LBA, I_LWX, I_LBX, I_LLAM,
       I_WLRU, I_WOUT, I_WGRP, I_BGRP, I_WRT, I_BRT, I_WEG, I_WEU, I_WED, I_FNORM };

DI float mod_val(const KArgs& a, int v, int ch, int k) {
    const float* mp = (const float*)(a.ws + WS_MODP); const int n = ch * 1024 + k;
    return ((mp[(0 * 3 + v) * 6144 + n] + mp[(1 * 3 + v) * 6144 + n]) + (mp[(2 * 3 + v) * 6144 + n] + mp[(3 * 3 + v) * 6144 + n])) + a.in[I_BMOD][n];
}

#define XB_TMO      128
#define XB_XCNT(j)  (256  + 64 * (j))
#define XB_XSUB(j)  (1280 + 64 * (j))
#define XB_XGEN(j)  (2304 + 64 * (j))
#define XB_TOP      3328
#define XB_TOPGEN   3392
#define XCD_BAR_WORDS 3456
#define XB_SPIN_CAP (1u << 18)
__device__ __forceinline__ unsigned xb_ld(unsigned* p)              { return __hip_atomic_load(p, __ATOMIC_RELAXED, __HIP_MEMORY_SCOPE_AGENT); }
__device__ __forceinline__ unsigned xb_add(unsigned* p, unsigned v) { return __hip_atomic_fetch_add(p, v, __ATOMIC_RELAXED, __HIP_MEMORY_SCOPE_AGENT); }
__device__ __forceinline__ unsigned xb_xcc_id() { return (unsigned)__builtin_amdgcn_s_getreg((3 << 11) | 20) & 0xFu; }
#define XB_SPIN(cond, bar) do { unsigned _sp = 0; while (cond) { __builtin_amdgcn_s_sleep(1); \
    if ((++_sp & 255u) == 0u) { if (xb_ld(&(bar)[XB_TMO])) break; if (_sp > XB_SPIN_CAP) { atomicAdd(&(bar)[XB_TMO], 1u); break; } } } } while (0)
struct XcdBarrier { unsigned* bar; unsigned x; volatile LAS unsigned* st; };
__device__ __forceinline__ XcdBarrier xcd_barrier_post(unsigned* bar, volatile LAS unsigned* st) {
    XcdBarrier b; b.bar = bar; b.x = xb_xcc_id(); b.st = st;
    if (threadIdx.x == 0) (void)xb_add(&bar[XB_XCNT(b.x)], 1u);
    return b;
}
__device__ __forceinline__ void xcd_barrier_complete(unsigned* bar, unsigned x, unsigned& nloc, unsigned& nx) {
    const unsigned G = gridDim.x * gridDim.y * gridDim.z;
    unsigned sum, cnt, mine, sp = 0u;
    for (;;) {
        sum = 0u; cnt = 0u; mine = 0u;
#pragma unroll
        for (unsigned j = 0; j < 16; ++j) { const unsigned c = xb_ld(&bar[XB_XCNT(j)]); sum += c; cnt += (c > 0u) ? 1u : 0u; mine = (j == x) ? c : mine; }
        if (sum == G) break;
        __builtin_amdgcn_s_sleep(1);
        if ((++sp & 255u) == 0u) { if (xb_ld(&bar[XB_TMO])) break; if (sp > XB_SPIN_CAP) { atomicAdd(&bar[XB_TMO], 1u); break; } }
    }
    nloc = mine > 0u ? mine : 1u; nx = cnt > 0u ? cnt : 1u;
}
__device__ __forceinline__ void xcd_barrier(const XcdBarrier& b) {
    asm volatile("s_waitcnt vmcnt(0)" ::: "memory");
    __syncthreads();
    if (threadIdx.x == 0) {
        unsigned* bar = b.bar;
        __builtin_amdgcn_s_waitcnt(0);
        unsigned nloc = b.st[0], nx = b.st[1];
        if (nloc == 0u) { xcd_barrier_complete(bar, b.x, nloc, nx); b.st[0] = nloc; b.st[1] = nx; }
        const unsigned old = xb_add(&bar[XB_XSUB(b.x)], 1u);
        const unsigned gen = old / nloc;
        if (old + 1u == (gen + 1u) * nloc) {
            __builtin_amdgcn_fence(__ATOMIC_RELEASE, "agent");
            asm volatile("s_waitcnt vmcnt(0)" ::: "memory");
            const unsigned og = xb_add(&bar[XB_TOP], 1u);
            const unsigned tg = og / nx;
            if (og + 1u == (tg + 1u) * nx) xb_add(&bar[XB_TOPGEN], 1u);
            else XB_SPIN(xb_ld(&bar[XB_TOPGEN]) == tg, bar);
            __builtin_amdgcn_fence(__ATOMIC_ACQUIRE, "agent");
            xb_add(&bar[XB_XGEN(b.x)], 1u);
            asm volatile("s_waitcnt vmcnt(0)" ::: "memory");
        } else {
            XB_SPIN(xb_ld(&bar[XB_XGEN(b.x)]) == gen, bar);
            __builtin_amdgcn_fence(__ATOMIC_ACQUIRE, "agent");
            asm volatile("s_waitcnt vmcnt(0)" ::: "memory");
        }
    }
    __syncthreads();
}

namespace pg8 {
constexpr int BM = 256, BK = 64, HALF = 128, HTB = HALF * BK * 2, STAGE_BYTES = 8 * HTB, NXCD = 8, WGM = 8;
DI int lds_byte(int r, int c) { const int st = (r >> 4) * 2 + (c >> 5), rr = r & 15, cc = c & 31, ob = rr * 64 + cc * 2; return st * 1024 + (ob ^ (((ob >> 9) & 1) << 5)); }
DI void stage_rc(int b, int& R, int& C) { const int st = b / 1024, sb = b % 1024, swz = sb ^ (((sb >> 9) & 1) << 5); R = (st >> 1) * 16 + swz / 64; C = (st & 1) * 32 + (swz % 64) / 2; }
DI int perm32(int rho) { const int n = rho >> 4, i = rho & 15; return 8 * (i >> 2) + 4 * n + (i & 3); }
DI int bmap(int mode, int R) {
    if (mode == 1) return (R & ~31) + perm32(R & 31);
    if (mode == 2) { const int wc = R >> 5, n = (R >> 4) & 1, low = R & 15; return 64 * (wc >> 1) + 32 * n + 16 * (wc & 1) + low; }
    return R;
}
struct Unit { const char* A; const char* B; int pm, pn, aux, bmode; };
DI bool static_tile(int i, int G, int c, int nM, int nN, int& pm, int& pn) {
    const int nwg = nM * nN; const long L = (long)i * G + c; if (L >= nwg) return false;
    int wgid = (int)L; { const int q = nwg / NXCD, r = nwg % NXCD, xcd = wgid % NXCD, off = wgid / NXCD; wgid = (xcd < r ? xcd * (q + 1) : r * (q + 1) + (xcd - r) * q) + off; }
    const int nig = WGM * nN, gid = wgid / nig, fm = gid * WGM, gsz = (nM - fm) < WGM ? (nM - fm) : WGM;
    pm = fm + ((wgid % nig) % gsz); pn = (wgid % nig) / gsz; return true;
}

template <class Epi, class Sched>
DI void gemm_phase(LAS unsigned char* lds, const int K, const Sched& S, const Epi& E) {
    const int tid = tid_fresh(), wid = __builtin_amdgcn_readfirstlane(tid >> 6), lane = tid & 63, wr = wid >> 2, wc = wid & 3, fr = lane & 15, fq = lane >> 4;
    const int nt = K / BK;
    int Rr[2], Cc[2];
#pragma unroll
    for (int i = 0; i < 2; ++i) stage_rc(tid * 16 + i * 8192, Rr[i], Cc[i]);
    unsigned voffA[2][2], voffB[2];
    const size_t kstep = (size_t)(BK * 2);
    const size_t hstep = (size_t)HALF * K * 2;
    const unsigned ldsw = (unsigned)wid * 1024u;
    const int aoff = lds_byte(wr * 64 + fr, fq * 8), boff = lds_byte(wc * 32 + fr, fq * 8);
#define PG8_SA(b, h) (((b) * 2 + (h)) * HTB)
#define PG8_SB(b, h) ((4 + (b) * 2 + (h)) * HTB)
#define PG8_STAGE(bufoff, gbase, voff) do { _Pragma("unroll") for (int _i = 0; _i < 2; ++_i) \
        __builtin_amdgcn_global_load_lds((const unsigned*)((const char*)(gbase) + (voff)[_i]), (LAS unsigned*)(lds + (bufoff) + ldsw + _i * 8192), 16, 0, 0); } while (0)
#define PG8_LDA(dst, b, h) do { _Pragma("unroll") for (int m = 0; m < 4; ++m) _Pragma("unroll") for (int k = 0; k < 2; ++k) dst[m][k] = *(const LAS bf16x8*)(lds + PG8_SA(b, h) + aoff + m * 2048 + k * 1024); } while (0)
#define PG8_LDB(dst, b, h) do { _Pragma("unroll") for (int n = 0; n < 2; ++n) _Pragma("unroll") for (int k = 0; k < 2; ++k) dst[n][k] = *(const LAS bf16x8*)(lds + PG8_SB(b, h) + boff + n * 2048 + k * 1024); } while (0)
#define PG8_MMA(ai, bj, At, Bt) do { __builtin_amdgcn_s_setprio(1); _Pragma("unroll") for (int m = 0; m < 4; ++m) _Pragma("unroll") for (int n = 0; n < 2; ++n) _Pragma("unroll") for (int k = 0; k < 2; ++k) \
        acc[ai][bj][m][n] = __builtin_amdgcn_mfma_f32_16x16x32_bf16(Bt[n][k], At[m][k], acc[ai][bj][m][n], 0, 0, 0); __builtin_amdgcn_s_setprio(0); } while (0)
#define PG8_WAIT_V(n) asm volatile("s_waitcnt vmcnt(" #n ")" ::: "memory")
#define PG8_WAIT_L(n) asm volatile("s_waitcnt lgkmcnt(" #n ")" ::: "memory")
#define PG8_BAR __builtin_amdgcn_s_barrier()
#define PG8_SCHED __builtin_amdgcn_sched_barrier(0)
#define PG8_SETB(u) do { _Pragma("unroll") for (int _i = 0; _i < 2; ++_i) voffB[_i] = (unsigned)(bmap((u).bmode, Rr[_i]) * K + Cc[_i]) * 2u; } while (0)
    Unit cur, nxt; int ui = 0;
    if (!S.next(0, cur)) return;
    f32x4 acc[2][2][4][2];
#pragma unroll
    for (int a = 0; a < 2; ++a)
#pragma unroll
        for (int b = 0; b < 2; ++b)
#pragma unroll
            for (int m = 0; m < 4; ++m)
#pragma unroll
                for (int n = 0; n < 2; ++n) acc[a][b][m][n] = (f32x4){0.f, 0.f, 0.f, 0.f};
    bf16x8 At[4][2], B0[2][2], B1[2][2];
    const char* cA = cur.A; const char* cB = cur.B;
    S.offsA(cur, 0, Rr, Cc, voffA); PG8_SETB(cur);
    PG8_STAGE(PG8_SB(0, 0), cB, voffB); PG8_STAGE(PG8_SB(0, 1), cB + hstep, voffB); PG8_STAGE(PG8_SA(0, 0), cA, voffA[0]); PG8_STAGE(PG8_SA(0, 1), cA, voffA[1]);
    if (wr == 1) PG8_BAR;
    PG8_WAIT_V(2); PG8_BAR;
    PG8_STAGE(PG8_SB(1, 0), cB + kstep, voffB); PG8_STAGE(PG8_SA(1, 0), cA + kstep, voffA[0]); PG8_STAGE(PG8_SB(1, 1), cB + hstep + kstep, voffB);
    PG8_WAIT_V(6); PG8_BAR;
    for (;;) {
        const bool has_next = S.next(ui + 1, nxt);
        const char* nA = has_next ? nxt.A : cA; const char* nB = has_next ? nxt.B : cB;
        for (int t = 0; t < nt; t += 2) {
            const bool last = (t == nt - 2);
            const char* a1 = cA + (size_t)(t + 1) * kstep;
            const char* a2 = last ? nA : cA + (size_t)(t + 2) * kstep; const char* b2 = last ? nB : cB + (size_t)(t + 2) * kstep;
            const char* a3 = a2 + kstep; const char* b3 = b2 + kstep;
            if (last && has_next) PG8_SETB(nxt);
            PG8_LDB(B0, 0, 0); PG8_LDB(B1, 0, 1); PG8_SCHED; PG8_LDA(At, 0, 0); PG8_STAGE(PG8_SA(1, 1), a1, voffA[1]);
            PG8_WAIT_V(8); PG8_WAIT_L(0); PG8_BAR; PG8_MMA(0, 0, At, B0); PG8_MMA(0, 1, At, B1); PG8_BAR; PG8_SCHED;
            if (last && has_next) S.offsA(nxt, ui + 1, Rr, Cc, voffA);
            PG8_LDA(At, 0, 1); PG8_STAGE(PG8_SB(0, 0), b2, voffB); PG8_STAGE(PG8_SB(0, 1), b2 + hstep, voffB); PG8_STAGE(PG8_SA(0, 0), a2, voffA[0]);
            PG8_WAIT_V(8); PG8_WAIT_L(0); PG8_BAR; PG8_MMA(1, 0, At, B0); PG8_MMA(1, 1, At, B1); PG8_BAR; PG8_SCHED;
            PG8_LDB(B0, 1, 0); PG8_LDB(B1, 1, 1); PG8_SCHED; PG8_LDA(At, 1, 0); PG8_STAGE(PG8_SA(0, 1), a2, voffA[1]);
            PG8_WAIT_V(8); PG8_WAIT_L(0); PG8_BAR; PG8_MMA(0, 0, At, B0); PG8_MMA(0, 1, At, B1); PG8_BAR; PG8_SCHED;
            PG8_LDA(At, 1, 1); PG8_STAGE(PG8_SB(1, 0), b3, voffB); PG8_STAGE(PG8_SB(1, 1), b3 + hstep, voffB); PG8_STAGE(PG8_SA(1, 0), a3, voffA[0]);
            PG8_WAIT_V(8); PG8_WAIT_L(0); PG8_BAR; PG8_MMA(1, 0, At, B0); PG8_MMA(1, 1, At, B1); PG8_BAR; PG8_SCHED;
        }
        if (wr == 0) PG8_BAR;
        const bool keep = E(acc, cur, wr, wc, fr, fq);
        if (!has_next) break;
        if (!keep) {
#pragma unroll
            for (int a = 0; a < 2; ++a)
#pragma unroll
                for (int b = 0; b < 2; ++b)
#pragma unroll
                    for (int m = 0; m < 4; ++m)
#pragma unroll
                        for (int n = 0; n < 2; ++n) acc[a][b][m][n] = (f32x4){0.f, 0.f, 0.f, 0.f};
        }
        cur = nxt; cA = nA; cB = nB; ++ui;
        if (wr == 1) PG8_BAR;
    }
    PG8_WAIT_V(0);
    PG8_BAR;
#undef PG8_SA
#undef PG8_SB
#undef PG8_STAGE
#undef PG8_LDA
#undef PG8_LDB
#undef PG8_MMA
#undef PG8_WAIT_V
#undef PG8_WAIT_L
#undef PG8_BAR
#undef PG8_SCHED
#undef PG8_SETB
}
DI void dense_offs(int K, const int (&R)[2], const int (&C)[2], unsigned (&voffA)[2][2]) {
#pragma unroll
    for (int h = 0; h < 2; ++h)
#pragma unroll
        for (int i = 0; i < 2; ++i) voffA[h][i] = (unsigned)((h * HALF + R[i]) * K + C[i]) * 2u;
}
}
using pg8::Unit;

#define EPI_LOOP_ROWS for (int ai = 0; ai < 2; ++ai) _Pragma("unroll") for (int m = 0; m < 4; ++m)

DI void cvt_tile(LAS float* tile, const float* src, int ld_src, bf16_t* dst, int ld_dst, float scale) {
    const int tid = tid_fresh();
    __syncthreads();
#pragma unroll
    for (int i = 0; i < 2; ++i) { const int kr = (tid >> 4) + 32 * i, nc = (tid & 15) * 4; const f32x4 v = *(const f32x4*)(src + (size_t)kr * ld_src + nc);
        tile[kr * 65 + nc + 0] = v[0]; tile[kr * 65 + nc + 1] = v[1]; tile[kr * 65 + nc + 2] = v[2]; tile[kr * 65 + nc + 3] = v[3]; }
    __syncthreads();
    const int n = tid >> 3, kc = (tid & 7) * 8; float v[8];
#pragma unroll
    for (int j = 0; j < 8; ++j) v[j] = tile[(kc + j) * 65 + n] * scale;
    u32x4 w; w.x = cvt_pk_bf16(v[0], v[1]); w.y = cvt_pk_bf16(v[2], v[3]); w.z = cvt_pk_bf16(v[4], v[5]); w.w = cvt_pk_bf16(v[6], v[7]);
    *(u32x4*)(dst + (size_t)n * ld_dst + kc) = w;
}

DI void phase0a(const KArgs& a, LAS unsigned char* lds) {
    const int tid = tid_fresh(), G = gridDim.x;
    LAS float* fl = (LAS float*)lds;
    constexpr int NU_MOD = 192, NU_ROPE = 1, NU_ROUTW = 1, T_WIN = 16 * 112, T_PROJ = 3 * 256, T_LB = 128;
    constexpr int U0 = NU_MOD, U1 = U0 + NU_ROPE, U2 = U1 + NU_ROUTW, U3 = U2 + T_WIN, U4 = U3 + T_PROJ, U5 = U4 + T_LB;
    for (int u = blockIdx.x; u < U5; u += G) {
        if (u < U0) {
            const int ks = u / 48, cg = u % 48;
            __syncthreads();
            for (int i = tid; i < 768; i += 512) { const int v = i >> 8, k = 256 * ks + (i & 255); const float x = (v == 0) ? a.in[I_C][k] : (v == 1) ? a.in[I_C][1024 + k] : a.in[I_CCTX][k]; fl[i] = silu_(x); }
            __syncthreads();
            const int rl = tid >> 5, cl = tid & 31; float acc[3][4];
#pragma unroll
            for (int v = 0; v < 3; ++v) for (int j = 0; j < 4; ++j) acc[v][j] = 0.f;
            for (int s = 0; s < 16; ++s) { const int kk = 16 * s + rl; const f32x4 w = *(const f32x4*)(a.in[I_WMOD] + (size_t)(256 * ks + kk) * 6144 + 128 * cg + 4 * cl);
#pragma unroll
                for (int v = 0; v < 3; ++v) { const float sv = fl[v * 256 + kk]; acc[v][0] += sv * w[0]; acc[v][1] += sv * w[1]; acc[v][2] += sv * w[2]; acc[v][3] += sv * w[3]; } }
            __syncthreads();
            LAS float* red = fl + 1024;
#pragma unroll
            for (int v = 0; v < 3; ++v) for (int j = 0; j < 4; ++j) red[(rl * 3 + v) * 128 + 4 * cl + j] = acc[v][j];
            __syncthreads();
            if (tid < 384) { const int v = tid >> 7, c = tid & 127; float s = 0.f; for (int r = 0; r < 16; ++r) s += red[(r * 3 + v) * 128 + c];
                ((float*)(a.ws + WS_MODP))[(ks * 3 + v) * 6144 + 128 * cg + c] = s; }
        } else if (u < U1) {
            f32x2* tab = (f32x2*)(a.ws + WS_ROPE);
            for (int i = tid; i < 320 * 32; i += 512) { const int p = i >> 5, fi = i & 31; const float pos = (float)(p < 256 ? p : p - 256);
                const float freq = ex2(-(float)fi * (13.287712379549449f / 32.0f)); float rev = pos * freq * 0.15915494309189535f; rev -= floorf(rev);
                tab[i] = (f32x2){__builtin_amdgcn_cosf(rev), __builtin_amdgcn_sinf(rev)}; }
        } else if (u < U2) {
            bf16_t* hi = (bf16_t*)(a.ws + WS_WRH); bf16_t* lo = hi + 64 * 1024;
            for (int i = tid; i < 64 * 1024; i += 512) { const int n = i >> 10, k = i & 1023; float w = 0.f;
                if (n < 4) w = a.in[I_WGRP][k * 4 + n]; else if (n < 36) w = a.in[I_WRT][k * 32 + (n - 4)];
                const unsigned short h16 = f2bf(w); hi[i] = h16; lo[i] = f2bf(w - bf2f(h16)); }
        } else if (u < U3) {
            const int t = u - U2, kt = t / 112, nt = t % 112;
            cvt_tile(fl, a.in[I_WIN] + (size_t)(64 * kt) * NCOL + 64 * nt, NCOL, (bf16_t*)(a.ws + WS_WIN) + (size_t)(64 * nt) * 1024 + 64 * kt, 1024, 1.f);
        } else if (u < U4) {
            const int t = u - U3, w = t >> 8, kt = (t & 255) >> 4, nt = t & 15;
            const float* src = a.in[w == 0 ? I_WRET : w == 1 ? I_WLRU : I_WOUT]; bf16_t* dst = (bf16_t*)(a.ws + (w == 0 ? WS_WRET : w == 1 ? WS_WLRU : WS_WOUT));
            cvt_tile(fl, src + (size_t)(64 * kt) * 1024 + 64 * nt, 1024, dst + (size_t)(64 * nt) * 1024 + 64 * kt, 1024, 1.f);
        } else {
            const int t = u - U4, mat = t >> 5, blk = (t >> 2) & 7, kt = (t >> 1) & 1, nt = t & 1, dir = mat >> 1;
            const float* src = a.in[(mat & 1) ? I_LWX : I_LWA] + (size_t)(dir * 8 + blk) * 128 * 128;
            bf16_t* dst = (bf16_t*)(a.ws + WS_WLB) + (size_t)(mat * 8 + blk) * 128 * 128;
            cvt_tile(fl, src + (size_t)(64 * kt) * 128 + 64 * nt, 128, dst + (size_t)(64 * nt) * 128 + 64 * kt, 128, -LOG2E);
        }
    }
}

DI void phase0b(const KArgs& a, LAS unsigned char* lds) {
    const int tid = tid_fresh(), G = gridDim.x, lane = tid & 63, wid = tid >> 6;
    LAS float* gm = (LAS float*)lds;
    LAS float* sh = gm + 3072;
    __syncthreads();
    for (int i = tid; i < 3072; i += 512) { const int v = i >> 10, k = i & 1023; gm[i] = a.in[I_NORM1][k] * (1.0f + mod_val(a, v, 1, k)); sh[i] = mod_val(a, v, 0, k); }
    if (blockIdx.x == G - 1) { float* mt = (float*)(a.ws + WS_MODT);
        for (int i = tid; i < 2048; i += 512) { const int v = i >> 10, k = i & 1023; mt[i] = mod_val(a, v, 2, k); mt[2048 + i] = a.in[I_NORM2][k] * (1.0f + mod_val(a, v, 4, k)); mt[4096 + i] = mod_val(a, v, 3, k); mt[6144 + i] = mod_val(a, v, 5, k); } }
    __syncthreads();
    for (int u = blockIdx.x; u < 160; u += G) {
        const int rt = u / 20, ct = u % 20;
        const int col0 = ct < 4 ? 512 + 128 * ct : ct < 12 ? 1024 + 128 * (ct - 4) : 3072 + 128 * (ct - 12);
        const int rb = wid >> 2, cb = wid & 3, r = lane & 31, h = lane >> 5;
        const float* xr = a.in[I_CTX] + (size_t)(64 * rt + 32 * rb + r) * 1024;
        float ss = 0.f;
#pragma unroll 16
        for (int s = 0; s < 64; ++s) { const f32x4 p = *(const f32x4*)(xr + 16 * s + 8 * h), q = *(const f32x4*)(xr + 16 * s + 8 * h + 4);
            ss += (p[0] * p[0] + p[1] * p[1]) + (p[2] * p[2] + p[3] * p[3]) + (q[0] * q[0] + q[1] * q[1]) + (q[2] * q[2] + q[3] * q[3]); }
        ss += __shfl_xor(ss, 32);
        const float rstd = rsqrtf(ss * (1.0f / 1024.0f) + EPSV);
        const bf16_t* wrow = (const bf16_t*)(a.ws + WS_WIN) + (size_t)(col0 + 32 * cb + r) * 1024;
        f32x16 acc = zero16();
#pragma unroll 8
        for (int s = 0; s < 64; ++s) { const int k0 = 16 * s + 8 * h;
            const f32x4 p = *(const f32x4*)(xr + k0), q = *(const f32x4*)(xr + k0 + 4);
            const f32x4 g0 = *(const LAS f32x4*)(gm + 2048 + k0), g1 = *(const LAS f32x4*)(gm + 2048 + k0 + 4), s0 = *(const LAS f32x4*)(sh + 2048 + k0), s1 = *(const LAS f32x4*)(sh + 2048 + k0 + 4);
            u32x4 w; w.x = cvt_pk_bf16(p[0] * rstd * g0[0] + s0[0], p[1] * rstd * g0[1] + s0[1]); w.y = cvt_pk_bf16(p[2] * rstd * g0[2] + s0[2], p[3] * rstd * g0[3] + s0[3]);
            w.z = cvt_pk_bf16(q[0] * rstd * g1[0] + s1[0], q[1] * rstd * g1[1] + s1[1]); w.w = cvt_pk_bf16(q[2] * rstd * g1[2] + s1[2], q[3] * rstd * g1[3] + s1[3]);
            const bf16x8 af = __builtin_bit_cast(bf16x8, w); const bf16x8 bfr = *(const bf16x8*)(wrow + k0);
            acc = MFMA32(af, bfr, acc); }
        const int ccol = 128 * (ct < 4 ? ct : ct < 12 ? ct - 4 : ct - 12) + 32 * cb + r;
        bf16_t* dst = (bf16_t*)(a.ws + (ct < 4 ? WS_CTXK : ct < 12 ? WS_CTXV : WS_CTXX)); const int ldd = ct < 4 ? 512 : 1024; const float sc = ct < 4 ? 0.08838834764831845f : 1.0f;
#pragma unroll
        for (int i = 0; i < 16; ++i) dst[(size_t)(64 * rt + 32 * rb + crow(i, h)) * ldd + ccol] = f2bf(acc[i] * sc);
    }
    for (int row = blockIdx.x * 8 + wid; row < NT; row += G * 8) {
        const int v = row / SEQ; const float* xr = a.in[I_X] + (size_t)row * 1024; f32x4 x[4]; float ss = 0.f;
#pragma unroll
        for (int j = 0; j < 4; ++j) { x[j] = *(const f32x4*)(xr + 4 * lane + 256 * j); ss += (x[j][0] * x[j][0] + x[j][1] * x[j][1]) + (x[j][2] * x[j][2] + x[j][3] * x[j][3]); }
#pragma unroll
        for (int o = 32; o >= 1; o >>= 1) ss += __shfl_xor(ss, o);
        const float rstd = rsqrtf(ss * (1.0f / 1024.0f) + EPSV);
        bf16_t* dst = (bf16_t*)(a.ws + WS_HX) + (size_t)row * 1024;
#pragma unroll
        for (int j = 0; j < 4; ++j) { const int k0 = 4 * lane + 256 * j; const f32x4 g = *(const LAS f32x4*)(gm + v * 1024 + k0), s = *(const LAS f32x4*)(sh + v * 1024 + k0);
            u32x2 w; w.x = cvt_pk_bf16(x[j][0] * rstd * g[0] + s[0], x[j][1] * rstd * g[1] + s[1]); w.y = cvt_pk_bf16(x[j][2] * rstd * g[2] + s[2], x[j][3] * rstd * g[3] + s[3]);
            *(u32x2*)(dst + k0) = w; }
    }
}

struct OrderIn {
    const char* A; const char* B; int G, c;
    DI bool next(int i, Unit& u) const { int pm, pn; if (!pg8::static_tile(i, G, c, NT / 256, NCOL / 256, pm, pn)) return false;
        u.pm = pm; u.pn = pn; u.A = A + (size_t)pm * 256 * 1024 * 2; u.B = B + (size_t)pn * 256 * 1024 * 2; u.aux = 0; u.bmode = pn < 4 ? 2 : 1; return true; }
    DI void offsA(const Unit&, int, const int (&R)[2], const int (&C)[2], unsigned (&v)[2][2]) const { pg8::dense_offs(1024, R, C, v); }
};
struct EpiIn {
    unsigned char* ws; bf16_t* glog; const float* bgate; const f32x2* rope;
    DI bool operator()(f32x4 (&acc)[2][2][4][2], const Unit& u, int wr, int wc, int fr, int fq) const {
        const int pn = u.pn;
        if (pn < 4) {
            bf16_t* dst = (bf16_t*)(ws + (pn < 2 ? WS_ZQ : WS_ZK)); const float sc = pn < 2 ? 1.0f : 0.08838834764831845f;
            const int half = wc >> 1, f0 = 16 * (wc & 1) + 4 * fq;
#pragma unroll
            EPI_LOOP_ROWS { const int row = u.pm * 256 + ai * 128 + wr * 64 + m * 16 + fr; const int t = row & (SEQ - 1); const int pos = half ? 256 + (t & 63) : (t >> 6);
                const f32x2* tb = rope + pos * 32 + f0; f32x2 cs[4];
#pragma unroll
                for (int j = 0; j < 4; ++j) cs[j] = tb[j];
#pragma unroll
                for (int bj = 0; bj < 2; ++bj) { const f32x4 x1 = acc[ai][bj][m][0], x2 = acc[ai][bj][m][1]; float o1[4], o2[4];
#pragma unroll
                    for (int j = 0; j < 4; ++j) { o1[j] = (x1[j] * cs[j][0] - x2[j] * cs[j][1]) * sc; o2[j] = (x1[j] * cs[j][1] + x2[j] * cs[j][0]) * sc; }
                    bf16_t* p = dst + (size_t)row * 512 + (pn & 1) * 256 + bj * 128 + 64 * half + f0;
                    u32x2 w1, w2; w1.x = cvt_pk_bf16(o1[0], o1[1]); w1.y = cvt_pk_bf16(o1[2], o1[3]); w2.x = cvt_pk_bf16(o2[0], o2[1]); w2.y = cvt_pk_bf16(o2[2], o2[3]);
                    *(u32x2*)p = w1; *(u32x2*)(p + 32) = w2; } }
            return false;
        }
        int act, ldd, cb; bf16_t* dst;
        if (pn < 8) { dst = (bf16_t*)(ws + WS_ZV); act = 0; ldd = 1024; cb = (pn - 4) * 256; }
        else if (pn < 12) { dst = (bf16_t*)(ws + WS_ZG); act = 1; ldd = 1024; cb = (pn - 8) * 256; }
        else if (pn < 16) { dst = (bf16_t*)(ws + WS_ZXL); act = 0; ldd = 1024; cb = (pn - 12) * 256; }
        else if (pn < 20) { dst = (bf16_t*)(ws + WS_ZGL); act = 2; ldd = 1024; cb = (pn - 16) * 256; }
        else { dst = glog; act = 3; ldd = 2048; cb = (pn - 20) * 256; }
#pragma unroll
        for (int bj = 0; bj < 2; ++bj) { const int col = cb + bj * 128 + wc * 32 + 8 * fq; f32x4 b0 = (f32x4){0.f, 0.f, 0.f, 0.f}, b1 = b0;
            if (act == 3) { b0 = *(const f32x4*)(bgate + col); b1 = *(const f32x4*)(bgate + col + 4); }
#pragma unroll
            EPI_LOOP_ROWS { const int row = u.pm * 256 + ai * 128 + wr * 64 + m * 16 + fr; f32x4 v0 = acc[ai][bj][m][0] + b0, v1 = acc[ai][bj][m][1] + b1;
                if (act == 1) {
#pragma unroll
                    for (int j = 0; j < 4; ++j) { v0[j] = silu_(v0[j]); v1[j] = silu_(v1[j]); } }
                if (act == 2) {
#pragma unroll
                    for (int j = 0; j < 4; ++j) { v0[j] = gelu_tanh(v0[j]); v1[j] = gelu_tanh(v1[j]); } }
                u32x4 w; w.x = cvt_pk_bf16(v0[0], v0[1]); w.y = cvt_pk_bf16(v0[2], v0[3]); w.z = cvt_pk_bf16(v1[0], v1[1]); w.w = cvt_pk_bf16(v1[2], v1[3]);
                *(u32x4*)(dst + (size_t)row * ldd + col) = w; } }
        return false;
    }
};

constexpr int R1_RSV = 576, R1_RSK = 320;
DI void r1_unit(LAS unsigned char* lds, const bf16_t* kp, int kld, const bf16_t* vp, int vld, int nrows, float lg2, int dir, float* outp) {
    const int tid = tid_fresh(), lane = tid & 63, wid = tid >> 6, h = lane >> 5;
    LAS unsigned char* Vt = lds; LAS unsigned char* Kw = lds + 64 * R1_RSV;
    const int mh = wid >> 2, nb = wid & 3;
    f32x16 acc[4];
#pragma unroll
    for (int mi = 0; mi < 4; ++mi) acc[mi] = zero16();
    const unsigned lb = (unsigned)((8 * h + ((lane & 15) >> 2))) , blk = (lane >> 4) & 1, p = lane & 3;
    const unsigned lbV = (unsigned)(size_t)Vt + lb * R1_RSV + 32 * blk + 8 * p + (128 * mh) * 2;
    const unsigned lbK = (unsigned)(size_t)Kw + lb * R1_RSK + 32 * blk + 8 * p + (32 * nb) * 2;
    for (int ch = 0; ch < nrows / 64; ++ch) {
        __syncthreads();
#pragma unroll
        for (int i = 0; i < 4; ++i) { const int pid = tid + 512 * i, row = pid >> 5, c16 = pid & 31;
            const u32x4 v = *(const u32x4*)(vp + (size_t)(64 * ch + row) * vld + c16 * 8); *(LAS u32x4*)(Vt + row * R1_RSV + c16 * 16) = v; }
#pragma unroll
        for (int i = 0; i < 2; ++i) { const int pid = tid + 512 * i, row = pid >> 4, c16 = pid & 15; const int jj = 64 * ch + row;
            const u32x4 kv = *(const u32x4*)(kp + (size_t)jj * kld + c16 * 8);
            const float w = ex2(lg2 * (float)(dir ? jj : nrows - 1 - jj));
            u32x4 o;
#pragma unroll
            for (int e = 0; e < 4; ++e) { const float lo = __uint_as_float(kv[e] << 16), hi = __uint_as_float(kv[e] & 0xffff0000u); o[e] = cvt_pk_bf16(lo * w, hi * w); }
            *(LAS u32x4*)(Kw + row * R1_RSK + c16 * 16) = o; }
        __syncthreads();
#pragma unroll
        for (int ks = 0; ks < 4; ++ks) {
            bf16x8 av[4]; tr_frag4<0, 64, 4 * R1_RSV>(lbV + ks * 16 * R1_RSV, av[0], av[1], av[2], av[3]);
            const bf16x8 bw = tr_frag<0, 4 * R1_RSK>(lbK + ks * 16 * R1_RSK);
#pragma unroll
            for (int mi = 0; mi < 4; ++mi) acc[mi] = MFMA32(av[mi], bw, acc[mi]);
        }
    }
    const int c = lane & 31;
    float* ob = outp + (size_t)(128 * mh + 4 * h) * 128 + 32 * nb + c;
#pragma unroll
    for (int mi = 0; mi < 4; ++mi)
#pragma unroll
        for (int i = 0; i < 16; ++i) ob[(32 * mi + (i & 3) + 8 * (i >> 2)) * 128] = acc[mi][i];
}

template <bool FULL, int DIR>
DI void lru_scan(f32x16 (&acc)[2][2], float Hin, f32x2* agg_out) {
    const int lane = tid_fresh() & 63, h = lane >> 5;
    float sA[8], sU[8];
#pragma unroll
    for (int s = 0; s < 8; ++s) { const int mb = s >> 2, g = s & 3; float A = 1.f, U = 0.f;
#pragma unroll
        for (int e = 0; e < 4; ++e) { const int i = 4 * g + (DIR == 0 ? e : 3 - e); U = acc[0][mb][i] * U + acc[1][mb][i]; A *= acc[0][mb][i]; }
        sA[s] = A; sU[s] = U; }
    float pA[8], pU[8];
#pragma unroll
    for (int s = 0; s < 8; ++s) { pA[s] = __shfl_xor(sA[s], 32); pU[s] = __shfl_xor(sU[s], 32); }
    const bool first = (h == (DIR == 0 ? 0 : 1));
    if (!FULL) {
        float A = 1.f, U = 0.f;
#pragma unroll
        for (int q = 0; q < 8; ++q) { const int s = DIR == 0 ? q : 7 - q;
            const float A1 = first ? sA[s] : pA[s], U1 = first ? sU[s] : pU[s], A2 = first ? pA[s] : sA[s], U2 = first ? pU[s] : sU[s];
            U = A1 * U + U1; A *= A1; U = A2 * U + U2; A *= A2; }
        if (h == 0) *agg_out = (f32x2){A, U};
    } else {
        float H = Hin;
        float st[8];
#pragma unroll
        for (int q = 0; q < 8; ++q) { const int s = DIR == 0 ? q : 7 - q;
            const float A1 = first ? sA[s] : pA[s], U1 = first ? sU[s] : pU[s], A2 = first ? pA[s] : sA[s], U2 = first ? pU[s] : sU[s];
            const float Hm = A1 * H + U1; st[s] = first ? H : Hm; H = A2 * Hm + U2; }
#pragma unroll
        for (int s = 0; s < 8; ++s) { const int mb = s >> 2, g = s & 3; float hv = st[s];
#pragma unroll
            for (int e = 0; e < 4; ++e) { const int i = 4 * g + (DIR == 0 ? e : 3 - e); hv = acc[0][mb][i] * hv + acc[1][mb][i]; acc[1][mb][i] = hv; } }
    }
}

constexpr int LX_RS = 272;
template <bool FULL>
DI void lru_run(const KArgs& a, LAS unsigned char* lds, int b, int n, int tile0, int ntiles, bool is_ctx) {
    const int tid = tid_fresh(), lane = tid & 63, wid = __builtin_amdgcn_readfirstlane(tid >> 6), h = lane >> 5, c = lane & 31;
    LAS unsigned char* raw = lds;
    LAS unsigned char* xcb = lds + 67 * LX_RS;
    LAS float* cw = (LAS float*)(xcb + 64 * LX_RS);
    LAS float* hfb = cw + 640;
    LAS float* hbb = hfb + 64 * 132;
    const int Ls = is_ctx ? CTXL : SEQ;
    const bf16_t* xl = is_ctx ? (const bf16_t*)(a.ws + WS_CTXX) + (size_t)(b * CTXL) * 1024 + 128 * n : (const bf16_t*)(a.ws + WS_ZXL) + (size_t)(b * SEQ) * 1024 + 128 * n;
    const int dir = wid >> 2, nq = wid & 3, gc = 128 * n + 32 * nq + c;
    __syncthreads();
    for (int i = tid; i < 640; i += 512) { const int k = i >> 7, ch = i & 127; cw[i] = k < 4 ? a.in[I_CONVW][k * 1024 + 128 * n + ch] : a.in[I_CONVB][128 * n + ch]; }
    bf16x8 Bw[2][8];
    {   const bf16_t* wa = (const bf16_t*)(a.ws + WS_WLB) + (size_t)((2 * dir) * 8 + n) * 128 * 128 + (size_t)(32 * nq + c) * 128 + 8 * h;
#pragma unroll
        for (int ks = 0; ks < 8; ++ks) { Bw[0][ks] = *(const bf16x8*)(wa + 16 * ks); Bw[1][ks] = *(const bf16x8*)(wa + (size_t)8 * 128 * 128 + 16 * ks); } }
    const float ba2 = -LOG2E * a.in[I_LBA][dir * 1024 + gc], bx2 = -LOG2E * a.in[I_LBX][dir * 1024 + gc];
    const float cl = -8.0f * softplus_(-a.in[I_LLAM][dir * 1024 + gc]) * LOG2E;
    const size_t chain0 = ((size_t)(b * 2 + dir) * 1024 + gc) * NSLOT;
    u32x4 pre[3];
#define LRU_LOADRAW(tile_) do { _Pragma("unroll") for (int i_ = 0; i_ < 3; ++i_) { const int pid_ = tid + 512 * i_; pre[i_] = (u32x4){0u, 0u, 0u, 0u}; \
        if (pid_ < 67 * 16) { const int t_ = (tile_) * LT + (pid_ >> 4) - 1; if (t_ >= 0 && t_ < Ls) pre[i_] = *(const u32x4*)(xl + (size_t)t_ * 1024 + (pid_ & 15) * 8); } } } while (0)
    LRU_LOADRAW(tile0);
    for (int it = 0; it < ntiles; ++it) {
        const int tile = tile0 + it, t0 = tile * LT;
#pragma unroll
        for (int i = 0; i < 3; ++i) { const int pid = tid + 512 * i; if (pid < 67 * 16) *(LAS u32x4*)(raw + (pid >> 4) * LX_RS + (pid & 15) * 16) = pre[i]; }
        if (it + 1 < ntiles) LRU_LOADRAW(tile + 1);
        const int slot = is_ctx ? (dir == 0 ? tile : 3 - tile) : (dir == 0 ? 4 + tile : 4 + (NLT - 1 - tile));
        float Hin = 0.f; if (FULL) Hin = ((const float*)(a.ws + WS_LHIN))[chain0 + slot];
        u32x4 gpre[2]; bf16_t* gtile = (bf16_t*)(a.ws + WS_ZGL) + (size_t)(b * SEQ + t0) * 1024 + 128 * n;
        if (FULL) {
#pragma unroll
            for (int i = 0; i < 2; ++i) { const int pid = tid + 512 * i; gpre[i] = *(const u32x4*)(gtile + (size_t)(pid >> 4) * 1024 + (pid & 15) * 8); } }
        lds_barrier();
        {
            const int row = tid >> 3, c0 = (tid & 7) * 16; float o[16];
#pragma unroll
            for (int j = 0; j < 16; j += 4) { const f32x4 bv = *(const LAS f32x4*)(cw + 512 + c0 + j); o[j] = bv[0]; o[j + 1] = bv[1]; o[j + 2] = bv[2]; o[j + 3] = bv[3]; }
#pragma unroll
            for (int k = 0; k < 4; ++k) { const u32x4 p0 = *(const LAS u32x4*)(raw + (row + k) * LX_RS + c0 * 2), p1 = *(const LAS u32x4*)(raw + (row + k) * LX_RS + c0 * 2 + 16);
#pragma unroll
                for (int e = 0; e < 4; ++e) { const f32x4 w0 = *(const LAS f32x4*)(cw + k * 128 + c0 + 4 * (e >> 1) ), w1 = *(const LAS f32x4*)(cw + k * 128 + c0 + 8 + 4 * (e >> 1));
                    o[2 * e] += w0[2 * (e & 1)] * __uint_as_float(p0[e] << 16); o[2 * e + 1] += w0[2 * (e & 1) + 1] * __uint_as_float(p0[e] & 0xffff0000u);
                    o[8 + 2 * e] += w1[2 * (e & 1)] * __uint_as_float(p1[e] << 16); o[8 + 2 * e + 1] += w1[2 * (e & 1) + 1] * __uint_as_float(p1[e] & 0xffff0000u); } }
            u32x4 w0, w1;
#pragma unroll
            for (int e = 0; e < 4; ++e) { w0[e] = cvt_pk_bf16(o[2 * e], o[2 * e + 1]); w1[e] = cvt_pk_bf16(o[8 + 2 * e], o[8 + 2 * e + 1]); }
            *(LAS u32x4*)(xcb + row * LX_RS + c0 * 2) = w0; *(LAS u32x4*)(xcb + row * LX_RS + c0 * 2 + 16) = w1;
        }
        lds_barrier();
        f32x16 acc[2][2];
#pragma unroll
        for (int q = 0; q < 2; ++q) for (int mb = 0; mb < 2; ++mb) acc[q][mb] = zero16();
#pragma unroll
        for (int ks = 0; ks < 8; ++ks) {
            const bf16x8 a0 = *(const LAS bf16x8*)(xcb + c * LX_RS + (16 * ks + 8 * h) * 2), a1 = *(const LAS bf16x8*)(xcb + (32 + c) * LX_RS + (16 * ks + 8 * h) * 2);
            acc[0][0] = MFMA32(a0, Bw[0][ks], acc[0][0]); acc[0][1] = MFMA32(a1, Bw[0][ks], acc[0][1]); acc[1][0] = MFMA32(a0, Bw[1][ks], acc[1][0]); acc[1][1] = MFMA32(a1, Bw[1][ks], acc[1][1]);
        }
#pragma unroll
        for (int mb = 0; mb < 2; ++mb)
#pragma unroll
            for (int i = 0; i < 16; ++i) { const int row = 32 * mb + crow(i, h);
                const float r = rcpf_(1.0f + ex2(acc[0][mb][i] + ba2)), ig = rcpf_(1.0f + ex2(acc[1][mb][i] + bx2));
                const float av = ex2(cl * r); const float s = sqrtf(fmaxf(1.0f - av * av, 0.f));
                acc[0][mb][i] = av; acc[1][mb][i] = s * ig * bf2f(*(const LAS bf16_t*)(xcb + row * LX_RS + (32 * nq + c) * 2)); }
        f32x2* aggp = (f32x2*)(a.ws + WS_LAGG) + chain0 + slot;
        if (dir == 0) lru_scan<FULL, 0>(acc, Hin, aggp); else lru_scan<FULL, 1>(acc, Hin, aggp);
        if (FULL) {
            LAS float* hd = dir == 0 ? hfb : hbb;
#pragma unroll
            for (int mb = 0; mb < 2; ++mb)
#pragma unroll
                for (int i = 0; i < 16; ++i) hd[(32 * mb + crow(i, h)) * 132 + 32 * nq + c] = acc[1][mb][i];
            lds_barrier();
#pragma unroll
            for (int i = 0; i < 2; ++i) { const int pid = tid + 512 * i, row = pid >> 4, c8 = (pid & 15) * 8;
                const f32x4 f0 = *(const LAS f32x4*)(hfb + row * 132 + c8), f1 = *(const LAS f32x4*)(hfb + row * 132 + c8 + 4), b0 = *(const LAS f32x4*)(hbb + row * 132 + c8), b1 = *(const LAS f32x4*)(hbb + row * 132 + c8 + 4);
                const u32x4 g = gpre[i]; u32x4 o;
                o[0] = cvt_pk_bf16((f0[0] + b0[0]) * __uint_as_float(g[0] << 16), (f0[1] + b0[1]) * __uint_as_float(g[0] & 0xffff0000u));
                o[1] = cvt_pk_bf16((f0[2] + b0[2]) * __uint_as_float(g[1] << 16), (f0[3] + b0[3]) * __uint_as_float(g[1] & 0xffff0000u));
                o[2] = cvt_pk_bf16((f1[0] + b1[0]) * __uint_as_float(g[2] << 16), (f1[1] + b1[1]) * __uint_as_float(g[2] & 0xffff0000u));
                o[3] = cvt_pk_bf16((f1[2] + b1[2]) * __uint_as_float(g[3] << 16), (f1[3] + b1[3]) * __uint_as_float(g[3] & 0xffff0000u));
                *(u32x4*)(gtile + (size_t)row * 1024 + c8) = o; }
        }
    }
#undef LRU_LOADRAW
}

DI void ret_decays(const KArgs& a, int h, float& lgf2, float& lgb2) {
    lgf2 = -softplus_(-a.in[I_RDECAY][h]) * LOG2E; lgb2 = -softplus_(-a.in[I_RDECAY][4 + h]) * LOG2E;
}

DI void phase2a(const KArgs& a, LAS unsigned char* lds) {
    const int G = gridDim.x;
    constexpr int NU_R1 = NB_ * NH * NSC * 2, NU_CK = NB_ * NH * 2, NU_LX = NB_ * 8 * 16, NU_LC = NB_ * 8;
    for (int u = blockIdx.x; u < NU_R1 + NU_CK + NU_LX + NU_LC; u += G) {
        if (SUBSEL(1) && u < NU_R1) {
            const int dir = u & 1, sc = (u >> 1) & 31, h = (u >> 6) & 3, b = u >> 8; float lgf2, lgb2; ret_decays(a, h, lgf2, lgb2);
            float* o = (float*)(a.ws + WS_HX) + (size_t)(((b * 4 + h) * 32 + sc) * 2 + dir) * 32768;
            PB(100); r1_unit(lds, (const bf16_t*)(a.ws + WS_ZK) + (size_t)(b * SEQ + sc * SCH) * 512 + h * 128, 512, (const bf16_t*)(a.ws + WS_ZV) + (size_t)(b * SEQ + sc * SCH) * 1024 + h * 256, 1024, SCH, dir ? lgb2 : lgf2, dir, o); PE(100);
        } else if (SUBSEL(1) && u < NU_R1 + NU_CK) {
            const int q = u - NU_R1, dir = q & 1, h = (q >> 1) & 3, b = q >> 3; float lgf2, lgb2; ret_decays(a, h, lgf2, lgb2);
            float* o = (float*)(a.ws + WS_CTXS) + (size_t)((b * 4 + h) * 2 + dir) * 32768;
            r1_unit(lds, (const bf16_t*)(a.ws + WS_CTXK) + (size_t)(b * CTXL) * 512 + h * 128, 512, (const bf16_t*)(a.ws + WS_CTXV) + (size_t)(b * CTXL) * 1024 + h * 256, 1024, CTXL, dir ? lgb2 : lgf2, dir, o);
        } else if (SUBSEL(2) && u < NU_R1 + NU_CK + NU_LX) {
            const int q = u - NU_R1 - NU_CK, b = q >> 7, n = (q >> 4) & 7, r = q & 15;
            PB(101); lru_run<false>(a, lds, b, n, 16 * r, 16, false); PE(101);
        } else if (SUBSEL(2)) {
            const int q = u - NU_R1 - NU_CK - NU_LX, b = q >> 3, n = q & 7;
            lru_run<false>(a, lds, b, n, 0, 4, true);
        }
    }
}

DI void phase2b(const KArgs& a) {
    const int tid = tid_fresh(), G = gridDim.x, lane = tid & 63, wid = tid >> 6;
    for (int e = blockIdx.x * 512 + tid; e < NB_ * NH * 2 * 8192; e += G * 512) {
        const int e4 = e & 8191, dir = (e >> 13) & 1, h = (e >> 14) & 3, b = e >> 16;
        float lgf2, lgb2; ret_decays(a, h, lgf2, lgb2); const float gC = ex2((dir ? lgb2 : lgf2) * (float)SCH);
        f32x4 S = *(const f32x4*)((const float*)(a.ws + WS_CTXS) + (size_t)((b * 4 + h) * 2 + dir) * 32768 + 4 * e4);
        const float* kv = (const float*)(a.ws + WS_HX) + (size_t)((b * 4 + h) * 32 * 2 + dir) * 32768 + 4 * e4;
        bf16_t* so = (bf16_t*)(a.ws + WS_SBF) + (size_t)((b * 4 + h) * 32 * 2 + dir) * 32768 + 4 * e4;
        for (int s0 = 0; s0 < NSC; s0 += 8) {
            f32x4 kvv[8];
#pragma unroll
            for (int j = 0; j < 8; ++j) { const int sc = dir ? NSC - 1 - (s0 + j) : s0 + j; kvv[j] = *(const f32x4*)(kv + (size_t)sc * 65536); }
#pragma unroll
            for (int j = 0; j < 8; ++j) { const int sc = dir ? NSC - 1 - (s0 + j) : s0 + j;
                u32x2 w; w.x = cvt_pk_bf16(S[0], S[1]); w.y = cvt_pk_bf16(S[2], S[3]); *(u32x2*)(so + (size_t)sc * 65536) = w;
                S = S * gC + kvv[j]; }
        }
    }
    for (int ch = blockIdx.x * 8 + wid; ch < NB_ * 2 * 1024; ch += G * 8) {
        const f32x2* ag = (const f32x2*)(a.ws + WS_LAGG) + (size_t)ch * NSLOT; float* hin = (float*)(a.ws + WS_LHIN) + (size_t)ch * NSLOT;
        float carry = 0.f;
        for (int rd = 0; rd < 5; ++rd) { const int slot = 64 * rd + lane;
            f32x2 v = (f32x2){1.f, 0.f}; if (slot < 4 + NLT) v = ag[slot];
            float A = v[0], U = v[1];
#pragma unroll
            for (int o = 1; o < 64; o <<= 1) { const float Ap = __shfl_up(A, o), Up = __shfl_up(U, o); if (lane >= o) { U = A * Up + U; A = A * Ap; } }
            const float incl = A * carry + U;
            float excl = __shfl_up(incl, 1); if (lane == 0) excl = carry;
            if (slot < 4 + NLT) hin[slot] = excl;
            carry = __shfl(incl, 63);
        }
    }
}

constexpr int R3_RSQ = 272, R3_RSK = 272, R3_RSV = 576, R3_RSP = 144;
DI void r3_unit(const KArgs& a, LAS unsigned char* lds, int b, int hh, int qb) {
    const int tid = tid_fresh(), lane = tid & 63, wid = tid >> 6, h = lane >> 5, c = lane & 31;
    LAS unsigned char* Qs = lds; LAS unsigned char* Ks = Qs + 128 * R3_RSQ; LAS unsigned char* Vs = Ks + 64 * R3_RSK; LAS unsigned char* Ps = Vs + 64 * R3_RSV;
    LAS float* red = (LAS float*)(Ps + 128 * R3_RSP);
    const int sc = qb >> 2, blk = qb & 3;
    float lgf2, lgb2; ret_decays(a, hh, lgf2, lgb2);
    const size_t tok0 = (size_t)b * SEQ + 128 * qb, tokS = (size_t)b * SEQ + SCH * sc;
    __syncthreads();
#pragma unroll
    for (int i = 0; i < 4; ++i) { const int pid = tid + 512 * i, row = pid >> 4, c16 = pid & 15;
        *(LAS u32x4*)(Qs + row * R3_RSQ + c16 * 16) = *(const u32x4*)((const bf16_t*)(a.ws + WS_ZQ) + (tok0 + row) * 512 + hh * 128 + c16 * 8); }
    __syncthreads();
    const int rb = wid >> 1, dvh = wid & 1;
    f32x16 O[4];
    {
#pragma unroll
        for (int nb = 0; nb < 4; ++nb) O[nb] = zero16();
#pragma unroll 1
        for (int d = 0; d < 2; ++d) {
            const bf16_t* Sg = (const bf16_t*)(a.ws + WS_SBF) + (size_t)(((b * 4 + hh) * 32 + sc) * 2 + d) * 32768 + (size_t)(128 * dvh + c) * 128 + 8 * h;
            f32x16 tmp[4];
#pragma unroll
            for (int nb = 0; nb < 4; ++nb) tmp[nb] = zero16();
#pragma unroll 2
            for (int ks = 0; ks < 8; ++ks) { const bf16x8 af = *(const LAS bf16x8*)(Qs + (32 * rb + c) * R3_RSQ + (16 * ks + 8 * h) * 2);
#pragma unroll
                for (int nb = 0; nb < 4; ++nb) { const bf16x8 bfr = *(const bf16x8*)(Sg + (size_t)(32 * nb) * 128 + 16 * ks); tmp[nb] = MFMA32(af, bfr, tmp[nb]); } }
            const float lg = d ? lgb2 : lgf2; const float e0 = d ? (float)(SCH - 128 * blk - 32 * rb - 4 * h) : (float)(128 * blk + 32 * rb + 4 * h + 1), sg = d ? -1.f : 1.f;
#pragma unroll
            for (int i = 0; i < 16; ++i) { const float dec = ex2(lg * (e0 + sg * (float)((i & 3) + 8 * (i >> 2))));
#pragma unroll
                for (int nb = 0; nb < 4; ++nb) O[nb][i] += dec * tmp[nb][i]; }
        }
    }
    const unsigned lb = (unsigned)(8 * h + ((lane & 15) >> 2)), tb = (lane >> 4) & 1, tp = lane & 3;
    const unsigned lbV = (unsigned)(size_t)Vs + lb * R3_RSV + 32 * tb + 8 * tp + (128 * dvh) * 2;
    const int jbk = wid & 1, ib = wid >> 1;
    for (int jb = 0; jb < 8; ++jb) {
        u32x4 kreg[2], vreg[4];
#pragma unroll
        for (int i = 0; i < 2; ++i) { const int pid = tid + 512 * i, row = pid >> 4, c16 = pid & 15; kreg[i] = *(const u32x4*)((const bf16_t*)(a.ws + WS_ZK) + (tokS + 64 * jb + row) * 512 + hh * 128 + c16 * 8); }
#pragma unroll
        for (int i = 0; i < 4; ++i) { const int pid = tid + 512 * i, row = pid >> 5, c16 = pid & 31; vreg[i] = *(const u32x4*)((const bf16_t*)(a.ws + WS_ZV) + (tokS + 64 * jb + row) * 1024 + hh * 256 + c16 * 8); }
        __syncthreads();
#pragma unroll
        for (int i = 0; i < 2; ++i) { const int pid = tid + 512 * i, row = pid >> 4, c16 = pid & 15; *(LAS u32x4*)(Ks + row * R3_RSK + c16 * 16) = kreg[i]; }
#pragma unroll
        for (int i = 0; i < 4; ++i) { const int pid = tid + 512 * i, row = pid >> 5, c16 = pid & 31; *(LAS u32x4*)(Vs + row * R3_RSV + c16 * 16) = vreg[i]; }
        __syncthreads();
        f32x16 st = zero16();
#pragma unroll
        for (int ks = 0; ks < 8; ++ks) { const bf16x8 kf = *(const LAS bf16x8*)(Ks + (32 * jbk + c) * R3_RSK + (16 * ks + 8 * h) * 2), qf = *(const LAS bf16x8*)(Qs + (32 * ib + c) * R3_RSQ + (16 * ks + 8 * h) * 2);
            st = MFMA32(kf, qf, st); }
        {
            const int ti = 128 * blk + 32 * ib + c;
#pragma unroll
            for (int g = 0; g < 4; ++g) { float pv[4];
#pragma unroll
                for (int e = 0; e < 4; ++e) { const int tj = 64 * jb + 32 * jbk + 8 * g + 4 * h + e; const int d = ti - tj; const float w = d >= 0 ? ex2(lgf2 * (float)d) : ex2(lgb2 * (float)(-d)); pv[e] = st[4 * g + e] * w; }
                u32x2 w2; w2.x = cvt_pk_bf16(pv[0], pv[1]); w2.y = cvt_pk_bf16(pv[2], pv[3]);
                *(LAS u32x2*)(Ps + (32 * ib + c) * R3_RSP + (32 * jbk + 8 * g + 4 * h) * 2) = w2; }
        }
        __syncthreads();
#pragma unroll
        for (int ks = 0; ks < 4; ++ks) { const bf16x8 pf = *(const LAS bf16x8*)(Ps + (32 * rb + c) * R3_RSP + (16 * ks + 8 * h) * 2);
            bf16x8 vf[4]; tr_frag4<0, 64, 4 * R3_RSV>(lbV + ks * 16 * R3_RSV, vf[0], vf[1], vf[2], vf[3]);
#pragma unroll
            for (int nb = 0; nb < 4; ++nb) O[nb] = MFMA32(pf, vf[nb], O[nb]); }
    }
    float s1[16], s2[16];
#pragma unroll
    for (int i = 0; i < 16; ++i) { float x = 0.f, y = 0.f;
#pragma unroll
        for (int nb = 0; nb < 4; ++nb) { x += O[nb][i]; y += O[nb][i] * O[nb][i]; }
#pragma unroll
        for (int o = 16; o >= 1; o >>= 1) { x += __shfl_xor(x, o); y += __shfl_xor(y, o); }
        s1[i] = x; s2[i] = y; }
    if (c == 0) {
#pragma unroll
        for (int i = 0; i < 16; ++i) { const int row = 32 * rb + crow(i, h); red[(row * 2 + dvh) * 2 + 0] = s1[i]; red[(row * 2 + dvh) * 2 + 1] = s2[i]; } }
    __syncthreads();
    bf16_t* gp = (bf16_t*)(a.ws + WS_ZG) + tok0 * 1024 + hh * 256 + 128 * dvh + c;
#pragma unroll
    for (int i = 0; i < 16; ++i) { const int row = 32 * rb + crow(i, h);
        const float sx = red[(row * 2 + 0) * 2 + 0] + red[(row * 2 + 1) * 2 + 0], sy = red[(row * 2 + 0) * 2 + 1] + red[(row * 2 + 1) * 2 + 1];
        const float mu = sx * (1.0f / 256.0f), var = fmaxf(sy * (1.0f / 256.0f) - mu * mu, 0.f), rstd = rsqrtf(var + EPSV);
#pragma unroll
        for (int nb = 0; nb < 4; ++nb) { bf16_t* p = gp + (size_t)row * 1024 + 32 * nb; const float gain = a.in[I_RNORM][hh * 256 + 128 * dvh + 32 * nb + c];
            *p = f2bf((O[nb][i] - mu) * rstd * gain * bf2f(*p)); } }
}

DI void phase2c(const KArgs& a, LAS unsigned char* lds) {
    const int G = gridDim.x;
    constexpr int NU_R3 = NB_ * NH * (SEQ / 128), NU_L3 = NB_ * 8 * 16;
    for (int u = blockIdx.x; u < NU_R3 + NU_L3; u += G) {
        if (SUBSEL(1) && u < NU_R3) { const int b = u >> 9, hh = (u >> 7) & 3, qb = u & 127; PB(102); r3_unit(a, lds, b, hh, qb); PE(102); }
        else if (SUBSEL(2)) { const int q = u - NU_R3, b = q >> 7, n = (q >> 4) & 7, r = q & 15; PB(103); lru_run<true>(a, lds, b, n, 16 * r, 16, false); PE(103); }
    }
}

DI void phase3_cvt(const KArgs& a, LAS unsigned char* lds) {
    const int G = gridDim.x; LAS float* fl = (LAS float*)lds;
    constexpr int T_GU = 32 * 2 * 16 * 12, T_DN = 32 * 12 * 16;
    for (int t = blockIdx.x; t < T_GU + T_DN; t += G) {
        if (t < T_GU) { const int e = t / 384, r = t % 384, mat = r / 192, kt = (r % 192) / 12, nn = r % 12;
            const float* src = a.in[mat ? I_WEU : I_WEG] + (size_t)e * 1024 * 768 + (size_t)(64 * kt) * 768 + 64 * nn;
            bf16_t* dst = (bf16_t*)(a.ws + WS_WGU) + ((size_t)(e * 6 + (nn >> 1)) * 256 + mat * 128 + (nn & 1) * 64) * 1024 + 64 * kt;
            cvt_tile(fl, src, 768, dst, 1024, 1.f);
        } else { const int q = t - T_GU, e = q / 192, r = q % 192, kt = r / 16, nt = r % 16;
            const float* src = a.in[I_WED] + (size_t)e * 768 * 1024 + (size_t)(64 * kt) * 1024 + 64 * nt;
            bf16_t* dst = (bf16_t*)(a.ws + WS_WDN) + ((size_t)e * 1024 + 64 * nt) * 768 + 64 * kt;
            cvt_tile(fl, src, 1024, dst, 768, 1.f);
        }
    }
    __syncthreads();
}
struct OrderMerge {
    const char* A0; const char* A1; const char* B0; const char* B1; int G, c;
    DI bool next(int i, Unit& u) const { int pm, pn; if (!pg8::static_tile(i >> 1, G, c, NT / 256, 4, pm, pn)) return false;
        const int st = i & 1; u.pm = pm; u.pn = pn; u.aux = st; u.bmode = 1; u.A = (st ? A1 : A0) + (size_t)pm * 256 * 1024 * 2; u.B = (st ? B1 : B0) + (size_t)pn * 256 * 1024 * 2; return true; }
    DI void offsA(const Unit&, int, const int (&R)[2], const int (&C)[2], unsigned (&v)[2][2]) const { pg8::dense_offs(1024, R, C, v); }
};
struct EpiMerge {
    const bf16_t* glog; bf16_t* out;
    DI bool operator()(f32x4 (&acc)[2][2][4][2], const Unit& u, int wr, int wc, int fr, int fq) const {
#pragma unroll
        for (int bj = 0; bj < 2; ++bj) { const int col = u.pn * 256 + bj * 128 + wc * 32 + 8 * fq;
#pragma unroll
            EPI_LOOP_ROWS { const int row = u.pm * 256 + ai * 128 + wr * 64 + m * 16 + fr;
                const u32x4 gl = *(const u32x4*)(glog + (size_t)row * 2048 + 1024 + col);
                if (u.aux == 0) { const u32x4 gr = *(const u32x4*)(glog + (size_t)row * 2048 + col);
#pragma unroll
                    for (int e = 0; e < 4; ++e) { const float r0 = __uint_as_float(gr[e] << 16), r1 = __uint_as_float(gr[e] & 0xffff0000u), l0 = __uint_as_float(gl[e] << 16), l1 = __uint_as_float(gl[e] & 0xffff0000u);
                        const float q0 = (1.0f + ex2(-LOG2E * l0)) * rcpf_(1.0f + ex2(-LOG2E * r0)), q1 = (1.0f + ex2(-LOG2E * l1)) * rcpf_(1.0f + ex2(-LOG2E * r1));
                        acc[ai][bj][m][e >> 1][2 * (e & 1)] *= q0; acc[ai][bj][m][e >> 1][2 * (e & 1) + 1] *= q1; }
                } else { float v[8];
#pragma unroll
                    for (int e = 0; e < 4; ++e) { const float l0 = __uint_as_float(gl[e] << 16), l1 = __uint_as_float(gl[e] & 0xffff0000u);
                        v[2 * e] = acc[ai][bj][m][e >> 1][2 * (e & 1)] * sigm(l0); v[2 * e + 1] = acc[ai][bj][m][e >> 1][2 * (e & 1) + 1] * sigm(l1); }
                    u32x4 w; w.x = cvt_pk_bf16(v[0], v[1]); w.y = cvt_pk_bf16(v[2], v[3]); w.z = cvt_pk_bf16(v[4], v[5]); w.w = cvt_pk_bf16(v[6], v[7]);
                    *(u32x4*)(out + (size_t)row * 1024 + col) = w; } } }
        return u.aux == 0;
    }
};

struct OrderOut {
    const char* A; const char* B; int G, c;
    DI bool next(int i, Unit& u) const { int pm, pn; if (!pg8::static_tile(i, G, c, NT / 256, 4, pm, pn)) return false;
        u.pm = pm; u.pn = pn; u.aux = 0; u.bmode = 0; u.A = A + (size_t)pm * 256 * 1024 * 2; u.B = B + (size_t)pn * 256 * 1024 * 2; return true; }
    DI void offsA(const Unit&, int, const int (&R)[2], const int (&C)[2], unsigned (&v)[2][2]) const { pg8::dense_offs(1024, R, C, v); }
};
struct EpiOut {
    const KArgs* a;
    DI bool operator()(f32x4 (&acc)[2][2][4][2], const Unit& u, int wr, int wc, int fr, int fq) const {
        const int b = (u.pm * 256) / SEQ;
#pragma unroll
        for (int bj = 0; bj < 2; ++bj)
#pragma unroll
            for (int n = 0; n < 2; ++n) { const int col = u.pn * 256 + bj * 128 + wc * 32 + 16 * n + 4 * fq; f32x4 g;
#pragma unroll
                for (int j = 0; j < 4; ++j) g[j] = 0.f;
                g = *(const f32x4*)((const float*)(a->ws + WS_MODT) + b * 1024 + col);
#pragma unroll
                EPI_LOOP_ROWS { const size_t off = (size_t)(u.pm * 256 + ai * 128 + wr * 64 + m * 16 + fr) * 1024 + col;
                    *(f32x4*)(a->out + off) = *(const f32x4*)(a->in[I_X] + off) + g * acc[ai][bj][m][n]; } }
        return false;
    }
};

DI void phase5(const KArgs& a, LAS unsigned char* lds) {
    const int tid = tid_fresh(), G = gridDim.x, lane = tid & 63, wid = tid >> 6;
    LAS float* gm = (LAS float*)lds;
    LAS float* sh = gm + 2048;
    LAS float* lg = sh + 2048;
    LAS int* lcnt = (LAS int*)(lg + 128 * 40);
    LAS int* rinfo = lcnt + 64;
    LAS float* rw = (LAS float*)(rinfo + 512);
    __syncthreads();
    for (int i = tid; i < 2048; i += 512) { const float* mt = (const float*)(a.ws + WS_MODT); gm[i] = mt[2048 + i]; sh[i] = mt[4096 + i]; }
    if (blockIdx.x == 0) for (int i = tid; i < 512; i += 512) ((unsigned*)(a.ws + WS_HX2) + (size_t)NT * 512)[i] = 0u;
    bf16_t* hx2 = (bf16_t*)(a.ws + WS_HX2);
    int* cnt = (int*)(a.ws + WS_CTL) + CW_CNT;
    for (int rt = blockIdx.x; rt < NT / 128; rt += G) {
        __syncthreads();
        if (tid < 32) lcnt[tid] = 0;
        for (int rr = 0; rr < 16; ++rr) { const int row = 128 * rt + 16 * wid + rr; const int v = row / SEQ; const float* xr = a.out + (size_t)row * 1024; f32x4 x[4]; float ss = 0.f;
#pragma unroll
            for (int j = 0; j < 4; ++j) { x[j] = *(const f32x4*)(xr + 4 * lane + 256 * j); ss += (x[j][0] * x[j][0] + x[j][1] * x[j][1]) + (x[j][2] * x[j][2] + x[j][3] * x[j][3]); }
#pragma unroll
            for (int o = 32; o >= 1; o >>= 1) ss += __shfl_xor(ss, o);
            const float rstd = rsqrtf(ss * (1.0f / 1024.0f) + EPSV);
#pragma unroll
            for (int j = 0; j < 4; ++j) { const int k0 = 4 * lane + 256 * j; const f32x4 g = *(const LAS f32x4*)(gm + v * 1024 + k0), s = *(const LAS f32x4*)(sh + v * 1024 + k0);
                u32x2 w; w.x = cvt_pk_bf16(x[j][0] * rstd * g[0] + s[0], x[j][1] * rstd * g[1] + s[1]); w.y = cvt_pk_bf16(x[j][2] * rstd * g[2] + s[2], x[j][3] * rstd * g[3] + s[3]);
                *(u32x2*)(hx2 + (size_t)row * 1024 + k0) = w; } }
        __syncthreads();
        {
            const int rb = wid >> 1, cb = wid & 1, r = lane & 31, h = lane >> 5;
            const bf16_t* ar = hx2 + (size_t)(128 * rt + 32 * rb + r) * 1024 + 8 * h;
            const bf16_t* bh = (const bf16_t*)(a.ws + WS_WRH) + (size_t)(32 * cb + r) * 1024 + 8 * h; const bf16_t* bl = bh + 64 * 1024;
            f32x16 acc = zero16();
#pragma unroll 8
            for (int ks = 0; ks < 64; ++ks) { const bf16x8 af = *(const bf16x8*)(ar + 16 * ks), b1 = *(const bf16x8*)(bh + 16 * ks), b2 = *(const bf16x8*)(bl + 16 * ks);
                acc = MFMA32(af, b1, acc); acc = MFMA32(af, b2, acc); }
            const int col = 32 * cb + r;
            if (col < 36) {
#pragma unroll
                for (int i = 0; i < 16; ++i) lg[(32 * rb + crow(i, h)) * 40 + col] = acc[i]; }
        }
        __syncthreads();
        if (tid < 128) { const LAS float* l = lg + tid * 40;
            int gs = 0; float best = l[0] + a.in[I_BGRP][0];
#pragma unroll
            for (int g = 1; g < 4; ++g) { const float v = l[g] + a.in[I_BGRP][g]; if (v > best) { best = v; gs = g; } }
            const float mx = fmaxf(fmaxf(l[0], l[1]), fmaxf(l[2], l[3])); float den = 0.f;
#pragma unroll
            for (int g = 0; g < 4; ++g) den += expf(l[g] - mx);
            const float pg = expf(l[gs] - mx) / den;
            int i0 = 0, i1 = -1; float v0 = -3.0e38f, v1 = -3.0e38f;
#pragma unroll
            for (int e = 0; e < 8; ++e) { const float v = l[4 + 8 * gs + e] + a.in[I_BRT][8 * gs + e];
                if (v > v0) { v1 = v0; i1 = i0; v0 = v; i0 = e; } else if (v > v1) { v1 = v; i1 = e; } }
            const float e0 = l[4 + 8 * gs + i0], e1 = l[4 + 8 * gs + i1], m2 = fmaxf(e0, e1), x0 = expf(e0 - m2), x1 = expf(e1 - m2), inv = 1.0f / (x0 + x1);
            const int ex0 = 8 * gs + i0, ex1 = 8 * gs + i1;
            rinfo[tid * 4 + 0] = ex0; rinfo[tid * 4 + 1] = atomicAdd((int*)&lcnt[ex0], 1); rinfo[tid * 4 + 2] = ex1; rinfo[tid * 4 + 3] = atomicAdd((int*)&lcnt[ex1], 1);
            rw[tid * 2 + 0] = pg * x0 * inv; rw[tid * 2 + 1] = pg * x1 * inv; }
        __syncthreads();
        if (tid < 32) lcnt[32 + tid] = lcnt[tid] ? atomicAdd(&cnt[tid], lcnt[tid]) : 0;
        __syncthreads();
        if (tid < 128) { const int tok = 128 * rt + tid; const int e0 = rinfo[tid * 4 + 0], s0 = lcnt[32 + e0] + rinfo[tid * 4 + 1], e1 = rinfo[tid * 4 + 2], s1 = lcnt[32 + e1] + rinfo[tid * 4 + 3];
            int* ptok = (int*)(a.ws + WS_PTOK); ptok[(size_t)e0 * 65536 + s0] = tok; ptok[(size_t)e1 * 65536 + s1] = tok;
            unsigned* ro = (unsigned*)(a.ws + WS_ROUTE) + (size_t)tok * 8; ro[0] = e0; ro[1] = s0; ro[2] = e1; ro[3] = s1; ro[4] = __float_as_uint(rw[tid * 2]); ro[5] = __float_as_uint(rw[tid * 2 + 1]); }
    }
}

DI void moe_tiles(const KArgs& a, LAS int* tt) {
    __syncthreads();
    if (threadIdx.x == 0) { const int* cnt = (const int*)(a.ws + WS_CTL) + CW_CNT; int s = 0; for (int e = 0; e < 32; ++e) { tt[e] = s; s += (cnt[e] + 255) >> 8; } tt[32] = s; }
    __syncthreads();
}
DI int moe_expert(const LAS int* tt, int rt) { int e = 0;
#pragma unroll
    for (int q = 16; q >= 1; q >>= 1) if (tt[e + q] <= rt) e += q;
    return e; }
struct OrderMoe1 {
    const char* A; const char* B; const LAS int* tt; const LAS int* tok; int G, c;
    DI bool next(int i, Unit& u) const { const int L = i * G + c; if (L >= tt[32] * 6) return false; const int rt = L / 6, ct = L % 6, e = moe_expert(tt, rt);
        u.pm = rt; u.pn = ct; u.aux = e; u.bmode = 1; u.A = A; u.B = B + (size_t)(e * 6 + ct) * 256 * 1024 * 2; return true; }
    DI void offsA(const Unit&, int ui, const int (&R)[2], const int (&C)[2], unsigned (&v)[2][2]) const {
#pragma unroll
        for (int h = 0; h < 2; ++h)
#pragma unroll
            for (int i = 0; i < 2; ++i) v[h][i] = (unsigned)tok[ui * 256 + h * 128 + R[i]] * 2048u + (unsigned)C[i] * 2u; }
};
struct EpiMoe1 {
    bf16_t* hid;
    DI bool operator()(f32x4 (&acc)[2][2][4][2], const Unit& u, int wr, int wc, int fr, int fq) const {
        const int col = u.pn * 128 + wc * 32 + 8 * fq;
#pragma unroll
        EPI_LOOP_ROWS { const size_t row = (size_t)u.pm * 256 + ai * 128 + wr * 64 + m * 16 + fr; float v[8];
#pragma unroll
            for (int n = 0; n < 2; ++n)
#pragma unroll
                for (int j = 0; j < 4; ++j) v[4 * n + j] = silu_(acc[ai][0][m][n][j]) * acc[ai][1][m][n][j];
            u32x4 w; w.x = cvt_pk_bf16(v[0], v[1]); w.y = cvt_pk_bf16(v[2], v[3]); w.z = cvt_pk_bf16(v[4], v[5]); w.w = cvt_pk_bf16(v[6], v[7]);
            *(u32x4*)(hid + row * 768 + col) = w; }
        return false;
    }
};
struct OrderMoe2 {
    const char* A; const char* B; const LAS int* tt; int G, c;
    DI bool next(int i, Unit& u) const { const int L = i * G + c; if (L >= tt[32] * 4) return false; const int rt = L >> 2, ct = L & 3, e = moe_expert(tt, rt);
        u.pm = rt; u.pn = ct; u.aux = e; u.bmode = 1; u.A = A + (size_t)rt * 256 * 768 * 2; u.B = B + ((size_t)e * 1024 + 256 * ct) * 768 * 2; return true; }
    DI void offsA(const Unit&, int, const int (&R)[2], const int (&C)[2], unsigned (&v)[2][2]) const { pg8::dense_offs(768, R, C, v); }
};
struct EpiMoe2 {
    bf16_t* ye;
    DI bool operator()(f32x4 (&acc)[2][2][4][2], const Unit& u, int wr, int wc, int fr, int fq) const {
#pragma unroll
        for (int bj = 0; bj < 2; ++bj) { const int col = u.pn * 256 + bj * 128 + wc * 32 + 8 * fq;
#pragma unroll
            EPI_LOOP_ROWS { const size_t row = (size_t)u.pm * 256 + ai * 128 + wr * 64 + m * 16 + fr; const f32x4 v0 = acc[ai][bj][m][0], v1 = acc[ai][bj][m][1];
                u32x4 w; w.x = cvt_pk_bf16(v0[0], v0[1]); w.y = cvt_pk_bf16(v0[2], v0[3]); w.z = cvt_pk_bf16(v1[0], v1[1]); w.w = cvt_pk_bf16(v1[2], v1[3]);
                *(u32x4*)(ye + row * 1024 + col) = w; } }
        return false;
    }
};

DI void phase8(const KArgs& a, LAS unsigned char* lds) {
    const int tid = tid_fresh(), G = gridDim.x, lane = tid & 63, wid = tid >> 6;
    LAS float* g2 = (LAS float*)lds;
    LAS int* tt = (LAS int*)(g2 + 2048);
    moe_tiles(a, tt);
    for (int i = tid; i < 2048; i += 512) g2[i] = ((const float*)(a.ws + WS_MODT))[6144 + i];
    __syncthreads();
    const bf16_t* ye = (const bf16_t*)(a.ws + WS_YE);
    for (int row = blockIdx.x * 8 + wid; row < NT; row += G * 8) {
        const int v = row / SEQ; const unsigned* ro = (const unsigned*)(a.ws + WS_ROUTE) + (size_t)row * 8;
        const size_t p0 = (size_t)tt[ro[0]] * 256 + ro[1], p1 = (size_t)tt[ro[2]] * 256 + ro[3]; const float w0 = __uint_as_float(ro[4]), w1 = __uint_as_float(ro[5]);
        float* xr = a.out + (size_t)row * 1024; f32x4 x[4]; float ss = 0.f;
#pragma unroll
        for (int j = 0; j < 4; ++j) { const int k0 = 4 * lane + 256 * j; x[j] = *(const f32x4*)(xr + k0);
            const u32x2 ya = *(const u32x2*)(ye + p0 * 1024 + k0), yb = *(const u32x2*)(ye + p1 * 1024 + k0); const f32x4 g = *(const LAS f32x4*)(g2 + v * 1024 + k0);
            x[j][0] += g[0] * (w0 * __uint_as_float(ya[0] << 16) + w1 * __uint_as_float(yb[0] << 16)); x[j][1] += g[1] * (w0 * __uint_as_float(ya[0] & 0xffff0000u) + w1 * __uint_as_float(yb[0] & 0xffff0000u));
            x[j][2] += g[2] * (w0 * __uint_as_float(ya[1] << 16) + w1 * __uint_as_float(yb[1] << 16)); x[j][3] += g[3] * (w0 * __uint_as_float(ya[1] & 0xffff0000u) + w1 * __uint_as_float(yb[1] & 0xffff0000u));
            ss += (x[j][0] * x[j][0] + x[j][1] * x[j][1]) + (x[j][2] * x[j][2] + x[j][3] * x[j][3]); }
#pragma unroll
        for (int o = 32; o >= 1; o >>= 1) ss += __shfl_xor(ss, o);
        const float rstd = rsqrtf(ss * (1.0f / 1024.0f) + EPSV);
#pragma unroll
        for (int j = 0; j < 4; ++j) { const int k0 = 4 * lane + 256 * j; const f32x4 fn = *(const f32x4*)(a.in[I_FNORM] + k0); *(f32x4*)(xr + k0) = x[j] * rstd * fn; }
    }
}

constexpr int N_PHASES = 12;
__global__ void __launch_bounds__(512, 2) fwd_kernel(KArgs a) {
    extern __shared__ __attribute__((aligned(16))) unsigned char lds_raw[];
    LAS unsigned char* lds = (LAS unsigned char*)lds_raw;
    volatile LAS unsigned* misc = (volatile LAS unsigned*)(lds + LDS_MISC);
    if (threadIdx.x < 8) misc[threadIdx.x] = 0u;
#ifdef PROBE_ID
    if (threadIdx.x == 0) { probe_words()[0] = 0; probe_words()[1] = 0; }
#endif
    __syncthreads();
    XcdBarrier bar; bar.bar = (unsigned*)(a.ws + WS_CTL) + CW_BAR; bar.x = 0; bar.st = misc;
    const bool one = (a.ph_hi - a.ph_lo) > 1;
    if (one) bar = xcd_barrier_post((unsigned*)(a.ws + WS_CTL) + CW_BAR, misc);
#ifdef ONLY_PHASE
#define IN(k) ((k) == ONLY_PHASE)
#else
#define IN(k) (a.ph_lo <= (k) && (k) < a.ph_hi)
#endif
#define SEAM(k) do { if (IN(k) && IN((k) + 1)) xcd_barrier(bar); PE(k); PB((k) + 1); } while (0)
    const int G = gridDim.x, c = blockIdx.x;
    PB(0);
    if (IN(0)) { phase0a(a, lds); } SEAM(0);
    if (IN(1)) { phase0b(a, lds); } SEAM(1);
    if (IN(2)) { __syncthreads(); OrderIn S{(const char*)(a.ws + WS_HX), (const char*)(a.ws + WS_WIN), G, c};
        EpiIn E{a.ws, (bf16_t*)a.out, a.in[I_BGATE], (const f32x2*)(a.ws + WS_ROPE)}; pg8::gemm_phase(lds, 1024, S, E); } SEAM(2);
    if (IN(3)) { phase2a(a, lds); } SEAM(3);
    if (IN(4)) { phase2b(a); } SEAM(4);
    if (IN(5)) { phase2c(a, lds); } SEAM(5);
    if (IN(6)) { PB(104); phase3_cvt(a, lds); PE(104);
        OrderMerge S{(const char*)(a.ws + WS_ZG), (const char*)(a.ws + WS_ZGL), (const char*)(a.ws + WS_WRET), (const char*)(a.ws + WS_WLRU), G, c};
        EpiMerge E{(const bf16_t*)a.out, (bf16_t*)(a.ws + WS_HX)}; pg8::gemm_phase(lds, 1024, S, E); } SEAM(6);
    if (IN(7)) { __syncthreads(); OrderOut S{(const char*)(a.ws + WS_HX), (const char*)(a.ws + WS_WOUT), G, c}; EpiOut E{&a}; pg8::gemm_phase(lds, 1024, S, E); } SEAM(7);
    if (IN(8)) { phase5(a, lds); } SEAM(8);
    if (IN(9)) {
        LAS int* tt = (LAS int*)(lds + LDS_MISC + 64); LAS int* tok = (LAS int*)(lds + LDS_TOK);
        moe_tiles(a, tt);
        {
            const int tid = tid_fresh();
            const int* cnt = (const int*)(a.ws + WS_CTL) + CW_CNT; const int* ptok = (const int*)(a.ws + WS_PTOK);
            for (int i = 0; i < 8; ++i) { const int L = i * G + c; if (L >= tt[32] * 6) break; const int rt = L / 6, e = moe_expert(tt, rt), r0 = (rt - tt[e]) * 256;
                if (tid < 256) tok[i * 256 + tid] = (r0 + tid < cnt[e]) ? ptok[(size_t)e * 65536 + r0 + tid] : NT; }
            __syncthreads();
        }
        OrderMoe1 S{(const char*)(a.ws + WS_HX2), (const char*)(a.ws + WS_WGU), tt, tok, G, c}; EpiMoe1 E{(bf16_t*)(a.ws + WS_HID)}; pg8::gemm_phase(lds, 1024, S, E); } SEAM(9);
    if (IN(10)) { LAS int* tt = (LAS int*)(lds + LDS_MISC + 64); moe_tiles(a, tt);
        OrderMoe2 S{(const char*)(a.ws + WS_HID), (const char*)(a.ws + WS_WDN), tt, G, c}; EpiMoe2 E{(bf16_t*)(a.ws + WS_YE)}; pg8::gemm_phase(lds, 768, S, E); } SEAM(10);
    if (IN(11)) { phase8(a, lds); }
    PE(11);
#ifdef PROBE_ID
    if (blockIdx.x == 0 && threadIdx.x == 0) { const unsigned long long w = probe_words()[1] * 4ull, t0 = wall_clock64(); while (wall_clock64() - t0 < w) __builtin_amdgcn_s_sleep(8); }
#endif
#undef IN
#undef SEAM
}

extern "C" void kernel_launch(void* const* d_in, const int* in_sizes, int n_in, void* d_out, int out_size, void* d_ws, size_t ws_size, hipStream_t stream) {
    static int grid = 0;
    if (grid == 0) {
        if (n_in != 30 || out_size != NT * DM || ws_size < WS_NEED) { fprintf(stderr, "kernel_launch: unexpected shapes (n_in %d out %d ws %zu)\n", n_in, out_size, ws_size); grid = -1; return; }
        int dev = 0, cus = 0;
        if (hipGetDevice(&dev) != hipSuccess || hipDeviceGetAttribute(&cus, hipDeviceAttributeMultiprocessorCount, dev) != hipSuccess) { grid = -1; return; }
        if (hipFuncSetAttribute((const void*)fwd_kernel, hipFuncAttributeMaxDynamicSharedMemorySize, LDS_BYTES) != hipSuccess) { fprintf(stderr, "kernel_launch: hipFuncSetAttribute failed\n"); grid = -1; return; }
        int per_cu = 0; (void)hipOccupancyMaxActiveBlocksPerMultiprocessor(&per_cu, (const void*)fwd_kernel, 512, LDS_BYTES); (void)hipGetLastError();
        grid = cus;
    }
    if (grid < 0) return;
    (void)hipMemsetAsync((char*)d_ws + WS_CTL, 0, 1 * MiB, stream);
    KArgs a{};
    for (int i = 0; i < 30; ++i) a.in[i] = (const float*)d_in[i];
    a.out = (float*)d_out; a.ws = (unsigned char*)d_ws;
#if N_LAUNCH_SPLIT
    for (int p = 0; p < N_PHASES; ++p) { a.ph_lo = p; a.ph_hi = p + 1; hipLaunchKernelGGL(fwd_kernel, dim3(grid), dim3(512), LDS_BYTES, stream, a); }
#else
    a.ph_lo = 0; a.ph_hi = N_PHASES; hipLaunchKernelGGL(fwd_kernel, dim3(grid), dim3(512), LDS_BYTES, stream, a);
#endif
}
```

```cpp
#include <hip/hip_runtime.h>
#include <cstdio>
#include <cstdint>

#ifndef N_LAUNCH_SPLIT
#define N_LAUNCH_SPLIT 0
#endif

#define DI __device__ __forceinline__
#ifdef SUB
#define SUBSEL(k) ((k) == SUB)
#else
#define SUBSEL(k) true
#endif
#define LAS __attribute__((address_space(3)))
typedef unsigned short bf16_t;
typedef short bf16x8 __attribute__((ext_vector_type(8)));
typedef short s16x4 __attribute__((ext_vector_type(4)));
typedef float f32x2 __attribute__((ext_vector_type(2)));
typedef float f32x4 __attribute__((ext_vector_type(4)));
typedef float f32x16 __attribute__((ext_vector_type(16)));
typedef unsigned u32x2 __attribute__((ext_vector_type(2)));
typedef unsigned u32x4 __attribute__((ext_vector_type(4)));

constexpr int NB_ = 2, SEQ = 16384, NT = NB_ * SEQ, DM = 1024, CTXL = 256, NTC = NB_ * CTXL;
constexpr int NH = 4, DK = 128, DV = 256, QW = 512, VW = 1024, LW = 1024;
constexpr int NCOL = 7168;
constexpr int NE = 32, EH = 768;
constexpr float EPSV = 1e-6f;
constexpr float LOG2E = 1.4426950408889634f;
constexpr int SCH = 512, NSC = SEQ / SCH;
constexpr int LT = 64, NLT = SEQ / LT, NSLOT = 320;

constexpr size_t MiB = 1u << 20;
constexpr size_t WS_CTL = 0;
constexpr size_t WS_MODP = 1 * MiB;
constexpr size_t WS_MODT = 1 * MiB + 384 * 1024;
constexpr size_t WS_RDEC = 1 * MiB + 448 * 1024;
constexpr size_t WS_ROPE = 1 * MiB + 512 * 1024;
constexpr size_t WS_WRH = 1 * MiB + 768 * 1024;
constexpr size_t WS_LAGG = 2 * MiB;
constexpr size_t WS_LHIN = 12 * MiB;
constexpr size_t WS_CTXK = 17 * MiB;
constexpr size_t WS_CTXV = 17 * MiB + 512 * 1024;
constexpr size_t WS_CTXX = 18 * MiB + 512 * 1024;
constexpr size_t WS_CTXS = 20 * MiB;
constexpr size_t WS_ROUTE = 22 * MiB;
constexpr size_t WS_PTOK = 23 * MiB;
constexpr size_t WS_WIN = 32 * MiB;
constexpr size_t WS_WRET = 46 * MiB, WS_WLRU = 48 * MiB, WS_WOUT = 50 * MiB;
constexpr size_t WS_WLB = 52 * MiB;
constexpr size_t WS_HX = 56 * MiB;
constexpr size_t WS_ZQ = 120 * MiB, WS_ZK = 152 * MiB, WS_ZV = 184 * MiB, WS_ZG = 248 * MiB, WS_ZXL = 312 * MiB, WS_ZGL = 376 * MiB;
constexpr size_t WS_SBF = 440 * MiB;
constexpr size_t WS_WGU = 120 * MiB;
constexpr size_t WS_WDN = 440 * MiB;
constexpr size_t WS_HX2 = 248 * MiB;
constexpr size_t WS_HID = 313 * MiB;
constexpr size_t WS_YE = 56 * MiB;
constexpr size_t WS_NEED = 512 * MiB;
constexpr int CW_BAR = 4096, CW_CNT = 16384;

constexpr int LDS_SCR = 0, LDS_TOK = 131072, LDS_MISC = 131072 + 8192, LDS_BYTES = 147456;

DI int tid_fresh() { int t = threadIdx.x; asm volatile("" : "+v"(t)); return t; }
#ifdef PROBE_ID
DI volatile LAS unsigned long long* probe_words() { extern __shared__ __attribute__((aligned(16))) unsigned char lds_raw[]; return (volatile LAS unsigned long long*)((LAS unsigned char*)lds_raw + 131072 + 8192 + 1024); }
#define PB(id) do { if ((id) == PROBE_ID && threadIdx.x == 0) probe_words()[0] = wall_clock64(); } while (0)
#define PE(id) do { if ((id) == PROBE_ID && threadIdx.x == 0) probe_words()[1] += wall_clock64() - probe_words()[0]; } while (0)
#else
#define PB(id) do {} while (0)
#define PE(id) do {} while (0)
#endif
DI float bf2f(unsigned short b) { return __uint_as_float(((unsigned)b) << 16); }
typedef __bf16 bf16x2_t __attribute__((ext_vector_type(2)));
DI unsigned cvt_pk_bf16(float lo, float hi) { const f32x2 v = {lo, hi}; return __builtin_bit_cast(unsigned, __builtin_convertvector(v, bf16x2_t)); }
DI unsigned short f2bf(float f) { return (unsigned short)(cvt_pk_bf16(f, 0.f) & 0xffffu); }
DI float ex2(float x) { return __builtin_amdgcn_exp2f(x); }
DI float rcpf_(float x) { return __builtin_amdgcn_rcpf(x); }
DI float sigm(float x) { return rcpf_(1.0f + ex2(-LOG2E * x)); }
DI float silu_(float x) { return x * sigm(x); }
DI float gelu_tanh(float x) { const float z = 0.7978845608028654f * (x + 0.044715f * x * x * x); return x * sigm(2.0f * z); }
DI float softplus_(float x) { return x > 20.f ? x : log1pf(expf(x)); }
DI int crow(int i, int h) { return (i & 3) + 8 * (i >> 2) + 4 * h; }
#define MFMA32(a, b, c) __builtin_amdgcn_mfma_f32_32x32x16_bf16((a), (b), (c), 0, 0, 0)
DI void lds_wait() { asm volatile("s_waitcnt lgkmcnt(0)" ::: "memory"); }
template <int O0, int O1> DI bf16x8 tr_frag(unsigned addr) {
    s16x4 lo, hi;
    asm volatile("ds_read_b64_tr_b16 %0, %2 offset:%3\n\tds_read_b64_tr_b16 %1, %2 offset:%4\n\ts_waitcnt lgkmcnt(0)" : "=&v"(lo), "=&v"(hi) : "v"(addr), "i"(O0), "i"(O1) : "memory");
    return __builtin_shufflevector(lo, hi, 0, 1, 2, 3, 4, 5, 6, 7);
}
template <int O, int S, int T> DI void tr_frag4(unsigned addr, bf16x8& f0, bf16x8& f1, bf16x8& f2, bf16x8& f3) {
    s16x4 a0, a1, b0, b1, c0, c1, d0, d1;
    asm volatile("ds_read_b64_tr_b16 %0, %8 offset:%9\n\tds_read_b64_tr_b16 %1, %8 offset:%10\n\t"
                 "ds_read_b64_tr_b16 %2, %8 offset:%11\n\tds_read_b64_tr_b16 %3, %8 offset:%12\n\t"
                 "ds_read_b64_tr_b16 %4, %8 offset:%13\n\tds_read_b64_tr_b16 %5, %8 offset:%14\n\t"
                 "ds_read_b64_tr_b16 %6, %8 offset:%15\n\tds_read_b64_tr_b16 %7, %8 offset:%16\n\ts_waitcnt lgkmcnt(0)"
                 : "=&v"(a0), "=&v"(a1), "=&v"(b0), "=&v"(b1), "=&v"(c0), "=&v"(c1), "=&v"(d0), "=&v"(d1)
                 : "v"(addr), "i"(O), "i"(O + T), "i"(O + S), "i"(O + S + T), "i"(O + 2 * S), "i"(O + 2 * S + T), "i"(O + 3 * S), "i"(O + 3 * S + T) : "memory");
    f0 = __builtin_shufflevector(a0, a1, 0, 1, 2, 3, 4, 5, 6, 7); f1 = __builtin_shufflevector(b0, b1, 0, 1, 2, 3, 4, 5, 6, 7);
    f2 = __builtin_shufflevector(c0, c1, 0, 1, 2, 3, 4, 5, 6, 7); f3 = __builtin_shufflevector(d0, d1, 0, 1, 2, 3, 4, 5, 6, 7);
}
DI void lds_barrier() { asm volatile("s_waitcnt lgkmcnt(0)" ::: "memory"); __builtin_amdgcn_s_barrier(); asm volatile("" ::: "memory"); }
DI f32x16 zero16() { f32x16 z; for (int i = 0; i < 16; ++i) z[i] = 0.f; return z; }

struct KArgs {
    const float* in[30];
    float* out;
    unsigned char* ws;
    int ph_lo, ph_hi;
};
enum { I_X = 0, I_C, I_CTX, I_CCTX, I_WMOD, I_BMOD, I_NORM1, I_NORM2, I_WIN, I_BGATE, I_RDECAY, I_RNORM, I_WRET, I_CONVW, I_CONVB, I_LWA, I_LBA, I_LWX, I_LBX, I_LLAM,
       I_WLRU, I_WOUT, I_WGRP, I_BGRP, I_WRT, I_BRT, I_WEG, I_WEU, I_WED, I_FNORM };

DI float mod_val(const KArgs& a, int v, int ch, int k) {
    const float* mp = (const float*)(a.ws + WS_MODP); const int n = ch * 1024 + k;
    return ((mp[(0 * 3 + v) * 6144 + n] + mp[(1 * 3 + v) * 6144 + n]) + (mp[(2 * 3 + v) * 6144 + n] + mp[(3 * 3 + v) * 6144 + n])) + a.in[I_BMOD][n];
}

#define XB_TMO      128
#define XB_XCNT(j)  (256  + 64 * (j))
#define XB_XSUB(j)  (1280 + 64 * (j))
#define XB_XGEN(j)  (2304 + 64 * (j))
#define XB_TOP      3328
#define XB_TOPGEN   3392
#define XCD_BAR_WORDS 3456
#define XB_SPIN_CAP (1u << 18)
__device__ __forceinline__ unsigned xb_ld(unsigned* p)              { return __hip_atomic_load(p, __ATOMIC_RELAXED, __HIP_MEMORY_SCOPE_AGENT); }
__device__ __forceinline__ unsigned xb_add(unsigned* p, unsigned v) { return __hip_atomic_fetch_add(p, v, __ATOMIC_RELAXED, __HIP_MEMORY_SCOPE_AGENT); }
__device__ __forceinline__ unsigned xb_xcc_id() { return (unsigned)__builtin_amdgcn_s_getreg((3 << 11) | 20) & 0xFu; }
#define XB_SPIN(cond, bar) do { unsigned _sp = 0; while (cond) { __builtin_amdgcn_s_sleep(1); \
    if ((++_sp & 255u) == 0u) { if (xb_ld(&(bar)[XB_TMO])) break; if (_sp > XB_SPIN_CAP) { atomicAdd(&(bar)[XB_TMO], 1u); break; } } } } while (0)
struct XcdBarrier { unsigned* bar; unsigned x; volatile LAS unsigned* st; };
__device__ __forceinline__ XcdBarrier xcd_barrier_post(unsigned* bar, volatile LAS unsigned* st) {
    XcdBarrier b; b.bar = bar; b.x = xb_xcc_id(); b.st = st;
    if (threadIdx.x == 0) (void)xb_add(&bar[XB_XCNT(b.x)], 1u);
    return b;
}
__device__ __forceinline__ void xcd_barrier_complete(unsigned* bar, unsigned x, unsigned& nloc, unsigned& nx) {
    const unsigned G = gridDim.x * gridDim.y * gridDim.z;
    unsigned sum, cnt, mine, sp = 0u;
    for (;;) {
        sum = 0u; cnt = 0u; mine = 0u;
#pragma unroll
        for (unsigned j = 0; j < 16; ++j) { const unsigned c = xb_ld(&bar[XB_XCNT(j)]); sum += c; cnt += (c > 0u) ? 1u : 0u; mine = (j == x) ? c : mine; }
        if (sum == G) break;
        __builtin_amdgcn_s_sleep(1);
        if ((++sp & 255u) == 0u) { if (xb_ld(&bar[XB_TMO])) break; if (sp > XB_SPIN_CAP) { atomicAdd(&bar[XB_TMO], 1u); break; } }
    }
    nloc = mine > 0u ? mine : 1u; nx = cnt > 0u ? cnt : 1u;
}
__device__ __forceinline__ void xcd_barrier(const XcdBarrier& b) {
    asm volatile("s_waitcnt vmcnt(0)" ::: "memory");
    __syncthreads();
    if (threadIdx.x == 0) {
        unsigned* bar = b.bar;
        __builtin_amdgcn_s_waitcnt(0);
        unsigned nloc = b.st[0], nx = b.st[1];
        if (nloc == 0u) { xcd_barrier_complete(bar, b.x, nloc, nx); b.st[0] = nloc; b.st[1] = nx; }
        const unsigned old = xb_add(&bar[XB_XSUB(b.x)], 1u);
        const unsigned gen = old / nloc;
        if (old + 1u == (gen + 1u) * nloc) {
            __builtin_amdgcn_fence(__ATOMIC_RELEASE, "agent");
            asm volatile("s_waitcnt vmcnt(0)" ::: "memory");
            const unsigned og = xb_add(&bar[XB_TOP], 1u);
            const unsigned tg = og / nx;
            if (og + 1u == (tg + 1u) * nx) xb_add(&bar[XB_TOPGEN], 1u);
            else XB_SPIN(xb_ld(&bar[XB_TOPGEN]) == tg, bar);
            __builtin_amdgcn_fence(__ATOMIC_ACQUIRE, "agent");
            xb_add(&bar[XB_XGEN(b.x)], 1u);
            asm volatile("s_waitcnt vmcnt(0)" ::: "memory");
        } else {
            XB_SPIN(xb_ld(&bar[XB_XGEN(b.x)]) == gen, bar);
            __builtin_amdgcn_fence(__ATOMIC_ACQUIRE, "agent");
            asm volatile("s_waitcnt vmcnt(0)" ::: "memory");
        }
    }
    __syncthreads();
}

namespace pg8 {
constexpr int BM = 256, BK = 64, HALF = 128, HTB = HALF * BK * 2, STAGE_BYTES = 8 * HTB, NXCD = 8, WGM = 8;
DI int lds_byte(int r, int c) { const int st = (r >> 4) * 2 + (c >> 5), rr = r & 15, cc = c & 31, ob = rr * 64 + cc * 2; return st * 1024 + (ob ^ (((ob >> 9) & 1) << 5)); }
DI void stage_rc(int b, int& R, int& C) { const int st = b / 1024, sb = b % 1024, swz = sb ^ (((sb >> 9) & 1) << 5); R = (st >> 1) * 16 + swz / 64; C = (st & 1) * 32 + (swz % 64) / 2; }
DI int perm32(int rho) { const int n = rho >> 4, i = rho & 15; return 8 * (i >> 2) + 4 * n + (i & 3); }
DI int bmap(int mode, int R) {
    if (mode == 1) return (R & ~31) + perm32(R & 31);
    if (mode == 2) { const int wc = R >> 5, n = (R >> 4) & 1, low = R & 15; return 64 * (wc >> 1) + 32 * n + 16 * (wc & 1) + low; }
    return R;
}
struct Unit { const char* A; const char* B; int pm, pn, aux, bmode; };
DI bool static_tile(int i, int G, int c, int nM, int nN, int& pm, int& pn) {
    const int nwg = nM * nN; const long L = (long)i * G + c; if (L >= nwg) return false;
    int wgid = (int)L; { const int q = nwg / NXCD, r = nwg % NXCD, xcd = wgid % NXCD, off = wgid / NXCD; wgid = (xcd < r ? xcd * (q + 1) : r * (q + 1) + (xcd - r) * q) + off; }
    const int nig = WGM * nN, gid = wgid / nig, fm = gid * WGM, gsz = (nM - fm) < WGM ? (nM - fm) : WGM;
    pm = fm + ((wgid % nig) % gsz); pn = (wgid % nig) / gsz; return true;
}

template <class Epi, class Sched>
DI void gemm_phase(LAS unsigned char* lds, const int K, const Sched& S, const Epi& E) {
    const int tid = tid_fresh(), wid = __builtin_amdgcn_readfirstlane(tid >> 6), lane = tid & 63, wr = wid >> 2, wc = wid & 3, fr = lane & 15, fq = lane >> 4;
    const int nt = K / BK;
    int Rr[2], Cc[2];
#pragma unroll
    for (int i = 0; i < 2; ++i) stage_rc(tid * 16 + i * 8192, Rr[i], Cc[i]);
    unsigned voffA[2][2], voffB[2];
    const size_t kstep = (size_t)(BK * 2);
    const size_t hstep = (size_t)HALF * K * 2;
    const unsigned ldsw = (unsigned)wid * 1024u;
    const int aoff = lds_byte(wr * 64 + fr, fq * 8), boff = lds_byte(wc * 32 + fr, fq * 8);
#define PG8_SA(b, h) (((b) * 2 + (h)) * HTB)
#define PG8_SB(b, h) ((4 + (b) * 2 + (h)) * HTB)
#define PG8_STAGE(bufoff, gbase, voff) do { _Pragma("unroll") for (int _i = 0; _i < 2; ++_i) \
        __builtin_amdgcn_global_load_lds((const unsigned*)((const char*)(gbase) + (voff)[_i]), (LAS unsigned*)(lds + (bufoff) + ldsw + _i * 8192), 16, 0, 0); } while (0)
#define PG8_LDA(dst, b, h) do { _Pragma("unroll") for (int m = 0; m < 4; ++m) _Pragma("unroll") for (int k = 0; k < 2; ++k) dst[m][k] = *(const LAS bf16x8*)(lds + PG8_SA(b, h) + aoff + m * 2048 + k * 1024); } while (0)
#define PG8_LDB(dst, b, h) do { _Pragma("unroll") for (int n = 0; n < 2; ++n) _Pragma("unroll") for (int k = 0; k < 2; ++k) dst[n][k] = *(const LAS bf16x8*)(lds + PG8_SB(b, h) + boff + n * 2048 + k * 1024); } while (0)
#define PG8_MMA(ai, bj, At, Bt) do { __builtin_amdgcn_s_setprio(1); _Pragma("unroll") for (int m = 0; m < 4; ++m) _Pragma("unroll") for (int n = 0; n < 2; ++n) _Pragma("unroll") for (int k = 0; k < 2; ++k) \
        acc[ai][bj][m][n] = __builtin_amdgcn_mfma_f32_16x16x32_bf16(Bt[n][k], At[m][k], acc[ai][bj][m][n], 0, 0, 0); __builtin_amdgcn_s_setprio(0); } while (0)
#define PG8_WAIT_V(n) asm volatile("s_waitcnt vmcnt(" #n ")" ::: "memory")
#define PG8_WAIT_L(n) asm volatile("s_waitcnt lgkmcnt(" #n ")" ::: "memory")
#define PG8_BAR __builtin_amdgcn_s_barrier()
#define PG8_SCHED __builtin_amdgcn_sched_barrier(0)
#define PG8_SETB(u) do { _Pragma("unroll") for (int _i = 0; _i < 2; ++_i) voffB[_i] = (unsigned)(bmap((u).bmode, Rr[_i]) * K + Cc[_i]) * 2u; } while (0)
    Unit cur, nxt; int ui = 0;
    if (!S.next(0, cur)) return;
    f32x4 acc[2][2][4][2];
#pragma unroll
    for (int a = 0; a < 2; ++a)
#pragma unroll
        for (int b = 0; b < 2; ++b)
#pragma unroll
            for (int m = 0; m < 4; ++m)
#pragma unroll
                for (int n = 0; n < 2; ++n) acc[a][b][m][n] = (f32x4){0.f, 0.f, 0.f, 0.f};
    bf16x8 At[4][2], B0[2][2], B1[2][2];
    const char* cA = cur.A; const char* cB = cur.B;
    S.offsA(cur, 0, Rr, Cc, voffA); PG8_SETB(cur);
    PG8_STAGE(PG8_SB(0, 0), cB, voffB); PG8_STAGE(PG8_SB(0, 1), cB + hstep, voffB); PG8_STAGE(PG8_SA(0, 0), cA, voffA[0]); PG8_STAGE(PG8_SA(0, 1), cA, voffA[1]);
    if (wr == 1) PG8_BAR;
    PG8_WAIT_V(2); PG8_BAR;
    PG8_STAGE(PG8_SB(1, 0), cB + kstep, voffB); PG8_STAGE(PG8_SA(1, 0), cA + kstep, voffA[0]); PG8_STAGE(PG8_SB(1, 1), cB + hstep + kstep, voffB);
    PG8_WAIT_V(6); PG8_BAR;
    for (;;) {
        const bool has_next = S.next(ui + 1, nxt);
        const char* nA = has_next ? nxt.A : cA; const char* nB = has_next ? nxt.B : cB;
        for (int t = 0; t < nt; t += 2) {
            const bool last = (t == nt - 2);
            const char* a1 = cA + (size_t)(t + 1) * kstep;
            const char* a2 = last ? nA : cA + (size_t)(t + 2) * kstep; const char* b2 = last ? nB : cB + (size_t)(t + 2) * kstep;
            const char* a3 = a2 + kstep; const char* b3 = b2 + kstep;
            if (last && has_next) PG8_SETB(nxt);
            PG8_LDB(B0, 0, 0); PG8_LDB(B1, 0, 1); PG8_SCHED; PG8_LDA(At, 0, 0); PG8_STAGE(PG8_SA(1, 1), a1, voffA[1]);
            PG8_WAIT_V(8); PG8_WAIT_L(0); PG8_BAR; PG8_MMA(0, 0, At, B0); PG8_MMA(0, 1, At, B1); PG8_BAR; PG8_SCHED;
            if (last && has_next) S.offsA(nxt, ui + 1, Rr, Cc, voffA);
            PG8_LDA(At, 0, 1); PG8_STAGE(PG8_SB(0, 0), b2, voffB); PG8_STAGE(PG8_SB(0, 1), b2 + hstep, voffB); PG8_STAGE(PG8_SA(0, 0), a2, voffA[0]);
            PG8_WAIT_V(8); PG8_WAIT_L(0); PG8_BAR; PG8_MMA(1, 0, At, B0); PG8_MMA(1, 1, At, B1); PG8_BAR; PG8_SCHED;
            PG8_LDB(B0, 1, 0); PG8_LDB(B1, 1, 1); PG8_SCHED; PG8_LDA(At, 1, 0); PG8_STAGE(PG8_SA(0, 1), a2, voffA[1]);
            PG8_WAIT_V(8); PG8_WAIT_L(0); PG8_BAR; PG8_MMA(0, 0, At, B0); PG8_MMA(0, 1, At, B1); PG8_BAR; PG8_SCHED;
            PG8_LDA(At, 1, 1); PG8_STAGE(PG8_SB(1, 0), b3, voffB); PG8_STAGE(PG8_SB(1, 1), b3 + hstep, voffB); PG8_STAGE(PG8_SA(1, 0), a3, voffA[0]);
            PG8_WAIT_V(8); PG8_WAIT_L(0); PG8_BAR; PG8_MMA(1, 0, At, B0); PG8_MMA(1, 1, At, B1); PG8_BAR; PG8_SCHED;
        }
        if (wr == 0) PG8_BAR;
        const bool keep = E(acc, cur, wr, wc, fr, fq);
        if (!has_next) break;
        if (!keep) {
#pragma unroll
            for (int a = 0; a < 2; ++a)
#pragma unroll
                for (int b = 0; b < 2; ++b)
#pragma unroll
                    for (int m = 0; m < 4; ++m)
#pragma unroll
                        for (int n = 0; n < 2; ++n) acc[a][b][m][n] = (f32x4){0.f, 0.f, 0.f, 0.f};
        }
        cur = nxt; cA = nA; cB = nB; ++ui;
        if (wr == 1) PG8_BAR;
    }
    PG8_WAIT_V(0);
    PG8_BAR;
#undef PG8_SA
#undef PG8_SB
#undef PG8_STAGE
#undef PG8_LDA
#undef PG8_LDB
#undef PG8_MMA
#undef PG8_WAIT_V
#undef PG8_WAIT_L
#undef PG8_BAR
#undef PG8_SCHED
#undef PG8_SETB
}
DI void dense_offs(int K, const int (&R)[2], const int (&C)[2], unsigned (&voffA)[2][2]) {
#pragma unroll
    for (int h = 0; h < 2; ++h)
#pragma unroll
        for (int i = 0; i < 2; ++i) voffA[h][i] = (unsigned)((h * HALF + R[i]) * K + C[i]) * 2u;
}
}
using pg8::Unit;

#define EPI_LOOP_ROWS for (int ai = 0; ai < 2; ++ai) _Pragma("unroll") for (int m = 0; m < 4; ++m)

DI void cvt_tile(LAS float* tile, const float* src, int ld_src, bf16_t* dst, int ld_dst, float scale) {
    const int tid = tid_fresh();
    __syncthreads();
#pragma unroll
    for (int i = 0; i < 2; ++i) { const int kr = (tid >> 4) + 32 * i, nc = (tid & 15) * 4; const f32x4 v = *(const f32x4*)(src + (size_t)kr * ld_src + nc);
        tile[kr * 65 + nc + 0] = v[0]; tile[kr * 65 + nc + 1] = v[1]; tile[kr * 65 + nc + 2] = v[2]; tile[kr * 65 + nc + 3] = v[3]; }
    __syncthreads();
    const int n = tid >> 3, kc = (tid & 7) * 8; float v[8];
#pragma unroll
    for (int j = 0; j < 8; ++j) v[j] = tile[(kc + j) * 65 + n] * scale;
    u32x4 w; w.x = cvt_pk_bf16(v[0], v[1]); w.y = cvt_pk_bf16(v[2], v[3]); w.z = cvt_pk_bf16(v[4], v[5]); w.w = cvt_pk_bf16(v[6], v[7]);
    *(u32x4*)(dst + (size_t)n * ld_dst + kc) = w;
}

DI void cvt_tile4(LAS float* tile, const float* src, int ld_src, bf16_t* dst, size_t hi_stride, int ld_dst) {
    const int tid = tid_fresh();
    f32x4 v[8];
#pragma unroll
    for (int i = 0; i < 8; ++i) v[i] = *(const f32x4*)(src + (size_t)((tid >> 6) + 8 * i) * ld_src + 4 * (tid & 63));
    __syncthreads();
#pragma unroll
    for (int i = 0; i < 8; ++i) *(LAS f32x4*)(tile + ((tid >> 6) + 8 * i) * 260 + 4 * (tid & 63)) = v[i];
    __syncthreads();
    const int n = tid & 255, kh = tid >> 8; bf16_t* d = dst + (size_t)(n >> 7) * hi_stride + (size_t)(n & 127) * ld_dst + 32 * kh;
#pragma unroll
    for (int q = 0; q < 4; ++q) { float x[8];
#pragma unroll
        for (int j = 0; j < 8; ++j) x[j] = tile[(32 * kh + 8 * q + j) * 260 + n];
        u32x4 w; w.x = cvt_pk_bf16(x[0], x[1]); w.y = cvt_pk_bf16(x[2], x[3]); w.z = cvt_pk_bf16(x[4], x[5]); w.w = cvt_pk_bf16(x[6], x[7]);
        *(u32x4*)(d + 8 * q) = w; }
}

DI void phase0a(const KArgs& a, LAS unsigned char* lds) {
    const int tid = tid_fresh(), G = gridDim.x;
    LAS float* fl = (LAS float*)lds;
    constexpr int NU_MOD = 192, NU_ROPE = 1, NU_ROUTW = 1, T_WIN = 16 * 28, T_PROJ = 3 * 64, T_LB = 128;
    constexpr int U0 = NU_MOD, U1 = U0 + NU_ROPE, U2 = U1 + NU_ROUTW, U3 = U2 + T_WIN, U4 = U3 + T_PROJ, U5 = U4 + T_LB;
    for (int u = blockIdx.x; u < U5; u += G) {
        if (u < U0) {
            const int ks = u / 48, cg = u % 48;
            __syncthreads();
            for (int i = tid; i < 768; i += 512) { const int v = i >> 8, k = 256 * ks + (i & 255); const float x = (v == 0) ? a.in[I_C][k] : (v == 1) ? a.in[I_C][1024 + k] : a.in[I_CCTX][k]; fl[i] = silu_(x); }
            __syncthreads();
            const int rl = tid >> 5, cl = tid & 31; float acc[3][4];
#pragma unroll
            for (int v = 0; v < 3; ++v) for (int j = 0; j < 4; ++j) acc[v][j] = 0.f;
            for (int s = 0; s < 16; ++s) { const int kk = 16 * s + rl; const f32x4 w = *(const f32x4*)(a.in[I_WMOD] + (size_t)(256 * ks + kk) * 6144 + 128 * cg + 4 * cl);
#pragma unroll
                for (int v = 0; v < 3; ++v) { const float sv = fl[v * 256 + kk]; acc[v][0] += sv * w[0]; acc[v][1] += sv * w[1]; acc[v][2] += sv * w[2]; acc[v][3] += sv * w[3]; } }
            __syncthreads();
            LAS float* red = fl + 1024;
#pragma unroll
            for (int v = 0; v < 3; ++v) for (int j = 0; j < 4; ++j) red[(rl * 3 + v) * 128 + 4 * cl + j] = acc[v][j];
            __syncthreads();
            if (tid < 384) { const int v = tid >> 7, c = tid & 127; float s = 0.f; for (int r = 0; r < 16; ++r) s += red[(r * 3 + v) * 128 + c];
                ((float*)(a.ws + WS_MODP))[(ks * 3 + v) * 6144 + 128 * cg + c] = s; }
        } else if (u < U1) {
            f32x2* tab = (f32x2*)(a.ws + WS_ROPE);
            if (tid < 8) ((float*)(a.ws + WS_RDEC))[tid] = -softplus_(-a.in[I_RDECAY][tid]) * LOG2E;
            for (int i = tid; i < 320 * 32; i += 512) { const int p = i >> 5, fi = i & 31; const float pos = (float)(p < 256 ? p : p - 256);
                const float freq = ex2(-(float)fi * (13.287712379549449f / 32.0f)); float rev = pos * freq * 0.15915494309189535f; rev -= floorf(rev);
                tab[i] = (f32x2){__builtin_amdgcn_cosf(rev), __builtin_amdgcn_sinf(rev)}; }
        } else if (u < U2) {
            bf16_t* hi = (bf16_t*)(a.ws + WS_WRH); bf16_t* lo = hi + 64 * 1024;
            for (int i = tid; i < 64 * 1024; i += 512) { const int n = i >> 10, k = i & 1023; float w = 0.f;
                if (n < 4) w = a.in[I_WGRP][k * 4 + n]; else if (n < 36) w = a.in[I_WRT][k * 32 + (n - 4)];
                const unsigned short h16 = f2bf(w); hi[i] = h16; lo[i] = f2bf(w - bf2f(h16)); }
        } else if (u < U3) {
            const int t = u - U2, kt = t / 28, ng = t % 28;
            cvt_tile4(fl, a.in[I_WIN] + (size_t)(64 * kt) * NCOL + 256 * ng, NCOL, (bf16_t*)(a.ws + WS_WIN) + (size_t)(256 * ng) * 1024 + 64 * kt, (size_t)128 * 1024, 1024);
        } else if (u < U4) {
            const int t = u - U3, w = t >> 6, kt = (t & 63) >> 2, ng = t & 3;
            const float* src = a.in[w == 0 ? I_WRET : w == 1 ? I_WLRU : I_WOUT]; bf16_t* dst = (bf16_t*)(a.ws + (w == 0 ? WS_WRET : w == 1 ? WS_WLRU : WS_WOUT));
            cvt_tile4(fl, src + (size_t)(64 * kt) * 1024 + 256 * ng, 1024, dst + (size_t)(256 * ng) * 1024 + 64 * kt, (size_t)128 * 1024, 1024);
        } else {
            const int t = u - U4, mat = t >> 5, blk = (t >> 2) & 7, kt = (t >> 1) & 1, nt = t & 1, dir = mat >> 1;
            const float* src = a.in[(mat & 1) ? I_LWX : I_LWA] + (size_t)(dir * 8 + blk) * 128 * 128;
            bf16_t* dst = (bf16_t*)(a.ws + WS_WLB) + (size_t)(mat * 8 + blk) * 128 * 128;
            cvt_tile(fl, src + (size_t)(64 * kt) * 128 + 64 * nt, 128, dst + (size_t)(64 * nt) * 128 + 64 * kt, 128, -LOG2E);
        }
    }
}

DI void phase0b(const KArgs& a, LAS unsigned char* lds) {
    const int tid = tid_fresh(), G = gridDim.x, lane = tid & 63, wid = tid >> 6;
    LAS float* gm = (LAS float*)lds;
    LAS float* sh = gm + 3072;
    __syncthreads();
    for (int i = tid; i < 3072; i += 512) { const int v = i >> 10, k = i & 1023; gm[i] = a.in[I_NORM1][k] * (1.0f + mod_val(a, v, 1, k)); sh[i] = mod_val(a, v, 0, k); }
    if (blockIdx.x == G - 1) { float* mt = (float*)(a.ws + WS_MODT);
        for (int i = tid; i < 2048; i += 512) { const int v = i >> 10, k = i & 1023; mt[i] = mod_val(a, v, 2, k); mt[2048 + i] = a.in[I_NORM2][k] * (1.0f + mod_val(a, v, 4, k)); mt[4096 + i] = mod_val(a, v, 3, k); mt[6144 + i] = mod_val(a, v, 5, k); } }
    __syncthreads();
    PB(105);
    for (int u = blockIdx.x; u < 160; u += G) {
        const int rt = u / 10, ct = u % 10;
        const int col0 = ct < 2 ? 512 + 256 * ct : ct < 6 ? 1024 + 256 * (ct - 2) : 3072 + 256 * (ct - 6);
        LAS unsigned char* At = lds + 24576;
        __syncthreads();
        {   f32x4 x[4][4];
#pragma unroll
            for (int q = 0; q < 4; ++q)
#pragma unroll
                for (int j = 0; j < 4; ++j) x[q][j] = *(const f32x4*)(a.in[I_CTX] + (size_t)(32 * rt + 4 * wid + q) * 1024 + 4 * lane + 256 * j);
#pragma unroll
            for (int q = 0; q < 4; ++q) { float ss = 0.f;
#pragma unroll
                for (int j = 0; j < 4; ++j) ss += (x[q][j][0] * x[q][j][0] + x[q][j][1] * x[q][j][1]) + (x[q][j][2] * x[q][j][2] + x[q][j][3] * x[q][j][3]);
#pragma unroll
                for (int o = 32; o >= 1; o >>= 1) ss += __shfl_xor(ss, o);
                const float rstd = rsqrtf(ss * (1.0f / 1024.0f) + EPSV);
#pragma unroll
                for (int j = 0; j < 4; ++j) { const int k0 = 4 * lane + 256 * j; const f32x4 g = *(const LAS f32x4*)(gm + 2048 + k0), sv = *(const LAS f32x4*)(sh + 2048 + k0);
                    u32x2 w; w.x = cvt_pk_bf16(x[q][j][0] * rstd * g[0] + sv[0], x[q][j][1] * rstd * g[1] + sv[1]); w.y = cvt_pk_bf16(x[q][j][2] * rstd * g[2] + sv[2], x[q][j][3] * rstd * g[3] + sv[3]);
                    *(LAS u32x2*)(At + (4 * wid + q) * 2064 + k0 * 2) = w; } }
        }
        __syncthreads();
        const int r = lane & 31, h = lane >> 5;
        const bf16_t* wrow = (const bf16_t*)(a.ws + WS_WIN) + (size_t)(col0 + 32 * wid + r) * 1024 + 8 * h;
        f32x16 acc = zero16();
#pragma unroll 16
        for (int s2 = 0; s2 < 64; ++s2) { const bf16x8 bfr = *(const bf16x8*)(wrow + 16 * s2); const bf16x8 af = *(const LAS bf16x8*)(At + r * 2064 + (16 * s2 + 8 * h) * 2);
            acc = MFMA32(af, bfr, acc); }
        const int ccol = 256 * (ct < 2 ? ct : ct < 6 ? ct - 2 : ct - 6) + 32 * wid + r;
        bf16_t* dst = (bf16_t*)(a.ws + (ct < 2 ? WS_CTXK : ct < 6 ? WS_CTXV : WS_CTXX)); const int ldd = ct < 2 ? 512 : 1024; const float scv = ct < 2 ? 0.08838834764831845f : 1.0f;
#pragma unroll
        for (int i = 0; i < 16; ++i) dst[(size_t)(32 * rt + crow(i, h)) * ldd + ccol] = f2bf(acc[i] * scv);
    }
    PE(105);
    PB(106);
    {   const int rstep = G * 8; int row = blockIdx.x * 8 + wid; f32x4 x[4];
        if (row < NT) {
#pragma unroll
            for (int j = 0; j < 4; ++j) x[j] = *(const f32x4*)(a.in[I_X] + (size_t)row * 1024 + 4 * lane + 256 * j); }
        for (; row < NT; row += rstep) {
            const int v = row / SEQ; f32x4 xn[4]; const int nrow = row + rstep;
            if (nrow < NT) {
#pragma unroll
                for (int j = 0; j < 4; ++j) xn[j] = *(const f32x4*)(a.in[I_X] + (size_t)nrow * 1024 + 4 * lane + 256 * j); }
            float ss = 0.f;
#pragma unroll
            for (int j = 0; j < 4; ++j) ss += (x[j][0] * x[j][0] + x[j][1] * x[j][1]) + (x[j][2] * x[j][2] + x[j][3] * x[j][3]);
#pragma unroll
            for (int o = 32; o >= 1; o >>= 1) ss += __shfl_xor(ss, o);
            const float rstd = rsqrtf(ss * (1.0f / 1024.0f) + EPSV);
            bf16_t* dst = (bf16_t*)(a.ws + WS_HX) + (size_t)row * 1024;
#pragma unroll
            for (int j = 0; j < 4; ++j) { const int k0 = 4 * lane + 256 * j; const f32x4 g = *(const LAS f32x4*)(gm + v * 1024 + k0), sv = *(const LAS f32x4*)(sh + v * 1024 + k0);
                u32x2 w; w.x = cvt_pk_bf16(x[j][0] * rstd * g[0] + sv[0], x[j][1] * rstd * g[1] + sv[1]); w.y = cvt_pk_bf16(x[j][2] * rstd * g[2] + sv[2], x[j][3] * rstd * g[3] + sv[3]);
                *(u32x2*)(dst + k0) = w; }
#pragma unroll
            for (int j = 0; j < 4; ++j) x[j] = xn[j];
        }
    }
    PE(106);
}

struct OrderIn {
    const char* A; const char* B; int G, c;
    DI bool next(int i, Unit& u) const { int pm, pn; if (!pg8::static_tile(i, G, c, NT / 256, NCOL / 256, pm, pn)) return false;
        u.pm = pm; u.pn = pn; u.A = A + (size_t)pm * 256 * 1024 * 2; u.B = B + (size_t)pn * 256 * 1024 * 2; u.aux = 0; u.bmode = pn < 4 ? 2 : 1; return true; }
    DI void offsA(const Unit&, int, const int (&R)[2], const int (&C)[2], unsigned (&v)[2][2]) const { pg8::dense_offs(1024, R, C, v); }
};
struct EpiIn {
    unsigned char* ws; bf16_t* glog; const float* bgate; const f32x2* rope;
    DI bool operator()(f32x4 (&acc)[2][2][4][2], const Unit& u, int wr, int wc, int fr, int fq) const {
        const int pn = u.pn;
        if (pn < 4) {
            bf16_t* dst = (bf16_t*)(ws + (pn < 2 ? WS_ZQ : WS_ZK)); const float sc = pn < 2 ? 1.0f : 0.08838834764831845f;
            const int half = wc >> 1, f0 = 16 * (wc & 1) + 4 * fq;
#pragma unroll
            EPI_LOOP_ROWS { const int row = u.pm * 256 + ai * 128 + wr * 64 + m * 16 + fr; const int t = row & (SEQ - 1); const int pos = half ? 256 + (t & 63) : (t >> 6);
                const f32x2* tb = rope + pos * 32 + f0; f32x2 cs[4];
#pragma unroll
                for (int j = 0; j < 4; ++j) cs[j] = tb[j];
#pragma unroll
                for (int bj = 0; bj < 2; ++bj) { const f32x4 x1 = acc[ai][bj][m][0], x2 = acc[ai][bj][m][1]; float o1[4], o2[4];
#pragma unroll
                    for (int j = 0; j < 4; ++j) { o1[j] = (x1[j] * cs[j][0] - x2[j] * cs[j][1]) * sc; o2[j] = (x1[j] * cs[j][1] + x2[j] * cs[j][0]) * sc; }
                    bf16_t* p = dst + (size_t)row * 512 + (pn & 1) * 256 + bj * 128 + 64 * half + f0;
                    u32x2 w1, w2; w1.x = cvt_pk_bf16(o1[0], o1[1]); w1.y = cvt_pk_bf16(o1[2], o1[3]); w2.x = cvt_pk_bf16(o2[0], o2[1]); w2.y = cvt_pk_bf16(o2[2], o2[3]);
                    *(u32x2*)p = w1; *(u32x2*)(p + 32) = w2; } }
            return false;
        }
        int act, ldd, cb; bf16_t* dst;
        if (pn < 8) { dst = (bf16_t*)(ws + WS_ZV); act = 0; ldd = 1024; cb = (pn - 4) * 256; }
        else if (pn < 12) { dst = (bf16_t*)(ws + WS_ZG); act = 1; ldd = 1024; cb = (pn - 8) * 256; }
        else if (pn < 16) { dst = (bf16_t*)(ws + WS_ZXL); act = 0; ldd = 1024; cb = (pn - 12) * 256; }
        else if (pn < 20) { dst = (bf16_t*)(ws + WS_ZGL); act = 2; ldd = 1024; cb = (pn - 16) * 256; }
        else { dst = glog; act = 3; ldd = 2048; cb = (pn - 20) * 256; }
#pragma unroll
        for (int bj = 0; bj < 2; ++bj) { const int col = cb + bj * 128 + wc * 32 + 8 * fq; f32x4 b0 = (f32x4){0.f, 0.f, 0.f, 0.f}, b1 = b0;
            if (act == 3) { b0 = *(const f32x4*)(bgate + col); b1 = *(const f32x4*)(bgate + col + 4); }
#pragma unroll
            EPI_LOOP_ROWS { const int row = u.pm * 256 + ai * 128 + wr * 64 + m * 16 + fr; f32x4 v0 = acc[ai][bj][m][0] + b0, v1 = acc[ai][bj][m][1] + b1;
                if (act == 1) {
#pragma unroll
                    for (int j = 0; j < 4; ++j) { v0[j] = silu_(v0[j]); v1[j] = silu_(v1[j]); } }
                if (act == 2) {
#pragma unroll
                    for (int j = 0; j < 4; ++j) { v0[j] = gelu_tanh(v0[j]); v1[j] = gelu_tanh(v1[j]); } }
                u32x4 w; w.x = cvt_pk_bf16(v0[0], v0[1]); w.y = cvt_pk_bf16(v0[2], v0[3]); w.z = cvt_pk_bf16(v1[0], v1[1]); w.w = cvt_pk_bf16(v1[2], v1[3]);
                *(u32x4*)(dst + (size_t)row * ldd + col) = w; } }
        return false;
    }
};

constexpr int R1_RSV = 576, R1_RSK = 320;
DI void r1_unit(LAS unsigned char* lds, const bf16_t* kp, int kld, const bf16_t* vp, int vld, int nrows, float lg2, int dir, float* outp) {
    const int tid = tid_fresh(), lane = tid & 63, wid = tid >> 6, h = lane >> 5;
    LAS unsigned char* Vt = lds; LAS unsigned char* Kw = lds + 64 * R1_RSV;
    const int mh = wid >> 2, nb = wid & 3;
    f32x16 acc[4];
#pragma unroll
    for (int mi = 0; mi < 4; ++mi) acc[mi] = zero16();
    const unsigned lb = (unsigned)((8 * h + ((lane & 15) >> 2))) , blk = (lane >> 4) & 1, p = lane & 3;
    const unsigned lbV = (unsigned)(size_t)Vt + lb * R1_RSV + 32 * blk + 8 * p + (128 * mh) * 2;
    const unsigned lbK = (unsigned)(size_t)Kw + lb * R1_RSK + 32 * blk + 8 * p + (32 * nb) * 2;
    for (int ch = 0; ch < nrows / 64; ++ch) {
        __syncthreads();
#pragma unroll
        for (int i = 0; i < 4; ++i) { const int pid = tid + 512 * i, row = pid >> 5, c16 = pid & 31;
            const u32x4 v = *(const u32x4*)(vp + (size_t)(64 * ch + row) * vld + c16 * 8); *(LAS u32x4*)(Vt + row * R1_RSV + c16 * 16) = v; }
#pragma unroll
        for (int i = 0; i < 2; ++i) { const int pid = tid + 512 * i, row = pid >> 4, c16 = pid & 15; const int jj = 64 * ch + row;
            const u32x4 kv = *(const u32x4*)(kp + (size_t)jj * kld + c16 * 8);
            const float w = ex2(lg2 * (float)(dir ? jj : nrows - 1 - jj));
            u32x4 o;
#pragma unroll
            for (int e = 0; e < 4; ++e) { const float lo = __uint_as_float(kv[e] << 16), hi = __uint_as_float(kv[e] & 0xffff0000u); o[e] = cvt_pk_bf16(lo * w, hi * w); }
            *(LAS u32x4*)(Kw + row * R1_RSK + c16 * 16) = o; }
        __syncthreads();
#pragma unroll
        for (int ks = 0; ks < 4; ++ks) {
            bf16x8 av[4]; tr_frag4<0, 64, 4 * R1_RSV>(lbV + ks * 16 * R1_RSV, av[0], av[1], av[2], av[3]);
            const bf16x8 bw = tr_frag<0, 4 * R1_RSK>(lbK + ks * 16 * R1_RSK);
#pragma unroll
            for (int mi = 0; mi < 4; ++mi) acc[mi] = MFMA32(av[mi], bw, acc[mi]);
        }
    }
    const int c = lane & 31;
    float* ob = outp + (size_t)(128 * mh + 4 * h) * 128 + 32 * nb + c;
#pragma unroll
    for (int mi = 0; mi < 4; ++mi)
#pragma unroll
        for (int i = 0; i < 16; ++i) ob[(32 * mi + (i & 3) + 8 * (i >> 2)) * 128] = acc[mi][i];
}

template <bool FULL, int DIR>
DI void lru_scan(f32x16 (&acc)[2][2], float Hin, f32x2* agg_out) {
    const int lane = tid_fresh() & 63, h = lane >> 5;
    float sA[8], sU[8];
#pragma unroll
    for (int s = 0; s < 8; ++s) { const int mb = s >> 2, g = s & 3; float A = 1.f, U = 0.f;
#pragma unroll
        for (int e = 0; e < 4; ++e) { const int i = 4 * g + (DIR == 0 ? e : 3 - e); U = acc[0][mb][i] * U + acc[1][mb][i]; A *= acc[0][mb][i]; }
        sA[s] = A; sU[s] = U; }
    float pA[8], pU[8];
#pragma unroll
    for (int s = 0; s < 8; ++s) { pA[s] = __shfl_xor(sA[s], 32); pU[s] = __shfl_xor(sU[s], 32); }
    const bool first = (h == (DIR == 0 ? 0 : 1));
    if (!FULL) {
        float A = 1.f, U = 0.f;
#pragma unroll
        for (int q = 0; q < 8; ++q) { const int s = DIR == 0 ? q : 7 - q;
            const float A1 = first ? sA[s] : pA[s], U1 = first ? sU[s] : pU[s], A2 = first ? pA[s] : sA[s], U2 = first ? pU[s] : sU[s];
            U = A1 * U + U1; A *= A1; U = A2 * U + U2; A *= A2; }
        if (h == 0) *agg_out = (f32x2){A, U};
    } else {
        float H = Hin;
        float st[8];
#pragma unroll
        for (int q = 0; q < 8; ++q) { const int s = DIR == 0 ? q : 7 - q;
            const float A1 = first ? sA[s] : pA[s], U1 = first ? sU[s] : pU[s], A2 = first ? pA[s] : sA[s], U2 = first ? pU[s] : sU[s];
            const float Hm = A1 * H + U1; st[s] = first ? H : Hm; H = A2 * Hm + U2; }
#pragma unroll
        for (int s = 0; s < 8; ++s) { const int mb = s >> 2, g = s & 3; float hv = st[s];
#pragma unroll
            for (int e = 0; e < 4; ++e) { const int i = 4 * g + (DIR == 0 ? e : 3 - e); hv = acc[0][mb][i] * hv + acc[1][mb][i]; acc[1][mb][i] = hv; } }
    }
}

constexpr int LX_RS = 272;
template <bool FULL>
DI void lru_run(const KArgs& a, LAS unsigned char* lds, int b, int n, int tile0, int ntiles, bool is_ctx) {
    const int tid = tid_fresh(), lane = tid & 63, wid = __builtin_amdgcn_readfirstlane(tid >> 6), h = lane >> 5, c = lane & 31;
    LAS unsigned char* raw = lds;
    LAS unsigned char* xcb = lds + 67 * LX_RS;
    LAS float* cw = (LAS float*)(xcb + 64 * LX_RS);
    LAS float* hfb = cw + 640;
    LAS float* hbb = hfb + 64 * 132;
    const int Ls = is_ctx ? CTXL : SEQ;
    const bf16_t* xl = is_ctx ? (const bf16_t*)(a.ws + WS_CTXX) + (size_t)(b * CTXL) * 1024 + 128 * n : (const bf16_t*)(a.ws + WS_ZXL) + (size_t)(b * SEQ) * 1024 + 128 * n;
    const int dir = wid >> 2, nq = wid & 3, gc = 128 * n + 32 * nq + c;
    __syncthreads();
    for (int i = tid; i < 640; i += 512) { const int k = i >> 7, ch = i & 127; cw[i] = k < 4 ? a.in[I_CONVW][k * 1024 + 128 * n + ch] : a.in[I_CONVB][128 * n + ch]; }
    bf16x8 Bw[2][8];
    {   const bf16_t* wa = (const bf16_t*)(a.ws + WS_WLB) + (size_t)((2 * dir) * 8 + n) * 128 * 128 + (size_t)(32 * nq + c) * 128 + 8 * h;
#pragma unroll
        for (int ks = 0; ks < 8; ++ks) { Bw[0][ks] = *(const bf16x8*)(wa + 16 * ks); Bw[1][ks] = *(const bf16x8*)(wa + (size_t)8 * 128 * 128 + 16 * ks); } }
    const float ba2 = -LOG2E * a.in[I_LBA][dir * 1024 + gc], bx2 = -LOG2E * a.in[I_LBX][dir * 1024 + gc];
    const float cl = -8.0f * softplus_(-a.in[I_LLAM][dir * 1024 + gc]) * LOG2E;
    const size_t chain0 = ((size_t)(b * 2 + dir) * 1024 + gc) * NSLOT;
    u32x4 pre[3];
#define LRU_LOADRAW(tile_) do { _Pragma("unroll") for (int i_ = 0; i_ < 3; ++i_) { const int pid_ = tid + 512 * i_; pre[i_] = (u32x4){0u, 0u, 0u, 0u}; \
        if (pid_ < 67 * 16) { const int t_ = (tile_) * LT + (pid_ >> 4) - 1; if (t_ >= 0 && t_ < Ls) pre[i_] = *(const u32x4*)(xl + (size_t)t_ * 1024 + (pid_ & 15) * 8); } } } while (0)
    LRU_LOADRAW(tile0);
    for (int it = 0; it < ntiles; ++it) {
        const int tile = tile0 + it, t0 = tile * LT;
#pragma unroll
        for (int i = 0; i < 3; ++i) { const int pid = tid + 512 * i; if (pid < 67 * 16) *(LAS u32x4*)(raw + (pid >> 4) * LX_RS + (pid & 15) * 16) = pre[i]; }
        if (it + 1 < ntiles) LRU_LOADRAW(tile + 1);
        const int slot = is_ctx ? (dir == 0 ? tile : 3 - tile) : (dir == 0 ? 4 + tile : 4 + (NLT - 1 - tile));
        float Hin = 0.f; if (FULL) Hin = ((const float*)(a.ws + WS_LHIN))[chain0 + slot];
        u32x4 gpre[2]; bf16_t* gtile = (bf16_t*)(a.ws + WS_ZGL) + (size_t)(b * SEQ + t0) * 1024 + 128 * n;
        if (FULL) {
#pragma unroll
            for (int i = 0; i < 2; ++i) { const int pid = tid + 512 * i; gpre[i] = *(const u32x4*)(gtile + (size_t)(pid >> 4) * 1024 + (pid & 15) * 8); } }
        lds_barrier();
        {
            const int row = tid >> 3, c0 = (tid & 7) * 16; float o[16];
#pragma unroll
            for (int j = 0; j < 16; j += 4) { const f32x4 bv = *(const LAS f32x4*)(cw + 512 + c0 + j); o[j] = bv[0]; o[j + 1] = bv[1]; o[j + 2] = bv[2]; o[j + 3] = bv[3]; }
#pragma unroll
            for (int k = 0; k < 4; ++k) { const u32x4 p0 = *(const LAS u32x4*)(raw + (row + k) * LX_RS + c0 * 2), p1 = *(const LAS u32x4*)(raw + (row + k) * LX_RS + c0 * 2 + 16);
#pragma unroll
                for (int e = 0; e < 4; ++e) { const f32x4 w0 = *(const LAS f32x4*)(cw + k * 128 + c0 + 4 * (e >> 1) ), w1 = *(const LAS f32x4*)(cw + k * 128 + c0 + 8 + 4 * (e >> 1));
                    o[2 * e] += w0[2 * (e & 1)] * __uint_as_float(p0[e] << 16); o[2 * e + 1] += w0[2 * (e & 1) + 1] * __uint_as_float(p0[e] & 0xffff0000u);
                    o[8 + 2 * e] += w1[2 * (e & 1)] * __uint_as_float(p1[e] << 16); o[8 + 2 * e + 1] += w1[2 * (e & 1) + 1] * __uint_as_float(p1[e] & 0xffff0000u); } }
            u32x4 w0, w1;
#pragma unroll
            for (int e = 0; e < 4; ++e) { w0[e] = cvt_pk_bf16(o[2 * e], o[2 * e + 1]); w1[e] = cvt_pk_bf16(o[8 + 2 * e], o[8 + 2 * e + 1]); }
            *(LAS u32x4*)(xcb + row * LX_RS + c0 * 2) = w0; *(LAS u32x4*)(xcb + row * LX_RS + c0 * 2 + 16) = w1;
        }
        lds_barrier();
        f32x16 acc[2][2];
#pragma unroll
        for (int q = 0; q < 2; ++q) for (int mb = 0; mb < 2; ++mb) acc[q][mb] = zero16();
#pragma unroll
        for (int ks = 0; ks < 8; ++ks) {
            const bf16x8 a0 = *(const LAS bf16x8*)(xcb + c * LX_RS + (16 * ks + 8 * h) * 2), a1 = *(const LAS bf16x8*)(xcb + (32 + c) * LX_RS + (16 * ks + 8 * h) * 2);
            acc[0][0] = MFMA32(a0, Bw[0][ks], acc[0][0]); acc[0][1] = MFMA32(a1, Bw[0][ks], acc[0][1]); acc[1][0] = MFMA32(a0, Bw[1][ks], acc[1][0]); acc[1][1] = MFMA32(a1, Bw[1][ks], acc[1][1]);
        }
#pragma unroll
        for (int mb = 0; mb < 2; ++mb)
#pragma unroll
            for (int i = 0; i < 16; ++i) { const int row = 32 * mb + crow(i, h);
                const float r = rcpf_(1.0f + ex2(acc[0][mb][i] + ba2)), ig = rcpf_(1.0f + ex2(acc[1][mb][i] + bx2));
                const float av = ex2(cl * r); const float s = sqrtf(fmaxf(1.0f - av * av, 0.f));
                acc[0][mb][i] = av; acc[1][mb][i] = s * ig * bf2f(*(const LAS bf16_t*)(xcb + row * LX_RS + (32 * nq + c) * 2)); }
        f32x2* aggp = (f32x2*)(a.ws + WS_LAGG) + chain0 + slot;
        if (dir == 0) lru_scan<FULL, 0>(acc, Hin, aggp); else lru_scan<FULL, 1>(acc, Hin, aggp);
        if (FULL) {
            LAS float* hd = dir == 0 ? hfb : hbb;
#pragma unroll
            for (int mb = 0; mb < 2; ++mb)
#pragma unroll
                for (int i = 0; i < 16; ++i) hd[(32 * mb + crow(i, h)) * 132 + 32 * nq + c] = acc[1][mb][i];
            lds_barrier();
#pragma unroll
            for (int i = 0; i < 2; ++i) { const int pid = tid + 512 * i, row = pid >> 4, c8 = (pid & 15) * 8;
                const f32x4 f0 = *(const LAS f32x4*)(hfb + row * 132 + c8), f1 = *(const LAS f32x4*)(hfb + row * 132 + c8 + 4), b0 = *(const LAS f32x4*)(hbb + row * 132 + c8), b1 = *(const LAS f32x4*)(hbb + row * 132 + c8 + 4);
                const u32x4 g = gpre[i]; u32x4 o;
                o[0] = cvt_pk_bf16((f0[0] + b0[0]) * __uint_as_float(g[0] << 16), (f0[1] + b0[1]) * __uint_as_float(g[0] & 0xffff0000u));
                o[1] = cvt_pk_bf16((f0[2] + b0[2]) * __uint_as_float(g[1] << 16), (f0[3] + b0[3]) * __uint_as_float(g[1] & 0xffff0000u));
                o[2] = cvt_pk_bf16((f1[0] + b1[0]) * __uint_as_float(g[2] << 16), (f1[1] + b1[1]) * __uint_as_float(g[2] & 0xffff0000u));
                o[3] = cvt_pk_bf16((f1[2] + b1[2]) * __uint_as_float(g[3] << 16), (f1[3] + b1[3]) * __uint_as_float(g[3] & 0xffff0000u));
                *(u32x4*)(gtile + (size_t)row * 1024 + c8) = o; }
        }
    }
#undef LRU_LOADRAW
}

DI void ret_decays(const KArgs& a, int h, float& lgf2, float& lgb2) {
    const float* rd = (const float*)(a.ws + WS_RDEC); lgf2 = rd[h]; lgb2 = rd[4 + h];
}

DI void phase2a(const KArgs& a, LAS unsigned char* lds) {
    const int G = gridDim.x;
    constexpr int NU_R1 = NB_ * NH * NSC * 2, NU_CK = NB_ * NH * 2, NU_LX = NB_ * 8 * 16, NU_LC = NB_ * 8;
    for (int u = blockIdx.x; u < NU_R1 + NU_CK + NU_LX + NU_LC; u += G) {
        if (SUBSEL(1) && u < NU_R1) {
            const int dir = u & 1, sc = (u >> 1) & 31, h = (u >> 6) & 3, b = u >> 8; float lgf2, lgb2; ret_decays(a, h, lgf2, lgb2);
            float* o = (float*)(a.ws + WS_HX) + (size_t)(((b * 4 + h) * 32 + sc) * 2 + dir) * 32768;
            PB(100); r1_unit(lds, (const bf16_t*)(a.ws + WS_ZK) + (size_t)(b * SEQ + sc * SCH) * 512 + h * 128, 512, (const bf16_t*)(a.ws + WS_ZV) + (size_t)(b * SEQ + sc * SCH) * 1024 + h * 256, 1024, SCH, dir ? lgb2 : lgf2, dir, o); PE(100);
        } else if (SUBSEL(1) && u < NU_R1 + NU_CK) {
            const int q = u - NU_R1, dir = q & 1, h = (q >> 1) & 3, b = q >> 3; float lgf2, lgb2; ret_decays(a, h, lgf2, lgb2);
            float* o = (float*)(a.ws + WS_CTXS) + (size_t)((b * 4 + h) * 2 + dir) * 32768;
            r1_unit(lds, (const bf16_t*)(a.ws + WS_CTXK) + (size_t)(b * CTXL) * 512 + h * 128, 512, (const bf16_t*)(a.ws + WS_CTXV) + (size_t)(b * CTXL) * 1024 + h * 256, 1024, CTXL, dir ? lgb2 : lgf2, dir, o);
        } else if (SUBSEL(2) && u < NU_R1 + NU_CK + NU_LX) {
            const int q = u - NU_R1 - NU_CK, b = q >> 7, n = (q >> 4) & 7, r = q & 15;
            PB(101); lru_run<false>(a, lds, b, n, 16 * r, 16, false); PE(101);
        } else if (SUBSEL(2)) {
            const int q = u - NU_R1 - NU_CK - NU_LX, b = q >> 3, n = q & 7;
            lru_run<false>(a, lds, b, n, 0, 4, true);
        }
    }
}

DI void phase2b(const KArgs& a) {
    const int tid = tid_fresh(), G = gridDim.x, lane = tid & 63, wid = tid >> 6;
    for (int e = blockIdx.x * 512 + tid; e < NB_ * NH * 2 * 8192; e += G * 512) {
        const int e4 = e & 8191, dir = (e >> 13) & 1, h = (e >> 14) & 3, b = e >> 16;
        float lgf2, lgb2; ret_decays(a, h, lgf2, lgb2); const float gC = ex2((dir ? lgb2 : lgf2) * (float)SCH);
        f32x4 S = *(const f32x4*)((const float*)(a.ws + WS_CTXS) + (size_t)((b * 4 + h) * 2 + dir) * 32768 + 4 * e4);
        const float* kv = (const float*)(a.ws + WS_HX) + (size_t)((b * 4 + h) * 32 * 2 + dir) * 32768 + 4 * e4;
        bf16_t* so = (bf16_t*)(a.ws + WS_SBF) + (size_t)((b * 4 + h) * 32 * 2 + dir) * 32768 + 4 * e4;
        for (int s0 = 0; s0 < NSC; s0 += 8) {
            f32x4 kvv[8];
#pragma unroll
            for (int j = 0; j < 8; ++j) { const int sc = dir ? NSC - 1 - (s0 + j) : s0 + j; kvv[j] = *(const f32x4*)(kv + (size_t)sc * 65536); }
#pragma unroll
            for (int j = 0; j < 8; ++j) { const int sc = dir ? NSC - 1 - (s0 + j) : s0 + j;
                u32x2 w; w.x = cvt_pk_bf16(S[0], S[1]); w.y = cvt_pk_bf16(S[2], S[3]); *(u32x2*)(so + (size_t)sc * 65536) = w;
                S = S * gC + kvv[j]; }
        }
    }
    for (int ch = blockIdx.x * 8 + wid; ch < NB_ * 2 * 1024; ch += G * 8) {
        const f32x2* ag = (const f32x2*)(a.ws + WS_LAGG) + (size_t)ch * NSLOT; float* hin = (float*)(a.ws + WS_LHIN) + (size_t)ch * NSLOT;
        float carry = 0.f;
        for (int rd = 0; rd < 5; ++rd) { const int slot = 64 * rd + lane;
            f32x2 v = (f32x2){1.f, 0.f}; if (slot < 4 + NLT) v = ag[slot];
            float A = v[0], U = v[1];
#pragma unroll
            for (int o = 1; o < 64; o <<= 1) { const float Ap = __shfl_up(A, o), Up = __shfl_up(U, o); if (lane >= o) { U = A * Up + U; A = A * Ap; } }
            const float incl = A * carry + U;
            float excl = __shfl_up(incl, 1); if (lane == 0) excl = carry;
            if (slot < 4 + NLT) hin[slot] = excl;
            carry = __shfl(incl, 63);
        }
    }
}

constexpr int R3_KB = 16384, R3_VB = 32768;
template <int O, int T> DI void tr_frag2x2(unsigned a0, unsigned a1, bf16x8& f0, bf16x8& f1, bf16x8& f2, bf16x8& f3) {
    s16x4 r0, r1, r2, r3, r4, r5, r6, r7;
    asm volatile("ds_read_b64_tr_b16 %0, %8 offset:%10\n\tds_read_b64_tr_b16 %1, %8 offset:%11\n\t"
                 "ds_read_b64_tr_b16 %2, %8 offset:%12\n\tds_read_b64_tr_b16 %3, %8 offset:%13\n\t"
                 "ds_read_b64_tr_b16 %4, %9 offset:%10\n\tds_read_b64_tr_b16 %5, %9 offset:%11\n\t"
                 "ds_read_b64_tr_b16 %6, %9 offset:%12\n\tds_read_b64_tr_b16 %7, %9 offset:%13\n\ts_waitcnt lgkmcnt(0)"
                 : "=&v"(r0), "=&v"(r1), "=&v"(r2), "=&v"(r3), "=&v"(r4), "=&v"(r5), "=&v"(r6), "=&v"(r7)
                 : "v"(a0), "v"(a1), "i"(O), "i"(O + T), "i"(O + 256), "i"(O + 256 + T) : "memory");
    f0 = __builtin_shufflevector(r0, r1, 0, 1, 2, 3, 4, 5, 6, 7); f1 = __builtin_shufflevector(r2, r3, 0, 1, 2, 3, 4, 5, 6, 7);
    f2 = __builtin_shufflevector(r4, r5, 0, 1, 2, 3, 4, 5, 6, 7); f3 = __builtin_shufflevector(r6, r7, 0, 1, 2, 3, 4, 5, 6, 7);
}
DI bf16x8 scale_frag(bf16x8 f, float s) { const u32x4 u = __builtin_bit_cast(u32x4, f); u32x4 o;
#pragma unroll
    for (int e = 0; e < 4; ++e) o[e] = cvt_pk_bf16(__uint_as_float(u[e] << 16) * s, __uint_as_float(u[e] & 0xffff0000u) * s);
    return __builtin_bit_cast(bf16x8, o); }
#define GLDS16(gp, lp) __builtin_amdgcn_global_load_lds((const unsigned*)(gp), (LAS unsigned*)(lp), 16, 0, 0)

DI void r3_unit(const KArgs& a, LAS unsigned char* lds, int b, int hh, int qb2) {
    const int tid = tid_fresh(), lane = tid & 63, wid = __builtin_amdgcn_readfirstlane(tid >> 6), h = lane >> 5, c = lane & 31;
    const int sc = qb2 >> 1, qpos = 256 * (qb2 & 1) + 32 * wid + c;
    float lgf2, lgb2; ret_decays(a, hh, lgf2, lgb2);
    const size_t tokS = (size_t)b * SEQ + SCH * sc, tokQ = tokS + qpos;
    LAS unsigned char* R0 = lds; LAS unsigned char* R1 = lds + 65536;
    const bf16_t* zk = (const bf16_t*)(a.ws + WS_ZK) + tokS * 512 + hh * 128; const bf16_t* zv = (const bf16_t*)(a.ws + WS_ZV) + tokS * 1024 + hh * 256;
    const unsigned wl = (unsigned)wid * 1024u;
    const unsigned soff = (unsigned)((tid >> 4) * 256 + (((tid & 15) ^ ((tid >> 4) & 15)) << 4));
    const unsigned koff = (unsigned)((tid >> 4) * 1024 + (((tid & 15) ^ ((tid >> 4) & 15)) << 4));
    const unsigned voff = (unsigned)((tid >> 5) * 2048 + (((tid & 31) ^ (((tid >> 5) & 3) << 2)) << 4));
#define R3_STAGE_KV(jb_, buf_) do { const char* kb_ = (const char*)zk + (size_t)(jb_) * 65536; const char* vb_ = (const char*)zv + (size_t)(jb_) * 131072; \
        _Pragma("unroll") for (int i_ = 0; i_ < 2; ++i_) GLDS16(kb_ + i_ * 32768 + koff, (buf_) + i_ * 8192 + wl); \
        _Pragma("unroll") for (int i_ = 0; i_ < 4; ++i_) GLDS16(vb_ + i_ * 32768 + voff, (buf_) + R3_KB + i_ * 8192 + wl); } while (0)
    __syncthreads();
#pragma unroll
    for (int d = 0; d < 2; ++d) { const char* Sg = (const char*)((const bf16_t*)(a.ws + WS_SBF) + (size_t)(((b * 4 + hh) * 32 + sc) * 2 + d) * 32768);
#pragma unroll
        for (int i = 0; i < 8; ++i) GLDS16(Sg + i * 8192 + soff, (d ? R1 : R0) + i * 8192 + wl); }
    bf16x8 Qf[8];
    {   const bf16_t* qp = (const bf16_t*)(a.ws + WS_ZQ) + tokQ * 512 + hh * 128 + 8 * h;
#pragma unroll
        for (int ks = 0; ks < 8; ++ks) Qf[ks] = *(const bf16x8*)(qp + 16 * ks); }
    f32x16 OT[8];
#pragma unroll
    for (int nb = 0; nb < 8; ++nb) OT[nb] = zero16();
    const unsigned xq = (unsigned)(c & 15), rowb = (unsigned)c * 256u;
#pragma unroll
    for (int d = 0; d < 2; ++d) {
        if (d == 0) asm volatile("s_waitcnt vmcnt(16)" ::: "memory"); else asm volatile("s_waitcnt vmcnt(6)" ::: "memory");
        __builtin_amdgcn_s_barrier(); asm volatile("" ::: "memory");
        const float dec = d == 0 ? ex2(lgf2 * (float)(qpos + 1)) : ex2(lgb2 * (float)(SCH - qpos));
        const unsigned Sb = (unsigned)(size_t)(d ? R1 : R0) + rowb;
#pragma unroll
        for (int ks = 0; ks < 8; ++ks) { const bf16x8 qs = scale_frag(Qf[ks], dec); const unsigned co = (((unsigned)(2 * ks + h)) ^ xq) << 4;
#pragma unroll
            for (int nb = 0; nb < 8; ++nb) { const bf16x8 sf = *(const LAS bf16x8*)(size_t)(Sb + 32 * 256 * nb + co); OT[nb] = MFMA32(sf, qs, OT[nb]); if (nb == 3) asm volatile("" ::: "memory"); }
            asm volatile("" ::: "memory"); }
        if (d == 0) { lds_barrier(); R3_STAGE_KV(0, R0); if (tid < 256) ((LAS float*)(R0 + 49152))[tid] = a.in[I_RNORM][hh * 256 + tid]; }
    }
    const unsigned q4 = (unsigned)((lane & 15) >> 2), vlane = (unsigned)(4 * h + q4) * 512u + 32u * ((lane >> 4) & 1) + 8u * (lane & 3);
#pragma unroll 1
    for (int jb = 0; jb < 8; ++jb) {
        LAS unsigned char* buf = (jb & 1) ? R1 : R0;
        asm volatile("s_waitcnt vmcnt(0)" ::: "memory");
        lds_barrier();
        if (jb + 1 < 8) { if (jb & 1) R3_STAGE_KV(jb + 1, R0); else R3_STAGE_KV(jb + 1, R1); }
        const unsigned Kb = (unsigned)(size_t)buf + rowb, Vb = (unsigned)(size_t)buf + R3_KB + vlane;
#pragma unroll
        for (int jt = 0; jt < 2; ++jt) {
            f32x16 st = zero16();
#pragma unroll
            for (int ks = 0; ks < 8; ++ks) { const bf16x8 kf = *(const LAS bf16x8*)(size_t)(Kb + 32 * 256 * jt + ((((unsigned)(2 * ks + h)) ^ xq) << 4)); st = MFMA32(kf, Qf[ks], st); }
#pragma unroll
            for (int s2 = 0; s2 < 2; ++s2) { u32x4 pk;
#pragma unroll
                for (int e = 0; e < 4; ++e) { float v[2];
#pragma unroll
                    for (int z = 0; z < 2; ++z) { const int i = 8 * s2 + 2 * e + z; const int dd = qpos - (64 * jb + 32 * jt + (i & 3) + 8 * (i >> 2) + 4 * h);
                        v[z] = st[i] * (dd >= 0 ? ex2(lgf2 * (float)dd) : ex2(lgb2 * (float)(-dd))); }
                    pk[e] = cvt_pk_bf16(v[0], v[1]); }
                const bf16x8 pb = __builtin_bit_cast(bf16x8, pk);
#pragma unroll
                for (int hf = 0; hf < 2; ++hf) {
                    bf16x8 v0, v1, v2, v3; const unsigned a0 = Vb + 64u * ((unsigned)(2 * hf) ^ q4), a1 = Vb + 64u * ((unsigned)(2 * hf + 1) ^ q4);
                    if (jt == 0 && s2 == 0) tr_frag2x2<0, 4096>(a0, a1, v0, v1, v2, v3);
                    if (jt == 0 && s2 == 1) tr_frag2x2<8192, 4096>(a0, a1, v0, v1, v2, v3);
                    if (jt == 1 && s2 == 0) tr_frag2x2<16384, 4096>(a0, a1, v0, v1, v2, v3);
                    if (jt == 1 && s2 == 1) tr_frag2x2<24576, 4096>(a0, a1, v0, v1, v2, v3);
                    OT[2 * hf] = MFMA32(v0, pb, OT[2 * hf]); OT[2 * hf + 4] = MFMA32(v1, pb, OT[2 * hf + 4]);
                    OT[2 * hf + 1] = MFMA32(v2, pb, OT[2 * hf + 1]); OT[2 * hf + 5] = MFMA32(v3, pb, OT[2 * hf + 5]);
                }
            }
        }
    }
    float s1 = 0.f, s2 = 0.f;
#pragma unroll
    for (int nb = 0; nb < 8; ++nb)
#pragma unroll
        for (int i = 0; i < 16; ++i) { s1 += OT[nb][i]; s2 += OT[nb][i] * OT[nb][i]; }
    s1 += __shfl_xor(s1, 32); s2 += __shfl_xor(s2, 32);
    const float mu = s1 * (1.0f / 256.0f), rstd = rsqrtf(fmaxf(s2 * (1.0f / 256.0f) - mu * mu, 0.f) + EPSV);
    const int t2 = tid_fresh(), h2 = (t2 >> 5) & 1;
    bf16_t* gp = (bf16_t*)(a.ws + WS_ZG) + ((size_t)b * SEQ + SCH * sc + 256 * (qb2 & 1) + 32 * (t2 >> 6) + (t2 & 31)) * 1024 + hh * 256 + 4 * h2;
    const LAS float* gn = (const LAS float*)(R0 + 49152) + 4 * h2;
#pragma unroll
    for (int hv = 0; hv < 2; ++hv) {
        u32x2 sg[4][4];
#pragma unroll
        for (int q = 0; q < 4; ++q)
#pragma unroll
            for (int g = 0; g < 4; ++g) sg[q][g] = *(const u32x2*)(gp + 32 * (4 * hv + q) + 8 * g);
#pragma unroll
        for (int q = 0; q < 4; ++q)
#pragma unroll
            for (int g = 0; g < 4; ++g) { const int nb = 4 * hv + q, dv0 = 32 * nb + 8 * g; const f32x4 gain = *(const LAS f32x4*)(gn + dv0);
                u32x2 o; o.x = cvt_pk_bf16((OT[nb][4 * g] - mu) * rstd * gain[0] * __uint_as_float(sg[q][g].x << 16), (OT[nb][4 * g + 1] - mu) * rstd * gain[1] * __uint_as_float(sg[q][g].x & 0xffff0000u));
                o.y = cvt_pk_bf16((OT[nb][4 * g + 2] - mu) * rstd * gain[2] * __uint_as_float(sg[q][g].y << 16), (OT[nb][4 * g + 3] - mu) * rstd * gain[3] * __uint_as_float(sg[q][g].y & 0xffff0000u));
                *(u32x2*)(gp + dv0) = o; }
        asm volatile("" ::: "memory");
    }
#undef R3_STAGE_KV
}

DI void phase2c(const KArgs& a, LAS unsigned char* lds) {
    const int G = gridDim.x;
    constexpr int NU_R3 = NB_ * NH * (SEQ / 256), NU_L3 = NB_ * 8 * 16;
    for (int u = blockIdx.x; u < NU_R3 + NU_L3; u += G) {
        if (SUBSEL(1) && u < NU_R3) { const int b = u >> 8, hh = (u >> 6) & 3, qb2 = u & 63; PB(102); r3_unit(a, lds, b, hh, qb2); PE(102); }
        else if (SUBSEL(2)) { const int q = u - NU_R3, b = q >> 7, n = (q >> 4) & 7, r = q & 15; PB(103); lru_run<true>(a, lds, b, n, 16 * r, 16, false); PE(103); }
    }
}

DI void cvt4_decode(const KArgs& a, int t, const float*& src, int& ld_src, bf16_t*& dst, size_t& hi_stride, int& ld_dst) {
    constexpr int T_GU = 32 * 2 * 16 * 3;
    if (t < T_GU) { const int e = t / 96, r = t % 96, mat = r / 48, kt = (r % 48) / 3, ng = r % 3;
        src = a.in[mat ? I_WEU : I_WEG] + (size_t)e * 1024 * 768 + (size_t)(64 * kt) * 768 + 256 * ng; ld_src = 768;
        dst = (bf16_t*)(a.ws + WS_WGU) + ((size_t)(e * 6 + 2 * ng) * 256 + mat * 128) * 1024 + 64 * kt; hi_stride = (size_t)256 * 1024; ld_dst = 1024;
    } else { const int q = t - T_GU, e = q / 48, r = q % 48, kt = r / 4, ng = r % 4;
        src = a.in[I_WED] + (size_t)e * 768 * 1024 + (size_t)(64 * kt) * 1024 + 256 * ng; ld_src = 1024;
        dst = (bf16_t*)(a.ws + WS_WDN) + ((size_t)e * 1024 + 256 * ng) * 768 + 64 * kt; hi_stride = (size_t)128 * 768; ld_dst = 768; }
}
DI void phase3_cvt(const KArgs& a, LAS unsigned char* lds) {
    const int G = gridDim.x, tid = tid_fresh(); LAS float* tile = (LAS float*)lds;
    constexpr int T_ALL = 32 * 2 * 16 * 3 + 32 * 12 * 4;
    int t = blockIdx.x; if (t >= T_ALL) return;
    const float* src; int ld_src; bf16_t* dst; size_t hi; int ld_dst; cvt4_decode(a, t, src, ld_src, dst, hi, ld_dst);
    f32x4 v[8];
#pragma unroll
    for (int i = 0; i < 8; ++i) v[i] = *(const f32x4*)(src + (size_t)((tid >> 6) + 8 * i) * ld_src + 4 * (tid & 63));
    for (;;) {
        lds_barrier();
#pragma unroll
        for (int i = 0; i < 8; ++i) *(LAS f32x4*)(tile + ((tid >> 6) + 8 * i) * 260 + 4 * (tid & 63)) = v[i];
        const int tn = t + G; bf16_t* dcur = dst; const size_t hcur = hi; const int ldcur = ld_dst;
        if (tn < T_ALL) { cvt4_decode(a, tn, src, ld_src, dst, hi, ld_dst);
#pragma unroll
            for (int i = 0; i < 8; ++i) v[i] = *(const f32x4*)(src + (size_t)((tid >> 6) + 8 * i) * ld_src + 4 * (tid & 63)); }
        lds_barrier();
        const int n = tid & 255, kh = tid >> 8; bf16_t* d = dcur + (size_t)(n >> 7) * hcur + (size_t)(n & 127) * ldcur + 32 * kh;
#pragma unroll
        for (int q = 0; q < 4; ++q) { float x[8];
#pragma unroll
            for (int j = 0; j < 8; ++j) x[j] = tile[(32 * kh + 8 * q + j) * 260 + n];
            u32x4 w; w.x = cvt_pk_bf16(x[0], x[1]); w.y = cvt_pk_bf16(x[2], x[3]); w.z = cvt_pk_bf16(x[4], x[5]); w.w = cvt_pk_bf16(x[6], x[7]);
            *(u32x4*)(d + 8 * q) = w; }
        if (tn >= T_ALL) break;
        t = tn;
    }
    __syncthreads();
}
struct OrderMerge {
    const char* A0; const char* A1; const char* B0; const char* B1; int G, c;
    DI bool next(int i, Unit& u) const { int pm, pn; if (!pg8::static_tile(i >> 1, G, c, NT / 256, 4, pm, pn)) return false;
        const int st = i & 1; u.pm = pm; u.pn = pn; u.aux = st; u.bmode = 1; u.A = (st ? A1 : A0) + (size_t)pm * 256 * 1024 * 2; u.B = (st ? B1 : B0) + (size_t)pn * 256 * 1024 * 2; return true; }
    DI void offsA(const Unit&, int, const int (&R)[2], const int (&C)[2], unsigned (&v)[2][2]) const { pg8::dense_offs(1024, R, C, v); }
};
struct EpiMerge {
    const bf16_t* glog; bf16_t* out;
    DI bool operator()(f32x4 (&acc)[2][2][4][2], const Unit& u, int wr, int wc, int fr, int fq) const {
#pragma unroll
        for (int bj = 0; bj < 2; ++bj) { const int col = u.pn * 256 + bj * 128 + wc * 32 + 8 * fq;
#pragma unroll
            EPI_LOOP_ROWS { const int row = u.pm * 256 + ai * 128 + wr * 64 + m * 16 + fr;
                const u32x4 gl = *(const u32x4*)(glog + (size_t)row * 2048 + 1024 + col);
                if (u.aux == 0) { const u32x4 gr = *(const u32x4*)(glog + (size_t)row * 2048 + col);
#pragma unroll
                    for (int e = 0; e < 4; ++e) { const float r0 = __uint_as_float(gr[e] << 16), r1 = __uint_as_float(gr[e] & 0xffff0000u), l0 = __uint_as_float(gl[e] << 16), l1 = __uint_as_float(gl[e] & 0xffff0000u);
                        const float q0 = (1.0f + ex2(-LOG2E * l0)) * rcpf_(1.0f + ex2(-LOG2E * r0)), q1 = (1.0f + ex2(-LOG2E * l1)) * rcpf_(1.0f + ex2(-LOG2E * r1));
                        acc[ai][bj][m][e >> 1][2 * (e & 1)] *= q0; acc[ai][bj][m][e >> 1][2 * (e & 1) + 1] *= q1; }
                } else { float v[8];
#pragma unroll
                    for (int e = 0; e < 4; ++e) { const float l0 = __uint_as_float(gl[e] << 16), l1 = __uint_as_float(gl[e] & 0xffff0000u);
                        v[2 * e] = acc[ai][bj][m][e >> 1][2 * (e & 1)] * sigm(l0); v[2 * e + 1] = acc[ai][bj][m][e >> 1][2 * (e & 1) + 1] * sigm(l1); }
                    u32x4 w; w.x = cvt_pk_bf16(v[0], v[1]); w.y = cvt_pk_bf16(v[2], v[3]); w.z = cvt_pk_bf16(v[4], v[5]); w.w = cvt_pk_bf16(v[6], v[7]);
                    *(u32x4*)(out + (size_t)row * 1024 + col) = w; } } }
        return u.aux == 0;
    }
};

struct OrderOut {
    const char* A; const char* B; int G, c;
    DI bool next(int i, Unit& u) const { int pm, pn; if (!pg8::static_tile(i, G, c, NT / 256, 4, pm, pn)) return false;
        u.pm = pm; u.pn = pn; u.aux = 0; u.bmode = 0; u.A = A + (size_t)pm * 256 * 1024 * 2; u.B = B + (size_t)pn * 256 * 1024 * 2; return true; }
    DI void offsA(const Unit&, int, const int (&R)[2], const int (&C)[2], unsigned (&v)[2][2]) const { pg8::dense_offs(1024, R, C, v); }
};
struct EpiOut {
    const KArgs* a;
    DI bool operator()(f32x4 (&acc)[2][2][4][2], const Unit& u, int wr, int wc, int fr, int fq) const {
        const int b = (u.pm * 256) / SEQ;
#pragma unroll
        for (int bj = 0; bj < 2; ++bj)
#pragma unroll
            for (int n = 0; n < 2; ++n) { const int col = u.pn * 256 + bj * 128 + wc * 32 + 16 * n + 4 * fq; f32x4 g;
#pragma unroll
                for (int j = 0; j < 4; ++j) g[j] = 0.f;
                g = *(const f32x4*)((const float*)(a->ws + WS_MODT) + b * 1024 + col);
#pragma unroll
                EPI_LOOP_ROWS { const size_t off = (size_t)(u.pm * 256 + ai * 128 + wr * 64 + m * 16 + fr) * 1024 + col;
                    *(f32x4*)(a->out + off) = *(const f32x4*)(a->in[I_X] + off) + g * acc[ai][bj][m][n]; } }
        return false;
    }
};

DI void phase5(const KArgs& a, LAS unsigned char* lds) {
    const int tid = tid_fresh(), G = gridDim.x, lane = tid & 63, wid = tid >> 6;
    LAS float* gm = (LAS float*)lds;
    LAS float* sh = gm + 2048;
    LAS float* lg = sh + 2048;
    LAS int* lcnt = (LAS int*)(lg + 128 * 40);
    LAS int* rinfo = lcnt + 64;
    LAS float* rw = (LAS float*)(rinfo + 512);
    __syncthreads();
    for (int i = tid; i < 2048; i += 512) { const float* mt = (const float*)(a.ws + WS_MODT); gm[i] = mt[2048 + i]; sh[i] = mt[4096 + i]; }
    if (blockIdx.x == 0) for (int i = tid; i < 512; i += 512) ((unsigned*)(a.ws + WS_HX2) + (size_t)NT * 512)[i] = 0u;
    bf16_t* hx2 = (bf16_t*)(a.ws + WS_HX2);
    int* cnt = (int*)(a.ws + WS_CTL) + CW_CNT;
    for (int rt = blockIdx.x; rt < NT / 128; rt += G) {
        __syncthreads();
        if (tid < 32) lcnt[tid] = 0;
        {   const int row0 = 128 * rt + 16 * wid, v = row0 / SEQ; f32x4 x[4];
#pragma unroll
            for (int j = 0; j < 4; ++j) x[j] = *(const f32x4*)(a.out + (size_t)row0 * 1024 + 4 * lane + 256 * j);
            for (int rr = 0; rr < 16; ++rr) { const int row = row0 + rr; f32x4 xn[4];
                if (rr < 15) {
#pragma unroll
                    for (int j = 0; j < 4; ++j) xn[j] = *(const f32x4*)(a.out + (size_t)(row + 1) * 1024 + 4 * lane + 256 * j); }
                float ss = 0.f;
#pragma unroll
                for (int j = 0; j < 4; ++j) ss += (x[j][0] * x[j][0] + x[j][1] * x[j][1]) + (x[j][2] * x[j][2] + x[j][3] * x[j][3]);
#pragma unroll
                for (int o = 32; o >= 1; o >>= 1) ss += __shfl_xor(ss, o);
                const float rstd = rsqrtf(ss * (1.0f / 1024.0f) + EPSV);
#pragma unroll
                for (int j = 0; j < 4; ++j) { const int k0 = 4 * lane + 256 * j; const f32x4 g = *(const LAS f32x4*)(gm + v * 1024 + k0), sv = *(const LAS f32x4*)(sh + v * 1024 + k0);
                    u32x2 w; w.x = cvt_pk_bf16(x[j][0] * rstd * g[0] + sv[0], x[j][1] * rstd * g[1] + sv[1]); w.y = cvt_pk_bf16(x[j][2] * rstd * g[2] + sv[2], x[j][3] * rstd * g[3] + sv[3]);
                    *(u32x2*)(hx2 + (size_t)row * 1024 + k0) = w; }
#pragma unroll
                for (int j = 0; j < 4; ++j) x[j] = xn[j];
            }
        }
        __syncthreads();
        {
            const int rb = wid >> 1, cb = wid & 1, r = lane & 31, h = lane >> 5;
            const bf16_t* ar = hx2 + (size_t)(128 * rt + 32 * rb + r) * 1024 + 8 * h;
            const bf16_t* bh = (const bf16_t*)(a.ws + WS_WRH) + (size_t)(32 * cb + r) * 1024 + 8 * h; const bf16_t* bl = bh + 64 * 1024;
            f32x16 acc = zero16();
#pragma unroll 8
            for (int ks = 0; ks < 64; ++ks) { const bf16x8 af = *(const bf16x8*)(ar + 16 * ks), b1 = *(const bf16x8*)(bh + 16 * ks), b2 = *(const bf16x8*)(bl + 16 * ks);
                acc = MFMA32(af, b1, acc); acc = MFMA32(af, b2, acc); }
            const int col = 32 * cb + r;
            if (col < 36) {
#pragma unroll
                for (int i = 0; i < 16; ++i) lg[(32 * rb + crow(i, h)) * 40 + col] = acc[i]; }
        }
        __syncthreads();
        if (tid < 128) { const LAS float* l = lg + tid * 40;
            int gs = 0; float best = l[0] + a.in[I_BGRP][0];
#pragma unroll
            for (int g = 1; g < 4; ++g) { const float v = l[g] + a.in[I_BGRP][g]; if (v > best) { best = v; gs = g; } }
            const float mx = fmaxf(fmaxf(l[0], l[1]), fmaxf(l[2], l[3])); float den = 0.f;
#pragma unroll
            for (int g = 0; g < 4; ++g) den += expf(l[g] - mx);
            const float pg = expf(l[gs] - mx) / den;
            int i0 = 0, i1 = -1; float v0 = -3.0e38f, v1 = -3.0e38f;
#pragma unroll
            for (int e = 0; e < 8; ++e) { const float v = l[4 + 8 * gs + e] + a.in[I_BRT][8 * gs + e];
                if (v > v0) { v1 = v0; i1 = i0; v0 = v; i0 = e; } else if (v > v1) { v1 = v; i1 = e; } }
            const float e0 = l[4 + 8 * gs + i0], e1 = l[4 + 8 * gs + i1], m2 = fmaxf(e0, e1), x0 = expf(e0 - m2), x1 = expf(e1 - m2), inv = 1.0f / (x0 + x1);
            const int ex0 = 8 * gs + i0, ex1 = 8 * gs + i1;
            rinfo[tid * 4 + 0] = ex0; rinfo[tid * 4 + 1] = atomicAdd((int*)&lcnt[ex0], 1); rinfo[tid * 4 + 2] = ex1; rinfo[tid * 4 + 3] = atomicAdd((int*)&lcnt[ex1], 1);
            rw[tid * 2 + 0] = pg * x0 * inv; rw[tid * 2 + 1] = pg * x1 * inv; }
        __syncthreads();
        if (tid < 32) lcnt[32 + tid] = lcnt[tid] ? atomicAdd(&cnt[tid], lcnt[tid]) : 0;
        __syncthreads();
        if (tid < 128) { const int tok = 128 * rt + tid; const int e0 = rinfo[tid * 4 + 0], s0 = lcnt[32 + e0] + rinfo[tid * 4 + 1], e1 = rinfo[tid * 4 + 2], s1 = lcnt[32 + e1] + rinfo[tid * 4 + 3];
            int* ptok = (int*)(a.ws + WS_PTOK); ptok[(size_t)e0 * 65536 + s0] = tok; ptok[(size_t)e1 * 65536 + s1] = tok;
            unsigned* ro = (unsigned*)(a.ws + WS_ROUTE) + (size_t)tok * 8; ro[0] = e0; ro[1] = s0; ro[2] = e1; ro[3] = s1; ro[4] = __float_as_uint(rw[tid * 2]); ro[5] = __float_as_uint(rw[tid * 2 + 1]); }
    }
}

DI void moe_tiles(const KArgs& a, LAS int* tt) {
    __syncthreads();
    if (threadIdx.x == 0) { const int* cnt = (const int*)(a.ws + WS_CTL) + CW_CNT; int s = 0; for (int e = 0; e < 32; ++e) { tt[e] = s; s += (cnt[e] + 255) >> 8; } tt[32] = s; }
    __syncthreads();
}
DI int moe_expert(const LAS int* tt, int rt) { int e = 0;
#pragma unroll
    for (int q = 16; q >= 1; q >>= 1) if (tt[e + q] <= rt) e += q;
    return e; }
struct OrderMoe1 {
    const char* A; const char* B; const LAS int* tt; const LAS int* tok; int G, c;
    DI bool next(int i, Unit& u) const { const int L = i * G + c; if (L >= tt[32] * 6) return false; const int rt = L / 6, ct = L % 6, e = moe_expert(tt, rt);
        u.pm = rt; u.pn = ct; u.aux = e; u.bmode = 1; u.A = A; u.B = B + (size_t)(e * 6 + ct) * 256 * 1024 * 2; return true; }
    DI void offsA(const Unit&, int ui, const int (&R)[2], const int (&C)[2], unsigned (&v)[2][2]) const {
#pragma unroll
        for (int h = 0; h < 2; ++h)
#pragma unroll
            for (int i = 0; i < 2; ++i) v[h][i] = (unsigned)tok[ui * 256 + h * 128 + R[i]] * 2048u + (unsigned)C[i] * 2u; }
};
struct EpiMoe1 {
    bf16_t* hid;
    DI bool operator()(f32x4 (&acc)[2][2][4][2], const Unit& u, int wr, int wc, int fr, int fq) const {
        const int col = u.pn * 128 + wc * 32 + 8 * fq;
#pragma unroll
        EPI_LOOP_ROWS { const size_t row = (size_t)u.pm * 256 + ai * 128 + wr * 64 + m * 16 + fr; float v[8];
#pragma unroll
            for (int n = 0; n < 2; ++n)
#pragma unroll
                for (int j = 0; j < 4; ++j) v[4 * n + j] = silu_(acc[ai][0][m][n][j]) * acc[ai][1][m][n][j];
            u32x4 w; w.x = cvt_pk_bf16(v[0], v[1]); w.y = cvt_pk_bf16(v[2], v[3]); w.z = cvt_pk_bf16(v[4], v[5]); w.w = cvt_pk_bf16(v[6], v[7]);
            *(u32x4*)(hid + row * 768 + col) = w; }
        return false;
    }
};
struct OrderMoe2 {
    const char* A; const char* B; const LAS int* tt; int G, c;
    DI bool next(int i, Unit& u) const { const int L = i * G + c; if (L >= tt[32] * 4) return false; const int rt = L >> 2, ct = L & 3, e = moe_expert(tt, rt);
        u.pm = rt; u.pn = ct; u.aux = e; u.bmode = 1; u.A = A + (size_t)rt * 256 * 768 * 2; u.B = B + ((size_t)e * 1024 + 256 * ct) * 768 * 2; return true; }
    DI void offsA(const Unit&, int, const int (&R)[2], const int (&C)[2], unsigned (&v)[2][2]) const { pg8::dense_offs(768, R, C, v); }
};
struct EpiMoe2 {
    bf16_t* ye;
    DI bool operator()(f32x4 (&acc)[2][2][4][2], const Unit& u, int wr, int wc, int fr, int fq) const {
#pragma unroll
        for (int bj = 0; bj < 2; ++bj) { const int col = u.pn * 256 + bj * 128 + wc * 32 + 8 * fq;
#pragma unroll
            EPI_LOOP_ROWS { const size_t row = (size_t)u.pm * 256 + ai * 128 + wr * 64 + m * 16 + fr; const f32x4 v0 = acc[ai][bj][m][0], v1 = acc[ai][bj][m][1];
                u32x4 w; w.x = cvt_pk_bf16(v0[0], v0[1]); w.y = cvt_pk_bf16(v0[2], v0[3]); w.z = cvt_pk_bf16(v1[0], v1[1]); w.w = cvt_pk_bf16(v1[2], v1[3]);
                *(u32x4*)(ye + row * 1024 + col) = w; } }
        return false;
    }
};

DI void phase8(const KArgs& a, LAS unsigned char* lds) {
    const int tid = tid_fresh(), G = gridDim.x, lane = tid & 63, wid = tid >> 6;
    LAS float* g2 = (LAS float*)lds;
    LAS int* tt = (LAS int*)(g2 + 2048);
    moe_tiles(a, tt);
    for (int i = tid; i < 2048; i += 512) g2[i] = ((const float*)(a.ws + WS_MODT))[6144 + i];
    __syncthreads();
    const bf16_t* ye = (const bf16_t*)(a.ws + WS_YE);
    for (int row = blockIdx.x * 8 + wid; row < NT; row += G * 8) {
        const int v = row / SEQ; const unsigned* ro = (const unsigned*)(a.ws + WS_ROUTE) + (size_t)row * 8;
        const size_t p0 = (size_t)tt[ro[0]] * 256 + ro[1], p1 = (size_t)tt[ro[2]] * 256 + ro[3]; const float w0 = __uint_as_float(ro[4]), w1 = __uint_as_float(ro[5]);
        float* xr = a.out + (size_t)row * 1024; f32x4 x[4]; float ss = 0.f;
#pragma unroll
        for (int j = 0; j < 4; ++j) { const int k0 = 4 * lane + 256 * j; x[j] = *(const f32x4*)(xr + k0);
            const u32x2 ya = *(const u32x2*)(ye + p0 * 1024 + k0), yb = *(const u32x2*)(ye + p1 * 1024 + k0); const f32x4 g = *(const LAS f32x4*)(g2 + v * 1024 + k0);
            x[j][0] += g[0] * (w0 * __uint_as_float(ya[0] << 16) + w1 * __uint_as_float(yb[0] << 16)); x[j][1] += g[1] * (w0 * __uint_as_float(ya[0] & 0xffff0000u) + w1 * __uint_as_float(yb[0] & 0xffff0000u));
            x[j][2] += g[2] * (w0 * __uint_as_float(ya[1] << 16) + w1 * __uint_as_float(yb[1] << 16)); x[j][3] += g[3] * (w0 * __uint_as_float(ya[1] & 0xffff0000u) + w1 * __uint_as_float(yb[1] & 0xffff0000u));
            ss += (x[j][0] * x[j][0] + x[j][1] * x[j][1]) + (x[j][2] * x[j][2] + x[j][3] * x[j][3]); }
#pragma unroll
        for (int o = 32; o >= 1; o >>= 1) ss += __shfl_xor(ss, o);
        const float rstd = rsqrtf(ss * (1.0f / 1024.0f) + EPSV);
#pragma unroll
        for (int j = 0; j < 4; ++j) { const int k0 = 4 * lane + 256 * j; const f32x4 fn = *(const f32x4*)(a.in[I_FNORM] + k0); *(f32x4*)(xr + k0) = x[j] * rstd * fn; }
    }
}

constexpr int N_PHASES = 12;
__global__ void __launch_bounds__(512, 2) fwd_kernel(KArgs a) {
    extern __shared__ __attribute__((aligned(16))) unsigned char lds_raw[];
    LAS unsigned char* lds = (LAS unsigned char*)lds_raw;
    volatile LAS unsigned* misc = (volatile LAS unsigned*)(lds + LDS_MISC);
    if (threadIdx.x < 8) misc[threadIdx.x] = 0u;
#ifdef PROBE_ID
    if (threadIdx.x == 0) { probe_words()[0] = 0; probe_words()[1] = 0; }
#endif
    __syncthreads();
    XcdBarrier bar; bar.bar = (unsigned*)(a.ws + WS_CTL) + CW_BAR; bar.x = 0; bar.st = misc;
    const bool one = (a.ph_hi - a.ph_lo) > 1;
    if (one) bar = xcd_barrier_post((unsigned*)(a.ws + WS_CTL) + CW_BAR, misc);
#ifdef ONLY_PHASE
#define IN(k) ((k) == ONLY_PHASE)
#else
#define IN(k) (a.ph_lo <= (k) && (k) < a.ph_hi)
#endif
#define SEAM(k) do { if (IN(k) && IN((k) + 1)) xcd_barrier(bar); PE(k); PB((k) + 1); } while (0)
    const int G = gridDim.x, c = blockIdx.x;
    PB(0);
    if (IN(0)) { phase0a(a, lds); } SEAM(0);
    if (IN(1)) { phase0b(a, lds); } SEAM(1);
    if (IN(2)) { __syncthreads(); OrderIn S{(const char*)(a.ws + WS_HX), (const char*)(a.ws + WS_WIN), G, c};
        EpiIn E{a.ws, (bf16_t*)a.out, a.in[I_BGATE], (const f32x2*)(a.ws + WS_ROPE)}; pg8::gemm_phase(lds, 1024, S, E); } SEAM(2);
    if (IN(3)) { phase2a(a, lds); } SEAM(3);
    if (IN(4)) { phase2b(a); } SEAM(4);
    if (IN(5)) { phase2c(a, lds); } SEAM(5);
    if (IN(6)) {
        const bool cvt_first = (c & 1) == 0;
        if (cvt_first) { PB(104); phase3_cvt(a, lds); PE(104); }
        {   OrderMerge S{(const char*)(a.ws + WS_ZG), (const char*)(a.ws + WS_ZGL), (const char*)(a.ws + WS_WRET), (const char*)(a.ws + WS_WLRU), G, c};
            EpiMerge E{(const bf16_t*)a.out, (bf16_t*)(a.ws + WS_HX)}; __syncthreads(); pg8::gemm_phase(lds, 1024, S, E); }
        if (!cvt_first) { phase3_cvt(a, lds); } } SEAM(6);
    if (IN(7)) { __syncthreads(); OrderOut S{(const char*)(a.ws + WS_HX), (const char*)(a.ws + WS_WOUT), G, c}; EpiOut E{&a}; pg8::gemm_phase(lds, 1024, S, E); } SEAM(7);
    if (IN(8)) { phase5(a, lds); } SEAM(8);
    if (IN(9)) {
        LAS int* tt = (LAS int*)(lds + LDS_MISC + 64); LAS int* tok = (LAS int*)(lds + LDS_TOK);
        moe_tiles(a, tt);
        {
            const int tid = tid_fresh();
            const int* cnt = (const int*)(a.ws + WS_CTL) + CW_CNT; const int* ptok = (const int*)(a.ws + WS_PTOK);
            for (int i = 0; i < 8; ++i) { const int L = i * G + c; if (L >= tt[32] * 6) break; const int rt = L / 6, e = moe_expert(tt, rt), r0 = (rt - tt[e]) * 256;
                if (tid < 256) tok[i * 256 + tid] = (r0 + tid < cnt[e]) ? ptok[(size_t)e * 65536 + r0 + tid] : NT; }
            __syncthreads();
        }
        OrderMoe1 S{(const char*)(a.ws + WS_HX2), (const char*)(a.ws + WS_WGU), tt, tok, G, c}; EpiMoe1 E{(bf16_t*)(a.ws + WS_HID)}; pg8::gemm_phase(lds, 1024, S, E); } SEAM(9);
    if (IN(10)) { LAS int* tt = (LAS int*)(lds + LDS_MISC + 64); moe_tiles(a, tt);
        OrderMoe2 S{(const char*)(a.ws + WS_HID), (const char*)(a.ws + WS_WDN), tt, G, c}; EpiMoe2 E{(bf16_t*)(a.ws + WS_YE)}; pg8::gemm_phase(lds, 768, S, E); } SEAM(10);
    if (IN(11)) { phase8(a, lds); }
    PE(11);
#ifdef PROBE_ID
    if (blockIdx.x == 0 && threadIdx.x == 0) { const unsigned long long w = probe_words()[1] * 4ull, t0 = wall_clock64(); while (wall_clock64() - t0 < w) __builtin_amdgcn_s_sleep(8); }
#endif
#undef IN
#undef SEAM
}

extern "C" void kernel_launch(void* const* d_in, const int* in_sizes, int n_in, void* d_out, int out_size, void* d_ws, size_t ws_size, hipStream_t stream) {
    static int grid = 0;
    if (grid == 0) {
        if (n_in != 30 || out_size != NT * DM || ws_size < WS_NEED) { fprintf(stderr, "kernel_launch: unexpected shapes (n_in %d out %d ws %zu)\n", n_in, out_size, ws_size); grid = -1; return; }
        int dev = 0, cus = 0;
        if (hipGetDevice(&dev) != hipSuccess || hipDeviceGetAttribute(&cus, hipDeviceAttributeMultiprocessorCount, dev) != hipSuccess) { grid = -1; return; }
        if (hipFuncSetAttribute((const void*)fwd_kernel, hipFuncAttributeMaxDynamicSharedMemorySize, LDS_BYTES) != hipSuccess) { fprintf(stderr, "kernel_launch: hipFuncSetAttribute failed\n"); grid = -1; return; }
        int per_cu = 0; (void)hipOccupancyMaxActiveBlocksPerMultiprocessor(&per_cu, (const void*)fwd_kernel, 512, LDS_BYTES); (void)hipGetLastError();
        grid = cus;
    }
    if (grid < 0) return;
    (void)hipMemsetAsync((char*)d_ws + WS_CTL, 0, 1 * MiB, stream);
    KArgs a{};
    for (int i = 0; i < 30; ++i) a.in[i] = (const float*)d_in[i];
    a.out = (float*)d_out; a.ws = (unsigned char*)d_ws;
#if N_LAUNCH_SPLIT
    for (int p = 0; p < N_PHASES; ++p) { a.ph_lo = p; a.ph_hi = p + 1; hipLaunchKernelGGL(fwd_kernel, dim3(grid), dim3(512), LDS_BYTES, stream, a); }
#else
    a.ph_lo = 0; a.ph_hi = N_PHASES; hipLaunchKernelGGL(fwd_kernel, dim3(grid), dim3(512), LDS_BYTES, stream, a);
#endif
}
```

```cpp
#include <hip/hip_runtime.h>
#include <cstdio>
#include <cstdint>

#ifndef N_LAUNCH_SPLIT
#define N_LAUNCH_SPLIT 0
#endif

#define DI __device__ __forceinline__
#ifdef SUB
#define SUBSEL(k) ((k) == SUB)
#else
#define SUBSEL(k) true
#endif
#define LAS __attribute__((address_space(3)))
typedef unsigned short bf16_t;
typedef short bf16x8 __attribute__((ext_vector_type(8)));
typedef short s16x4 __attribute__((ext_vector_type(4)));
typedef float f32x2 __attribute__((ext_vector_type(2)));
typedef float f32x4 __attribute__((ext_vector_type(4)));
typedef float f32x16 __attribute__((ext_vector_type(16)));
typedef unsigned u32x2 __attribute__((ext_vector_type(2)));
typedef unsigned u32x4 __attribute__((ext_vector_type(4)));
typedef int v8i_t __attribute__((ext_vector_type(8)));
typedef int v4i_t __attribute__((ext_vector_type(4)));

constexpr int NB_ = 2, SEQ = 16384, NT = NB_ * SEQ, DM = 1024, CTXL = 256, NTC = NB_ * CTXL;
constexpr int NH = 4, DK = 128, DV = 256, QW = 512, VW = 1024, LW = 1024;
constexpr int NCOL = 7168;
constexpr int NE = 32, EH = 768;
constexpr float EPSV = 1e-6f;
constexpr float LOG2E = 1.4426950408889634f;
constexpr int SCH = 512, NSC = SEQ / SCH;
constexpr int LT = 64, NLT = SEQ / LT, NSLOT = 320;

constexpr size_t MiB = 1u << 20;
constexpr size_t WS_CTL = 0;
constexpr size_t WS_MODP = 1 * MiB;
constexpr size_t WS_MODT = 1 * MiB + 384 * 1024;
constexpr size_t WS_RDEC = 1 * MiB + 448 * 1024;
constexpr size_t WS_ROPE = 1 * MiB + 512 * 1024;
constexpr size_t WS_WRH = 1 * MiB + 768 * 1024;
constexpr size_t WS_LAGG = 2 * MiB;
constexpr size_t WS_LHIN = 12 * MiB;
constexpr size_t WS_CTXK = 17 * MiB;
constexpr size_t WS_CTXV = 17 * MiB + 512 * 1024;
constexpr size_t WS_CTXX = 18 * MiB + 512 * 1024;
constexpr size_t WS_CTXS = 20 * MiB;
constexpr size_t WS_ROUTE = 22 * MiB;
constexpr size_t WS_PTOK = 23 * MiB;
constexpr size_t WS_WIN = 32 * MiB;
constexpr size_t WS_WRET = 46 * MiB, WS_WLRU = 48 * MiB, WS_WOUT = 50 * MiB;
constexpr size_t WS_WLB = 52 * MiB;
constexpr size_t WS_HX = 56 * MiB;
constexpr size_t WS_ZQ = 120 * MiB, WS_ZK = 152 * MiB, WS_ZV = 184 * MiB, WS_ZG = 248 * MiB, WS_ZXL = 312 * MiB, WS_ZGL = 376 * MiB;
constexpr size_t WS_SBF = 440 * MiB;
constexpr size_t WS_WGU = 120 * MiB;
constexpr size_t WS_WDN = 440 * MiB;
constexpr size_t WS_HX2 = 248 * MiB;
constexpr size_t WS_HID = 313 * MiB;
constexpr size_t WS_HX2Q = 168 * MiB;
constexpr size_t WS_YE = 56 * MiB;
constexpr size_t WS_NEED = 512 * MiB;
constexpr int CW_BAR = 4096, CW_CNT = 16384;

constexpr int LDS_SCR = 0, LDS_TOK = 131072, LDS_MISC = 131072 + 8192, LDS_BYTES = 147456;

DI int tid_fresh() { int t = threadIdx.x; asm volatile("" : "+v"(t)); return t; }
#ifdef PROBE_ID
DI volatile LAS unsigned long long* probe_words() { extern __shared__ __attribute__((aligned(16))) unsigned char lds_raw[]; return (volatile LAS unsigned long long*)((LAS unsigned char*)lds_raw + 131072 + 8192 + 1024); }
#define PB(id) do { if ((id) == PROBE_ID && threadIdx.x == 0) probe_words()[0] = wall_clock64(); } while (0)
#define PE(id) do { if ((id) == PROBE_ID && threadIdx.x == 0) probe_words()[1] += wall_clock64() - probe_words()[0]; } while (0)
#else
#define PB(id) do {} while (0)
#define PE(id) do {} while (0)
#endif
DI float bf2f(unsigned short b) { return __uint_as_float(((unsigned)b) << 16); }
typedef __bf16 bf16x2_t __attribute__((ext_vector_type(2)));
DI unsigned cvt_pk_bf16(float lo, float hi) { const f32x2 v = {lo, hi}; return __builtin_bit_cast(unsigned, __builtin_convertvector(v, bf16x2_t)); }
DI unsigned cvt4_fp8(float a, float b, float c, float d) { int p = 0; p = __builtin_amdgcn_cvt_pk_fp8_f32(fminf(fmaxf(a, -448.f), 448.f), fminf(fmaxf(b, -448.f), 448.f), p, false);
    p = __builtin_amdgcn_cvt_pk_fp8_f32(fminf(fmaxf(c, -448.f), 448.f), fminf(fmaxf(d, -448.f), 448.f), p, true); return (unsigned)p; }
DI unsigned short f2bf(float f) { return (unsigned short)(cvt_pk_bf16(f, 0.f) & 0xffffu); }
DI float ex2(float x) { return __builtin_amdgcn_exp2f(x); }
DI float rcpf_(float x) { return __builtin_amdgcn_rcpf(x); }
DI float sigm(float x) { return rcpf_(1.0f + ex2(-LOG2E * x)); }
DI float silu_(float x) { return x * sigm(x); }
DI float gelu_tanh(float x) { const float z = 0.7978845608028654f * (x + 0.044715f * x * x * x); return x * sigm(2.0f * z); }
DI float softplus_(float x) { return x > 20.f ? x : log1pf(expf(x)); }
DI int crow(int i, int h) { return (i & 3) + 8 * (i >> 2) + 4 * h; }
#define MFMA32(a, b, c) __builtin_amdgcn_mfma_f32_32x32x16_bf16((a), (b), (c), 0, 0, 0)
DI void lds_wait() { asm volatile("s_waitcnt lgkmcnt(0)" ::: "memory"); }
template <int O0, int O1> DI bf16x8 tr_frag(unsigned addr) {
    s16x4 lo, hi;
    asm volatile("ds_read_b64_tr_b16 %0, %2 offset:%3\n\tds_read_b64_tr_b16 %1, %2 offset:%4\n\ts_waitcnt lgkmcnt(0)" : "=&v"(lo), "=&v"(hi) : "v"(addr), "i"(O0), "i"(O1) : "memory");
    return __builtin_shufflevector(lo, hi, 0, 1, 2, 3, 4, 5, 6, 7);
}
template <int O, int S, int T> DI void tr_frag4(unsigned addr, bf16x8& f0, bf16x8& f1, bf16x8& f2, bf16x8& f3) {
    s16x4 a0, a1, b0, b1, c0, c1, d0, d1;
    asm volatile("ds_read_b64_tr_b16 %0, %8 offset:%9\n\tds_read_b64_tr_b16 %1, %8 offset:%10\n\t"
                 "ds_read_b64_tr_b16 %2, %8 offset:%11\n\tds_read_b64_tr_b16 %3, %8 offset:%12\n\t"
                 "ds_read_b64_tr_b16 %4, %8 offset:%13\n\tds_read_b64_tr_b16 %5, %8 offset:%14\n\t"
                 "ds_read_b64_tr_b16 %6, %8 offset:%15\n\tds_read_b64_tr_b16 %7, %8 offset:%16\n\ts_waitcnt lgkmcnt(0)"
                 : "=&v"(a0), "=&v"(a1), "=&v"(b0), "=&v"(b1), "=&v"(c0), "=&v"(c1), "=&v"(d0), "=&v"(d1)
                 : "v"(addr), "i"(O), "i"(O + T), "i"(O + S), "i"(O + S + T), "i"(O + 2 * S), "i"(O + 2 * S + T), "i"(O + 3 * S), "i"(O + 3 * S + T) : "memory");
    f0 = __builtin_shufflevector(a0, a1, 0, 1, 2, 3, 4, 5, 6, 7); f1 = __builtin_shufflevector(b0, b1, 0, 1, 2, 3, 4, 5, 6, 7);
    f2 = __builtin_shufflevector(c0, c1, 0, 1, 2, 3, 4, 5, 6, 7); f3 = __builtin_shufflevector(d0, d1, 0, 1, 2, 3, 4, 5, 6, 7);
}
DI void lds_barrier() { asm volatile("s_waitcnt lgkmcnt(0)" ::: "memory"); __builtin_amdgcn_s_barrier(); asm volatile("" ::: "memory"); }
DI f32x16 zero16() { f32x16 z; for (int i = 0; i < 16; ++i) z[i] = 0.f; return z; }

struct KArgs {
    const float* in[30];
    float* out;
    unsigned char* ws;
    int ph_lo, ph_hi;
};
enum { I_X = 0, I_C, I_CTX, I_CCTX, I_WMOD, I_BMOD, I_NORM1, I_NORM2, I_WIN, I_BGATE, I_RDECAY, I_RNORM, I_WRET, I_CONVW, I_CONVB, I_LWA, I_LBA, I_LWX, I_LBX, I_LLAM,
       I_WLRU, I_WOUT, I_WGRP, I_BGRP, I_WRT, I_BRT, I_WEG, I_WEU, I_WED, I_FNORM };

DI float mod_val(const KArgs& a, int v, int ch, int k) {
    const float* mp = (const float*)(a.ws + WS_MODP); const int n = ch * 1024 + k;
    return ((mp[(0 * 3 + v) * 6144 + n] + mp[(1 * 3 + v) * 6144 + n]) + (mp[(2 * 3 + v) * 6144 + n] + mp[(3 * 3 + v) * 6144 + n])) + a.in[I_BMOD][n];
}

#define XB_TMO      128
#define XB_XCNT(j)  (256  + 64 * (j))
#define XB_XSUB(j)  (1280 + 64 * (j))
#define XB_XGEN(j)  (2304 + 64 * (j))
#define XB_TOP      3328
#define XB_TOPGEN   3392
#define XCD_BAR_WORDS 3456
#define XB_SPIN_CAP (1u << 18)
__device__ __forceinline__ unsigned xb_ld(unsigned* p)              { return __hip_atomic_load(p, __ATOMIC_RELAXED, __HIP_MEMORY_SCOPE_AGENT); }
__device__ __forceinline__ unsigned xb_add(unsigned* p, unsigned v) { return __hip_atomic_fetch_add(p, v, __ATOMIC_RELAXED, __HIP_MEMORY_SCOPE_AGENT); }
__device__ __forceinline__ unsigned xb_xcc_id() { return (unsigned)__builtin_amdgcn_s_getreg((3 << 11) | 20) & 0xFu; }
#define XB_SPIN(cond, bar) do { unsigned _sp = 0; while (cond) { __builtin_amdgcn_s_sleep(1); \
    if ((++_sp & 255u) == 0u) { if (xb_ld(&(bar)[XB_TMO])) break; if (_sp > XB_SPIN_CAP) { atomicAdd(&(bar)[XB_TMO], 1u); break; } } } } while (0)
struct XcdBarrier { unsigned* bar; unsigned x; volatile LAS unsigned* st; };
__device__ __forceinline__ XcdBarrier xcd_barrier_post(unsigned* bar, volatile LAS unsigned* st) {
    XcdBarrier b; b.bar = bar; b.x = xb_xcc_id(); b.st = st;
    if (threadIdx.x == 0) (void)xb_add(&bar[XB_XCNT(b.x)], 1u);
    return b;
}
__device__ __forceinline__ void xcd_barrier_complete(unsigned* bar, unsigned x, unsigned& nloc, unsigned& nx) {
    const unsigned G = gridDim.x * gridDim.y * gridDim.z;
    unsigned sum, cnt, mine, sp = 0u;
    for (;;) {
        sum = 0u; cnt = 0u; mine = 0u;
#pragma unroll
        for (unsigned j = 0; j < 16; ++j) { const unsigned c = xb_ld(&bar[XB_XCNT(j)]); sum += c; cnt += (c > 0u) ? 1u : 0u; mine = (j == x) ? c : mine; }
        if (sum == G) break;
        __builtin_amdgcn_s_sleep(1);
        if ((++sp & 255u) == 0u) { if (xb_ld(&bar[XB_TMO])) break; if (sp > XB_SPIN_CAP) { atomicAdd(&bar[XB_TMO], 1u); break; } }
    }
    nloc = mine > 0u ? mine : 1u; nx = cnt > 0u ? cnt : 1u;
}
__device__ __forceinline__ void xcd_barrier(const XcdBarrier& b) {
    asm volatile("s_waitcnt vmcnt(0)" ::: "memory");
    __syncthreads();
    if (threadIdx.x == 0) {
        unsigned* bar = b.bar;
        __builtin_amdgcn_s_waitcnt(0);
        unsigned nloc = b.st[0], nx = b.st[1];
        if (nloc == 0u) { xcd_barrier_complete(bar, b.x, nloc, nx); b.st[0] = nloc; b.st[1] = nx; }
        const unsigned old = xb_add(&bar[XB_XSUB(b.x)], 1u);
        const unsigned gen = old / nloc;
        if (old + 1u == (gen + 1u) * nloc) {
            __builtin_amdgcn_fence(__ATOMIC_RELEASE, "agent");
            asm volatile("s_waitcnt vmcnt(0)" ::: "memory");
            const unsigned og = xb_add(&bar[XB_TOP], 1u);
            const unsigned tg = og / nx;
            if (og + 1u == (tg + 1u) * nx) xb_add(&bar[XB_TOPGEN], 1u);
            else XB_SPIN(xb_ld(&bar[XB_TOPGEN]) == tg, bar);
            __builtin_amdgcn_fence(__ATOMIC_ACQUIRE, "agent");
            xb_add(&bar[XB_XGEN(b.x)], 1u);
            asm volatile("s_waitcnt vmcnt(0)" ::: "memory");
        } else {
            XB_SPIN(xb_ld(&bar[XB_XGEN(b.x)]) == gen, bar);
            __builtin_amdgcn_fence(__ATOMIC_ACQUIRE, "agent");
            asm volatile("s_waitcnt vmcnt(0)" ::: "memory");
        }
    }
    __syncthreads();
}

namespace pg8 {
constexpr int BM = 256, BK = 64, HALF = 128, HTB = HALF * BK * 2, STAGE_BYTES = 8 * HTB, NXCD = 8, WGM = 8;
DI int lds_byte(int r, int c) { const int st = (r >> 4) * 2 + (c >> 5), rr = r & 15, cc = c & 31, ob = rr * 64 + cc * 2; return st * 1024 + (ob ^ (((ob >> 9) & 1) << 5)); }
DI void stage_rc(int b, int& R, int& C) { const int st = b / 1024, sb = b % 1024, swz = sb ^ (((sb >> 9) & 1) << 5); R = (st >> 1) * 16 + swz / 64; C = (st & 1) * 32 + (swz % 64) / 2; }
DI int perm32(int rho) { const int n = rho >> 4, i = rho & 15; return 8 * (i >> 2) + 4 * n + (i & 3); }
DI int bmap(int mode, int R) {
    if (mode == 1) return (R & ~31) + perm32(R & 31);
    if (mode == 2) { const int wc = R >> 5, n = (R >> 4) & 1, low = R & 15; return 64 * (wc >> 1) + 32 * n + 16 * (wc & 1) + low; }
    return R;
}
struct Unit { const char* A; const char* B; int pm, pn, aux, bmode; };
DI bool static_tile(int i, int G, int c, int nM, int nN, int& pm, int& pn) {
    const int nwg = nM * nN; const long L = (long)i * G + c; if (L >= nwg) return false;
    int wgid = (int)L; { const int q = nwg / NXCD, r = nwg % NXCD, xcd = wgid % NXCD, off = wgid / NXCD; wgid = (xcd < r ? xcd * (q + 1) : r * (q + 1) + (xcd - r) * q) + off; }
    const int nig = WGM * nN, gid = wgid / nig, fm = gid * WGM, gsz = (nM - fm) < WGM ? (nM - fm) : WGM;
    pm = fm + ((wgid % nig) % gsz); pn = (wgid % nig) / gsz; return true;
}

template <bool F8, class Epi, class Sched>
DI void gemm_phase(LAS unsigned char* lds, const int K, const Sched& S, const Epi& E) {
    const int tid = tid_fresh(), wid = __builtin_amdgcn_readfirstlane(tid >> 6), lane = tid & 63, wr = wid >> 2, wc = wid & 3;
    const int rowb = F8 ? K : 2 * K, nt = rowb / 128;
    unsigned voffA[2][2], voffB[2];
    const size_t kstep = (size_t)(BK * 2);
    const size_t hstep = (size_t)HALF * rowb;
    const unsigned ldsw = (unsigned)wid * 1024u;
    const int aoff = lds_byte(wr * 64 + (lane & 15), (lane >> 4) * 8), boff = lds_byte(wc * 32 + (lane & 15), (lane >> 4) * 8);
#define PG8_SA(b, h) (((b) * 2 + (h)) * HTB)
#define PG8_SB(b, h) ((4 + (b) * 2 + (h)) * HTB)
#define PG8_STAGE(bufoff, gbase, voff) do { _Pragma("unroll") for (int _i = 0; _i < 2; ++_i) { unsigned vo_ = (voff)[_i]; asm volatile("" : "+v"(vo_));     \
        __builtin_amdgcn_global_load_lds((const unsigned*)((const char*)(gbase) + vo_), (LAS unsigned*)(lds + (bufoff) + ldsw + _i * 8192), 16, 0, 0); } } while (0)
#define PG8_LD8(p_) __builtin_shufflevector(*(const LAS v4i_t*)(p_), *(const LAS v4i_t*)((p_) + 1024), 0, 1, 2, 3, 4, 5, 6, 7)
#define PG8_LDA(dst, b, h) do { _Pragma("unroll") for (int m = 0; m < 4; ++m) dst[m] = PG8_LD8(lds + PG8_SA(b, h) + aoff + m * 2048); } while (0)
#define PG8_LDB(dst, b, h) do { _Pragma("unroll") for (int n = 0; n < 2; ++n) dst[n] = PG8_LD8(lds + PG8_SB(b, h) + boff + n * 2048); } while (0)
#define PG8_LO(v_) __builtin_bit_cast(bf16x8, __builtin_shufflevector(v_, v_, 0, 1, 2, 3))
#define PG8_HI(v_) __builtin_bit_cast(bf16x8, __builtin_shufflevector(v_, v_, 4, 5, 6, 7))
#define PG8_MMA(ai, bj, At, Bt) do { __builtin_amdgcn_s_setprio(1); _Pragma("unroll") for (int m = 0; m < 4; ++m) _Pragma("unroll") for (int n = 0; n < 2; ++n) { \
        if constexpr (F8) { acc[ai][bj][m][n] = __builtin_amdgcn_mfma_scale_f32_16x16x128_f8f6f4(Bt[n], At[m], acc[ai][bj][m][n], 0, 0, 0, 0x7f7f7f7f, 0, 0x7f7f7f7f); } \
        else { acc[ai][bj][m][n] = __builtin_amdgcn_mfma_f32_16x16x32_bf16(PG8_LO(Bt[n]), PG8_LO(At[m]), acc[ai][bj][m][n], 0, 0, 0); \
               acc[ai][bj][m][n] = __builtin_amdgcn_mfma_f32_16x16x32_bf16(PG8_HI(Bt[n]), PG8_HI(At[m]), acc[ai][bj][m][n], 0, 0, 0); } } \
        __builtin_amdgcn_s_setprio(0); } while (0)
#define PG8_WAIT_V(n) asm volatile("s_waitcnt vmcnt(" #n ")" ::: "memory")
#define PG8_WAIT_L(n) asm volatile("s_waitcnt lgkmcnt(" #n ")" ::: "memory")
#define PG8_BAR __builtin_amdgcn_s_barrier()
#define PG8_SCHED __builtin_amdgcn_sched_barrier(0)
#define PG8_RC() int Rr[2], Cc[2]; { const int t_ = tid_fresh(); _Pragma("unroll") for (int _i = 0; _i < 2; ++_i) stage_rc(t_ * 16 + _i * 8192, Rr[_i], Cc[_i]); }
#define PG8_SETB(u) do { PG8_RC(); _Pragma("unroll") for (int _i = 0; _i < 2; ++_i) voffB[_i] = (unsigned)(bmap((u).bmode, Rr[_i]) * rowb + Cc[_i] * 2); } while (0)
#define PG8_SETA(u, ui_) do { PG8_RC(); S.offsA((u), (ui_), Rr, Cc, voffA); } while (0)
    Unit cur, nxt; int ui = 0;
    if (!S.next(0, cur)) return;
    f32x4 acc[2][2][4][2];
#pragma unroll
    for (int a = 0; a < 2; ++a)
#pragma unroll
        for (int b = 0; b < 2; ++b)
#pragma unroll
            for (int m = 0; m < 4; ++m)
#pragma unroll
                for (int n = 0; n < 2; ++n) acc[a][b][m][n] = (f32x4){0.f, 0.f, 0.f, 0.f};
    v8i_t At[4], B0[2], B1[2];
    const char* cA = cur.A; const char* cB = cur.B;
    PG8_SETA(cur, 0); PG8_SETB(cur);
    PG8_STAGE(PG8_SB(0, 0), cB, voffB); PG8_STAGE(PG8_SB(0, 1), cB + hstep, voffB); PG8_STAGE(PG8_SA(0, 0), cA, voffA[0]); PG8_STAGE(PG8_SA(0, 1), cA, voffA[1]);
    if (wr == 1) PG8_BAR;
    PG8_WAIT_V(2); PG8_BAR;
    PG8_STAGE(PG8_SB(1, 0), cB + kstep, voffB); PG8_STAGE(PG8_SA(1, 0), cA + kstep, voffA[0]); PG8_STAGE(PG8_SB(1, 1), cB + hstep + kstep, voffB);
    PG8_WAIT_V(6); PG8_BAR;
    for (;;) {
        const bool has_next = S.next(ui + 1, nxt);
        const char* nA = has_next ? nxt.A : cA; const char* nB = has_next ? nxt.B : cB;
#pragma unroll 1
        for (int t = 0; t < nt; t += 2) {
            const bool last = (t == nt - 2);
            const char* a1 = cA + (size_t)(t + 1) * kstep;
            const char* a2 = last ? nA : cA + (size_t)(t + 2) * kstep; const char* b2 = last ? nB : cB + (size_t)(t + 2) * kstep;
            const char* a3 = a2 + kstep; const char* b3 = b2 + kstep;
            if (last && has_next) PG8_SETB(nxt);
            PG8_LDB(B0, 0, 0); PG8_LDB(B1, 0, 1); PG8_SCHED; PG8_LDA(At, 0, 0); PG8_STAGE(PG8_SA(1, 1), a1, voffA[1]);
            PG8_WAIT_V(8); PG8_WAIT_L(0); PG8_BAR; PG8_MMA(0, 0, At, B0); PG8_MMA(0, 1, At, B1); PG8_BAR; PG8_SCHED;
            if (last && has_next) PG8_SETA(nxt, ui + 1);
            PG8_LDA(At, 0, 1); PG8_STAGE(PG8_SB(0, 0), b2, voffB); PG8_STAGE(PG8_SB(0, 1), b2 + hstep, voffB); PG8_STAGE(PG8_SA(0, 0), a2, voffA[0]);
            PG8_WAIT_V(8); PG8_WAIT_L(0); PG8_BAR; PG8_MMA(1, 0, At, B0); PG8_MMA(1, 1, At, B1); PG8_BAR; PG8_SCHED;
            PG8_LDB(B0, 1, 0); PG8_LDB(B1, 1, 1); PG8_SCHED; PG8_LDA(At, 1, 0); PG8_STAGE(PG8_SA(0, 1), a2, voffA[1]);
            PG8_WAIT_V(8); PG8_WAIT_L(0); PG8_BAR; PG8_MMA(0, 0, At, B0); PG8_MMA(0, 1, At, B1); PG8_BAR; PG8_SCHED;
            PG8_LDA(At, 1, 1); PG8_STAGE(PG8_SB(1, 0), b3, voffB); PG8_STAGE(PG8_SB(1, 1), b3 + hstep, voffB); PG8_STAGE(PG8_SA(1, 0), a3, voffA[0]);
            PG8_WAIT_V(8); PG8_WAIT_L(0); PG8_BAR; PG8_MMA(1, 0, At, B0); PG8_MMA(1, 1, At, B1); PG8_BAR; PG8_SCHED;
        }
        if (wr == 0) PG8_BAR;
        bool keep; { const int t_ = tid_fresh(), l_ = t_ & 63; keep = E(acc, cur, wr, wc, l_ & 15, l_ >> 4); }
        if (!has_next) break;
        if (!keep) {
#pragma unroll
            for (int a = 0; a < 2; ++a)
#pragma unroll
                for (int b = 0; b < 2; ++b)
#pragma unroll
                    for (int m = 0; m < 4; ++m)
#pragma unroll
                        for (int n = 0; n < 2; ++n) acc[a][b][m][n] = (f32x4){0.f, 0.f, 0.f, 0.f};
        }
        cur = nxt; cA = nA; cB = nB; ++ui;
        if (wr == 1) PG8_BAR;
    }
    PG8_WAIT_V(0);
    PG8_BAR;
#undef PG8_SA
#undef PG8_SB
#undef PG8_STAGE
#undef PG8_LDA
#undef PG8_LD8
#undef PG8_LO
#undef PG8_HI
#undef PG8_LDB
#undef PG8_MMA
#undef PG8_WAIT_V
#undef PG8_WAIT_L
#undef PG8_BAR
#undef PG8_SCHED
#undef PG8_SETB
#undef PG8_SETA
#undef PG8_RC
}
DI void dense_offs(int rowbytes, const int (&R)[2], const int (&C)[2], unsigned (&voffA)[2][2]) {
#pragma unroll
    for (int h = 0; h < 2; ++h)
#pragma unroll
        for (int i = 0; i < 2; ++i) voffA[h][i] = (unsigned)((h * HALF + R[i]) * rowbytes + C[i] * 2);
}
}
using pg8::Unit;

#define EPI_LOOP_ROWS for (int ai = 0; ai < 2; ++ai) _Pragma("unroll") for (int m = 0; m < 4; ++m)

DI void cvt_tile(LAS float* tile, const float* src, int ld_src, bf16_t* dst, int ld_dst, float scale) {
    const int tid = tid_fresh();
    __syncthreads();
#pragma unroll
    for (int i = 0; i < 2; ++i) { const int kr = (tid >> 4) + 32 * i, nc = (tid & 15) * 4; const f32x4 v = *(const f32x4*)(src + (size_t)kr * ld_src + nc);
        tile[kr * 65 + nc + 0] = v[0]; tile[kr * 65 + nc + 1] = v[1]; tile[kr * 65 + nc + 2] = v[2]; tile[kr * 65 + nc + 3] = v[3]; }
    __syncthreads();
    const int n = tid >> 3, kc = (tid & 7) * 8; float v[8];
#pragma unroll
    for (int j = 0; j < 8; ++j) v[j] = tile[(kc + j) * 65 + n] * scale;
    u32x4 w; w.x = cvt_pk_bf16(v[0], v[1]); w.y = cvt_pk_bf16(v[2], v[3]); w.z = cvt_pk_bf16(v[4], v[5]); w.w = cvt_pk_bf16(v[6], v[7]);
    *(u32x4*)(dst + (size_t)n * ld_dst + kc) = w;
}

DI void cvt_tile4(LAS float* tile, const float* src, int ld_src, bf16_t* dst, size_t hi_stride, int ld_dst) {
    const int tid = tid_fresh();
    f32x4 v[8];
#pragma unroll
    for (int i = 0; i < 8; ++i) v[i] = *(const f32x4*)(src + (size_t)((tid >> 6) + 8 * i) * ld_src + 4 * (tid & 63));
    __syncthreads();
#pragma unroll
    for (int i = 0; i < 8; ++i) *(LAS f32x4*)(tile + ((tid >> 6) + 8 * i) * 260 + 4 * (tid & 63)) = v[i];
    __syncthreads();
    const int n = tid & 255, kh = tid >> 8; bf16_t* d = dst + (size_t)(n >> 7) * hi_stride + (size_t)(n & 127) * ld_dst + 32 * kh;
#pragma unroll
    for (int q = 0; q < 4; ++q) { float x[8];
#pragma unroll
        for (int j = 0; j < 8; ++j) x[j] = tile[(32 * kh + 8 * q + j) * 260 + n];
        u32x4 w; w.x = cvt_pk_bf16(x[0], x[1]); w.y = cvt_pk_bf16(x[2], x[3]); w.z = cvt_pk_bf16(x[4], x[5]); w.w = cvt_pk_bf16(x[6], x[7]);
        *(u32x4*)(d + 8 * q) = w; }
}

DI void phase0a(const KArgs& a, LAS unsigned char* lds) {
    const int tid = tid_fresh(), G = gridDim.x;
    LAS float* fl = (LAS float*)lds;
    constexpr int NU_MOD = 192, NU_ROPE = 1, NU_ROUTW = 1, T_WIN = 16 * 28, T_PROJ = 3 * 64, T_LB = 128;
    constexpr int U0 = NU_MOD, U1 = U0 + NU_ROPE, U2 = U1 + NU_ROUTW, U3 = U2 + T_WIN, U4 = U3 + T_PROJ, U5 = U4 + T_LB;
    for (int u = blockIdx.x; u < U5; u += G) {
        if (u < U0) {
            const int ks = u / 48, cg = u % 48;
            __syncthreads();
            for (int i = tid; i < 768; i += 512) { const int v = i >> 8, k = 256 * ks + (i & 255); const float x = (v == 0) ? a.in[I_C][k] : (v == 1) ? a.in[I_C][1024 + k] : a.in[I_CCTX][k]; fl[i] = silu_(x); }
            __syncthreads();
            const int rl = tid >> 5, cl = tid & 31; float acc[3][4];
#pragma unroll
            for (int v = 0; v < 3; ++v) for (int j = 0; j < 4; ++j) acc[v][j] = 0.f;
            for (int s = 0; s < 16; ++s) { const int kk = 16 * s + rl; const f32x4 w = *(const f32x4*)(a.in[I_WMOD] + (size_t)(256 * ks + kk) * 6144 + 128 * cg + 4 * cl);
#pragma unroll
                for (int v = 0; v < 3; ++v) { const float sv = fl[v * 256 + kk]; acc[v][0] += sv * w[0]; acc[v][1] += sv * w[1]; acc[v][2] += sv * w[2]; acc[v][3] += sv * w[3]; } }
            __syncthreads();
            LAS float* red = fl + 1024;
#pragma unroll
            for (int v = 0; v < 3; ++v) for (int j = 0; j < 4; ++j) red[(rl * 3 + v) * 128 + 4 * cl + j] = acc[v][j];
            __syncthreads();
            if (tid < 384) { const int v = tid >> 7, c = tid & 127; float s = 0.f; for (int r = 0; r < 16; ++r) s += red[(r * 3 + v) * 128 + c];
                ((float*)(a.ws + WS_MODP))[(ks * 3 + v) * 6144 + 128 * cg + c] = s; }
        } else if (u < U1) {
            f32x2* tab = (f32x2*)(a.ws + WS_ROPE);
            if (tid < 8) ((float*)(a.ws + WS_RDEC))[tid] = -softplus_(-a.in[I_RDECAY][tid]) * LOG2E;
            for (int i = tid; i < 320 * 32; i += 512) { const int p = i >> 5, fi = i & 31; const float pos = (float)(p < 256 ? p : p - 256);
                const float freq = ex2(-(float)fi * (13.287712379549449f / 32.0f)); float rev = pos * freq * 0.15915494309189535f; rev -= floorf(rev);
                tab[i] = (f32x2){__builtin_amdgcn_cosf(rev), __builtin_amdgcn_sinf(rev)}; }
        } else if (u < U2) {
            bf16_t* hi = (bf16_t*)(a.ws + WS_WRH); bf16_t* lo = hi + 64 * 1024;
            for (int i = tid; i < 64 * 1024; i += 512) { const int n = i >> 10, k = i & 1023; float w = 0.f;
                if (n < 4) w = a.in[I_WGRP][k * 4 + n]; else if (n < 36) w = a.in[I_WRT][k * 32 + (n - 4)];
                const unsigned short h16 = f2bf(w); hi[i] = h16; lo[i] = f2bf(w - bf2f(h16)); }
        } else if (u < U3) {
            const int t = u - U2, kt = t / 28, ng = t % 28;
            cvt_tile4(fl, a.in[I_WIN] + (size_t)(64 * kt) * NCOL + 256 * ng, NCOL, (bf16_t*)(a.ws + WS_WIN) + (size_t)(256 * ng) * 1024 + 64 * kt, (size_t)128 * 1024, 1024);
        } else if (u < U4) {
            const int t = u - U3, w = t >> 6, kt = (t & 63) >> 2, ng = t & 3;
            const float* src = a.in[w == 0 ? I_WRET : w == 1 ? I_WLRU : I_WOUT]; bf16_t* dst = (bf16_t*)(a.ws + (w == 0 ? WS_WRET : w == 1 ? WS_WLRU : WS_WOUT));
            cvt_tile4(fl, src + (size_t)(64 * kt) * 1024 + 256 * ng, 1024, dst + (size_t)(256 * ng) * 1024 + 64 * kt, (size_t)128 * 1024, 1024);
        } else {
            const int t = u - U4, mat = t >> 5, blk = (t >> 2) & 7, kt = (t >> 1) & 1, nt = t & 1, dir = mat >> 1;
            const float* src = a.in[(mat & 1) ? I_LWX : I_LWA] + (size_t)(dir * 8 + blk) * 128 * 128;
            bf16_t* dst = (bf16_t*)(a.ws + WS_WLB) + (size_t)(mat * 8 + blk) * 128 * 128;
            cvt_tile(fl, src + (size_t)(64 * kt) * 128 + 64 * nt, 128, dst + (size_t)(64 * nt) * 128 + 64 * kt, 128, -LOG2E);
        }
    }
}

DI void phase0b(const KArgs& a, LAS unsigned char* lds) {
    const int tid = tid_fresh(), G = gridDim.x, lane = tid & 63, wid = tid >> 6;
    LAS float* gm = (LAS float*)lds;
    LAS float* sh = gm + 3072;
    __syncthreads();
    for (int i = tid; i < 3072; i += 512) { const int v = i >> 10, k = i & 1023; gm[i] = a.in[I_NORM1][k] * (1.0f + mod_val(a, v, 1, k)); sh[i] = mod_val(a, v, 0, k); }
    if (blockIdx.x == G - 1) { float* mt = (float*)(a.ws + WS_MODT);
        for (int i = tid; i < 2048; i += 512) { const int v = i >> 10, k = i & 1023; mt[i] = mod_val(a, v, 2, k); mt[2048 + i] = a.in[I_NORM2][k] * (1.0f + mod_val(a, v, 4, k)); mt[4096 + i] = mod_val(a, v, 3, k); mt[6144 + i] = mod_val(a, v, 5, k); } }
    __syncthreads();
    PB(105);
    for (int u = blockIdx.x; u < 160; u += G) {
        const int rt = u / 10, ct = u % 10;
        const int col0 = ct < 2 ? 512 + 256 * ct : ct < 6 ? 1024 + 256 * (ct - 2) : 3072 + 256 * (ct - 6);
        LAS unsigned char* At = lds + 24576;
        __syncthreads();
        {   f32x4 x[4][4];
#pragma unroll
            for (int q = 0; q < 4; ++q)
#pragma unroll
                for (int j = 0; j < 4; ++j) x[q][j] = *(const f32x4*)(a.in[I_CTX] + (size_t)(32 * rt + 4 * wid + q) * 1024 + 4 * lane + 256 * j);
#pragma unroll
            for (int q = 0; q < 4; ++q) { float ss = 0.f;
#pragma unroll
                for (int j = 0; j < 4; ++j) ss += (x[q][j][0] * x[q][j][0] + x[q][j][1] * x[q][j][1]) + (x[q][j][2] * x[q][j][2] + x[q][j][3] * x[q][j][3]);
#pragma unroll
                for (int o = 32; o >= 1; o >>= 1) ss += __shfl_xor(ss, o);
                const float rstd = rsqrtf(ss * (1.0f / 1024.0f) + EPSV);
#pragma unroll
                for (int j = 0; j < 4; ++j) { const int k0 = 4 * lane + 256 * j; const f32x4 g = *(const LAS f32x4*)(gm + 2048 + k0), sv = *(const LAS f32x4*)(sh + 2048 + k0);
                    u32x2 w; w.x = cvt_pk_bf16(x[q][j][0] * rstd * g[0] + sv[0], x[q][j][1] * rstd * g[1] + sv[1]); w.y = cvt_pk_bf16(x[q][j][2] * rstd * g[2] + sv[2], x[q][j][3] * rstd * g[3] + sv[3]);
                    *(LAS u32x2*)(At + (4 * wid + q) * 2064 + k0 * 2) = w; } }
        }
        __syncthreads();
        const int r = lane & 31, h = lane >> 5;
        const bf16_t* wrow = (const bf16_t*)(a.ws + WS_WIN) + (size_t)(col0 + 32 * wid + r) * 1024 + 8 * h;
        f32x16 acc = zero16();
#pragma unroll 16
        for (int s2 = 0; s2 < 64; ++s2) { const bf16x8 bfr = *(const bf16x8*)(wrow + 16 * s2); const bf16x8 af = *(const LAS bf16x8*)(At + r * 2064 + (16 * s2 + 8 * h) * 2);
            acc = MFMA32(af, bfr, acc); }
        const int ccol = 256 * (ct < 2 ? ct : ct < 6 ? ct - 2 : ct - 6) + 32 * wid + r;
        bf16_t* dst = (bf16_t*)(a.ws + (ct < 2 ? WS_CTXK : ct < 6 ? WS_CTXV : WS_CTXX)); const int ldd = ct < 2 ? 512 : 1024; const float scv = ct < 2 ? 0.08838834764831845f : 1.0f;
#pragma unroll
        for (int i = 0; i < 16; ++i) dst[(size_t)(32 * rt + crow(i, h)) * ldd + ccol] = f2bf(acc[i] * scv);
    }
    PE(105);
    PB(106);
    {   const int rstep = G * 8; int row = blockIdx.x * 8 + wid; f32x4 x[4];
        if (row < NT) {
#pragma unroll
            for (int j = 0; j < 4; ++j) x[j] = *(const f32x4*)(a.in[I_X] + (size_t)row * 1024 + 4 * lane + 256 * j); }
        for (; row < NT; row += rstep) {
            const int v = row / SEQ; f32x4 xn[4]; const int nrow = row + rstep;
            if (nrow < NT) {
#pragma unroll
                for (int j = 0; j < 4; ++j) xn[j] = *(const f32x4*)(a.in[I_X] + (size_t)nrow * 1024 + 4 * lane + 256 * j); }
            float ss = 0.f;
#pragma unroll
            for (int j = 0; j < 4; ++j) ss += (x[j][0] * x[j][0] + x[j][1] * x[j][1]) + (x[j][2] * x[j][2] + x[j][3] * x[j][3]);
#pragma unroll
            for (int o = 32; o >= 1; o >>= 1) ss += __shfl_xor(ss, o);
            const float rstd = rsqrtf(ss * (1.0f / 1024.0f) + EPSV);
            bf16_t* dst = (bf16_t*)(a.ws + WS_HX) + (size_t)row * 1024;
#pragma unroll
            for (int j = 0; j < 4; ++j) { const int k0 = 4 * lane + 256 * j; const f32x4 g = *(const LAS f32x4*)(gm + v * 1024 + k0), sv = *(const LAS f32x4*)(sh + v * 1024 + k0);
                u32x2 w; w.x = cvt_pk_bf16(x[j][0] * rstd * g[0] + sv[0], x[j][1] * rstd * g[1] + sv[1]); w.y = cvt_pk_bf16(x[j][2] * rstd * g[2] + sv[2], x[j][3] * rstd * g[3] + sv[3]);
                *(u32x2*)(dst + k0) = w; }
#pragma unroll
            for (int j = 0; j < 4; ++j) x[j] = xn[j];
        }
    }
    PE(106);
}

struct OrderIn {
    const char* A; const char* B; int G, c;
    DI bool next(int i, Unit& u) const { int pm, pn; if (!pg8::static_tile(i, G, c, NT / 256, NCOL / 256, pm, pn)) return false;
        u.pm = pm; u.pn = pn; u.A = A + (size_t)pm * 256 * 1024 * 2; u.B = B + (size_t)pn * 256 * 1024 * 2; u.aux = 0; u.bmode = pn < 4 ? 2 : 1; return true; }
    DI void offsA(const Unit&, int, const int (&R)[2], const int (&C)[2], unsigned (&v)[2][2]) const { pg8::dense_offs(2048, R, C, v); }
};
struct EpiIn {
    unsigned char* ws; bf16_t* glog; const float* bgate; const f32x2* rope;
    DI bool operator()(f32x4 (&acc)[2][2][4][2], const Unit& u, int wr, int wc, int fr, int fq) const {
        const int pn = u.pn;
        if (pn < 4) {
            bf16_t* dst = (bf16_t*)(ws + (pn < 2 ? WS_ZQ : WS_ZK)); const float sc = pn < 2 ? 1.0f : 0.08838834764831845f;
            const int half = wc >> 1, f0 = 16 * (wc & 1) + 4 * fq;
#pragma unroll
            EPI_LOOP_ROWS { const int row = u.pm * 256 + ai * 128 + wr * 64 + m * 16 + fr; const int t = row & (SEQ - 1); const int pos = half ? 256 + (t & 63) : (t >> 6);
                const f32x2* tb = rope + pos * 32 + f0; f32x2 cs[4];
#pragma unroll
                for (int j = 0; j < 4; ++j) cs[j] = tb[j];
#pragma unroll
                for (int bj = 0; bj < 2; ++bj) { const f32x4 x1 = acc[ai][bj][m][0], x2 = acc[ai][bj][m][1]; float o1[4], o2[4];
#pragma unroll
                    for (int j = 0; j < 4; ++j) { o1[j] = (x1[j] * cs[j][0] - x2[j] * cs[j][1]) * sc; o2[j] = (x1[j] * cs[j][1] + x2[j] * cs[j][0]) * sc; }
                    bf16_t* p = dst + (size_t)row * 512 + (pn & 1) * 256 + bj * 128 + 64 * half + f0;
                    u32x2 w1, w2; w1.x = cvt_pk_bf16(o1[0], o1[1]); w1.y = cvt_pk_bf16(o1[2], o1[3]); w2.x = cvt_pk_bf16(o2[0], o2[1]); w2.y = cvt_pk_bf16(o2[2], o2[3]);
                    *(u32x2*)p = w1; *(u32x2*)(p + 32) = w2; } }
            return false;
        }
        int act, ldd, cb; bf16_t* dst;
        if (pn < 8) { dst = (bf16_t*)(ws + WS_ZV); act = 0; ldd = 1024; cb = (pn - 4) * 256; }
        else if (pn < 12) { dst = (bf16_t*)(ws + WS_ZG); act = 1; ldd = 1024; cb = (pn - 8) * 256; }
        else if (pn < 16) { dst = (bf16_t*)(ws + WS_ZXL); act = 0; ldd = 1024; cb = (pn - 12) * 256; }
        else if (pn < 20) { dst = (bf16_t*)(ws + WS_ZGL); act = 2; ldd = 1024; cb = (pn - 16) * 256; }
        else { dst = glog; act = 3; ldd = 2048; cb = (pn - 20) * 256; }
#pragma unroll
        for (int bj = 0; bj < 2; ++bj) { const int col = cb + bj * 128 + wc * 32 + 8 * fq; f32x4 b0 = (f32x4){0.f, 0.f, 0.f, 0.f}, b1 = b0;
            if (act == 3) { b0 = *(const f32x4*)(bgate + col); b1 = *(const f32x4*)(bgate + col + 4); }
#pragma unroll
            EPI_LOOP_ROWS { const int row = u.pm * 256 + ai * 128 + wr * 64 + m * 16 + fr; f32x4 v0 = acc[ai][bj][m][0] + b0, v1 = acc[ai][bj][m][1] + b1;
                if (act == 1) {
#pragma unroll
                    for (int j = 0; j < 4; ++j) { v0[j] = silu_(v0[j]); v1[j] = silu_(v1[j]); } }
                if (act == 2) {
#pragma unroll
                    for (int j = 0; j < 4; ++j) { v0[j] = gelu_tanh(v0[j]); v1[j] = gelu_tanh(v1[j]); } }
                u32x4 w; w.x = cvt_pk_bf16(v0[0], v0[1]); w.y = cvt_pk_bf16(v0[2], v0[3]); w.z = cvt_pk_bf16(v1[0], v1[1]); w.w = cvt_pk_bf16(v1[2], v1[3]);
                *(u32x4*)(dst + (size_t)row * ldd + col) = w; } }
        return false;
    }
};

constexpr int R1_RSV = 576, R1_RSK = 320;
DI void r1_unit(LAS unsigned char* lds, const bf16_t* kp, int kld, const bf16_t* vp, int vld, int nrows, float lg2, int dir, float* outp) {
    const int tid = tid_fresh(), lane = tid & 63, wid = tid >> 6, h = lane >> 5;
    LAS unsigned char* Vt = lds; LAS unsigned char* Kw = lds + 64 * R1_RSV;
    const int mh = wid >> 2, nb = wid & 3;
    f32x16 acc[4];
#pragma unroll
    for (int mi = 0; mi < 4; ++mi) acc[mi] = zero16();
    const unsigned lb = (unsigned)((8 * h + ((lane & 15) >> 2))) , blk = (lane >> 4) & 1, p = lane & 3;
    const unsigned lbV = (unsigned)(size_t)Vt + lb * R1_RSV + 32 * blk + 8 * p + (128 * mh) * 2;
    const unsigned lbK = (unsigned)(size_t)Kw + lb * R1_RSK + 32 * blk + 8 * p + (32 * nb) * 2;
    for (int ch = 0; ch < nrows / 64; ++ch) {
        __syncthreads();
#pragma unroll
        for (int i = 0; i < 4; ++i) { const int pid = tid + 512 * i, row = pid >> 5, c16 = pid & 31;
            const u32x4 v = *(const u32x4*)(vp + (size_t)(64 * ch + row) * vld + c16 * 8); *(LAS u32x4*)(Vt + row * R1_RSV + c16 * 16) = v; }
#pragma unroll
        for (int i = 0; i < 2; ++i) { const int pid = tid + 512 * i, row = pid >> 4, c16 = pid & 15; const int jj = 64 * ch + row;
            const u32x4 kv = *(const u32x4*)(kp + (size_t)jj * kld + c16 * 8);
            const float w = ex2(lg2 * (float)(dir ? jj : nrows - 1 - jj));
            u32x4 o;
#pragma unroll
            for (int e = 0; e < 4; ++e) { const float lo = __uint_as_float(kv[e] << 16), hi = __uint_as_float(kv[e] & 0xffff0000u); o[e] = cvt_pk_bf16(lo * w, hi * w); }
            *(LAS u32x4*)(Kw + row * R1_RSK + c16 * 16) = o; }
        __syncthreads();
#pragma unroll
        for (int ks = 0; ks < 4; ++ks) {
            bf16x8 av[4]; tr_frag4<0, 64, 4 * R1_RSV>(lbV + ks * 16 * R1_RSV, av[0], av[1], av[2], av[3]);
            const bf16x8 bw = tr_frag<0, 4 * R1_RSK>(lbK + ks * 16 * R1_RSK);
#pragma unroll
            for (int mi = 0; mi < 4; ++mi) acc[mi] = MFMA32(av[mi], bw, acc[mi]);
        }
    }
    const int c = lane & 31;
    float* ob = outp + (size_t)(128 * mh + 4 * h) * 128 + 32 * nb + c;
#pragma unroll
    for (int mi = 0; mi < 4; ++mi)
#pragma unroll
        for (int i = 0; i < 16; ++i) ob[(32 * mi + (i & 3) + 8 * (i >> 2)) * 128] = acc[mi][i];
}

template <bool FULL, int DIR>
DI void lru_scan(f32x16 (&acc)[2][2], float Hin, f32x2* agg_out) {
    const int lane = tid_fresh() & 63, h = lane >> 5;
    float sA[8], sU[8];
#pragma unroll
    for (int s = 0; s < 8; ++s) { const int mb = s >> 2, g = s & 3; float A = 1.f, U = 0.f;
#pragma unroll
        for (int e = 0; e < 4; ++e) { const int i = 4 * g + (DIR == 0 ? e : 3 - e); U = acc[0][mb][i] * U + acc[1][mb][i]; A *= acc[0][mb][i]; }
        sA[s] = A; sU[s] = U; }
    float pA[8], pU[8];
#pragma unroll
    for (int s = 0; s < 8; ++s) { pA[s] = __shfl_xor(sA[s], 32); pU[s] = __shfl_xor(sU[s], 32); }
    const bool first = (h == (DIR == 0 ? 0 : 1));
    if (!FULL) {
        float A = 1.f, U = 0.f;
#pragma unroll
        for (int q = 0; q < 8; ++q) { const int s = DIR == 0 ? q : 7 - q;
            const float A1 = first ? sA[s] : pA[s], U1 = first ? sU[s] : pU[s], A2 = first ? pA[s] : sA[s], U2 = first ? pU[s] : sU[s];
            U = A1 * U + U1; A *= A1; U = A2 * U + U2; A *= A2; }
        if (h == 0) *agg_out = (f32x2){A, U};
    } else {
        float H = Hin;
        float st[8];
#pragma unroll
        for (int q = 0; q < 8; ++q) { const int s = DIR == 0 ? q : 7 - q;
            const float A1 = first ? sA[s] : pA[s], U1 = first ? sU[s] : pU[s], A2 = first ? pA[s] : sA[s], U2 = first ? pU[s] : sU[s];
            const float Hm = A1 * H + U1; st[s] = first ? H : Hm; H = A2 * Hm + U2; }
#pragma unroll
        for (int s = 0; s < 8; ++s) { const int mb = s >> 2, g = s & 3; float hv = st[s];
#pragma unroll
            for (int e = 0; e < 4; ++e) { const int i = 4 * g + (DIR == 0 ? e : 3 - e); hv = acc[0][mb][i] * hv + acc[1][mb][i]; acc[1][mb][i] = hv; } }
    }
}

constexpr int LX_RS = 272;
template <bool FULL>
DI void lru_run(const KArgs& a, LAS unsigned char* lds, int b, int n, int tile0, int ntiles, bool is_ctx) {
    const int tid = tid_fresh(), lane = tid & 63, wid = __builtin_amdgcn_readfirstlane(tid >> 6), h = lane >> 5, c = lane & 31;
    LAS unsigned char* raw = lds;
    LAS unsigned char* xcb = lds + 67 * LX_RS;
    LAS float* cw = (LAS float*)(xcb + 64 * LX_RS);
    LAS float* hfb = cw + 640;
    LAS float* hbb = hfb + 64 * 132;
    const int Ls = is_ctx ? CTXL : SEQ;
    const bf16_t* xl = is_ctx ? (const bf16_t*)(a.ws + WS_CTXX) + (size_t)(b * CTXL) * 1024 + 128 * n : (const bf16_t*)(a.ws + WS_ZXL) + (size_t)(b * SEQ) * 1024 + 128 * n;
    const int dir = wid >> 2, nq = wid & 3, gc = 128 * n + 32 * nq + c;
    __syncthreads();
    for (int i = tid; i < 640; i += 512) { const int k = i >> 7, ch = i & 127; cw[i] = k < 4 ? a.in[I_CONVW][k * 1024 + 128 * n + ch] : a.in[I_CONVB][128 * n + ch]; }
    bf16x8 Bw[2][8];
    {   const bf16_t* wa = (const bf16_t*)(a.ws + WS_WLB) + (size_t)((2 * dir) * 8 + n) * 128 * 128 + (size_t)(32 * nq + c) * 128 + 8 * h;
#pragma unroll
        for (int ks = 0; ks < 8; ++ks) { Bw[0][ks] = *(const bf16x8*)(wa + 16 * ks); Bw[1][ks] = *(const bf16x8*)(wa + (size_t)8 * 128 * 128 + 16 * ks); } }
    const float ba2 = -LOG2E * a.in[I_LBA][dir * 1024 + gc], bx2 = -LOG2E * a.in[I_LBX][dir * 1024 + gc];
    const float cl = -8.0f * softplus_(-a.in[I_LLAM][dir * 1024 + gc]) * LOG2E;
    const size_t chain0 = ((size_t)(b * 2 + dir) * 1024 + gc) * NSLOT;
    u32x4 pre[3];
#define LRU_LOADRAW(tile_) do { _Pragma("unroll") for (int i_ = 0; i_ < 3; ++i_) { const int pid_ = tid + 512 * i_; pre[i_] = (u32x4){0u, 0u, 0u, 0u}; \
        if (pid_ < 67 * 16) { const int t_ = (tile_) * LT + (pid_ >> 4) - 1; if (t_ >= 0 && t_ < Ls) pre[i_] = *(const u32x4*)(xl + (size_t)t_ * 1024 + (pid_ & 15) * 8); } } } while (0)
    LRU_LOADRAW(tile0);
    for (int it = 0; it < ntiles; ++it) {
        const int tile = tile0 + it, t0 = tile * LT;
#pragma unroll
        for (int i = 0; i < 3; ++i) { const int pid = tid + 512 * i; if (pid < 67 * 16) *(LAS u32x4*)(raw + (pid >> 4) * LX_RS + (pid & 15) * 16) = pre[i]; }
        if (it + 1 < ntiles) LRU_LOADRAW(tile + 1);
        const int slot = is_ctx ? (dir == 0 ? tile : 3 - tile) : (dir == 0 ? 4 + tile : 4 + (NLT - 1 - tile));
        float Hin = 0.f; if (FULL) Hin = ((const float*)(a.ws + WS_LHIN))[chain0 + slot];
        u32x4 gpre[2]; bf16_t* gtile = (bf16_t*)(a.ws + WS_ZGL) + (size_t)(b * SEQ + t0) * 1024 + 128 * n;
        if (FULL) {
#pragma unroll
            for (int i = 0; i < 2; ++i) { const int pid = tid + 512 * i; gpre[i] = *(const u32x4*)(gtile + (size_t)(pid >> 4) * 1024 + (pid & 15) * 8); } }
        lds_barrier();
        {
            const int row = tid >> 3, c0 = (tid & 7) * 16; float o[16];
#pragma unroll
            for (int j = 0; j < 16; j += 4) { const f32x4 bv = *(const LAS f32x4*)(cw + 512 + c0 + j); o[j] = bv[0]; o[j + 1] = bv[1]; o[j + 2] = bv[2]; o[j + 3] = bv[3]; }
#pragma unroll
            for (int k = 0; k < 4; ++k) { const u32x4 p0 = *(const LAS u32x4*)(raw + (row + k) * LX_RS + c0 * 2), p1 = *(const LAS u32x4*)(raw + (row + k) * LX_RS + c0 * 2 + 16);
#pragma unroll
                for (int e = 0; e < 4; ++e) { const f32x4 w0 = *(const LAS f32x4*)(cw + k * 128 + c0 + 4 * (e >> 1) ), w1 = *(const LAS f32x4*)(cw + k * 128 + c0 + 8 + 4 * (e >> 1));
                    o[2 * e] += w0[2 * (e & 1)] * __uint_as_float(p0[e] << 16); o[2 * e + 1] += w0[2 * (e & 1) + 1] * __uint_as_float(p0[e] & 0xffff0000u);
                    o[8 + 2 * e] += w1[2 * (e & 1)] * __uint_as_float(p1[e] << 16); o[8 + 2 * e + 1] += w1[2 * (e & 1) + 1] * __uint_as_float(p1[e] & 0xffff0000u); } }
            u32x4 w0, w1;
#pragma unroll
            for (int e = 0; e < 4; ++e) { w0[e] = cvt_pk_bf16(o[2 * e], o[2 * e + 1]); w1[e] = cvt_pk_bf16(o[8 + 2 * e], o[8 + 2 * e + 1]); }
            *(LAS u32x4*)(xcb + row * LX_RS + c0 * 2) = w0; *(LAS u32x4*)(xcb + row * LX_RS + c0 * 2 + 16) = w1;
        }
        lds_barrier();
        f32x16 acc[2][2];
#pragma unroll
        for (int q = 0; q < 2; ++q) for (int mb = 0; mb < 2; ++mb) acc[q][mb] = zero16();
#pragma unroll
        for (int ks = 0; ks < 8; ++ks) {
            const bf16x8 a0 = *(const LAS bf16x8*)(xcb + c * LX_RS + (16 * ks + 8 * h) * 2), a1 = *(const LAS bf16x8*)(xcb + (32 + c) * LX_RS + (16 * ks + 8 * h) * 2);
            acc[0][0] = MFMA32(a0, Bw[0][ks], acc[0][0]); acc[0][1] = MFMA32(a1, Bw[0][ks], acc[0][1]); acc[1][0] = MFMA32(a0, Bw[1][ks], acc[1][0]); acc[1][1] = MFMA32(a1, Bw[1][ks], acc[1][1]);
        }
#pragma unroll
        for (int mb = 0; mb < 2; ++mb)
#pragma unroll
            for (int i = 0; i < 16; ++i) { const int row = 32 * mb + crow(i, h);
                const float r = rcpf_(1.0f + ex2(acc[0][mb][i] + ba2)), ig = rcpf_(1.0f + ex2(acc[1][mb][i] + bx2));
                const float av = ex2(cl * r); const float s = sqrtf(fmaxf(1.0f - av * av, 0.f));
                acc[0][mb][i] = av; acc[1][mb][i] = s * ig * bf2f(*(const LAS bf16_t*)(xcb + row * LX_RS + (32 * nq + c) * 2)); }
        f32x2* aggp = (f32x2*)(a.ws + WS_LAGG) + chain0 + slot;
        if (dir == 0) lru_scan<FULL, 0>(acc, Hin, aggp); else lru_scan<FULL, 1>(acc, Hin, aggp);
        if (FULL) {
            LAS float* hd = dir == 0 ? hfb : hbb;
#pragma unroll
            for (int mb = 0; mb < 2; ++mb)
#pragma unroll
                for (int i = 0; i < 16; ++i) hd[(32 * mb + crow(i, h)) * 132 + 32 * nq + c] = acc[1][mb][i];
            lds_barrier();
#pragma unroll
            for (int i = 0; i < 2; ++i) { const int pid = tid + 512 * i, row = pid >> 4, c8 = (pid & 15) * 8;
                const f32x4 f0 = *(const LAS f32x4*)(hfb + row * 132 + c8), f1 = *(const LAS f32x4*)(hfb + row * 132 + c8 + 4), b0 = *(const LAS f32x4*)(hbb + row * 132 + c8), b1 = *(const LAS f32x4*)(hbb + row * 132 + c8 + 4);
                const u32x4 g = gpre[i]; u32x4 o;
                o[0] = cvt_pk_bf16((f0[0] + b0[0]) * __uint_as_float(g[0] << 16), (f0[1] + b0[1]) * __uint_as_float(g[0] & 0xffff0000u));
                o[1] = cvt_pk_bf16((f0[2] + b0[2]) * __uint_as_float(g[1] << 16), (f0[3] + b0[3]) * __uint_as_float(g[1] & 0xffff0000u));
                o[2] = cvt_pk_bf16((f1[0] + b1[0]) * __uint_as_float(g[2] << 16), (f1[1] + b1[1]) * __uint_as_float(g[2] & 0xffff0000u));
                o[3] = cvt_pk_bf16((f1[2] + b1[2]) * __uint_as_float(g[3] << 16), (f1[3] + b1[3]) * __uint_as_float(g[3] & 0xffff0000u));
                *(u32x4*)(gtile + (size_t)row * 1024 + c8) = o; }
        }
    }
#undef LRU_LOADRAW
}

DI void ret_decays(const KArgs& a, int h, float& lgf2, float& lgb2) {
    const float* rd = (const float*)(a.ws + WS_RDEC); lgf2 = rd[h]; lgb2 = rd[4 + h];
}

DI void phase2a(const KArgs& a, LAS unsigned char* lds) {
    const int G = gridDim.x;
    constexpr int NU_R1 = NB_ * NH * NSC * 2, NU_CK = NB_ * NH * 2, NU_LX = NB_ * 8 * 16, NU_LC = NB_ * 8;
    for (int u = blockIdx.x; u < NU_R1 + NU_CK + NU_LX + NU_LC; u += G) {
        if (SUBSEL(1) && u < NU_R1) {
            const int dir = u & 1, sc = (u >> 1) & 31, h = (u >> 6) & 3, b = u >> 8; float lgf2, lgb2; ret_decays(a, h, lgf2, lgb2);
            float* o = (float*)(a.ws + WS_HX) + (size_t)(((b * 4 + h) * 32 + sc) * 2 + dir) * 32768;
            PB(100); r1_unit(lds, (const bf16_t*)(a.ws + WS_ZK) + (size_t)(b * SEQ + sc * SCH) * 512 + h * 128, 512, (const bf16_t*)(a.ws + WS_ZV) + (size_t)(b * SEQ + sc * SCH) * 1024 + h * 256, 1024, SCH, dir ? lgb2 : lgf2, dir, o); PE(100);
        } else if (SUBSEL(1) && u < NU_R1 + NU_CK) {
            const int q = u - NU_R1, dir = q & 1, h = (q >> 1) & 3, b = q >> 3; float lgf2, lgb2; ret_decays(a, h, lgf2, lgb2);
            float* o = (float*)(a.ws + WS_CTXS) + (size_t)((b * 4 + h) * 2 + dir) * 32768;
            r1_unit(lds, (const bf16_t*)(a.ws + WS_CTXK) + (size_t)(b * CTXL) * 512 + h * 128, 512, (const bf16_t*)(a.ws + WS_CTXV) + (size_t)(b * CTXL) * 1024 + h * 256, 1024, CTXL, dir ? lgb2 : lgf2, dir, o);
        } else if (SUBSEL(2) && u < NU_R1 + NU_CK + NU_LX) {
            const int q = u - NU_R1 - NU_CK, b = q >> 7, n = (q >> 4) & 7, r = q & 15;
            PB(101); lru_run<false>(a, lds, b, n, 16 * r, 16, false); PE(101);
        } else if (SUBSEL(2)) {
            const int q = u - NU_R1 - NU_CK - NU_LX, b = q >> 3, n = q & 7;
            lru_run<false>(a, lds, b, n, 0, 4, true);
        }
    }
}

DI void phase2b(const KArgs& a) {
    const int tid = tid_fresh(), G = gridDim.x, lane = tid & 63, wid = tid >> 6;
    for (int e = blockIdx.x * 512 + tid; e < NB_ * NH * 2 * 8192; e += G * 512) {
        const int e4 = e & 8191, dir = (e >> 13) & 1, h = (e >> 14) & 3, b = e >> 16;
        float lgf2, lgb2; ret_decays(a, h, lgf2, lgb2); const float gC = ex2((dir ? lgb2 : lgf2) * (float)SCH);
        f32x4 S = *(const f32x4*)((const float*)(a.ws + WS_CTXS) + (size_t)((b * 4 + h) * 2 + dir) * 32768 + 4 * e4);
        const float* kv = (const float*)(a.ws + WS_HX) + (size_t)((b * 4 + h) * 32 * 2 + dir) * 32768 + 4 * e4;
        bf16_t* so = (bf16_t*)(a.ws + WS_SBF) + (size_t)((b * 4 + h) * 32 * 2 + dir) * 32768 + 4 * e4;
        for (int s0 = 0; s0 < NSC; s0 += 8) {
            f32x4 kvv[8];
#pragma unroll
            for (int j = 0; j < 8; ++j) { const int sc = dir ? NSC - 1 - (s0 + j) : s0 + j; kvv[j] = *(const f32x4*)(kv + (size_t)sc * 65536); }
#pragma unroll
            for (int j = 0; j < 8; ++j) { const int sc = dir ? NSC - 1 - (s0 + j) : s0 + j;
                u32x2 w; w.x = cvt_pk_bf16(S[0], S[1]); w.y = cvt_pk_bf16(S[2], S[3]); *(u32x2*)(so + (size_t)sc * 65536) = w;
                S = S * gC + kvv[j]; }
        }
    }
    for (int ch = blockIdx.x * 8 + wid; ch < NB_ * 2 * 1024; ch += G * 8) {
        const f32x2* ag = (const f32x2*)(a.ws + WS_LAGG) + (size_t)ch * NSLOT; float* hin = (float*)(a.ws + WS_LHIN) + (size_t)ch * NSLOT;
        float carry = 0.f;
        for (int rd = 0; rd < 5; ++rd) { const int slot = 64 * rd + lane;
            f32x2 v = (f32x2){1.f, 0.f}; if (slot < 4 + NLT) v = ag[slot];
            float A = v[0], U = v[1];
#pragma unroll
            for (int o = 1; o < 64; o <<= 1) { const float Ap = __shfl_up(A, o), Up = __shfl_up(U, o); if (lane >= o) { U = A * Up + U; A = A * Ap; } }
            const float incl = A * carry + U;
            float excl = __shfl_up(incl, 1); if (lane == 0) excl = carry;
            if (slot < 4 + NLT) hin[slot] = excl;
            carry = __shfl(incl, 63);
        }
    }
}

constexpr int R3_KB = 16384, R3_VB = 32768;
template <int O, int T> DI void tr_frag2x2(unsigned a0, unsigned a1, bf16x8& f0, bf16x8& f1, bf16x8& f2, bf16x8& f3) {
    s16x4 r0, r1, r2, r3, r4, r5, r6, r7;
    asm volatile("ds_read_b64_tr_b16 %0, %8 offset:%10\n\tds_read_b64_tr_b16 %1, %8 offset:%11\n\t"
                 "ds_read_b64_tr_b16 %2, %8 offset:%12\n\tds_read_b64_tr_b16 %3, %8 offset:%13\n\t"
                 "ds_read_b64_tr_b16 %4, %9 offset:%10\n\tds_read_b64_tr_b16 %5, %9 offset:%11\n\t"
                 "ds_read_b64_tr_b16 %6, %9 offset:%12\n\tds_read_b64_tr_b16 %7, %9 offset:%13\n\ts_waitcnt lgkmcnt(0)"
                 : "=&v"(r0), "=&v"(r1), "=&v"(r2), "=&v"(r3), "=&v"(r4), "=&v"(r5), "=&v"(r6), "=&v"(r7)
                 : "v"(a0), "v"(a1), "i"(O), "i"(O + T), "i"(O + 256), "i"(O + 256 + T) : "memory");
    f0 = __builtin_shufflevector(r0, r1, 0, 1, 2, 3, 4, 5, 6, 7); f1 = __builtin_shufflevector(r2, r3, 0, 1, 2, 3, 4, 5, 6, 7);
    f2 = __builtin_shufflevector(r4, r5, 0, 1, 2, 3, 4, 5, 6, 7); f3 = __builtin_shufflevector(r6, r7, 0, 1, 2, 3, 4, 5, 6, 7);
}
DI bf16x8 scale_frag(bf16x8 f, float s) { const u32x4 u = __builtin_bit_cast(u32x4, f); u32x4 o;
#pragma unroll
    for (int e = 0; e < 4; ++e) o[e] = cvt_pk_bf16(__uint_as_float(u[e] << 16) * s, __uint_as_float(u[e] & 0xffff0000u) * s);
    return __builtin_bit_cast(bf16x8, o); }
#define GLDS16(gp, lp) __builtin_amdgcn_global_load_lds((const unsigned*)(gp), (LAS unsigned*)(lp), 16, 0, 0)

DI void r3_unit(const KArgs& a, LAS unsigned char* lds, int b, int hh, int qb2) {
    const int tid = tid_fresh(), lane = tid & 63, wid = __builtin_amdgcn_readfirstlane(tid >> 6), h = lane >> 5, c = lane & 31;
    const int sc = qb2 >> 1, qpos = 256 * (qb2 & 1) + 32 * wid + c;
    float lgf2, lgb2; ret_decays(a, hh, lgf2, lgb2);
    const size_t tokS = (size_t)b * SEQ + SCH * sc, tokQ = tokS + qpos;
    LAS unsigned char* R0 = lds; LAS unsigned char* R1 = lds + 65536;
    const bf16_t* zk = (const bf16_t*)(a.ws + WS_ZK) + tokS * 512 + hh * 128; const bf16_t* zv = (const bf16_t*)(a.ws + WS_ZV) + tokS * 1024 + hh * 256;
    const unsigned wl = (unsigned)wid * 1024u;
    const unsigned soff = (unsigned)((tid >> 4) * 256 + (((tid & 15) ^ ((tid >> 4) & 15)) << 4));
    const unsigned koff = (unsigned)((tid >> 4) * 1024 + (((tid & 15) ^ ((tid >> 4) & 15)) << 4));
    const unsigned voff = (unsigned)((tid >> 5) * 2048 + (((tid & 31) ^ (((tid >> 5) & 3) << 2)) << 4));
#define R3_STAGE_KV(jb_, buf_) do { const char* kb_ = (const char*)zk + (size_t)(jb_) * 65536; const char* vb_ = (const char*)zv + (size_t)(jb_) * 131072; \
        _Pragma("unroll") for (int i_ = 0; i_ < 2; ++i_) GLDS16(kb_ + i_ * 32768 + koff, (buf_) + i_ * 8192 + wl); \
        _Pragma("unroll") for (int i_ = 0; i_ < 4; ++i_) GLDS16(vb_ + i_ * 32768 + voff, (buf_) + R3_KB + i_ * 8192 + wl); } while (0)
    __syncthreads();
#pragma unroll
    for (int d = 0; d < 2; ++d) { const char* Sg = (const char*)((const bf16_t*)(a.ws + WS_SBF) + (size_t)(((b * 4 + hh) * 32 + sc) * 2 + d) * 32768);
#pragma unroll
        for (int i = 0; i < 8; ++i) GLDS16(Sg + i * 8192 + soff, (d ? R1 : R0) + i * 8192 + wl); }
    bf16x8 Qf[8];
    {   const bf16_t* qp = (const bf16_t*)(a.ws + WS_ZQ) + tokQ * 512 + hh * 128 + 8 * h;
#pragma unroll
        for (int ks = 0; ks < 8; ++ks) Qf[ks] = *(const bf16x8*)(qp + 16 * ks); }
    f32x16 OT[8];
#pragma unroll
    for (int nb = 0; nb < 8; ++nb) OT[nb] = zero16();
    const unsigned xq = (unsigned)(c & 15), rowb = (unsigned)c * 256u;
#pragma unroll
    for (int d = 0; d < 2; ++d) {
        if (d == 0) asm volatile("s_waitcnt vmcnt(16)" ::: "memory"); else asm volatile("s_waitcnt vmcnt(6)" ::: "memory");
        __builtin_amdgcn_s_barrier(); asm volatile("" ::: "memory");
        const float dec = d == 0 ? ex2(lgf2 * (float)(qpos + 1)) : ex2(lgb2 * (float)(SCH - qpos));
        const unsigned Sb = (unsigned)(size_t)(d ? R1 : R0) + rowb;
#pragma unroll
        for (int ks = 0; ks < 8; ++ks) { const bf16x8 qs = scale_frag(Qf[ks], dec); const unsigned co = (((unsigned)(2 * ks + h)) ^ xq) << 4;
#pragma unroll
            for (int nb = 0; nb < 8; ++nb) { const bf16x8 sf = *(const LAS bf16x8*)(size_t)(Sb + 32 * 256 * nb + co); OT[nb] = MFMA32(sf, qs, OT[nb]); if (nb == 3) asm volatile("" ::: "memory"); }
            asm volatile("" ::: "memory"); }
        if (d == 0) { lds_barrier(); R3_STAGE_KV(0, R0); if (tid < 256) ((LAS float*)(R0 + 49152))[tid] = a.in[I_RNORM][hh * 256 + tid]; }
    }
    const unsigned q4 = (unsigned)((lane & 15) >> 2), vlane = (unsigned)(4 * h + q4) * 512u + 32u * ((lane >> 4) & 1) + 8u * (lane & 3);
#pragma unroll 1
    for (int jb = 0; jb < 8; ++jb) {
        LAS unsigned char* buf = (jb & 1) ? R1 : R0;
        asm volatile("s_waitcnt vmcnt(0)" ::: "memory");
        lds_barrier();
        if (jb + 1 < 8) { if (jb & 1) R3_STAGE_KV(jb + 1, R0); else R3_STAGE_KV(jb + 1, R1); }
        const unsigned Kb = (unsigned)(size_t)buf + rowb, Vb = (unsigned)(size_t)buf + R3_KB + vlane;
#pragma unroll
        for (int jt = 0; jt < 2; ++jt) {
            f32x16 st = zero16();
#pragma unroll
            for (int ks = 0; ks < 8; ++ks) { const bf16x8 kf = *(const LAS bf16x8*)(size_t)(Kb + 32 * 256 * jt + ((((unsigned)(2 * ks + h)) ^ xq) << 4)); st = MFMA32(kf, Qf[ks], st); }
#pragma unroll
            for (int s2 = 0; s2 < 2; ++s2) { u32x4 pk;
#pragma unroll
                for (int e = 0; e < 4; ++e) { float v[2];
#pragma unroll
                    for (int z = 0; z < 2; ++z) { const int i = 8 * s2 + 2 * e + z; const int dd = qpos - (64 * jb + 32 * jt + (i & 3) + 8 * (i >> 2) + 4 * h);
                        v[z] = st[i] * (dd >= 0 ? ex2(lgf2 * (float)dd) : ex2(lgb2 * (float)(-dd))); }
                    pk[e] = cvt_pk_bf16(v[0], v[1]); }
                const bf16x8 pb = __builtin_bit_cast(bf16x8, pk);
#pragma unroll
                for (int hf = 0; hf < 2; ++hf) {
                    bf16x8 v0, v1, v2, v3; const unsigned a0 = Vb + 64u * ((unsigned)(2 * hf) ^ q4), a1 = Vb + 64u * ((unsigned)(2 * hf + 1) ^ q4);
                    if (jt == 0 && s2 == 0) tr_frag2x2<0, 4096>(a0, a1, v0, v1, v2, v3);
                    if (jt == 0 && s2 == 1) tr_frag2x2<8192, 4096>(a0, a1, v0, v1, v2, v3);
                    if (jt == 1 && s2 == 0) tr_frag2x2<16384, 4096>(a0, a1, v0, v1, v2, v3);
                    if (jt == 1 && s2 == 1) tr_frag2x2<24576, 4096>(a0, a1, v0, v1, v2, v3);
                    OT[2 * hf] = MFMA32(v0, pb, OT[2 * hf]); OT[2 * hf + 4] = MFMA32(v1, pb, OT[2 * hf + 4]);
                    OT[2 * hf + 1] = MFMA32(v2, pb, OT[2 * hf + 1]); OT[2 * hf + 5] = MFMA32(v3, pb, OT[2 * hf + 5]);
                }
            }
        }
    }
    float s1 = 0.f, s2 = 0.f;
#pragma unroll
    for (int nb = 0; nb < 8; ++nb)
#pragma unroll
        for (int i = 0; i < 16; ++i) { s1 += OT[nb][i]; s2 += OT[nb][i] * OT[nb][i]; }
    s1 += __shfl_xor(s1, 32); s2 += __shfl_xor(s2, 32);
    const float mu = s1 * (1.0f / 256.0f), rstd = rsqrtf(fmaxf(s2 * (1.0f / 256.0f) - mu * mu, 0.f) + EPSV);
    const int t2 = tid_fresh(), h2 = (t2 >> 5) & 1;
    bf16_t* gp = (bf16_t*)(a.ws + WS_ZG) + ((size_t)b * SEQ + SCH * sc + 256 * (qb2 & 1) + 32 * (t2 >> 6) + (t2 & 31)) * 1024 + hh * 256 + 4 * h2;
    const LAS float* gn = (const LAS float*)(R0 + 49152) + 4 * h2;
#pragma unroll
    for (int hv = 0; hv < 2; ++hv) {
        u32x2 sg[4][4];
#pragma unroll
        for (int q = 0; q < 4; ++q)
#pragma unroll
            for (int g = 0; g < 4; ++g) sg[q][g] = *(const u32x2*)(gp + 32 * (4 * hv + q) + 8 * g);
#pragma unroll
        for (int q = 0; q < 4; ++q)
#pragma unroll
            for (int g = 0; g < 4; ++g) { const int nb = 4 * hv + q, dv0 = 32 * nb + 8 * g; const f32x4 gain = *(const LAS f32x4*)(gn + dv0);
                u32x2 o; o.x = cvt_pk_bf16((OT[nb][4 * g] - mu) * rstd * gain[0] * __uint_as_float(sg[q][g].x << 16), (OT[nb][4 * g + 1] - mu) * rstd * gain[1] * __uint_as_float(sg[q][g].x & 0xffff0000u));
                o.y = cvt_pk_bf16((OT[nb][4 * g + 2] - mu) * rstd * gain[2] * __uint_as_float(sg[q][g].y << 16), (OT[nb][4 * g + 3] - mu) * rstd * gain[3] * __uint_as_float(sg[q][g].y & 0xffff0000u));
                *(u32x2*)(gp + dv0) = o; }
        asm volatile("" ::: "memory");
    }
#undef R3_STAGE_KV
}

DI void phase2c(const KArgs& a, LAS unsigned char* lds) {
    const int G = gridDim.x;
    constexpr int NU_R3 = NB_ * NH * (SEQ / 256), NU_L3 = NB_ * 8 * 16;
    for (int u = blockIdx.x; u < NU_R3 + NU_L3; u += G) {
        if (SUBSEL(1) && u < NU_R3) { const int b = u >> 8, hh = (u >> 6) & 3, qb2 = u & 63; PB(102); r3_unit(a, lds, b, hh, qb2); PE(102); }
        else if (SUBSEL(2)) { const int q = u - NU_R3, b = q >> 7, n = (q >> 4) & 7, r = q & 15; PB(103); lru_run<true>(a, lds, b, n, 16 * r, 16, false); PE(103); }
    }
}

DI void cvt4_decode(const KArgs& a, int t, const float*& src, int& ld_src, unsigned char*& dst, size_t& hi_stride, int& ld_dst) {
    constexpr int T_GU = 32 * 2 * 16 * 3;
    if (t < T_GU) { const int e = t / 96, r = t % 96, mat = r / 48, kt = (r % 48) / 3, ng = r % 3;
        src = a.in[mat ? I_WEU : I_WEG] + (size_t)e * 1024 * 768 + (size_t)(64 * kt) * 768 + 256 * ng; ld_src = 768;
        dst = (unsigned char*)(a.ws + WS_WGU) + ((size_t)(e * 6 + 2 * ng) * 256 + mat * 128) * 1024 + 64 * kt; hi_stride = (size_t)256 * 1024; ld_dst = 1024;
    } else { const int q = t - T_GU, e = q / 48, r = q % 48, kt = r / 4, ng = r % 4;
        src = a.in[I_WED] + (size_t)e * 768 * 1024 + (size_t)(64 * kt) * 1024 + 256 * ng; ld_src = 1024;
        dst = (unsigned char*)(a.ws + WS_WDN) + ((size_t)e * 1024 + 256 * ng) * 768 + 64 * kt; hi_stride = (size_t)128 * 768; ld_dst = 768; }
}
DI void phase3_cvt(const KArgs& a, LAS unsigned char* lds) {
    const int G = gridDim.x, tid = tid_fresh(); LAS float* tile = (LAS float*)lds;
    constexpr int T_ALL = 32 * 2 * 16 * 3 + 32 * 12 * 4;
    int t = blockIdx.x; if (t >= T_ALL) return;
    const float* src; int ld_src; unsigned char* dst; size_t hi; int ld_dst; cvt4_decode(a, t, src, ld_src, dst, hi, ld_dst);
    f32x4 v[8];
#pragma unroll
    for (int i = 0; i < 8; ++i) v[i] = *(const f32x4*)(src + (size_t)((tid >> 6) + 8 * i) * ld_src + 4 * (tid & 63));
    for (;;) {
        lds_barrier();
#pragma unroll
        for (int i = 0; i < 8; ++i) *(LAS f32x4*)(tile + ((tid >> 6) + 8 * i) * 260 + 4 * (tid & 63)) = v[i];
        const int tn = t + G; unsigned char* dcur = dst; const size_t hcur = hi; const int ldcur = ld_dst;
        if (tn < T_ALL) { cvt4_decode(a, tn, src, ld_src, dst, hi, ld_dst);
#pragma unroll
            for (int i = 0; i < 8; ++i) v[i] = *(const f32x4*)(src + (size_t)((tid >> 6) + 8 * i) * ld_src + 4 * (tid & 63)); }
        lds_barrier();
        const int n = tid & 255, kh = tid >> 8; unsigned char* d = dcur + (size_t)(n >> 7) * hcur + (size_t)(n & 127) * ldcur + 32 * kh;
#pragma unroll
        for (int q = 0; q < 2; ++q) { float x[16];
#pragma unroll
            for (int j = 0; j < 16; ++j) x[j] = tile[(32 * kh + 16 * q + j) * 260 + n] * 64.0f;
            u32x4 w; w.x = cvt4_fp8(x[0], x[1], x[2], x[3]); w.y = cvt4_fp8(x[4], x[5], x[6], x[7]); w.z = cvt4_fp8(x[8], x[9], x[10], x[11]); w.w = cvt4_fp8(x[12], x[13], x[14], x[15]);
            *(u32x4*)(d + 16 * q) = w; }
        if (tn >= T_ALL) break;
        t = tn;
    }
    __syncthreads();
}
struct OrderMerge {
    const char* A0; const char* A1; const char* B0; const char* B1; int G, c;
    DI bool next(int i, Unit& u) const { int pm, pn; if (!pg8::static_tile(i >> 1, G, c, NT / 256, 4, pm, pn)) return false;
        const int st = i & 1; u.pm = pm; u.pn = pn; u.aux = st; u.bmode = 1; u.A = (st ? A1 : A0) + (size_t)pm * 256 * 1024 * 2; u.B = (st ? B1 : B0) + (size_t)pn * 256 * 1024 * 2; return true; }
    DI void offsA(const Unit&, int, const int (&R)[2], const int (&C)[2], unsigned (&v)[2][2]) const { pg8::dense_offs(2048, R, C, v); }
};
struct EpiMerge {
    const bf16_t* glog; bf16_t* out;
    DI bool operator()(f32x4 (&acc)[2][2][4][2], const Unit& u, int wr, int wc, int fr, int fq) const {
#pragma unroll
        for (int bj = 0; bj < 2; ++bj) { const int col = u.pn * 256 + bj * 128 + wc * 32 + 8 * fq;
#pragma unroll
            EPI_LOOP_ROWS { const int row = u.pm * 256 + ai * 128 + wr * 64 + m * 16 + fr;
                const u32x4 gl = *(const u32x4*)(glog + (size_t)row * 2048 + 1024 + col);
                if (u.aux == 0) { const u32x4 gr = *(const u32x4*)(glog + (size_t)row * 2048 + col);
#pragma unroll
                    for (int e = 0; e < 4; ++e) { const float r0 = __uint_as_float(gr[e] << 16), r1 = __uint_as_float(gr[e] & 0xffff0000u), l0 = __uint_as_float(gl[e] << 16), l1 = __uint_as_float(gl[e] & 0xffff0000u);
                        const float q0 = (1.0f + ex2(-LOG2E * l0)) * rcpf_(1.0f + ex2(-LOG2E * r0)), q1 = (1.0f + ex2(-LOG2E * l1)) * rcpf_(1.0f + ex2(-LOG2E * r1));
                        acc[ai][bj][m][e >> 1][2 * (e & 1)] *= q0; acc[ai][bj][m][e >> 1][2 * (e & 1) + 1] *= q1; }
                } else { float v[8];
#pragma unroll
                    for (int e = 0; e < 4; ++e) { const float l0 = __uint_as_float(gl[e] << 16), l1 = __uint_as_float(gl[e] & 0xffff0000u);
                        v[2 * e] = acc[ai][bj][m][e >> 1][2 * (e & 1)] * sigm(l0); v[2 * e + 1] = acc[ai][bj][m][e >> 1][2 * (e & 1) + 1] * sigm(l1); }
                    u32x4 w; w.x = cvt_pk_bf16(v[0], v[1]); w.y = cvt_pk_bf16(v[2], v[3]); w.z = cvt_pk_bf16(v[4], v[5]); w.w = cvt_pk_bf16(v[6], v[7]);
                    *(u32x4*)(out + (size_t)row * 1024 + col) = w; } } }
        return u.aux == 0;
    }
};

struct OrderOut {
    const char* A; const char* B; int G, c;
    DI bool next(int i, Unit& u) const { int pm, pn; if (!pg8::static_tile(i, G, c, NT / 256, 4, pm, pn)) return false;
        u.pm = pm; u.pn = pn; u.aux = 0; u.bmode = 0; u.A = A + (size_t)pm * 256 * 1024 * 2; u.B = B + (size_t)pn * 256 * 1024 * 2; return true; }
    DI void offsA(const Unit&, int, const int (&R)[2], const int (&C)[2], unsigned (&v)[2][2]) const { pg8::dense_offs(2048, R, C, v); }
};
struct EpiOut {
    const KArgs* a;
    DI bool operator()(f32x4 (&acc)[2][2][4][2], const Unit& u, int wr, int wc, int fr, int fq) const {
        const int b = (u.pm * 256) / SEQ;
#pragma unroll
        for (int bj = 0; bj < 2; ++bj)
#pragma unroll
            for (int n = 0; n < 2; ++n) { const int col = u.pn * 256 + bj * 128 + wc * 32 + 16 * n + 4 * fq; f32x4 g;
#pragma unroll
                for (int j = 0; j < 4; ++j) g[j] = 0.f;
                g = *(const f32x4*)((const float*)(a->ws + WS_MODT) + b * 1024 + col);
#pragma unroll
                EPI_LOOP_ROWS { const size_t off = (size_t)(u.pm * 256 + ai * 128 + wr * 64 + m * 16 + fr) * 1024 + col;
                    *(f32x4*)(a->out + off) = *(const f32x4*)(a->in[I_X] + off) + g * acc[ai][bj][m][n]; } }
        return false;
    }
};

DI void phase5(const KArgs& a, LAS unsigned char* lds) {
    const int tid = tid_fresh(), G = gridDim.x, lane = tid & 63, wid = tid >> 6;
    LAS float* gm = (LAS float*)lds;
    LAS float* sh = gm + 2048;
    LAS float* lg = sh + 2048;
    LAS int* lcnt = (LAS int*)(lg + 128 * 40);
    LAS int* rinfo = lcnt + 64;
    LAS float* rw = (LAS float*)(rinfo + 512);
    __syncthreads();
    for (int i = tid; i < 2048; i += 512) { const float* mt = (const float*)(a.ws + WS_MODT); gm[i] = mt[2048 + i]; sh[i] = mt[4096 + i]; }
    if (blockIdx.x == 0 && tid < 256) ((unsigned*)(a.ws + WS_HX2Q) + (size_t)NT * 256)[tid] = 0u;
    bf16_t* hx2 = (bf16_t*)(a.ws + WS_HX2);
    int* cnt = (int*)(a.ws + WS_CTL) + CW_CNT;
    for (int rt = blockIdx.x; rt < NT / 128; rt += G) {
        __syncthreads();
        if (tid < 32) lcnt[tid] = 0;
        {   const int row0 = 128 * rt + 16 * wid, v = row0 / SEQ; f32x4 x[4];
#pragma unroll
            for (int j = 0; j < 4; ++j) x[j] = *(const f32x4*)(a.out + (size_t)row0 * 1024 + 4 * lane + 256 * j);
            for (int rr = 0; rr < 16; ++rr) { const int row = row0 + rr; f32x4 xn[4];
                if (rr < 15) {
#pragma unroll
                    for (int j = 0; j < 4; ++j) xn[j] = *(const f32x4*)(a.out + (size_t)(row + 1) * 1024 + 4 * lane + 256 * j); }
                float ss = 0.f;
#pragma unroll
                for (int j = 0; j < 4; ++j) ss += (x[j][0] * x[j][0] + x[j][1] * x[j][1]) + (x[j][2] * x[j][2] + x[j][3] * x[j][3]);
#pragma unroll
                for (int o = 32; o >= 1; o >>= 1) ss += __shfl_xor(ss, o);
                const float rstd = rsqrtf(ss * (1.0f / 1024.0f) + EPSV);
#pragma unroll
                for (int j = 0; j < 4; ++j) { const int k0 = 4 * lane + 256 * j; const f32x4 g = *(const LAS f32x4*)(gm + v * 1024 + k0), sv = *(const LAS f32x4*)(sh + v * 1024 + k0);
                    u32x2 w; w.x = cvt_pk_bf16(x[j][0] * rstd * g[0] + sv[0], x[j][1] * rstd * g[1] + sv[1]); w.y = cvt_pk_bf16(x[j][2] * rstd * g[2] + sv[2], x[j][3] * rstd * g[3] + sv[3]);
                    *(u32x2*)(hx2 + (size_t)row * 1024 + k0) = w;
                    *(unsigned*)((unsigned char*)(a.ws + WS_HX2Q) + (size_t)row * 1024 + k0) = cvt4_fp8(16.f * (x[j][0] * rstd * g[0] + sv[0]), 16.f * (x[j][1] * rstd * g[1] + sv[1]), 16.f * (x[j][2] * rstd * g[2] + sv[2]), 16.f * (x[j][3] * rstd * g[3] + sv[3])); }
#pragma unroll
                for (int j = 0; j < 4; ++j) x[j] = xn[j];
            }
        }
        __syncthreads();
        {
            const int rb = wid >> 1, cb = wid & 1, r = lane & 31, h = lane >> 5;
            const bf16_t* ar = hx2 + (size_t)(128 * rt + 32 * rb + r) * 1024 + 8 * h;
            const bf16_t* bh = (const bf16_t*)(a.ws + WS_WRH) + (size_t)(32 * cb + r) * 1024 + 8 * h; const bf16_t* bl = bh + 64 * 1024;
            f32x16 acc = zero16();
#pragma unroll 8
            for (int ks = 0; ks < 64; ++ks) { const bf16x8 af = *(const bf16x8*)(ar + 16 * ks), b1 = *(const bf16x8*)(bh + 16 * ks), b2 = *(const bf16x8*)(bl + 16 * ks);
                acc = MFMA32(af, b1, acc); acc = MFMA32(af, b2, acc); }
            const int col = 32 * cb + r;
            if (col < 36) {
#pragma unroll
                for (int i = 0; i < 16; ++i) lg[(32 * rb + crow(i, h)) * 40 + col] = acc[i]; }
        }
        __syncthreads();
        if (tid < 128) { const LAS float* l = lg + tid * 40;
            int gs = 0; float best = l[0] + a.in[I_BGRP][0];
#pragma unroll
            for (int g = 1; g < 4; ++g) { const float v = l[g] + a.in[I_BGRP][g]; if (v > best) { best = v; gs = g; } }
            const float mx = fmaxf(fmaxf(l[0], l[1]), fmaxf(l[2], l[3])); float den = 0.f;
#pragma unroll
            for (int g = 0; g < 4; ++g) den += expf(l[g] - mx);
            const float pg = expf(l[gs] - mx) / den;
            int i0 = 0, i1 = -1; float v0 = -3.0e38f, v1 = -3.0e38f;
#pragma unroll
            for (int e = 0; e < 8; ++e) { const float v = l[4 + 8 * gs + e] + a.in[I_BRT][8 * gs + e];
                if (v > v0) { v1 = v0; i1 = i0; v0 = v; i0 = e; } else if (v > v1) { v1 = v; i1 = e; } }
            const float e0 = l[4 + 8 * gs + i0], e1 = l[4 + 8 * gs + i1], m2 = fmaxf(e0, e1), x0 = expf(e0 - m2), x1 = expf(e1 - m2), inv = 1.0f / (x0 + x1);
            const int ex0 = 8 * gs + i0, ex1 = 8 * gs + i1;
            rinfo[tid * 4 + 0] = ex0; rinfo[tid * 4 + 1] = atomicAdd((int*)&lcnt[ex0], 1); rinfo[tid * 4 + 2] = ex1; rinfo[tid * 4 + 3] = atomicAdd((int*)&lcnt[ex1], 1);
            rw[tid * 2 + 0] = pg * x0 * inv; rw[tid * 2 + 1] = pg * x1 * inv; }
        __syncthreads();
        if (tid < 32) lcnt[32 + tid] = lcnt[tid] ? atomicAdd(&cnt[tid], lcnt[tid]) : 0;
        __syncthreads();
        if (tid < 128) { const int tok = 128 * rt + tid; const int e0 = rinfo[tid * 4 + 0], s0 = lcnt[32 + e0] + rinfo[tid * 4 + 1], e1 = rinfo[tid * 4 + 2], s1 = lcnt[32 + e1] + rinfo[tid * 4 + 3];
            int* ptok = (int*)(a.ws + WS_PTOK); ptok[(size_t)e0 * 65536 + s0] = tok; ptok[(size_t)e1 * 65536 + s1] = tok;
            unsigned* ro = (unsigned*)(a.ws + WS_ROUTE) + (size_t)tok * 8; ro[0] = e0; ro[1] = s0; ro[2] = e1; ro[3] = s1; ro[4] = __float_as_uint(rw[tid * 2]); ro[5] = __float_as_uint(rw[tid * 2 + 1]); }
    }
}

DI void moe_tiles(const KArgs& a, LAS int* tt) {
    __syncthreads();
    if (threadIdx.x == 0) { const int* cnt = (const int*)(a.ws + WS_CTL) + CW_CNT; int s = 0; for (int e = 0; e < 32; ++e) { tt[e] = s; s += (cnt[e] + 255) >> 8; } tt[32] = s; }
    __syncthreads();
}
DI int moe_expert(const LAS int* tt, int rt) { int e = 0;
#pragma unroll
    for (int q = 16; q >= 1; q >>= 1) if (tt[e + q] <= rt) e += q;
    return e; }
struct OrderMoe1 {
    const char* A; const char* B; const LAS int* tt; const LAS int* tok; int G, c;
    DI bool next(int i, Unit& u) const { const int L = i * G + c; if (L >= tt[32] * 6) return false; const int rt = L / 6, ct = L % 6, e = moe_expert(tt, rt);
        u.pm = rt; u.pn = ct; u.aux = e; u.bmode = 1; u.A = A; u.B = B + (size_t)(e * 6 + ct) * 256 * 1024; return true; }
    DI void offsA(const Unit&, int ui, const int (&R)[2], const int (&C)[2], unsigned (&v)[2][2]) const {
#pragma unroll
        for (int h = 0; h < 2; ++h)
#pragma unroll
            for (int i = 0; i < 2; ++i) v[h][i] = (unsigned)tok[ui * 256 + h * 128 + R[i]] * 1024u + (unsigned)C[i] * 2u; }
};
struct EpiMoe1 {
    unsigned char* hid;
    DI bool operator()(f32x4 (&acc)[2][2][4][2], const Unit& u, int wr, int wc, int fr, int fq) const {
        const int col = u.pn * 128 + wc * 32 + 8 * fq;
#pragma unroll
        EPI_LOOP_ROWS { const size_t row = (size_t)u.pm * 256 + ai * 128 + wr * 64 + m * 16 + fr; float v[8];
#pragma unroll
            for (int n = 0; n < 2; ++n)
#pragma unroll
                for (int j = 0; j < 4; ++j) { const float g = acc[ai][0][m][n][j] * (1.0f / 1024.0f), up = acc[ai][1][m][n][j] * (1.0f / 1024.0f); v[4 * n + j] = silu_(g) * up * 8.0f; }
            u32x2 w; w.x = cvt4_fp8(v[0], v[1], v[2], v[3]); w.y = cvt4_fp8(v[4], v[5], v[6], v[7]);
            *(u32x2*)(hid + row * 768 + col) = w; }
        return false;
    }
};
struct OrderMoe2 {
    const char* A; const char* B; const LAS int* tt; int G, c;
    DI bool next(int i, Unit& u) const { const int L = i * G + c; if (L >= tt[32] * 4) return false; const int rt = L >> 2, ct = L & 3, e = moe_expert(tt, rt);
        u.pm = rt; u.pn = ct; u.aux = e; u.bmode = 1; u.A = A + (size_t)rt * 256 * 768; u.B = B + ((size_t)e * 1024 + 256 * ct) * 768; return true; }
    DI void offsA(const Unit&, int, const int (&R)[2], const int (&C)[2], unsigned (&v)[2][2]) const { pg8::dense_offs(768, R, C, v); }
};
struct EpiMoe2 {
    bf16_t* ye;
    DI bool operator()(f32x4 (&acc)[2][2][4][2], const Unit& u, int wr, int wc, int fr, int fq) const {
#pragma unroll
        for (int bj = 0; bj < 2; ++bj) { const int col = u.pn * 256 + bj * 128 + wc * 32 + 8 * fq;
#pragma unroll
            EPI_LOOP_ROWS { const size_t row = (size_t)u.pm * 256 + ai * 128 + wr * 64 + m * 16 + fr; const f32x4 v0 = acc[ai][bj][m][0] * (1.0f / 512.0f), v1 = acc[ai][bj][m][1] * (1.0f / 512.0f);
                u32x4 w; w.x = cvt_pk_bf16(v0[0], v0[1]); w.y = cvt_pk_bf16(v0[2], v0[3]); w.z = cvt_pk_bf16(v1[0], v1[1]); w.w = cvt_pk_bf16(v1[2], v1[3]);
                *(u32x4*)(ye + row * 1024 + col) = w; } }
        return false;
    }
};

DI void phase8(const KArgs& a, LAS unsigned char* lds) {
    const int tid = tid_fresh(), G = gridDim.x, lane = tid & 63, wid = tid >> 6;
    LAS float* g2 = (LAS float*)lds;
    LAS int* tt = (LAS int*)(g2 + 2048);
    moe_tiles(a, tt);
    for (int i = tid; i < 2048; i += 512) g2[i] = ((const float*)(a.ws + WS_MODT))[6144 + i];
    __syncthreads();
    const bf16_t* ye = (const bf16_t*)(a.ws + WS_YE);
    for (int row = blockIdx.x * 8 + wid; row < NT; row += G * 8) {
        const int v = row / SEQ; const unsigned* ro = (const unsigned*)(a.ws + WS_ROUTE) + (size_t)row * 8;
        const size_t p0 = (size_t)tt[ro[0]] * 256 + ro[1], p1 = (size_t)tt[ro[2]] * 256 + ro[3]; const float w0 = __uint_as_float(ro[4]), w1 = __uint_as_float(ro[5]);
        float* xr = a.out + (size_t)row * 1024; f32x4 x[4]; float ss = 0.f;
#pragma unroll
        for (int j = 0; j < 4; ++j) { const int k0 = 4 * lane + 256 * j; x[j] = *(const f32x4*)(xr + k0);
            const u32x2 ya = *(const u32x2*)(ye + p0 * 1024 + k0), yb = *(const u32x2*)(ye + p1 * 1024 + k0); const f32x4 g = *(const LAS f32x4*)(g2 + v * 1024 + k0);
            x[j][0] += g[0] * (w0 * __uint_as_float(ya[0] << 16) + w1 * __uint_as_float(yb[0] << 16)); x[j][1] += g[1] * (w0 * __uint_as_float(ya[0] & 0xffff0000u) + w1 * __uint_as_float(yb[0] & 0xffff0000u));
            x[j][2] += g[2] * (w0 * __uint_as_float(ya[1] << 16) + w1 * __uint_as_float(yb[1] << 16)); x[j][3] += g[3] * (w0 * __uint_as_float(ya[1] & 0xffff0000u) + w1 * __uint_as_float(yb[1] & 0xffff0000u));
            ss += (x[j][0] * x[j][0] + x[j][1] * x[j][1]) + (x[j][2] * x[j][2] + x[j][3] * x[j][3]); }
#pragma unroll
        for (int o = 32; o >= 1; o >>= 1) ss += __shfl_xor(ss, o);
        const float rstd = rsqrtf(ss * (1.0f / 1024.0f) + EPSV);
#pragma unroll
        for (int j = 0; j < 4; ++j) { const int k0 = 4 * lane + 256 * j; const f32x4 fn = *(const f32x4*)(a.in[I_FNORM] + k0); *(f32x4*)(xr + k0) = x[j] * rstd * fn; }
    }
}

constexpr int N_PHASES = 12;
__global__ void __launch_bounds__(512, 2) fwd_kernel(KArgs a) {
    extern __shared__ __attribute__((aligned(16))) unsigned char lds_raw[];
    LAS unsigned char* lds = (LAS unsigned char*)lds_raw;
    volatile LAS unsigned* misc = (volatile LAS unsigned*)(lds + LDS_MISC);
    if (threadIdx.x < 8) misc[threadIdx.x] = 0u;
#ifdef PROBE_ID
    if (threadIdx.x == 0) { probe_words()[0] = 0; probe_words()[1] = 0; }
#endif
    __syncthreads();
    XcdBarrier bar; bar.bar = (unsigned*)(a.ws + WS_CTL) + CW_BAR; bar.x = 0; bar.st = misc;
    const bool one = (a.ph_hi - a.ph_lo) > 1;
    if (one) bar = xcd_barrier_post((unsigned*)(a.ws + WS_CTL) + CW_BAR, misc);
#ifdef ONLY_PHASE
#define IN(k) ((k) == ONLY_PHASE)
#else
#define IN(k) (a.ph_lo <= (k) && (k) < a.ph_hi)
#endif
#define SEAM(k) do { if (IN(k) && IN((k) + 1)) xcd_barrier(bar); PE(k); PB((k) + 1); } while (0)
    const int G = gridDim.x, c = blockIdx.x;
    PB(0);
    if (IN(0)) { phase0a(a, lds); } SEAM(0);
    if (IN(1)) { phase0b(a, lds); } SEAM(1);
    if (IN(2)) { __syncthreads(); OrderIn S{(const char*)(a.ws + WS_HX), (const char*)(a.ws + WS_WIN), G, c};
        EpiIn E{a.ws, (bf16_t*)a.out, a.in[I_BGATE], (const f32x2*)(a.ws + WS_ROPE)}; pg8::gemm_phase<false>(lds, 1024, S, E); } SEAM(2);
    if (IN(3)) { phase2a(a, lds); } SEAM(3);
    if (IN(4)) { phase2b(a); } SEAM(4);
    if (IN(5)) { phase2c(a, lds); } SEAM(5);
    if (IN(6)) {
        const bool cvt_first = (c & 1) == 0;
        if (cvt_first) { PB(104); phase3_cvt(a, lds); PE(104); }
        {   OrderMerge S{(const char*)(a.ws + WS_ZG), (const char*)(a.ws + WS_ZGL), (const char*)(a.ws + WS_WRET), (const char*)(a.ws + WS_WLRU), G, c};
            EpiMerge E{(const bf16_t*)a.out, (bf16_t*)(a.ws + WS_HX)}; __syncthreads(); pg8::gemm_phase<false>(lds, 1024, S, E); }
        if (!cvt_first) { phase3_cvt(a, lds); } } SEAM(6);
    if (IN(7)) { __syncthreads(); OrderOut S{(const char*)(a.ws + WS_HX), (const char*)(a.ws + WS_WOUT), G, c}; EpiOut E{&a}; pg8::gemm_phase<false>(lds, 1024, S, E); } SEAM(7);
    if (IN(8)) { phase5(a, lds); } SEAM(8);
    if (IN(9)) {
        LAS int* tt = (LAS int*)(lds + LDS_MISC + 64); LAS int* tok = (LAS int*)(lds + LDS_TOK);
        moe_tiles(a, tt);
        {
            const int tid = tid_fresh();
            const int* cnt = (const int*)(a.ws + WS_CTL) + CW_CNT; const int* ptok = (const int*)(a.ws + WS_PTOK);
            for (int i = 0; i < 8; ++i) { const int L = i * G + c; if (L >= tt[32] * 6) break; const int rt = L / 6, e = moe_expert(tt, rt), r0 = (rt - tt[e]) * 256;
                if (tid < 256) tok[i * 256 + tid] = (r0 + tid < cnt[e]) ? ptok[(size_t)e * 65536 + r0 + tid] : NT; }
            __syncthreads();
        }
        OrderMoe1 S{(const char*)(a.ws + WS_HX2Q), (const char*)(a.ws + WS_WGU), tt, tok, G, c}; EpiMoe1 E{(unsigned char*)(a.ws + WS_HID)}; pg8::gemm_phase<true>(lds, 1024, S, E); } SEAM(9);
    if (IN(10)) { LAS int* tt = (LAS int*)(lds + LDS_MISC + 64); moe_tiles(a, tt);
        OrderMoe2 S{(const char*)(a.ws + WS_HID), (const char*)(a.ws + WS_WDN), tt, G, c}; EpiMoe2 E{(bf16_t*)(a.ws + WS_YE)}; pg8::gemm_phase<true>(lds, 768, S, E); } SEAM(10);
    if (IN(11)) { phase8(a, lds); }
    PE(11);
#ifdef PROBE_ID
    if (blockIdx.x == 0 && threadIdx.x == 0) { const unsigned long long w = probe_words()[1] * 4ull, t0 = wall_clock64(); while (wall_clock64() - t0 < w) __builtin_amdgcn_s_sleep(8); }
#endif
#undef IN
#undef SEAM
}

extern "C" void kernel_launch(void* const* d_in, const int* in_sizes, int n_in, void* d_out, int out_size, void* d_ws, size_t ws_size, hipStream_t stream) {
    static int grid = 0;
    if (grid == 0) {
        if (n_in != 30 || out_size != NT * DM || ws_size < WS_NEED) { fprintf(stderr, "kernel_launch: unexpected shapes (n_in %d out %d ws %zu)\n", n_in, out_size, ws_size); grid = -1; return; }
        int dev = 0, cus = 0;
        if (hipGetDevice(&dev) != hipSuccess || hipDeviceGetAttribute(&cus, hipDeviceAttributeMultiprocessorCount, dev) != hipSuccess) { grid = -1; return; }
        if (hipFuncSetAttribute((const void*)fwd_kernel, hipFuncAttributeMaxDynamicSharedMemorySize, LDS_BYTES) != hipSuccess) { fprintf(stderr, "kernel_launch: hipFuncSetAttribute failed\n"); grid = -1; return; }
        int per_cu = 0; (void)hipOccupancyMaxActiveBlocksPerMultiprocessor(&per_cu, (const void*)fwd_kernel, 512, LDS_BYTES); (void)hipGetLastError();
        grid = cus;
    }
    if (grid < 0) return;
    (void)hipMemsetAsync((char*)d_ws + WS_CTL, 0, 1 * MiB, stream);
    KArgs a{};
    for (int i = 0; i < 30; ++i) a.in[i] = (const float*)d_in[i];
    a.out = (float*)d_out; a.ws = (unsigned char*)d_ws;
#if N_LAUNCH_SPLIT
    for (int p = 0; p < N_PHASES; ++p) { a.ph_lo = p; a.ph_hi = p + 1; hipLaunchKernelGGL(fwd_kernel, dim3(grid), dim3(512), LDS_BYTES, stream, a); }
#else
    a.ph_lo = 0; a.ph_hi = N_PHASES; hipLaunchKernelGGL(fwd_kernel, dim3(grid), dim3(512), LDS_BYTES, stream, a);
#endif
}
```

```cpp
#include <hip/hip_runtime.h>
#include <cstdio>
#include <cstdint>

#ifndef N_LAUNCH_SPLIT
#define N_LAUNCH_SPLIT 0
#endif

#define DI __device__ __forceinline__
#ifdef SUB
#define SUBSEL(k) ((k) == SUB)
#else
#define SUBSEL(k) true
#endif
#define LAS __attribute__((address_space(3)))
typedef unsigned short bf16_t;
typedef short bf16x8 __attribute__((ext_vector_type(8)));
typedef short s16x4 __attribute__((ext_vector_type(4)));
typedef float f32x2 __attribute__((ext_vector_type(2)));
typedef float f32x4 __attribute__((ext_vector_type(4)));
typedef float f32x16 __attribute__((ext_vector_type(16)));
typedef unsigned u32x2 __attribute__((ext_vector_type(2)));
typedef unsigned u32x4 __attribute__((ext_vector_type(4)));
typedef int v8i_t __attribute__((ext_vector_type(8)));
typedef int v4i_t __attribute__((ext_vector_type(4)));

constexpr int NB_ = 2, SEQ = 16384, NT = NB_ * SEQ, DM = 1024, CTXL = 256, NTC = NB_ * CTXL;
constexpr int NH = 4, DK = 128, DV = 256, QW = 512, VW = 1024, LW = 1024;
constexpr int NCOL = 7168;
constexpr int NE = 32, EH = 768;
constexpr float EPSV = 1e-6f;
constexpr float LOG2E = 1.4426950408889634f;
constexpr int SCH = 512, NSC = SEQ / SCH;
constexpr int LT = 64, NLT = SEQ / LT, NSLOT = 320;

constexpr size_t MiB = 1u << 20;
constexpr size_t WS_CTL = 0;
constexpr size_t WS_MODP = 1 * MiB;
constexpr size_t WS_MODT = 1 * MiB + 384 * 1024;
constexpr size_t WS_RDEC = 1 * MiB + 448 * 1024;
constexpr size_t WS_ROPE = 1 * MiB + 512 * 1024;
constexpr size_t WS_WRH = 1 * MiB + 768 * 1024;
constexpr size_t WS_LAGG = 2 * MiB;
constexpr size_t WS_LHIN = 12 * MiB;
constexpr size_t WS_CTXK = 17 * MiB;
constexpr size_t WS_CTXV = 17 * MiB + 512 * 1024;
constexpr size_t WS_CTXX = 18 * MiB + 512 * 1024;
constexpr size_t WS_CTXS = 20 * MiB;
constexpr size_t WS_ROUTE = 22 * MiB;
constexpr size_t WS_PTOK = 23 * MiB;
constexpr size_t WS_WIN = 32 * MiB;
constexpr size_t WS_WRET = 46 * MiB, WS_WLRU = 48 * MiB, WS_WOUT = 50 * MiB;
constexpr size_t WS_WLB = 52 * MiB;
constexpr size_t WS_HX = 56 * MiB;
constexpr size_t WS_ZQ = 120 * MiB, WS_ZK = 152 * MiB, WS_ZV = 184 * MiB, WS_ZG = 248 * MiB, WS_ZXL = 312 * MiB, WS_ZGL = 376 * MiB;
constexpr size_t WS_SBF = 440 * MiB;
constexpr size_t WS_WGU = 120 * MiB;
constexpr size_t WS_WDN = 440 * MiB;
constexpr size_t WS_HX2 = 248 * MiB;
constexpr size_t WS_HID = 313 * MiB;
constexpr size_t WS_HX2Q = 168 * MiB;
constexpr size_t WS_YE = 56 * MiB;
constexpr size_t WS_D1 = 376 * MiB;
constexpr size_t WS_NEED = 512 * MiB;
constexpr int CW_BAR = 4096, CW_CNT = 16384;

constexpr int LDS_SCR = 0, LDS_TOK = 131072, LDS_MISC = 131072 + 8192, LDS_BYTES = 147456;

DI int tid_fresh() { int t = threadIdx.x; asm volatile("" : "+v"(t)); return t; }
#ifdef PROBE_ID
DI volatile LAS unsigned long long* probe_words() { extern __shared__ __attribute__((aligned(16))) unsigned char lds_raw[]; return (volatile LAS unsigned long long*)((LAS unsigned char*)lds_raw + 131072 + 8192 + 1024); }
#define PB(id) do { if ((id) == PROBE_ID && threadIdx.x == 0) probe_words()[0] = wall_clock64(); } while (0)
#define PE(id) do { if ((id) == PROBE_ID && threadIdx.x == 0) probe_words()[1] += wall_clock64() - probe_words()[0]; } while (0)
#else
#define PB(id) do {} while (0)
#define PE(id) do {} while (0)
#endif
DI float bf2f(unsigned short b) { return __uint_as_float(((unsigned)b) << 16); }
typedef __bf16 bf16x2_t __attribute__((ext_vector_type(2)));
DI unsigned cvt_pk_bf16(float lo, float hi) { const f32x2 v = {lo, hi}; return __builtin_bit_cast(unsigned, __builtin_convertvector(v, bf16x2_t)); }
DI unsigned cvt4_fp8(float a, float b, float c, float d) { int p = 0; p = __builtin_amdgcn_cvt_pk_fp8_f32(fminf(fmaxf(a, -448.f), 448.f), fminf(fmaxf(b, -448.f), 448.f), p, false);
    p = __builtin_amdgcn_cvt_pk_fp8_f32(fminf(fmaxf(c, -448.f), 448.f), fminf(fmaxf(d, -448.f), 448.f), p, true); return (unsigned)p; }
DI unsigned short f2bf(float f) { return (unsigned short)(cvt_pk_bf16(f, 0.f) & 0xffffu); }
DI float ex2(float x) { return __builtin_amdgcn_exp2f(x); }
DI float rcpf_(float x) { return __builtin_amdgcn_rcpf(x); }
DI float sigm(float x) { return rcpf_(1.0f + ex2(-LOG2E * x)); }
DI float silu_(float x) { return x * sigm(x); }
DI float gelu_tanh(float x) { const float z = 0.7978845608028654f * (x + 0.044715f * x * x * x); return x * sigm(2.0f * z); }
DI float softplus_(float x) { return x > 20.f ? x : log1pf(expf(x)); }
DI int crow(int i, int h) { return (i & 3) + 8 * (i >> 2) + 4 * h; }
#define MFMA32(a, b, c) __builtin_amdgcn_mfma_f32_32x32x16_bf16((a), (b), (c), 0, 0, 0)
DI void lds_wait() { asm volatile("s_waitcnt lgkmcnt(0)" ::: "memory"); }
template <int O0, int O1> DI bf16x8 tr_frag(unsigned addr) {
    s16x4 lo, hi;
    asm volatile("ds_read_b64_tr_b16 %0, %2 offset:%3\n\tds_read_b64_tr_b16 %1, %2 offset:%4\n\ts_waitcnt lgkmcnt(0)" : "=&v"(lo), "=&v"(hi) : "v"(addr), "i"(O0), "i"(O1) : "memory");
    return __builtin_shufflevector(lo, hi, 0, 1, 2, 3, 4, 5, 6, 7);
}
template <int O, int S, int T> DI void tr_frag4(unsigned addr, bf16x8& f0, bf16x8& f1, bf16x8& f2, bf16x8& f3) {
    s16x4 a0, a1, b0, b1, c0, c1, d0, d1;
    asm volatile("ds_read_b64_tr_b16 %0, %8 offset:%9\n\tds_read_b64_tr_b16 %1, %8 offset:%10\n\t"
                 "ds_read_b64_tr_b16 %2, %8 offset:%11\n\tds_read_b64_tr_b16 %3, %8 offset:%12\n\t"
                 "ds_read_b64_tr_b16 %4, %8 offset:%13\n\tds_read_b64_tr_b16 %5, %8 offset:%14\n\t"
                 "ds_read_b64_tr_b16 %6, %8 offset:%15\n\tds_read_b64_tr_b16 %7, %8 offset:%16\n\ts_waitcnt lgkmcnt(0)"
                 : "=&v"(a0), "=&v"(a1), "=&v"(b0), "=&v"(b1), "=&v"(c0), "=&v"(c1), "=&v"(d0), "=&v"(d1)
                 : "v"(addr), "i"(O), "i"(O + T), "i"(O + S), "i"(O + S + T), "i"(O + 2 * S), "i"(O + 2 * S + T), "i"(O + 3 * S), "i"(O + 3 * S + T) : "memory");
    f0 = __builtin_shufflevector(a0, a1, 0, 1, 2, 3, 4, 5, 6, 7); f1 = __builtin_shufflevector(b0, b1, 0, 1, 2, 3, 4, 5, 6, 7);
    f2 = __builtin_shufflevector(c0, c1, 0, 1, 2, 3, 4, 5, 6, 7); f3 = __builtin_shufflevector(d0, d1, 0, 1, 2, 3, 4, 5, 6, 7);
}
DI void lds_barrier() { asm volatile("s_waitcnt lgkmcnt(0)" ::: "memory"); __builtin_amdgcn_s_barrier(); asm volatile("" ::: "memory"); }
DI f32x16 zero16() { f32x16 z; for (int i = 0; i < 16; ++i) z[i] = 0.f; return z; }

struct KArgs {
    const float* in[30];
    float* out;
    unsigned char* ws;
    int ph_lo, ph_hi;
};
enum { I_X = 0, I_C, I_CTX, I_CCTX, I_WMOD, I_BMOD, I_NORM1, I_NORM2, I_WIN, I_BGATE, I_RDECAY, I_RNORM, I_WRET, I_CONVW, I_CONVB, I_LWA, I_LBA, I_LWX, I_LBX, I_LLAM,
       I_WLRU, I_WOUT, I_WGRP, I_BGRP, I_WRT, I_BRT, I_WEG, I_WEU, I_WED, I_FNORM };

DI float mod_val(const KArgs& a, int v, int ch, int k) {
    const float* mp = (const float*)(a.ws + WS_MODP); const int n = ch * 1024 + k;
    return ((mp[(0 * 3 + v) * 6144 + n] + mp[(1 * 3 + v) * 6144 + n]) + (mp[(2 * 3 + v) * 6144 + n] + mp[(3 * 3 + v) * 6144 + n])) + a.in[I_BMOD][n];
}

#define XB_TMO      128
#define XB_XCNT(j)  (256  + 64 * (j))
#define XB_XSUB(j)  (1280 + 64 * (j))
#define XB_XGEN(j)  (2304 + 64 * (j))
#define XB_TOP      3328
#define XB_TOPGEN   3392
#define XCD_BAR_WORDS 3456
#define XB_SPIN_CAP (1u << 18)
__device__ __forceinline__ unsigned xb_ld(unsigned* p)              { return __hip_atomic_load(p, __ATOMIC_RELAXED, __HIP_MEMORY_SCOPE_AGENT); }
__device__ __forceinline__ unsigned xb_add(unsigned* p, unsigned v) { return __hip_atomic_fetch_add(p, v, __ATOMIC_RELAXED, __HIP_MEMORY_SCOPE_AGENT); }
__device__ __forceinline__ unsigned xb_xcc_id() { return (unsigned)__builtin_amdgcn_s_getreg((3 << 11) | 20) & 0xFu; }
#define XB_SPIN(cond, bar) do { unsigned _sp = 0; while (cond) { __builtin_amdgcn_s_sleep(1); \
    if ((++_sp & 255u) == 0u) { if (xb_ld(&(bar)[XB_TMO])) break; if (_sp > XB_SPIN_CAP) { atomicAdd(&(bar)[XB_TMO], 1u); break; } } } } while (0)
struct XcdBarrier { unsigned* bar; unsigned x; volatile LAS unsigned* st; };
__device__ __forceinline__ XcdBarrier xcd_barrier_post(unsigned* bar, volatile LAS unsigned* st) {
    XcdBarrier b; b.bar = bar; b.x = xb_xcc_id(); b.st = st;
    if (threadIdx.x == 0) (void)xb_add(&bar[XB_XCNT(b.x)], 1u);
    return b;
}
__device__ __forceinline__ void xcd_barrier_complete(unsigned* bar, unsigned x, unsigned& nloc, unsigned& nx) {
    const unsigned G = gridDim.x * gridDim.y * gridDim.z;
    unsigned sum, cnt, mine, sp = 0u;
    for (;;) {
        sum = 0u; cnt = 0u; mine = 0u;
#pragma unroll
        for (unsigned j = 0; j < 16; ++j) { const unsigned c = xb_ld(&bar[XB_XCNT(j)]); sum += c; cnt += (c > 0u) ? 1u : 0u; mine = (j == x) ? c : mine; }
        if (sum == G) break;
        __builtin_amdgcn_s_sleep(1);
        if ((++sp & 255u) == 0u) { if (xb_ld(&bar[XB_TMO])) break; if (sp > XB_SPIN_CAP) { atomicAdd(&bar[XB_TMO], 1u); break; } }
    }
    nloc = mine > 0u ? mine : 1u; nx = cnt > 0u ? cnt : 1u;
}
__device__ __forceinline__ void xcd_barrier(const XcdBarrier& b) {
    asm volatile("s_waitcnt vmcnt(0)" ::: "memory");
    __syncthreads();
    if (threadIdx.x == 0) {
        unsigned* bar = b.bar;
        __builtin_amdgcn_s_waitcnt(0);
        unsigned nloc = b.st[0], nx = b.st[1];
        if (nloc == 0u) { xcd_barrier_complete(bar, b.x, nloc, nx); b.st[0] = nloc; b.st[1] = nx; }
        const unsigned old = xb_add(&bar[XB_XSUB(b.x)], 1u);
        const unsigned gen = old / nloc;
        if (old + 1u == (gen + 1u) * nloc) {
            __builtin_amdgcn_fence(__ATOMIC_RELEASE, "agent");
            asm volatile("s_waitcnt vmcnt(0)" ::: "memory");
            const unsigned og = xb_add(&bar[XB_TOP], 1u);
            const unsigned tg = og / nx;
            if (og + 1u == (tg + 1u) * nx) xb_add(&bar[XB_TOPGEN], 1u);
            else XB_SPIN(xb_ld(&bar[XB_TOPGEN]) == tg, bar);
            __builtin_amdgcn_fence(__ATOMIC_ACQUIRE, "agent");
            xb_add(&bar[XB_XGEN(b.x)], 1u);
            asm volatile("s_waitcnt vmcnt(0)" ::: "memory");
        } else {
            XB_SPIN(xb_ld(&bar[XB_XGEN(b.x)]) == gen, bar);
            __builtin_amdgcn_fence(__ATOMIC_ACQUIRE, "agent");
            asm volatile("s_waitcnt vmcnt(0)" ::: "memory");
        }
    }
    __syncthreads();
}

namespace pg8 {
constexpr int BM = 256, BK = 64, HALF = 128, HTB = HALF * BK * 2, STAGE_BYTES = 8 * HTB, NXCD = 8, WGM = 8;
DI int lds_byte(int r, int c) { const int st = (r >> 4) * 2 + (c >> 5), rr = r & 15, cc = c & 31, ob = rr * 64 + cc * 2; return st * 1024 + (ob ^ (((ob >> 9) & 1) << 5)); }
DI void stage_rc(int b, int& R, int& C) { const int st = b / 1024, sb = b % 1024, swz = sb ^ (((sb >> 9) & 1) << 5); R = (st >> 1) * 16 + swz / 64; C = (st & 1) * 32 + (swz % 64) / 2; }
DI int perm32(int rho) { const int n = rho >> 4, i = rho & 15; return 8 * (i >> 2) + 4 * n + (i & 3); }
DI int bmap(int mode, int R) {
    if (mode == 1) return (R & ~31) + perm32(R & 31);
    if (mode == 2) { const int wc = R >> 5, n = (R >> 4) & 1, low = R & 15; return 64 * (wc >> 1) + 32 * n + 16 * (wc & 1) + low; }
    return R;
}
struct Unit { const char* A; const char* B; int pm, pn, aux, bmode; };
DI bool static_tile(int i, int G, int c, int nM, int nN, int& pm, int& pn) {
    const int nwg = nM * nN; const long L = (long)i * G + c; if (L >= nwg) return false;
    int wgid = (int)L; { const int q = nwg / NXCD, r = nwg % NXCD, xcd = wgid % NXCD, off = wgid / NXCD; wgid = (xcd < r ? xcd * (q + 1) : r * (q + 1) + (xcd - r) * q) + off; }
    const int nig = WGM * nN, gid = wgid / nig, fm = gid * WGM, gsz = (nM - fm) < WGM ? (nM - fm) : WGM;
    pm = fm + ((wgid % nig) % gsz); pn = (wgid % nig) / gsz; return true;
}

template <bool F8, class Epi, class Sched>
DI void gemm_phase(LAS unsigned char* lds, const int K, const Sched& S, const Epi& E) {
    const int tid = tid_fresh(), wid = __builtin_amdgcn_readfirstlane(tid >> 6), lane = tid & 63, wr = wid >> 2, wc = wid & 3;
    const int rowb = F8 ? K : 2 * K, nt = rowb / 128;
    unsigned voffA[2][2], voffB[2];
    const size_t kstep = (size_t)(BK * 2);
    const size_t hstep = (size_t)HALF * rowb;
    const unsigned ldsw = (unsigned)wid * 1024u;
    const int aoff = lds_byte(wr * 64 + (lane & 15), (lane >> 4) * 8), boff = lds_byte(wc * 32 + (lane & 15), (lane >> 4) * 8);
#define PG8_SA(b, h) (((b) * 2 + (h)) * HTB)
#define PG8_SB(b, h) ((4 + (b) * 2 + (h)) * HTB)
#define PG8_STAGE(bufoff, gbase, voff) do { _Pragma("unroll") for (int _i = 0; _i < 2; ++_i) { unsigned vo_ = (voff)[_i]; asm volatile("" : "+v"(vo_));     \
        __builtin_amdgcn_global_load_lds((const unsigned*)((const char*)(gbase) + vo_), (LAS unsigned*)(lds + (bufoff) + ldsw + _i * 8192), 16, 0, 0); } } while (0)
#define PG8_LD8(p_) __builtin_shufflevector(*(const LAS v4i_t*)(p_), *(const LAS v4i_t*)((p_) + 1024), 0, 1, 2, 3, 4, 5, 6, 7)
#define PG8_LDA(dst, b, h) do { _Pragma("unroll") for (int m = 0; m < 4; ++m) dst[m] = PG8_LD8(lds + PG8_SA(b, h) + aoff + m * 2048); } while (0)
#define PG8_LDB(dst, b, h) do { _Pragma("unroll") for (int n = 0; n < 2; ++n) dst[n] = PG8_LD8(lds + PG8_SB(b, h) + boff + n * 2048); } while (0)
#define PG8_LO(v_) __builtin_bit_cast(bf16x8, __builtin_shufflevector(v_, v_, 0, 1, 2, 3))
#define PG8_HI(v_) __builtin_bit_cast(bf16x8, __builtin_shufflevector(v_, v_, 4, 5, 6, 7))
#define PG8_MMA(ai, bj, At, Bt) do { __builtin_amdgcn_s_setprio(1); _Pragma("unroll") for (int m = 0; m < 4; ++m) _Pragma("unroll") for (int n = 0; n < 2; ++n) { \
        if constexpr (F8) { acc[ai][bj][m][n] = __builtin_amdgcn_mfma_scale_f32_16x16x128_f8f6f4(Bt[n], At[m], acc[ai][bj][m][n], 0, 0, 0, 0x7f7f7f7f, 0, 0x7f7f7f7f); } \
        else { acc[ai][bj][m][n] = __builtin_amdgcn_mfma_f32_16x16x32_bf16(PG8_LO(Bt[n]), PG8_LO(At[m]), acc[ai][bj][m][n], 0, 0, 0); \
               acc[ai][bj][m][n] = __builtin_amdgcn_mfma_f32_16x16x32_bf16(PG8_HI(Bt[n]), PG8_HI(At[m]), acc[ai][bj][m][n], 0, 0, 0); } } \
        __builtin_amdgcn_s_setprio(0); } while (0)
#define PG8_WAIT_V(n) asm volatile("s_waitcnt vmcnt(" #n ")" ::: "memory")
#define PG8_WAIT_L(n) asm volatile("s_waitcnt lgkmcnt(" #n ")" ::: "memory")
#define PG8_BAR __builtin_amdgcn_s_barrier()
#define PG8_SCHED __builtin_amdgcn_sched_barrier(0)
#define PG8_RC() int Rr[2], Cc[2]; { const int t_ = tid_fresh(); _Pragma("unroll") for (int _i = 0; _i < 2; ++_i) stage_rc(t_ * 16 + _i * 8192, Rr[_i], Cc[_i]); }
#define PG8_SETB(u) do { PG8_RC(); _Pragma("unroll") for (int _i = 0; _i < 2; ++_i) voffB[_i] = (unsigned)(bmap((u).bmode, Rr[_i]) * rowb + Cc[_i] * 2); } while (0)
#define PG8_SETA(u, ui_) do { PG8_RC(); S.offsA((u), (ui_), Rr, Cc, voffA); } while (0)
    Unit cur, nxt; int ui = 0;
    if (!S.next(0, cur)) return;
    f32x4 acc[2][2][4][2];
#pragma unroll
    for (int a = 0; a < 2; ++a)
#pragma unroll
        for (int b = 0; b < 2; ++b)
#pragma unroll
            for (int m = 0; m < 4; ++m)
#pragma unroll
                for (int n = 0; n < 2; ++n) acc[a][b][m][n] = (f32x4){0.f, 0.f, 0.f, 0.f};
    v8i_t At[4], B0[2], B1[2];
    const char* cA = cur.A; const char* cB = cur.B;
    PG8_SETA(cur, 0); PG8_SETB(cur);
    PG8_STAGE(PG8_SB(0, 0), cB, voffB); PG8_STAGE(PG8_SB(0, 1), cB + hstep, voffB); PG8_STAGE(PG8_SA(0, 0), cA, voffA[0]); PG8_STAGE(PG8_SA(0, 1), cA, voffA[1]);
    if (wr == 1) PG8_BAR;
    PG8_WAIT_V(2); PG8_BAR;
    PG8_STAGE(PG8_SB(1, 0), cB + kstep, voffB); PG8_STAGE(PG8_SA(1, 0), cA + kstep, voffA[0]); PG8_STAGE(PG8_SB(1, 1), cB + hstep + kstep, voffB);
    PG8_WAIT_V(6); PG8_BAR;
    for (;;) {
        const bool has_next = S.next(ui + 1, nxt);
        const char* nA = has_next ? nxt.A : cA; const char* nB = has_next ? nxt.B : cB;
#pragma unroll 1
        for (int t = 0; t < nt; t += 2) {
            const bool last = (t == nt - 2);
            const char* a1 = cA + (size_t)(t + 1) * kstep;
            const char* a2 = last ? nA : cA + (size_t)(t + 2) * kstep; const char* b2 = last ? nB : cB + (size_t)(t + 2) * kstep;
            const char* a3 = a2 + kstep; const char* b3 = b2 + kstep;
            if (last && has_next) PG8_SETB(nxt);
            PG8_LDB(B0, 0, 0); PG8_LDB(B1, 0, 1); PG8_SCHED; PG8_LDA(At, 0, 0); PG8_STAGE(PG8_SA(1, 1), a1, voffA[1]);
            PG8_WAIT_V(8); PG8_WAIT_L(0); PG8_BAR; PG8_MMA(0, 0, At, B0); PG8_MMA(0, 1, At, B1); PG8_BAR; PG8_SCHED;
            if (last && has_next) PG8_SETA(nxt, ui + 1);
            PG8_LDA(At, 0, 1); PG8_STAGE(PG8_SB(0, 0), b2, voffB); PG8_STAGE(PG8_SB(0, 1), b2 + hstep, voffB); PG8_STAGE(PG8_SA(0, 0), a2, voffA[0]);
            PG8_WAIT_V(8); PG8_WAIT_L(0); PG8_BAR; PG8_MMA(1, 0, At, B0); PG8_MMA(1, 1, At, B1); PG8_BAR; PG8_SCHED;
            PG8_LDB(B0, 1, 0); PG8_LDB(B1, 1, 1); PG8_SCHED; PG8_LDA(At, 1, 0); PG8_STAGE(PG8_SA(0, 1), a2, voffA[1]);
            PG8_WAIT_V(8); PG8_WAIT_L(0); PG8_BAR; PG8_MMA(0, 0, At, B0); PG8_MMA(0, 1, At, B1); PG8_BAR; PG8_SCHED;
            PG8_LDA(At, 1, 1); PG8_STAGE(PG8_SB(1, 0), b3, voffB); PG8_STAGE(PG8_SB(1, 1), b3 + hstep, voffB); PG8_STAGE(PG8_SA(1, 0), a3, voffA[0]);
            PG8_WAIT_V(8); PG8_WAIT_L(0); PG8_BAR; PG8_MMA(1, 0, At, B0); PG8_MMA(1, 1, At, B1); PG8_BAR; PG8_SCHED;
        }
        if (wr == 0) PG8_BAR;
        bool keep; { const int t_ = tid_fresh(), l_ = t_ & 63; keep = E(acc, cur, wr, wc, l_ & 15, l_ >> 4); }
        if (!has_next) break;
        if (!keep) {
#pragma unroll
            for (int a = 0; a < 2; ++a)
#pragma unroll
                for (int b = 0; b < 2; ++b)
#pragma unroll
                    for (int m = 0; m < 4; ++m)
#pragma unroll
                        for (int n = 0; n < 2; ++n) acc[a][b][m][n] = (f32x4){0.f, 0.f, 0.f, 0.f};
        }
        cur = nxt; cA = nA; cB = nB; ++ui;
        if (wr == 1) PG8_BAR;
    }
    PG8_WAIT_V(0);
    PG8_BAR;
#undef PG8_SA
#undef PG8_SB
#undef PG8_STAGE
#undef PG8_LDA
#undef PG8_LD8
#undef PG8_LO
#undef PG8_HI
#undef PG8_LDB
#undef PG8_MMA
#undef PG8_WAIT_V
#undef PG8_WAIT_L
#undef PG8_BAR
#undef PG8_SCHED
#undef PG8_SETB
#undef PG8_SETA
#undef PG8_RC
}
DI void dense_offs(int rowbytes, const int (&R)[2], const int (&C)[2], unsigned (&voffA)[2][2]) {
#pragma unroll
    for (int h = 0; h < 2; ++h)
#pragma unroll
        for (int i = 0; i < 2; ++i) voffA[h][i] = (unsigned)((h * HALF + R[i]) * rowbytes + C[i] * 2);
}
}
using pg8::Unit;

#define EPI_LOOP_ROWS for (int ai = 0; ai < 2; ++ai) _Pragma("unroll") for (int m = 0; m < 4; ++m)

DI void cvt_tile(LAS float* tile, const float* src, int ld_src, bf16_t* dst, int ld_dst, float scale) {
    const int tid = tid_fresh();
    __syncthreads();
#pragma unroll
    for (int i = 0; i < 2; ++i) { const int kr = (tid >> 4) + 32 * i, nc = (tid & 15) * 4; const f32x4 v = *(const f32x4*)(src + (size_t)kr * ld_src + nc);
        tile[kr * 65 + nc + 0] = v[0]; tile[kr * 65 + nc + 1] = v[1]; tile[kr * 65 + nc + 2] = v[2]; tile[kr * 65 + nc + 3] = v[3]; }
    __syncthreads();
    const int n = tid >> 3, kc = (tid & 7) * 8; float v[8];
#pragma unroll
    for (int j = 0; j < 8; ++j) v[j] = tile[(kc + j) * 65 + n] * scale;
    u32x4 w; w.x = cvt_pk_bf16(v[0], v[1]); w.y = cvt_pk_bf16(v[2], v[3]); w.z = cvt_pk_bf16(v[4], v[5]); w.w = cvt_pk_bf16(v[6], v[7]);
    *(u32x4*)(dst + (size_t)n * ld_dst + kc) = w;
}

DI void cvt_tile4(LAS float* tile, const float* src, int ld_src, bf16_t* dst, size_t hi_stride, int ld_dst) {
    const int tid = tid_fresh();
    f32x4 v[8];
#pragma unroll
    for (int i = 0; i < 8; ++i) v[i] = *(const f32x4*)(src + (size_t)((tid >> 6) + 8 * i) * ld_src + 4 * (tid & 63));
    __syncthreads();
#pragma unroll
    for (int i = 0; i < 8; ++i) *(LAS f32x4*)(tile + ((tid >> 6) + 8 * i) * 260 + 4 * (tid & 63)) = v[i];
    __syncthreads();
    const int n = tid & 255, kh = tid >> 8; bf16_t* d = dst + (size_t)(n >> 7) * hi_stride + (size_t)(n & 127) * ld_dst + 32 * kh;
#pragma unroll
    for (int q = 0; q < 4; ++q) { float x[8];
#pragma unroll
        for (int j = 0; j < 8; ++j) x[j] = tile[(32 * kh + 8 * q + j) * 260 + n];
        u32x4 w; w.x = cvt_pk_bf16(x[0], x[1]); w.y = cvt_pk_bf16(x[2], x[3]); w.z = cvt_pk_bf16(x[4], x[5]); w.w = cvt_pk_bf16(x[6], x[7]);
        *(u32x4*)(d + 8 * q) = w; }
}

DI void phase0a(const KArgs& a, LAS unsigned char* lds) {
    const int tid = tid_fresh(), G = gridDim.x;
    LAS float* fl = (LAS float*)lds;
    constexpr int NU_MOD = 192, NU_ROPE = 1, NU_ROUTW = 1, T_WIN = 16 * 28, T_PROJ = 3 * 64, T_LB = 128;
    constexpr int U0 = NU_MOD, U1 = U0 + NU_ROPE, U2 = U1 + NU_ROUTW, U3 = U2 + T_WIN, U4 = U3 + T_PROJ, U5 = U4 + T_LB;
    for (int u = blockIdx.x; u < U5; u += G) {
        if (u < U0) {
            const int ks = u / 48, cg = u % 48;
            __syncthreads();
            for (int i = tid; i < 768; i += 512) { const int v = i >> 8, k = 256 * ks + (i & 255); const float x = (v == 0) ? a.in[I_C][k] : (v == 1) ? a.in[I_C][1024 + k] : a.in[I_CCTX][k]; fl[i] = silu_(x); }
            __syncthreads();
            const int rl = tid >> 5, cl = tid & 31; float acc[3][4];
#pragma unroll
            for (int v = 0; v < 3; ++v) for (int j = 0; j < 4; ++j) acc[v][j] = 0.f;
            for (int s = 0; s < 16; ++s) { const int kk = 16 * s + rl; const f32x4 w = *(const f32x4*)(a.in[I_WMOD] + (size_t)(256 * ks + kk) * 6144 + 128 * cg + 4 * cl);
#pragma unroll
                for (int v = 0; v < 3; ++v) { const float sv = fl[v * 256 + kk]; acc[v][0] += sv * w[0]; acc[v][1] += sv * w[1]; acc[v][2] += sv * w[2]; acc[v][3] += sv * w[3]; } }
            __syncthreads();
            LAS float* red = fl + 1024;
#pragma unroll
            for (int v = 0; v < 3; ++v) for (int j = 0; j < 4; ++j) red[(rl * 3 + v) * 128 + 4 * cl + j] = acc[v][j];
            __syncthreads();
            if (tid < 384) { const int v = tid >> 7, c = tid & 127; float s = 0.f; for (int r = 0; r < 16; ++r) s += red[(r * 3 + v) * 128 + c];
                ((float*)(a.ws + WS_MODP))[(ks * 3 + v) * 6144 + 128 * cg + c] = s; }
        } else if (u < U1) {
            f32x2* tab = (f32x2*)(a.ws + WS_ROPE);
            if (tid < 8) ((float*)(a.ws + WS_RDEC))[tid] = -softplus_(-a.in[I_RDECAY][tid]) * LOG2E;
            for (int i = tid; i < 320 * 32; i += 512) { const int p = i >> 5, fi = i & 31; const float pos = (float)(p < 256 ? p : p - 256);
                const float freq = ex2(-(float)fi * (13.287712379549449f / 32.0f)); float rev = pos * freq * 0.15915494309189535f; rev -= floorf(rev);
                tab[i] = (f32x2){__builtin_amdgcn_cosf(rev), __builtin_amdgcn_sinf(rev)}; }
        } else if (u < U2) {
            bf16_t* hi = (bf16_t*)(a.ws + WS_WRH); bf16_t* lo = hi + 64 * 1024;
            for (int i = tid; i < 64 * 1024; i += 512) { const int n = i >> 10, k = i & 1023; float w = 0.f;
                if (n < 4) w = a.in[I_WGRP][k * 4 + n]; else if (n < 36) w = a.in[I_WRT][k * 32 + (n - 4)];
                const unsigned short h16 = f2bf(w); hi[i] = h16; lo[i] = f2bf(w - bf2f(h16)); }
        } else if (u < U3) {
            const int t = u - U2, kt = t / 28, ng = t % 28;
            cvt_tile4(fl, a.in[I_WIN] + (size_t)(64 * kt) * NCOL + 256 * ng, NCOL, (bf16_t*)(a.ws + WS_WIN) + (size_t)(256 * ng) * 1024 + 64 * kt, (size_t)128 * 1024, 1024);
        } else if (u < U4) {
            const int t = u - U3, w = t >> 6, kt = (t & 63) >> 2, ng = t & 3;
            const float* src = a.in[w == 0 ? I_WRET : w == 1 ? I_WLRU : I_WOUT]; bf16_t* dst = (bf16_t*)(a.ws + (w == 0 ? WS_WRET : w == 1 ? WS_WLRU : WS_WOUT));
            cvt_tile4(fl, src + (size_t)(64 * kt) * 1024 + 256 * ng, 1024, dst + (size_t)(256 * ng) * 1024 + 64 * kt, (size_t)128 * 1024, 1024);
        } else {
            const int t = u - U4, mat = t >> 5, blk = (t >> 2) & 7, kt = (t >> 1) & 1, nt = t & 1, dir = mat >> 1;
            const float* src = a.in[(mat & 1) ? I_LWX : I_LWA] + (size_t)(dir * 8 + blk) * 128 * 128;
            bf16_t* dst = (bf16_t*)(a.ws + WS_WLB) + (size_t)(mat * 8 + blk) * 128 * 128;
            cvt_tile(fl, src + (size_t)(64 * kt) * 128 + 64 * nt, 128, dst + (size_t)(64 * nt) * 128 + 64 * kt, 128, -LOG2E);
        }
    }
}

DI void phase0b(const KArgs& a, LAS unsigned char* lds) {
    const int tid = tid_fresh(), G = gridDim.x, lane = tid & 63, wid = tid >> 6;
    LAS float* gm = (LAS float*)lds;
    LAS float* sh = gm + 3072;
    __syncthreads();
    for (int i = tid; i < 3072; i += 512) { const int v = i >> 10, k = i & 1023; gm[i] = a.in[I_NORM1][k] * (1.0f + mod_val(a, v, 1, k)); sh[i] = mod_val(a, v, 0, k); }
    if (blockIdx.x == G - 1) { float* mt = (float*)(a.ws + WS_MODT);
        for (int i = tid; i < 2048; i += 512) { const int v = i >> 10, k = i & 1023; mt[i] = mod_val(a, v, 2, k); mt[2048 + i] = a.in[I_NORM2][k] * (1.0f + mod_val(a, v, 4, k)); mt[4096 + i] = mod_val(a, v, 3, k); mt[6144 + i] = mod_val(a, v, 5, k); } }
    __syncthreads();
    PB(105);
    for (int u = blockIdx.x; u < 160; u += G) {
        const int rt = u / 10, ct = u % 10;
        const int col0 = ct < 2 ? 512 + 256 * ct : ct < 6 ? 1024 + 256 * (ct - 2) : 3072 + 256 * (ct - 6);
        LAS unsigned char* At = lds + 24576;
        __syncthreads();
        {   f32x4 x[4][4];
#pragma unroll
            for (int q = 0; q < 4; ++q)
#pragma unroll
                for (int j = 0; j < 4; ++j) x[q][j] = *(const f32x4*)(a.in[I_CTX] + (size_t)(32 * rt + 4 * wid + q) * 1024 + 4 * lane + 256 * j);
#pragma unroll
            for (int q = 0; q < 4; ++q) { float ss = 0.f;
#pragma unroll
                for (int j = 0; j < 4; ++j) ss += (x[q][j][0] * x[q][j][0] + x[q][j][1] * x[q][j][1]) + (x[q][j][2] * x[q][j][2] + x[q][j][3] * x[q][j][3]);
#pragma unroll
                for (int o = 32; o >= 1; o >>= 1) ss += __shfl_xor(ss, o);
                const float rstd = rsqrtf(ss * (1.0f / 1024.0f) + EPSV);
#pragma unroll
                for (int j = 0; j < 4; ++j) { const int k0 = 4 * lane + 256 * j; const f32x4 g = *(const LAS f32x4*)(gm + 2048 + k0), sv = *(const LAS f32x4*)(sh + 2048 + k0);
                    u32x2 w; w.x = cvt_pk_bf16(x[q][j][0] * rstd * g[0] + sv[0], x[q][j][1] * rstd * g[1] + sv[1]); w.y = cvt_pk_bf16(x[q][j][2] * rstd * g[2] + sv[2], x[q][j][3] * rstd * g[3] + sv[3]);
                    *(LAS u32x2*)(At + (4 * wid + q) * 2064 + k0 * 2) = w; } }
        }
        __syncthreads();
        const int r = lane & 31, h = lane >> 5;
        const bf16_t* wrow = (const bf16_t*)(a.ws + WS_WIN) + (size_t)(col0 + 32 * wid + r) * 1024 + 8 * h;
        f32x16 acc = zero16();
#pragma unroll 16
        for (int s2 = 0; s2 < 64; ++s2) { const bf16x8 bfr = *(const bf16x8*)(wrow + 16 * s2); const bf16x8 af = *(const LAS bf16x8*)(At + r * 2064 + (16 * s2 + 8 * h) * 2);
            acc = MFMA32(af, bfr, acc); }
        const int ccol = 256 * (ct < 2 ? ct : ct < 6 ? ct - 2 : ct - 6) + 32 * wid + r;
        bf16_t* dst = (bf16_t*)(a.ws + (ct < 2 ? WS_CTXK : ct < 6 ? WS_CTXV : WS_CTXX)); const int ldd = ct < 2 ? 512 : 1024; const float scv = ct < 2 ? 0.08838834764831845f : 1.0f;
#pragma unroll
        for (int i = 0; i < 16; ++i) dst[(size_t)(32 * rt + crow(i, h)) * ldd + ccol] = f2bf(acc[i] * scv);
    }
    PE(105);
    PB(106);
    {   const int rstep = G * 8; int row = blockIdx.x * 8 + wid; f32x4 x[4];
        if (row < NT) {
#pragma unroll
            for (int j = 0; j < 4; ++j) x[j] = *(const f32x4*)(a.in[I_X] + (size_t)row * 1024 + 4 * lane + 256 * j); }
        for (; row < NT; row += rstep) {
            const int v = row / SEQ; f32x4 xn[4]; const int nrow = row + rstep;
            if (nrow < NT) {
#pragma unroll
                for (int j = 0; j < 4; ++j) xn[j] = *(const f32x4*)(a.in[I_X] + (size_t)nrow * 1024 + 4 * lane + 256 * j); }
            float ss = 0.f;
#pragma unroll
            for (int j = 0; j < 4; ++j) ss += (x[j][0] * x[j][0] + x[j][1] * x[j][1]) + (x[j][2] * x[j][2] + x[j][3] * x[j][3]);
#pragma unroll
            for (int o = 32; o >= 1; o >>= 1) ss += __shfl_xor(ss, o);
            const float rstd = rsqrtf(ss * (1.0f / 1024.0f) + EPSV);
            bf16_t* dst = (bf16_t*)(a.ws + WS_HX) + (size_t)row * 1024;
#pragma unroll
            for (int j = 0; j < 4; ++j) { const int k0 = 4 * lane + 256 * j; const f32x4 g = *(const LAS f32x4*)(gm + v * 1024 + k0), sv = *(const LAS f32x4*)(sh + v * 1024 + k0);
                u32x2 w; w.x = cvt_pk_bf16(x[j][0] * rstd * g[0] + sv[0], x[j][1] * rstd * g[1] + sv[1]); w.y = cvt_pk_bf16(x[j][2] * rstd * g[2] + sv[2], x[j][3] * rstd * g[3] + sv[3]);
                *(u32x2*)(dst + k0) = w; }
#pragma unroll
            for (int j = 0; j < 4; ++j) x[j] = xn[j];
        }
    }
    PE(106);
}

struct OrderIn {
    const char* A; const char* B; int G, c;
    DI bool next(int i, Unit& u) const { int pm, pn; if (!pg8::static_tile(i, G, c, NT / 256, NCOL / 256, pm, pn)) return false;
        u.pm = pm; u.pn = pn; u.A = A + (size_t)pm * 256 * 1024 * 2; u.B = B + (size_t)pn * 256 * 1024 * 2; u.aux = 0; u.bmode = pn < 4 ? 2 : 1; return true; }
    DI void offsA(const Unit&, int, const int (&R)[2], const int (&C)[2], unsigned (&v)[2][2]) const { pg8::dense_offs(2048, R, C, v); }
};
struct EpiIn {
    unsigned char* ws; bf16_t* glog; const float* bgate; const f32x2* rope;
    DI bool operator()(f32x4 (&acc)[2][2][4][2], const Unit& u, int wr, int wc, int fr, int fq) const {
        const int pn = u.pn;
        if (pn < 4) {
            bf16_t* dst = (bf16_t*)(ws + (pn < 2 ? WS_ZQ : WS_ZK)); const float sc = pn < 2 ? 1.0f : 0.08838834764831845f;
            const int half = wc >> 1, f0 = 16 * (wc & 1) + 4 * fq;
#pragma unroll
            EPI_LOOP_ROWS { const int row = u.pm * 256 + ai * 128 + wr * 64 + m * 16 + fr; const int t = row & (SEQ - 1); const int pos = half ? 256 + (t & 63) : (t >> 6);
                const f32x2* tb = rope + pos * 32 + f0; f32x2 cs[4];
#pragma unroll
                for (int j = 0; j < 4; ++j) cs[j] = tb[j];
#pragma unroll
                for (int bj = 0; bj < 2; ++bj) { const f32x4 x1 = acc[ai][bj][m][0], x2 = acc[ai][bj][m][1]; float o1[4], o2[4];
#pragma unroll
                    for (int j = 0; j < 4; ++j) { o1[j] = (x1[j] * cs[j][0] - x2[j] * cs[j][1]) * sc; o2[j] = (x1[j] * cs[j][1] + x2[j] * cs[j][0]) * sc; }
                    bf16_t* p = dst + (size_t)row * 512 + (pn & 1) * 256 + bj * 128 + 64 * half + f0;
                    u32x2 w1, w2; w1.x = cvt_pk_bf16(o1[0], o1[1]); w1.y = cvt_pk_bf16(o1[2], o1[3]); w2.x = cvt_pk_bf16(o2[0], o2[1]); w2.y = cvt_pk_bf16(o2[2], o2[3]);
                    *(u32x2*)p = w1; *(u32x2*)(p + 32) = w2; } }
            return false;
        }
        int act, ldd, cb; bf16_t* dst;
        if (pn < 8) { dst = (bf16_t*)(ws + WS_ZV); act = 0; ldd = 1024; cb = (pn - 4) * 256; }
        else if (pn < 12) { dst = (bf16_t*)(ws + WS_ZG); act = 1; ldd = 1024; cb = (pn - 8) * 256; }
        else if (pn < 16) { dst = (bf16_t*)(ws + WS_ZXL); act = 0; ldd = 1024; cb = (pn - 12) * 256; }
        else if (pn < 20) { dst = (bf16_t*)(ws + WS_ZGL); act = 2; ldd = 1024; cb = (pn - 16) * 256; }
        else { dst = glog; act = 3; ldd = 2048; cb = (pn - 20) * 256; }
#pragma unroll
        for (int bj = 0; bj < 2; ++bj) { const int col = cb + bj * 128 + wc * 32 + 8 * fq; f32x4 b0 = (f32x4){0.f, 0.f, 0.f, 0.f}, b1 = b0;
            if (act == 3) { b0 = *(const f32x4*)(bgate + col); b1 = *(const f32x4*)(bgate + col + 4); }
#pragma unroll
            EPI_LOOP_ROWS { const int row = u.pm * 256 + ai * 128 + wr * 64 + m * 16 + fr; f32x4 v0 = acc[ai][bj][m][0] + b0, v1 = acc[ai][bj][m][1] + b1;
                if (act == 1) {
#pragma unroll
                    for (int j = 0; j < 4; ++j) { v0[j] = silu_(v0[j]); v1[j] = silu_(v1[j]); } }
                if (act == 2) {
#pragma unroll
                    for (int j = 0; j < 4; ++j) { v0[j] = gelu_tanh(v0[j]); v1[j] = gelu_tanh(v1[j]); } }
                u32x4 w; w.x = cvt_pk_bf16(v0[0], v0[1]); w.y = cvt_pk_bf16(v0[2], v0[3]); w.z = cvt_pk_bf16(v1[0], v1[1]); w.w = cvt_pk_bf16(v1[2], v1[3]);
                *(u32x4*)(dst + (size_t)row * ldd + col) = w; } }
        return false;
    }
};

constexpr int R1_RSV = 576, R1_RSK = 320;
DI void r1_unit(LAS unsigned char* lds, const bf16_t* kp, int kld, const bf16_t* vp, int vld, int nrows, float lg2, int dir, float* outp) {
    const int tid = tid_fresh(), lane = tid & 63, wid = tid >> 6, h = lane >> 5;
    LAS unsigned char* Vt = lds; LAS unsigned char* Kw = lds + 64 * R1_RSV;
    const int mh = wid >> 2, nb = wid & 3;
    f32x16 acc[4];
#pragma unroll
    for (int mi = 0; mi < 4; ++mi) acc[mi] = zero16();
    const unsigned lb = (unsigned)((8 * h + ((lane & 15) >> 2))) , blk = (lane >> 4) & 1, p = lane & 3;
    const unsigned lbV = (unsigned)(size_t)Vt + lb * R1_RSV + 32 * blk + 8 * p + (128 * mh) * 2;
    const unsigned lbK = (unsigned)(size_t)Kw + lb * R1_RSK + 32 * blk + 8 * p + (32 * nb) * 2;
    for (int ch = 0; ch < nrows / 64; ++ch) {
        __syncthreads();
#pragma unroll
        for (int i = 0; i < 4; ++i) { const int pid = tid + 512 * i, row = pid >> 5, c16 = pid & 31;
            const u32x4 v = *(const u32x4*)(vp + (size_t)(64 * ch + row) * vld + c16 * 8); *(LAS u32x4*)(Vt + row * R1_RSV + c16 * 16) = v; }
#pragma unroll
        for (int i = 0; i < 2; ++i) { const int pid = tid + 512 * i, row = pid >> 4, c16 = pid & 15; const int jj = 64 * ch + row;
            const u32x4 kv = *(const u32x4*)(kp + (size_t)jj * kld + c16 * 8);
            const float w = ex2(lg2 * (float)(dir ? jj : nrows - 1 - jj));
            u32x4 o;
#pragma unroll
            for (int e = 0; e < 4; ++e) { const float lo = __uint_as_float(kv[e] << 16), hi = __uint_as_float(kv[e] & 0xffff0000u); o[e] = cvt_pk_bf16(lo * w, hi * w); }
            *(LAS u32x4*)(Kw + row * R1_RSK + c16 * 16) = o; }
        __syncthreads();
#pragma unroll
        for (int ks = 0; ks < 4; ++ks) {
            bf16x8 av[4]; tr_frag4<0, 64, 4 * R1_RSV>(lbV + ks * 16 * R1_RSV, av[0], av[1], av[2], av[3]);
            const bf16x8 bw = tr_frag<0, 4 * R1_RSK>(lbK + ks * 16 * R1_RSK);
#pragma unroll
            for (int mi = 0; mi < 4; ++mi) acc[mi] = MFMA32(av[mi], bw, acc[mi]);
        }
    }
    const int c = lane & 31;
    float* ob = outp + (size_t)(128 * mh + 4 * h) * 128 + 32 * nb + c;
#pragma unroll
    for (int mi = 0; mi < 4; ++mi)
#pragma unroll
        for (int i = 0; i < 16; ++i) ob[(32 * mi + (i & 3) + 8 * (i >> 2)) * 128] = acc[mi][i];
}

template <bool FULL, int DIR>
DI void lru_scan(f32x16 (&acc)[2][2], float Hin, f32x2* agg_out) {
    const int lane = tid_fresh() & 63, h = lane >> 5;
    float sA[8], sU[8];
#pragma unroll
    for (int s = 0; s < 8; ++s) { const int mb = s >> 2, g = s & 3; float A = 1.f, U = 0.f;
#pragma unroll
        for (int e = 0; e < 4; ++e) { const int i = 4 * g + (DIR == 0 ? e : 3 - e); U = acc[0][mb][i] * U + acc[1][mb][i]; A *= acc[0][mb][i]; }
        sA[s] = A; sU[s] = U; }
    float pA[8], pU[8];
#pragma unroll
    for (int s = 0; s < 8; ++s) { pA[s] = __shfl_xor(sA[s], 32); pU[s] = __shfl_xor(sU[s], 32); }
    const bool first = (h == (DIR == 0 ? 0 : 1));
    if (!FULL) {
        float A = 1.f, U = 0.f;
#pragma unroll
        for (int q = 0; q < 8; ++q) { const int s = DIR == 0 ? q : 7 - q;
            const float A1 = first ? sA[s] : pA[s], U1 = first ? sU[s] : pU[s], A2 = first ? pA[s] : sA[s], U2 = first ? pU[s] : sU[s];
            U = A1 * U + U1; A *= A1; U = A2 * U + U2; A *= A2; }
        if (h == 0) *agg_out = (f32x2){A, U};
    } else {
        float H = Hin;
        float st[8];
#pragma unroll
        for (int q = 0; q < 8; ++q) { const int s = DIR == 0 ? q : 7 - q;
            const float A1 = first ? sA[s] : pA[s], U1 = first ? sU[s] : pU[s], A2 = first ? pA[s] : sA[s], U2 = first ? pU[s] : sU[s];
            const float Hm = A1 * H + U1; st[s] = first ? H : Hm; H = A2 * Hm + U2; }
#pragma unroll
        for (int s = 0; s < 8; ++s) { const int mb = s >> 2, g = s & 3; float hv = st[s];
#pragma unroll
            for (int e = 0; e < 4; ++e) { const int i = 4 * g + (DIR == 0 ? e : 3 - e); hv = acc[0][mb][i] * hv + acc[1][mb][i]; acc[1][mb][i] = hv; } }
    }
}

constexpr int LX_RS = 272;
template <bool FULL>
DI void lru_run(const KArgs& a, LAS unsigned char* lds, int b, int n, int tile0, int ntiles, bool is_ctx) {
    const int tid = tid_fresh(), lane = tid & 63, wid = __builtin_amdgcn_readfirstlane(tid >> 6), h = lane >> 5, c = lane & 31;
    LAS unsigned char* raw = lds;
    LAS unsigned char* xcb = lds + 67 * LX_RS;
    LAS float* cw = (LAS float*)(xcb + 64 * LX_RS);
    LAS float* hfb = cw + 640;
    LAS float* hbb = hfb + 64 * 132;
    const int Ls = is_ctx ? CTXL : SEQ;
    const bf16_t* xl = is_ctx ? (const bf16_t*)(a.ws + WS_CTXX) + (size_t)(b * CTXL) * 1024 + 128 * n : (const bf16_t*)(a.ws + WS_ZXL) + (size_t)(b * SEQ) * 1024 + 128 * n;
    const int dir = wid >> 2, nq = wid & 3, gc = 128 * n + 32 * nq + c;
    __syncthreads();
    for (int i = tid; i < 640; i += 512) { const int k = i >> 7, ch = i & 127; cw[i] = k < 4 ? a.in[I_CONVW][k * 1024 + 128 * n + ch] : a.in[I_CONVB][128 * n + ch]; }
    bf16x8 Bw[2][8];
    {   const bf16_t* wa = (const bf16_t*)(a.ws + WS_WLB) + (size_t)((2 * dir) * 8 + n) * 128 * 128 + (size_t)(32 * nq + c) * 128 + 8 * h;
#pragma unroll
        for (int ks = 0; ks < 8; ++ks) { Bw[0][ks] = *(const bf16x8*)(wa + 16 * ks); Bw[1][ks] = *(const bf16x8*)(wa + (size_t)8 * 128 * 128 + 16 * ks); } }
    const float ba2 = -LOG2E * a.in[I_LBA][dir * 1024 + gc], bx2 = -LOG2E * a.in[I_LBX][dir * 1024 + gc];
    const float cl = -8.0f * softplus_(-a.in[I_LLAM][dir * 1024 + gc]) * LOG2E;
    const size_t chain0 = ((size_t)(b * 2 + dir) * 1024 + gc) * NSLOT;
    u32x4 pre[3];
#define LRU_LOADRAW(tile_) do { _Pragma("unroll") for (int i_ = 0; i_ < 3; ++i_) { const int pid_ = tid + 512 * i_; pre[i_] = (u32x4){0u, 0u, 0u, 0u}; \
        if (pid_ < 67 * 16) { const int t_ = (tile_) * LT + (pid_ >> 4) - 1; if (t_ >= 0 && t_ < Ls) pre[i_] = *(const u32x4*)(xl + (size_t)t_ * 1024 + (pid_ & 15) * 8); } } } while (0)
    LRU_LOADRAW(tile0);
    for (int it = 0; it < ntiles; ++it) {
        const int tile = tile0 + it, t0 = tile * LT;
#pragma unroll
        for (int i = 0; i < 3; ++i) { const int pid = tid + 512 * i; if (pid < 67 * 16) *(LAS u32x4*)(raw + (pid >> 4) * LX_RS + (pid & 15) * 16) = pre[i]; }
        if (it + 1 < ntiles) LRU_LOADRAW(tile + 1);
        const int slot = is_ctx ? (dir == 0 ? tile : 3 - tile) : (dir == 0 ? 4 + tile : 4 + (NLT - 1 - tile));
        float Hin = 0.f; if (FULL) Hin = ((const float*)(a.ws + WS_LHIN))[chain0 + slot];
        u32x4 gpre[2]; bf16_t* gtile = (bf16_t*)(a.ws + WS_ZGL) + (size_t)(b * SEQ + t0) * 1024 + 128 * n;
        if (FULL) {
#pragma unroll
            for (int i = 0; i < 2; ++i) { const int pid = tid + 512 * i; gpre[i] = *(const u32x4*)(gtile + (size_t)(pid >> 4) * 1024 + (pid & 15) * 8); } }
        lds_barrier();
        {
            const int row = tid >> 3, c0 = (tid & 7) * 16; float o[16];
#pragma unroll
            for (int j = 0; j < 16; j += 4) { const f32x4 bv = *(const LAS f32x4*)(cw + 512 + c0 + j); o[j] = bv[0]; o[j + 1] = bv[1]; o[j + 2] = bv[2]; o[j + 3] = bv[3]; }
#pragma unroll
            for (int k = 0; k < 4; ++k) { const u32x4 p0 = *(const LAS u32x4*)(raw + (row + k) * LX_RS + c0 * 2), p1 = *(const LAS u32x4*)(raw + (row + k) * LX_RS + c0 * 2 + 16);
#pragma unroll
                for (int e = 0; e < 4; ++e) { const f32x4 w0 = *(const LAS f32x4*)(cw + k * 128 + c0 + 4 * (e >> 1) ), w1 = *(const LAS f32x4*)(cw + k * 128 + c0 + 8 + 4 * (e >> 1));
                    o[2 * e] += w0[2 * (e & 1)] * __uint_as_float(p0[e] << 16); o[2 * e + 1] += w0[2 * (e & 1) + 1] * __uint_as_float(p0[e] & 0xffff0000u);
                    o[8 + 2 * e] += w1[2 * (e & 1)] * __uint_as_float(p1[e] << 16); o[8 + 2 * e + 1] += w1[2 * (e & 1) + 1] * __uint_as_float(p1[e] & 0xffff0000u); } }
            u32x4 w0, w1;
#pragma unroll
            for (int e = 0; e < 4; ++e) { w0[e] = cvt_pk_bf16(o[2 * e], o[2 * e + 1]); w1[e] = cvt_pk_bf16(o[8 + 2 * e], o[8 + 2 * e + 1]); }
            *(LAS u32x4*)(xcb + row * LX_RS + c0 * 2) = w0; *(LAS u32x4*)(xcb + row * LX_RS + c0 * 2 + 16) = w1;
        }
        lds_barrier();
        f32x16 acc[2][2];
#pragma unroll
        for (int q = 0; q < 2; ++q) for (int mb = 0; mb < 2; ++mb) acc[q][mb] = zero16();
#pragma unroll
        for (int ks = 0; ks < 8; ++ks) {
            const bf16x8 a0 = *(const LAS bf16x8*)(xcb + c * LX_RS + (16 * ks + 8 * h) * 2), a1 = *(const LAS bf16x8*)(xcb + (32 + c) * LX_RS + (16 * ks + 8 * h) * 2);
            acc[0][0] = MFMA32(a0, Bw[0][ks], acc[0][0]); acc[0][1] = MFMA32(a1, Bw[0][ks], acc[0][1]); acc[1][0] = MFMA32(a0, Bw[1][ks], acc[1][0]); acc[1][1] = MFMA32(a1, Bw[1][ks], acc[1][1]);
        }
#pragma unroll
        for (int mb = 0; mb < 2; ++mb)
#pragma unroll
            for (int i = 0; i < 16; ++i) { const int row = 32 * mb + crow(i, h);
                const float r = rcpf_(1.0f + ex2(acc[0][mb][i] + ba2)), ig = rcpf_(1.0f + ex2(acc[1][mb][i] + bx2));
                const float av = ex2(cl * r); const float s = __builtin_amdgcn_sqrtf(__builtin_fmaf(-av, av, 1.0f));
                acc[0][mb][i] = av; acc[1][mb][i] = s * ig * bf2f(*(const LAS bf16_t*)(xcb + row * LX_RS + (32 * nq + c) * 2)); }
        f32x2* aggp = (f32x2*)(a.ws + WS_LAGG) + chain0 + slot;
        if (dir == 0) lru_scan<FULL, 0>(acc, Hin, aggp); else lru_scan<FULL, 1>(acc, Hin, aggp);
        if (FULL) {
            LAS float* hd = dir == 0 ? hfb : hbb;
#pragma unroll
            for (int mb = 0; mb < 2; ++mb)
#pragma unroll
                for (int i = 0; i < 16; ++i) hd[(32 * mb + crow(i, h)) * 132 + 32 * nq + c] = acc[1][mb][i];
            lds_barrier();
#pragma unroll
            for (int i = 0; i < 2; ++i) { const int pid = tid + 512 * i, row = pid >> 4, c8 = (pid & 15) * 8;
                const f32x4 f0 = *(const LAS f32x4*)(hfb + row * 132 + c8), f1 = *(const LAS f32x4*)(hfb + row * 132 + c8 + 4), b0 = *(const LAS f32x4*)(hbb + row * 132 + c8), b1 = *(const LAS f32x4*)(hbb + row * 132 + c8 + 4);
                const u32x4 g = gpre[i]; u32x4 o;
                o[0] = cvt_pk_bf16((f0[0] + b0[0]) * __uint_as_float(g[0] << 16), (f0[1] + b0[1]) * __uint_as_float(g[0] & 0xffff0000u));
                o[1] = cvt_pk_bf16((f0[2] + b0[2]) * __uint_as_float(g[1] << 16), (f0[3] + b0[3]) * __uint_as_float(g[1] & 0xffff0000u));
                o[2] = cvt_pk_bf16((f1[0] + b1[0]) * __uint_as_float(g[2] << 16), (f1[1] + b1[1]) * __uint_as_float(g[2] & 0xffff0000u));
                o[3] = cvt_pk_bf16((f1[2] + b1[2]) * __uint_as_float(g[3] << 16), (f1[3] + b1[3]) * __uint_as_float(g[3] & 0xffff0000u));
                *(u32x4*)(gtile + (size_t)row * 1024 + c8) = o; }
        }
    }
#undef LRU_LOADRAW
}

DI void ret_decays(const KArgs& a, int h, float& lgf2, float& lgb2) {
    const float* rd = (const float*)(a.ws + WS_RDEC); lgf2 = rd[h]; lgb2 = rd[4 + h];
}

DI void phase2a(const KArgs& a, LAS unsigned char* lds) {
    const int G = gridDim.x;
    constexpr int NU_R1 = NB_ * NH * NSC * 2, NU_CK = NB_ * NH * 2, NU_LX = NB_ * 8 * 16, NU_LC = NB_ * 8;
    for (int u = blockIdx.x; u < NU_R1 + NU_CK + NU_LX + NU_LC; u += G) {
        if (SUBSEL(1) && u < NU_R1) {
            const int w = u & 255, uu = (u & ~255) + 2 * ((w & 7) + 8 * (w >> 4)) + ((w >> 3) & 1);
            const int dir = uu & 1, sc = (uu >> 1) & 31, h = (uu >> 6) & 3, b = uu >> 8; float lgf2, lgb2; ret_decays(a, h, lgf2, lgb2);
            float* o = (float*)(a.ws + WS_HX) + (size_t)(((b * 4 + h) * 32 + sc) * 2 + dir) * 32768;
            PB(100); r1_unit(lds, (const bf16_t*)(a.ws + WS_ZK) + (size_t)(b * SEQ + sc * SCH) * 512 + h * 128, 512, (const bf16_t*)(a.ws + WS_ZV) + (size_t)(b * SEQ + sc * SCH) * 1024 + h * 256, 1024, SCH, dir ? lgb2 : lgf2, dir, o); PE(100);
        } else if (SUBSEL(1) && u < NU_R1 + NU_CK) {
            const int q = u - NU_R1, dir = q & 1, h = (q >> 1) & 3, b = q >> 3; float lgf2, lgb2; ret_decays(a, h, lgf2, lgb2);
            float* o = (float*)(a.ws + WS_CTXS) + (size_t)((b * 4 + h) * 2 + dir) * 32768;
            r1_unit(lds, (const bf16_t*)(a.ws + WS_CTXK) + (size_t)(b * CTXL) * 512 + h * 128, 512, (const bf16_t*)(a.ws + WS_CTXV) + (size_t)(b * CTXL) * 1024 + h * 256, 1024, CTXL, dir ? lgb2 : lgf2, dir, o);
        } else if (SUBSEL(2) && u < NU_R1 + NU_CK + NU_LX) {
            const int q = u - NU_R1 - NU_CK, b = q >> 7, n = (q >> 4) & 7, r = q & 15;
            PB(101); lru_run<false>(a, lds, b, n, 16 * r, 16, false); PE(101);
        } else if (SUBSEL(2)) {
            const int q = u - NU_R1 - NU_CK - NU_LX, b = q >> 3, n = q & 7;
            lru_run<false>(a, lds, b, n, 0, 4, true);
        }
    }
}

DI void phase2b(const KArgs& a) {
    const int tid = tid_fresh(), G = gridDim.x, lane = tid & 63, wid = tid >> 6;
    for (int e = blockIdx.x * 512 + tid; e < NB_ * NH * 2 * 8192; e += G * 512) {
        const int e4 = e & 8191, dir = (e >> 13) & 1, h = (e >> 14) & 3, b = e >> 16;
        float lgf2, lgb2; ret_decays(a, h, lgf2, lgb2); const float gC = ex2((dir ? lgb2 : lgf2) * (float)SCH);
        f32x4 S = *(const f32x4*)((const float*)(a.ws + WS_CTXS) + (size_t)((b * 4 + h) * 2 + dir) * 32768 + 4 * e4);
        const float* kv = (const float*)(a.ws + WS_HX) + (size_t)((b * 4 + h) * 32 * 2 + dir) * 32768 + 4 * e4;
        bf16_t* so = (bf16_t*)(a.ws + WS_SBF) + (size_t)((b * 4 + h) * 32 * 2 + dir) * 32768 + 4 * e4;
        for (int s0 = 0; s0 < NSC; s0 += 8) {
            f32x4 kvv[8];
#pragma unroll
            for (int j = 0; j < 8; ++j) { const int sc = dir ? NSC - 1 - (s0 + j) : s0 + j; kvv[j] = *(const f32x4*)(kv + (size_t)sc * 65536); }
#pragma unroll
            for (int j = 0; j < 8; ++j) { const int sc = dir ? NSC - 1 - (s0 + j) : s0 + j;
                u32x2 w; w.x = cvt_pk_bf16(S[0], S[1]); w.y = cvt_pk_bf16(S[2], S[3]); *(u32x2*)(so + (size_t)sc * 65536) = w;
                S = S * gC + kvv[j]; }
        }
    }
    for (int ch = blockIdx.x * 8 + wid; ch < NB_ * 2 * 1024; ch += G * 8) {
        const f32x2* ag = (const f32x2*)(a.ws + WS_LAGG) + (size_t)ch * NSLOT; float* hin = (float*)(a.ws + WS_LHIN) + (size_t)ch * NSLOT;
        float carry = 0.f;
        for (int rd = 0; rd < 5; ++rd) { const int slot = 64 * rd + lane;
            f32x2 v = (f32x2){1.f, 0.f}; if (slot < 4 + NLT) v = ag[slot];
            float A = v[0], U = v[1];
#pragma unroll
            for (int o = 1; o < 64; o <<= 1) { const float Ap = __shfl_up(A, o), Up = __shfl_up(U, o); if (lane >= o) { U = A * Up + U; A = A * Ap; } }
            const float incl = A * carry + U;
            float excl = __shfl_up(incl, 1); if (lane == 0) excl = carry;
            if (slot < 4 + NLT) hin[slot] = excl;
            carry = __shfl(incl, 63);
        }
    }
}

constexpr int R3_KB = 16384, R3_VB = 32768;
template <int O, int T> DI void tr_frag2x2(unsigned a0, unsigned a1, bf16x8& f0, bf16x8& f1, bf16x8& f2, bf16x8& f3) {
    s16x4 r0, r1, r2, r3, r4, r5, r6, r7;
    asm volatile("ds_read_b64_tr_b16 %0, %8 offset:%10\n\tds_read_b64_tr_b16 %1, %8 offset:%11\n\t"
                 "ds_read_b64_tr_b16 %2, %8 offset:%12\n\tds_read_b64_tr_b16 %3, %8 offset:%13\n\t"
                 "ds_read_b64_tr_b16 %4, %9 offset:%10\n\tds_read_b64_tr_b16 %5, %9 offset:%11\n\t"
                 "ds_read_b64_tr_b16 %6, %9 offset:%12\n\tds_read_b64_tr_b16 %7, %9 offset:%13\n\ts_waitcnt lgkmcnt(0)"
                 : "=&v"(r0), "=&v"(r1), "=&v"(r2), "=&v"(r3), "=&v"(r4), "=&v"(r5), "=&v"(r6), "=&v"(r7)
                 : "v"(a0), "v"(a1), "i"(O), "i"(O + T), "i"(O + 256), "i"(O + 256 + T) : "memory");
    f0 = __builtin_shufflevector(r0, r1, 0, 1, 2, 3, 4, 5, 6, 7); f1 = __builtin_shufflevector(r2, r3, 0, 1, 2, 3, 4, 5, 6, 7);
    f2 = __builtin_shufflevector(r4, r5, 0, 1, 2, 3, 4, 5, 6, 7); f3 = __builtin_shufflevector(r6, r7, 0, 1, 2, 3, 4, 5, 6, 7);
}
DI bf16x8 scale_frag(bf16x8 f, float s) { const u32x4 u = __builtin_bit_cast(u32x4, f); u32x4 o;
#pragma unroll
    for (int e = 0; e < 4; ++e) o[e] = cvt_pk_bf16(__uint_as_float(u[e] << 16) * s, __uint_as_float(u[e] & 0xffff0000u) * s);
    return __builtin_bit_cast(bf16x8, o); }
#define GLDS16(gp, lp) __builtin_amdgcn_global_load_lds((const unsigned*)(gp), (LAS unsigned*)(lp), 16, 0, 0)

DI void r3_unit(const KArgs& a, LAS unsigned char* lds, int b, int hh, int qb2) {
    const int tid = tid_fresh(), lane = tid & 63, wid = __builtin_amdgcn_readfirstlane(tid >> 6), h = lane >> 5, c = lane & 31;
    const int sc = qb2 >> 1, qpos = 256 * (qb2 & 1) + 32 * wid + c;
    float lgf2, lgb2; ret_decays(a, hh, lgf2, lgb2);
    const size_t tokS = (size_t)b * SEQ + SCH * sc, tokQ = tokS + qpos;
    LAS unsigned char* R0 = lds; LAS unsigned char* R1 = lds + 65536;
    const bf16_t* zk = (const bf16_t*)(a.ws + WS_ZK) + tokS * 512 + hh * 128; const bf16_t* zv = (const bf16_t*)(a.ws + WS_ZV) + tokS * 1024 + hh * 256;
    const unsigned wl = (unsigned)wid * 1024u;
    const unsigned soff = (unsigned)((tid >> 4) * 256 + (((tid & 15) ^ ((tid >> 4) & 15)) << 4));
    const unsigned koff = (unsigned)((tid >> 4) * 1024 + (((tid & 15) ^ ((tid >> 4) & 15)) << 4));
    const unsigned voff = (unsigned)((tid >> 5) * 2048 + (((tid & 31) ^ (((tid >> 5) & 3) << 2)) << 4));
#define R3_STAGE_KV(jb_, buf_) do { const char* kb_ = (const char*)zk + (size_t)(jb_) * 65536; const char* vb_ = (const char*)zv + (size_t)(jb_) * 131072; \
        _Pragma("unroll") for (int i_ = 0; i_ < 2; ++i_) GLDS16(kb_ + i_ * 32768 + koff, (buf_) + i_ * 8192 + wl); \
        _Pragma("unroll") for (int i_ = 0; i_ < 4; ++i_) GLDS16(vb_ + i_ * 32768 + voff, (buf_) + R3_KB + i_ * 8192 + wl); } while (0)
    __syncthreads();
    PB(110);
#pragma unroll
    for (int d = 0; d < 2; ++d) { const char* Sg = (const char*)((const bf16_t*)(a.ws + WS_SBF) + (size_t)(((b * 4 + hh) * 32 + sc) * 2 + d) * 32768);
#pragma unroll
        for (int i = 0; i < 8; ++i) GLDS16(Sg + i * 8192 + soff, (d ? R1 : R0) + i * 8192 + wl); }
    bf16x8 Qf[8];
    {   const bf16_t* qp = (const bf16_t*)(a.ws + WS_ZQ) + tokQ * 512 + hh * 128 + 8 * h;
#pragma unroll
        for (int ks = 0; ks < 8; ++ks) Qf[ks] = *(const bf16x8*)(qp + 16 * ks); }
    f32x16 OT[8];
#pragma unroll
    for (int nb = 0; nb < 8; ++nb) OT[nb] = zero16();
    const unsigned xq = (unsigned)(c & 15), rowb = (unsigned)c * 256u;
    float cf8[4], cfe[4], cb8[4], cbe[4];
#pragma unroll
    for (int k = 1; k < 4; ++k) { cf8[k] = __int_as_float(__builtin_amdgcn_readfirstlane(__float_as_int(ex2(-lgf2 * (float)(8 * k))))); cfe[k] = __int_as_float(__builtin_amdgcn_readfirstlane(__float_as_int(ex2(-lgf2 * (float)k))));
        cb8[k] = __int_as_float(__builtin_amdgcn_readfirstlane(__float_as_int(ex2(lgb2 * (float)(8 * k))))); cbe[k] = __int_as_float(__builtin_amdgcn_readfirstlane(__float_as_int(ex2(lgb2 * (float)k)))); }
    const int q0 = 256 * (qb2 & 1) + 32 * wid;
#pragma unroll
    for (int d = 0; d < 2; ++d) {
        if (d == 0) asm volatile("s_waitcnt vmcnt(16)" ::: "memory"); else asm volatile("s_waitcnt vmcnt(6)" ::: "memory");
        __builtin_amdgcn_s_barrier(); asm volatile("" ::: "memory");
        const float dec = d == 0 ? ex2(lgf2 * (float)(qpos + 1)) : ex2(lgb2 * (float)(SCH - qpos));
        const unsigned Sb = (unsigned)(size_t)(d ? R1 : R0) + rowb;
#pragma unroll
        for (int ks = 0; ks < 8; ++ks) { bf16x8 qf = Qf[ks]; asm volatile("" : "+v"(qf));
            const bf16x8 qs = scale_frag(qf, dec); const unsigned co = (((unsigned)(2 * ks + h)) ^ xq) << 4;
#pragma unroll
            for (int nb = 0; nb < 8; ++nb) { const bf16x8 sf = *(const LAS bf16x8*)(size_t)(Sb + 32 * 256 * nb + co); OT[nb] = MFMA32(sf, qs, OT[nb]); if (nb == 3) asm volatile("" ::: "memory"); }
            asm volatile("" ::: "memory"); }
        if (d == 0) { lds_barrier(); R3_STAGE_KV(0, R0); }
    }
    PE(110); PB(111);
    const unsigned q4 = (unsigned)((lane & 15) >> 2), vlane = (unsigned)(4 * h + q4) * 512u + 32u * ((lane >> 4) & 1) + 8u * (lane & 3);
#pragma unroll 1
    for (int jb = 0; jb < 8; ++jb) {
        LAS unsigned char* buf = (jb & 1) ? R1 : R0;
        asm volatile("s_waitcnt vmcnt(0)" ::: "memory");
        lds_barrier();
        if (jb + 1 < 8) { if (jb & 1) R3_STAGE_KV(jb + 1, R0); else R3_STAGE_KV(jb + 1, R1); }
        const unsigned Kb = (unsigned)(size_t)buf + rowb, Vb = (unsigned)(size_t)buf + R3_KB + vlane;
#pragma unroll
        for (int jt = 0; jt < 2; ++jt) {
            f32x16 st = zero16();
#pragma unroll
            for (int ks = 0; ks < 8; ++ks) { const bf16x8 kf = *(const LAS bf16x8*)(size_t)(Kb + 32 * 256 * jt + ((((unsigned)(2 * ks + h)) ^ xq) << 4)); st = MFMA32(kf, Qf[ks], st); }
            const int k0 = 64 * jb + 32 * jt;
            if (k0 == q0) {
#pragma unroll
                for (int i = 0; i < 16; ++i) { const int dd = qpos - (k0 + (i & 3) + 8 * (i >> 2) + 4 * h); st[i] *= (dd >= 0 ? ex2(lgf2 * (float)dd) : ex2(lgb2 * (float)(-dd))); }
            } else if (k0 < q0) { const float bh = ex2(lgf2 * (float)(q0 - k0 + c - 4 * h));
#pragma unroll
                for (int i = 0; i < 16; ++i) { float w = bh; if (i >> 2) w *= cf8[i >> 2]; if (i & 3) w *= cfe[i & 3]; st[i] *= w; }
            } else { const float bh = ex2(lgb2 * (float)(k0 - q0 + 4 * h - c));
#pragma unroll
                for (int i = 0; i < 16; ++i) { float w = bh; if (i >> 2) w *= cb8[i >> 2]; if (i & 3) w *= cbe[i & 3]; st[i] *= w; }
            }
#pragma unroll
            for (int s2 = 0; s2 < 2; ++s2) { u32x4 pk;
#pragma unroll
                for (int e = 0; e < 4; ++e) pk[e] = cvt_pk_bf16(st[8 * s2 + 2 * e], st[8 * s2 + 2 * e + 1]);
                const bf16x8 pb = __builtin_bit_cast(bf16x8, pk);
#pragma unroll
                for (int hf = 0; hf < 2; ++hf) {
                    bf16x8 v0, v1, v2, v3; const unsigned a0 = Vb + 64u * ((unsigned)(2 * hf) ^ q4), a1 = Vb + 64u * ((unsigned)(2 * hf + 1) ^ q4);
                    if (jt == 0 && s2 == 0) tr_frag2x2<0, 4096>(a0, a1, v0, v1, v2, v3);
                    if (jt == 0 && s2 == 1) tr_frag2x2<8192, 4096>(a0, a1, v0, v1, v2, v3);
                    if (jt == 1 && s2 == 0) tr_frag2x2<16384, 4096>(a0, a1, v0, v1, v2, v3);
                    if (jt == 1 && s2 == 1) tr_frag2x2<24576, 4096>(a0, a1, v0, v1, v2, v3);
                    OT[2 * hf] = MFMA32(v0, pb, OT[2 * hf]); OT[2 * hf + 4] = MFMA32(v1, pb, OT[2 * hf + 4]);
                    OT[2 * hf + 1] = MFMA32(v2, pb, OT[2 * hf + 1]); OT[2 * hf + 5] = MFMA32(v3, pb, OT[2 * hf + 5]);
                }
            }
        }
    }
    PE(111); PB(112);
    float s1 = 0.f, s2 = 0.f;
#pragma unroll
    for (int nb = 0; nb < 8; ++nb)
#pragma unroll
        for (int i = 0; i < 16; ++i) { s1 += OT[nb][i]; s2 += OT[nb][i] * OT[nb][i]; }
    s1 += __shfl_xor(s1, 32); s2 += __shfl_xor(s2, 32);
    const float mu = s1 * (1.0f / 256.0f), rstd = rsqrtf(fmaxf(s2 * (1.0f / 256.0f) - mu * mu, 0.f) + EPSV);
    lds_barrier();
    {   const int t2 = tid_fresh(), l2 = t2 & 63, w2 = t2 >> 6, h2 = l2 >> 5, c2 = l2 & 31;
        LAS unsigned char* slab = lds + (size_t)w2 * 16896;
#pragma unroll
        for (int nb = 0; nb < 8; ++nb)
#pragma unroll
            for (int g = 0; g < 4; ++g) { u32x2 o; o.x = cvt_pk_bf16((OT[nb][4 * g] - mu) * rstd, (OT[nb][4 * g + 1] - mu) * rstd); o.y = cvt_pk_bf16((OT[nb][4 * g + 2] - mu) * rstd, (OT[nb][4 * g + 3] - mu) * rstd);
                *(LAS u32x2*)(slab + c2 * 528 + (32 * nb + 8 * g + 4 * h2) * 2) = o; }
        bf16_t* gp = (bf16_t*)(a.ws + WS_ZG) + ((size_t)b * SEQ + SCH * sc + 256 * (qb2 & 1) + 32 * w2) * 1024 + hh * 256 + 8 * c2;
        const f32x4 gn0 = *(const f32x4*)(a.in[I_RNORM] + hh * 256 + 8 * c2), gn1 = *(const f32x4*)(a.in[I_RNORM] + hh * 256 + 8 * c2 + 4);
        u32x4 sg[16];
#pragma unroll
        for (int r = 0; r < 16; ++r) sg[r] = *(const u32x4*)(gp + (size_t)(2 * r + h2) * 1024);
        lds_wait();
#pragma unroll
        for (int r = 0; r < 16; ++r) { const u32x4 y = *(const LAS u32x4*)(slab + (2 * r + h2) * 528 + c2 * 16); u32x4 o;
            o[0] = cvt_pk_bf16(__uint_as_float(y[0] << 16) * gn0[0] * __uint_as_float(sg[r][0] << 16), __uint_as_float(y[0] & 0xffff0000u) * gn0[1] * __uint_as_float(sg[r][0] & 0xffff0000u));
            o[1] = cvt_pk_bf16(__uint_as_float(y[1] << 16) * gn0[2] * __uint_as_float(sg[r][1] << 16), __uint_as_float(y[1] & 0xffff0000u) * gn0[3] * __uint_as_float(sg[r][1] & 0xffff0000u));
            o[2] = cvt_pk_bf16(__uint_as_float(y[2] << 16) * gn1[0] * __uint_as_float(sg[r][2] << 16), __uint_as_float(y[2] & 0xffff0000u) * gn1[1] * __uint_as_float(sg[r][2] & 0xffff0000u));
            o[3] = cvt_pk_bf16(__uint_as_float(y[3] << 16) * gn1[2] * __uint_as_float(sg[r][3] << 16), __uint_as_float(y[3] & 0xffff0000u) * gn1[3] * __uint_as_float(sg[r][3] & 0xffff0000u));
            *(u32x4*)(gp + (size_t)(2 * r + h2) * 1024) = o; }
    }
    PE(112);
#undef R3_STAGE_KV
}

DI void phase2c(const KArgs& a, LAS unsigned char* lds) {
    const int G = gridDim.x;
    constexpr int NU_R3 = NB_ * NH * (SEQ / 256), NU_L3 = NB_ * 8 * 16;
    for (int u = blockIdx.x; u < NU_R3 + NU_L3; u += G) {
        if (SUBSEL(1) && u < NU_R3) { const int w = u & 255, uu = (u & ~255) + 2 * ((w & 7) + 8 * (w >> 4)) + ((w >> 3) & 1);
            const int b = uu >> 8, hh = (uu >> 6) & 3, qb2 = uu & 63; PB(102); r3_unit(a, lds, b, hh, qb2); PE(102); }
        else if (SUBSEL(2)) { const int q = u - NU_R3, b = q >> 7, n = (q >> 4) & 7, r = q & 15; PB(103); lru_run<true>(a, lds, b, n, 16 * r, 16, false); PE(103); }
    }
}

DI void cvt4_decode(const KArgs& a, int t, const float*& src, int& ld_src, unsigned char*& dst, size_t& hi_stride, int& ld_dst) {
    constexpr int T_GU = 32 * 2 * 16 * 3;
    if (t < T_GU) { const int e = t / 96, r = t % 96, mat = r / 48, kt = (r % 48) / 3, ng = r % 3;
        src = a.in[mat ? I_WEU : I_WEG] + (size_t)e * 1024 * 768 + (size_t)(64 * kt) * 768 + 256 * ng; ld_src = 768;
        dst = (unsigned char*)(a.ws + WS_WGU) + ((size_t)(e * 6 + 2 * ng) * 256 + mat * 128) * 1024 + 64 * kt; hi_stride = (size_t)256 * 1024; ld_dst = 1024;
    } else { const int q = t - T_GU, e = q / 48, r = q % 48, kt = r / 4, ng = r % 4;
        src = a.in[I_WED] + (size_t)e * 768 * 1024 + (size_t)(64 * kt) * 1024 + 256 * ng; ld_src = 1024;
        dst = (unsigned char*)(a.ws + WS_WDN) + ((size_t)e * 1024 + 256 * ng) * 768 + 64 * kt; hi_stride = (size_t)128 * 768; ld_dst = 768; }
}
DI void phase3_cvt(const KArgs& a, LAS unsigned char* lds) {
    const int G = gridDim.x, tid = tid_fresh(); LAS float* tile = (LAS float*)lds;
    constexpr int T_ALL = 32 * 2 * 16 * 3 + 32 * 12 * 4;
    const float* src; int ld_src; unsigned char* dA; size_t hA; int ldA; unsigned char* dB = nullptr; size_t hB = 0; int ldB = 0;
    f32x4 va[8], vb[8];
#define CVT_LOAD(v_, t_, d_, h_, l_) do { cvt4_decode(a, (t_), src, ld_src, d_, h_, l_); _Pragma("unroll") for (int i_ = 0; i_ < 8; ++i_) v_[i_] = *(const f32x4*)(src + (size_t)((tid >> 6) + 8 * i_) * ld_src + 4 * (tid & 63)); } while (0)
#define CVT_EMIT(v_, d_, h_, l_) do { lds_barrier(); _Pragma("unroll") for (int i_ = 0; i_ < 8; ++i_) *(LAS f32x4*)(tile + ((tid >> 6) + 8 * i_) * 260 + 4 * (tid & 63)) = v_[i_]; } while (0)
#define CVT_STORE(d_, h_, l_) do { lds_barrier(); const int n_ = tid & 255, kh_ = tid >> 8; unsigned char* p_ = (d_) + (size_t)(n_ >> 7) * (h_) + (size_t)(n_ & 127) * (l_) + 32 * kh_; \
        _Pragma("unroll") for (int q_ = 0; q_ < 2; ++q_) { float x_[16]; _Pragma("unroll") for (int j_ = 0; j_ < 16; ++j_) x_[j_] = tile[(32 * kh_ + 16 * q_ + j_) * 260 + n_] * 64.0f; \
            u32x4 w_; w_.x = cvt4_fp8(x_[0], x_[1], x_[2], x_[3]); w_.y = cvt4_fp8(x_[4], x_[5], x_[6], x_[7]); w_.z = cvt4_fp8(x_[8], x_[9], x_[10], x_[11]); w_.w = cvt4_fp8(x_[12], x_[13], x_[14], x_[15]); \
            *(u32x4*)(p_ + 16 * q_) = w_; } } while (0)
    int t = blockIdx.x; if (t >= T_ALL) return;
    CVT_LOAD(va, t, dA, hA, ldA);
    if (t + G < T_ALL) CVT_LOAD(vb, t + G, dB, hB, ldB);
    for (;;) {
        { unsigned char* d0 = dA; const size_t h0 = hA; const int l0 = ldA; CVT_EMIT(va, d0, h0, l0); if (t + 2 * G < T_ALL) CVT_LOAD(va, t + 2 * G, dA, hA, ldA); CVT_STORE(d0, h0, l0); }
        t += G; if (t >= T_ALL) break;
        { unsigned char* d0 = dB; const size_t h0 = hB; const int l0 = ldB; CVT_EMIT(vb, d0, h0, l0); if (t + 2 * G < T_ALL) CVT_LOAD(vb, t + 2 * G, dB, hB, ldB); CVT_STORE(d0, h0, l0); }
        t += G; if (t >= T_ALL) break;
    }
#undef CVT_LOAD
#undef CVT_EMIT
#undef CVT_STORE
    __syncthreads();
}
struct OrderMerge {
    const char* A0; const char* A1; const char* B0; const char* B1; int G, c;
    DI bool next(int i, Unit& u) const { int pm, pn; if (!pg8::static_tile(i >> 1, G, c, NT / 256, 4, pm, pn)) return false;
        const int st = i & 1; u.pm = pm; u.pn = pn; u.aux = st; u.bmode = 1; u.A = (st ? A1 : A0) + (size_t)pm * 256 * 1024 * 2; u.B = (st ? B1 : B0) + (size_t)pn * 256 * 1024 * 2; return true; }
    DI void offsA(const Unit&, int, const int (&R)[2], const int (&C)[2], unsigned (&v)[2][2]) const { pg8::dense_offs(2048, R, C, v); }
};
struct EpiMerge {
    const bf16_t* glog; bf16_t* out;
    DI bool operator()(f32x4 (&acc)[2][2][4][2], const Unit& u, int wr, int wc, int fr, int fq) const {
#pragma unroll
        for (int bj = 0; bj < 2; ++bj) { const int col = u.pn * 256 + bj * 128 + wc * 32 + 8 * fq;
#pragma unroll
            EPI_LOOP_ROWS { const int row = u.pm * 256 + ai * 128 + wr * 64 + m * 16 + fr;
                const u32x4 gl = *(const u32x4*)(glog + (size_t)row * 2048 + 1024 + col);
                if (u.aux == 0) { const u32x4 gr = *(const u32x4*)(glog + (size_t)row * 2048 + col);
#pragma unroll
                    for (int e = 0; e < 4; ++e) { const float r0 = __uint_as_float(gr[e] << 16), r1 = __uint_as_float(gr[e] & 0xffff0000u), l0 = __uint_as_float(gl[e] << 16), l1 = __uint_as_float(gl[e] & 0xffff0000u);
                        const float q0 = (1.0f + ex2(-LOG2E * l0)) * rcpf_(1.0f + ex2(-LOG2E * r0)), q1 = (1.0f + ex2(-LOG2E * l1)) * rcpf_(1.0f + ex2(-LOG2E * r1));
                        acc[ai][bj][m][e >> 1][2 * (e & 1)] *= q0; acc[ai][bj][m][e >> 1][2 * (e & 1) + 1] *= q1; }
                } else { float v[8];
#pragma unroll
                    for (int e = 0; e < 4; ++e) { const float l0 = __uint_as_float(gl[e] << 16), l1 = __uint_as_float(gl[e] & 0xffff0000u);
                        v[2 * e] = acc[ai][bj][m][e >> 1][2 * (e & 1)] * sigm(l0); v[2 * e + 1] = acc[ai][bj][m][e >> 1][2 * (e & 1) + 1] * sigm(l1); }
                    u32x4 w; w.x = cvt_pk_bf16(v[0], v[1]); w.y = cvt_pk_bf16(v[2], v[3]); w.z = cvt_pk_bf16(v[4], v[5]); w.w = cvt_pk_bf16(v[6], v[7]);
                    *(u32x4*)(out + (size_t)row * 1024 + col) = w; } } }
        return u.aux == 0;
    }
};

struct OrderOut {
    const char* A; const char* B; int G, c;
    DI bool next(int i, Unit& u) const { int pm, pn; if (!pg8::static_tile(i, G, c, NT / 256, 4, pm, pn)) return false;
        u.pm = pm; u.pn = pn; u.aux = 0; u.bmode = 1; u.A = A + (size_t)pm * 256 * 1024 * 2; u.B = B + (size_t)pn * 256 * 1024 * 2; return true; }
    DI void offsA(const Unit&, int, const int (&R)[2], const int (&C)[2], unsigned (&v)[2][2]) const { pg8::dense_offs(2048, R, C, v); }
};
struct EpiOut {
    const KArgs* a;
    DI bool operator()(f32x4 (&acc)[2][2][4][2], const Unit& u, int wr, int wc, int fr, int fq) const {
        const int b = (u.pm * 256) / SEQ; bf16_t* d1 = (bf16_t*)(a->ws + WS_D1);
#pragma unroll
        for (int bj = 0; bj < 2; ++bj) { const int col = u.pn * 256 + bj * 128 + wc * 32 + 8 * fq;
            const f32x4 g0 = *(const f32x4*)((const float*)(a->ws + WS_MODT) + b * 1024 + col), g1 = *(const f32x4*)((const float*)(a->ws + WS_MODT) + b * 1024 + col + 4);
#pragma unroll
            EPI_LOOP_ROWS { const size_t off = (size_t)(u.pm * 256 + ai * 128 + wr * 64 + m * 16 + fr) * 1024 + col; const f32x4 v0 = g0 * acc[ai][bj][m][0], v1 = g1 * acc[ai][bj][m][1];
                u32x4 w; w.x = cvt_pk_bf16(v0[0], v0[1]); w.y = cvt_pk_bf16(v0[2], v0[3]); w.z = cvt_pk_bf16(v1[0], v1[1]); w.w = cvt_pk_bf16(v1[2], v1[3]);
                *(u32x4*)(d1 + off) = w; } }
        return false;
    }
};

DI void phase5(const KArgs& a, LAS unsigned char* lds) {
    const int tid = tid_fresh(), G = gridDim.x, lane = tid & 63, wid = tid >> 6;
    LAS float* gm = (LAS float*)lds;
    LAS float* sh = gm + 2048;
    LAS float* lg = sh + 2048;
    LAS int* lcnt = (LAS int*)(lg + 128 * 40);
    LAS int* rinfo = lcnt + 64;
    LAS float* rw = (LAS float*)(rinfo + 512);
    __syncthreads();
    for (int i = tid; i < 2048; i += 512) { const float* mt = (const float*)(a.ws + WS_MODT); gm[i] = mt[2048 + i]; sh[i] = mt[4096 + i]; }
    if (blockIdx.x == 0 && tid < 256) ((unsigned*)(a.ws + WS_HX2Q) + (size_t)NT * 256)[tid] = 0u;
    bf16_t* hx2 = (bf16_t*)(a.ws + WS_HX2);
    int* cnt = (int*)(a.ws + WS_CTL) + CW_CNT;
    for (int rt = blockIdx.x; rt < NT / 128; rt += G) {
        __syncthreads();
        if (tid < 32) lcnt[tid] = 0;
        {   const int row0 = 128 * rt + 16 * wid, v = row0 / SEQ; f32x4 x[4]; u32x2 dl[4]; const bf16_t* d1 = (const bf16_t*)(a.ws + WS_D1);
#pragma unroll
            for (int j = 0; j < 4; ++j) { x[j] = *(const f32x4*)(a.in[I_X] + (size_t)row0 * 1024 + 4 * lane + 256 * j); dl[j] = *(const u32x2*)(d1 + (size_t)row0 * 1024 + 4 * lane + 256 * j); }
            for (int rr = 0; rr < 16; ++rr) { const int row = row0 + rr; f32x4 xn[4]; u32x2 dn[4];
                if (rr < 15) {
#pragma unroll
                    for (int j = 0; j < 4; ++j) { xn[j] = *(const f32x4*)(a.in[I_X] + (size_t)(row + 1) * 1024 + 4 * lane + 256 * j); dn[j] = *(const u32x2*)(d1 + (size_t)(row + 1) * 1024 + 4 * lane + 256 * j); } }
#pragma unroll
                for (int j = 0; j < 4; ++j) { x[j][0] += __uint_as_float(dl[j].x << 16); x[j][1] += __uint_as_float(dl[j].x & 0xffff0000u); x[j][2] += __uint_as_float(dl[j].y << 16); x[j][3] += __uint_as_float(dl[j].y & 0xffff0000u); }
                float ss = 0.f;
#pragma unroll
                for (int j = 0; j < 4; ++j) ss += (x[j][0] * x[j][0] + x[j][1] * x[j][1]) + (x[j][2] * x[j][2] + x[j][3] * x[j][3]);
#pragma unroll
                for (int o = 32; o >= 1; o >>= 1) ss += __shfl_xor(ss, o);
                const float rstd = rsqrtf(ss * (1.0f / 1024.0f) + EPSV);
#pragma unroll
                for (int j = 0; j < 4; ++j) { const int k0 = 4 * lane + 256 * j; const f32x4 g = *(const LAS f32x4*)(gm + v * 1024 + k0), sv = *(const LAS f32x4*)(sh + v * 1024 + k0);
                    u32x2 w; w.x = cvt_pk_bf16(x[j][0] * rstd * g[0] + sv[0], x[j][1] * rstd * g[1] + sv[1]); w.y = cvt_pk_bf16(x[j][2] * rstd * g[2] + sv[2], x[j][3] * rstd * g[3] + sv[3]);
                    *(u32x2*)(hx2 + (size_t)row * 1024 + k0) = w;
                    *(unsigned*)((unsigned char*)(a.ws + WS_HX2Q) + (size_t)row * 1024 + k0) = cvt4_fp8(16.f * (x[j][0] * rstd * g[0] + sv[0]), 16.f * (x[j][1] * rstd * g[1] + sv[1]), 16.f * (x[j][2] * rstd * g[2] + sv[2]), 16.f * (x[j][3] * rstd * g[3] + sv[3])); }
#pragma unroll
                for (int j = 0; j < 4; ++j) { x[j] = xn[j]; dl[j] = dn[j]; }
            }
        }
        __syncthreads();
        {
            const int rb = wid >> 1, cb = wid & 1, r = lane & 31, h = lane >> 5;
            const bf16_t* ar = hx2 + (size_t)(128 * rt + 32 * rb + r) * 1024 + 8 * h;
            const bf16_t* bh = (const bf16_t*)(a.ws + WS_WRH) + (size_t)(32 * cb + r) * 1024 + 8 * h; const bf16_t* bl = bh + 64 * 1024;
            f32x16 acc = zero16();
#pragma unroll 8
            for (int ks = 0; ks < 64; ++ks) { const bf16x8 af = *(const bf16x8*)(ar + 16 * ks), b1 = *(const bf16x8*)(bh + 16 * ks), b2 = *(const bf16x8*)(bl + 16 * ks);
                acc = MFMA32(af, b1, acc); acc = MFMA32(af, b2, acc); }
            const int col = 32 * cb + r;
            if (col < 36) {
#pragma unroll
                for (int i = 0; i < 16; ++i) lg[(32 * rb + crow(i, h)) * 40 + col] = acc[i]; }
        }
        __syncthreads();
        if (tid < 128) { const LAS float* l = lg + tid * 40;
            int gs = 0; float best = l[0] + a.in[I_BGRP][0];
#pragma unroll
            for (int g = 1; g < 4; ++g) { const float v = l[g] + a.in[I_BGRP][g]; if (v > best) { best = v; gs = g; } }
            const float mx = fmaxf(fmaxf(l[0], l[1]), fmaxf(l[2], l[3])); float den = 0.f;
#pragma unroll
            for (int g = 0; g < 4; ++g) den += expf(l[g] - mx);
            const float pg = expf(l[gs] - mx) / den;
            int i0 = 0, i1 = -1; float v0 = -3.0e38f, v1 = -3.0e38f;
#pragma unroll
            for (int e = 0; e < 8; ++e) { const float v = l[4 + 8 * gs + e] + a.in[I_BRT][8 * gs + e];
                if (v > v0) { v1 = v0; i1 = i0; v0 = v; i0 = e; } else if (v > v1) { v1 = v; i1 = e; } }
            const float e0 = l[4 + 8 * gs + i0], e1 = l[4 + 8 * gs + i1], m2 = fmaxf(e0, e1), x0 = expf(e0 - m2), x1 = expf(e1 - m2), inv = 1.0f / (x0 + x1);
            const int ex0 = 8 * gs + i0, ex1 = 8 * gs + i1;
            rinfo[tid * 4 + 0] = ex0; rinfo[tid * 4 + 1] = atomicAdd((int*)&lcnt[ex0], 1); rinfo[tid * 4 + 2] = ex1; rinfo[tid * 4 + 3] = atomicAdd((int*)&lcnt[ex1], 1);
            rw[tid * 2 + 0] = pg * x0 * inv; rw[tid * 2 + 1] = pg * x1 * inv; }
        __syncthreads();
        if (tid < 32) lcnt[32 + tid] = lcnt[tid] ? atomicAdd(&cnt[tid], lcnt[tid]) : 0;
        __syncthreads();
        if (tid < 128) { const int tok = 128 * rt + tid; const int e0 = rinfo[tid * 4 + 0], s0 = lcnt[32 + e0] + rinfo[tid * 4 + 1], e1 = rinfo[tid * 4 + 2], s1 = lcnt[32 + e1] + rinfo[tid * 4 + 3];
            int* ptok = (int*)(a.ws + WS_PTOK); ptok[(size_t)e0 * 65536 + s0] = tok; ptok[(size_t)e1 * 65536 + s1] = tok;
            unsigned* ro = (unsigned*)(a.ws + WS_ROUTE) + (size_t)tok * 8; ro[0] = e0; ro[1] = s0; ro[2] = e1; ro[3] = s1; ro[4] = __float_as_uint(rw[tid * 2]); ro[5] = __float_as_uint(rw[tid * 2 + 1]); }
    }
}

DI void moe_tiles(const KArgs& a, LAS int* tt) {
    __syncthreads();
    if (threadIdx.x == 0) { const int* cnt = (const int*)(a.ws + WS_CTL) + CW_CNT; int s = 0; for (int e = 0; e < 32; ++e) { tt[e] = s; s += (cnt[e] + 255) >> 8; } tt[32] = s; }
    __syncthreads();
}
DI int moe_expert(const LAS int* tt, int rt) { int e = 0;
#pragma unroll
    for (int q = 16; q >= 1; q >>= 1) if (tt[e + q] <= rt) e += q;
    return e; }
struct OrderMoe1 {
    const char* A; const char* B; const LAS int* tt; const LAS int* tok; int G, c;
    DI bool next(int i, Unit& u) const { const int L = i * G + c; if (L >= tt[32] * 6) return false; const int rt = L / 6, ct = L % 6, e = moe_expert(tt, rt);
        u.pm = rt; u.pn = ct; u.aux = e; u.bmode = 1; u.A = A; u.B = B + (size_t)(e * 6 + ct) * 256 * 1024; return true; }
    DI void offsA(const Unit&, int ui, const int (&R)[2], const int (&C)[2], unsigned (&v)[2][2]) const {
#pragma unroll
        for (int h = 0; h < 2; ++h)
#pragma unroll
            for (int i = 0; i < 2; ++i) v[h][i] = (unsigned)tok[ui * 256 + h * 128 + R[i]] * 1024u + (unsigned)C[i] * 2u; }
};
struct EpiMoe1 {
    unsigned char* hid;
    DI bool operator()(f32x4 (&acc)[2][2][4][2], const Unit& u, int wr, int wc, int fr, int fq) const {
        const int col = u.pn * 128 + wc * 32 + 8 * fq;
#pragma unroll
        EPI_LOOP_ROWS { const size_t row = (size_t)u.pm * 256 + ai * 128 + wr * 64 + m * 16 + fr; float v[8];
#pragma unroll
            for (int n = 0; n < 2; ++n)
#pragma unroll
                for (int j = 0; j < 4; ++j) { const float g = acc[ai][0][m][n][j] * (1.0f / 1024.0f), up = acc[ai][1][m][n][j] * (1.0f / 1024.0f); v[4 * n + j] = silu_(g) * up * 8.0f; }
            u32x2 w; w.x = cvt4_fp8(v[0], v[1], v[2], v[3]); w.y = cvt4_fp8(v[4], v[5], v[6], v[7]);
            *(u32x2*)(hid + row * 768 + col) = w; }
        return false;
    }
};
struct OrderMoe2 {
    const char* A; const char* B; const LAS int* tt; int G, c;
    DI bool next(int i, Unit& u) const { const int L = i * G + c; if (L >= tt[32] * 4) return false; const int rt = L >> 2, ct = L & 3, e = moe_expert(tt, rt);
        u.pm = rt; u.pn = ct; u.aux = e; u.bmode = 1; u.A = A + (size_t)rt * 256 * 768; u.B = B + ((size_t)e * 1024 + 256 * ct) * 768; return true; }
    DI void offsA(const Unit&, int, const int (&R)[2], const int (&C)[2], unsigned (&v)[2][2]) const { pg8::dense_offs(768, R, C, v); }
};
struct EpiMoe2 {
    bf16_t* ye;
    DI bool operator()(f32x4 (&acc)[2][2][4][2], const Unit& u, int wr, int wc, int fr, int fq) const {
#pragma unroll
        for (int bj = 0; bj < 2; ++bj) { const int col = u.pn * 256 + bj * 128 + wc * 32 + 8 * fq;
#pragma unroll
            EPI_LOOP_ROWS { const size_t row = (size_t)u.pm * 256 + ai * 128 + wr * 64 + m * 16 + fr; const f32x4 v0 = acc[ai][bj][m][0] * (1.0f / 512.0f), v1 = acc[ai][bj][m][1] * (1.0f / 512.0f);
                u32x4 w; w.x = cvt_pk_bf16(v0[0], v0[1]); w.y = cvt_pk_bf16(v0[2], v0[3]); w.z = cvt_pk_bf16(v1[0], v1[1]); w.w = cvt_pk_bf16(v1[2], v1[3]);
                *(u32x4*)(ye + row * 1024 + col) = w; } }
        return false;
    }
};

DI void phase8(const KArgs& a, LAS unsigned char* lds) {
    const int tid = tid_fresh(), G = gridDim.x, lane = tid & 63, wid = tid >> 6;
    LAS float* g2 = (LAS float*)lds;
    LAS int* tt = (LAS int*)(g2 + 2048);
    moe_tiles(a, tt);
    for (int i = tid; i < 2048; i += 512) g2[i] = ((const float*)(a.ws + WS_MODT))[6144 + i];
    __syncthreads();
    const bf16_t* ye = (const bf16_t*)(a.ws + WS_YE);
    for (int row = blockIdx.x * 8 + wid; row < NT; row += G * 8) {
        const int v = row / SEQ; const unsigned* ro = (const unsigned*)(a.ws + WS_ROUTE) + (size_t)row * 8;
        const size_t p0 = (size_t)tt[ro[0]] * 256 + ro[1], p1 = (size_t)tt[ro[2]] * 256 + ro[3]; const float w0 = __uint_as_float(ro[4]), w1 = __uint_as_float(ro[5]);
        float* xr = a.out + (size_t)row * 1024; const float* xi = a.in[I_X] + (size_t)row * 1024; const bf16_t* dr = (const bf16_t*)(a.ws + WS_D1) + (size_t)row * 1024; f32x4 x[4]; float ss = 0.f;
#pragma unroll
        for (int j = 0; j < 4; ++j) { const int k0 = 4 * lane + 256 * j; x[j] = *(const f32x4*)(xi + k0); { const u32x2 dd = *(const u32x2*)(dr + k0); x[j][0] += __uint_as_float(dd.x << 16); x[j][1] += __uint_as_float(dd.x & 0xffff0000u); x[j][2] += __uint_as_float(dd.y << 16); x[j][3] += __uint_as_float(dd.y & 0xffff0000u); }
            const u32x2 ya = *(const u32x2*)(ye + p0 * 1024 + k0), yb = *(const u32x2*)(ye + p1 * 1024 + k0); const f32x4 g = *(const LAS f32x4*)(g2 + v * 1024 + k0);
            x[j][0] += g[0] * (w0 * __uint_as_float(ya[0] << 16) + w1 * __uint_as_float(yb[0] << 16)); x[j][1] += g[1] * (w0 * __uint_as_float(ya[0] & 0xffff0000u) + w1 * __uint_as_float(yb[0] & 0xffff0000u));
            x[j][2] += g[2] * (w0 * __uint_as_float(ya[1] << 16) + w1 * __uint_as_float(yb[1] << 16)); x[j][3] += g[3] * (w0 * __uint_as_float(ya[1] & 0xffff0000u) + w1 * __uint_as_float(yb[1] & 0xffff0000u));
            ss += (x[j][0] * x[j][0] + x[j][1] * x[j][1]) + (x[j][2] * x[j][2] + x[j][3] * x[j][3]); }
#pragma unroll
        for (int o = 32; o >= 1; o >>= 1) ss += __shfl_xor(ss, o);
        const float rstd = rsqrtf(ss * (1.0f / 1024.0f) + EPSV);
#pragma unroll
        for (int j = 0; j < 4; ++j) { const int k0 = 4 * lane + 256 * j; const f32x4 fn = *(const f32x4*)(a.in[I_FNORM] + k0); *(f32x4*)(xr + k0) = x[j] * rstd * fn; }
    }
}

constexpr int N_PHASES = 12;
__global__ void __launch_bounds__(512, 2) fwd_kernel(KArgs a) {
    extern __shared__ __attribute__((aligned(16))) unsigned char lds_raw[];
    LAS unsigned char* lds = (LAS unsigned char*)lds_raw;
    volatile LAS unsigned* misc = (volatile LAS unsigned*)(lds + LDS_MISC);
    if (threadIdx.x < 8) misc[threadIdx.x] = 0u;
#ifdef PROBE_ID
    if (threadIdx.x == 0) { probe_words()[0] = 0; probe_words()[1] = 0; }
#endif
    __syncthreads();
    XcdBarrier bar; bar.bar = (unsigned*)(a.ws + WS_CTL) + CW_BAR; bar.x = 0; bar.st = misc;
    const bool one = (a.ph_hi - a.ph_lo) > 1;
    if (one) bar = xcd_barrier_post((unsigned*)(a.ws + WS_CTL) + CW_BAR, misc);
#ifdef ONLY_PHASE
#define IN(k) ((k) == ONLY_PHASE)
#else
#define IN(k) (a.ph_lo <= (k) && (k) < a.ph_hi)
#endif
#define SEAM(k) do { if (IN(k) && IN((k) + 1)) xcd_barrier(bar); PE(k); PB((k) + 1); } while (0)
    const int G = gridDim.x, c = blockIdx.x;
    PB(0);
    if (IN(0)) { phase0a(a, lds); } SEAM(0);
    if (IN(1)) { phase0b(a, lds); } SEAM(1);
    if (IN(2)) { __syncthreads(); OrderIn S{(const char*)(a.ws + WS_HX), (const char*)(a.ws + WS_WIN), G, c};
        EpiIn E{a.ws, (bf16_t*)a.out, a.in[I_BGATE], (const f32x2*)(a.ws + WS_ROPE)}; pg8::gemm_phase<false>(lds, 1024, S, E); } SEAM(2);
    if (IN(3)) { phase2a(a, lds); } SEAM(3);
    if (IN(4)) { phase2b(a); } SEAM(4);
    if (IN(5)) { phase2c(a, lds); } SEAM(5);
    if (IN(6)) {
        const bool cvt_first = (c & 1) == 0;
        if (cvt_first) { PB(104); phase3_cvt(a, lds); PE(104); }
        {   OrderMerge S{(const char*)(a.ws + WS_ZG), (const char*)(a.ws + WS_ZGL), (const char*)(a.ws + WS_WRET), (const char*)(a.ws + WS_WLRU), G, c};
            EpiMerge E{(const bf16_t*)a.out, (bf16_t*)(a.ws + WS_HX)}; __syncthreads(); pg8::gemm_phase<false>(lds, 1024, S, E); }
        if (!cvt_first) { phase3_cvt(a, lds); } } SEAM(6);
    if (IN(7)) { __syncthreads(); OrderOut S{(const char*)(a.ws + WS_HX), (const char*)(a.ws + WS_WOUT), G, c}; EpiOut E{&a}; pg8::gemm_phase<false>(lds, 1024, S, E); } SEAM(7);
    if (IN(8)) { phase5(a, lds); } SEAM(8);
    if (IN(9)) {
        LAS int* tt = (LAS int*)(lds + LDS_MISC + 64); LAS int* tok = (LAS int*)(lds + LDS_TOK);
        moe_tiles(a, tt);
        {
            const int tid = tid_fresh();
            const int* cnt = (const int*)(a.ws + WS_CTL) + CW_CNT; const int* ptok = (const int*)(a.ws + WS_PTOK);
            for (int i = 0; i < 8; ++i) { const int L = i * G + c; if (L >= tt[32] * 6) break; const int rt = L / 6, e = moe_expert(tt, rt), r0 = (rt - tt[e]) * 256;
                if (tid < 256) tok[i * 256 + tid] = (r0 + tid < cnt[e]) ? ptok[(size_t)e * 65536 + r0 + tid] : NT; }
            __syncthreads();
        }
        OrderMoe1 S{(const char*)(a.ws + WS_HX2Q), (const char*)(a.ws + WS_WGU), tt, tok, G, c}; EpiMoe1 E{(unsigned char*)(a.ws + WS_HID)}; pg8::gemm_phase<true>(lds, 1024, S, E); } SEAM(9);
    if (IN(10)) { LAS int* tt = (LAS int*)(lds + LDS_MISC + 64); moe_tiles(a, tt);
        OrderMoe2 S{(const char*)(a.ws + WS_HID), (const char*)(a.ws + WS_WDN), tt, G, c}; EpiMoe2 E{(bf16_t*)(a.ws + WS_YE)}; pg8::gemm_phase<true>(lds, 768, S, E); } SEAM(10);
    if (IN(11)) { phase8(a, lds); }
    PE(11);
#ifdef PROBE_ID
    if (blockIdx.x == 0 && threadIdx.x == 0) { const unsigned long long w = probe_words()[1] * 4ull, t0 = wall_clock64(); while (wall_clock64() - t0 < w) __builtin_amdgcn_s_sleep(8); }
#endif
#undef IN
#undef SEAM
}

extern "C" void kernel_launch(void* const* d_in, const int* in_sizes, int n_in, void* d_out, int out_size, void* d_ws, size_t ws_size, hipStream_t stream) {
    static int grid = 0;
    if (grid == 0) {
        if (n_in != 30 || out_size != NT * DM || ws_size < WS_NEED) { fprintf(stderr, "kernel_launch: unexpected shapes (n_in %d out %d ws %zu)\n", n_in, out_size, ws_size); grid = -1; return; }
        int dev = 0, cus = 0;
        if (hipGetDevice(&dev) != hipSuccess || hipDeviceGetAttribute(&cus, hipDeviceAttributeMultiprocessorCount, dev) != hipSuccess) { grid = -1; return; }
        if (hipFuncSetAttribute((const void*)fwd_kernel, hipFuncAttributeMaxDynamicSharedMemorySize, LDS_BYTES) != hipSuccess) { fprintf(stderr, "kernel_launch: hipFuncSetAttribute failed\n"); grid = -1; return; }
        int per_cu = 0; (void)hipOccupancyMaxActiveBlocksPerMultiprocessor(&per_cu, (const void*)fwd_kernel, 512, LDS_BYTES); (void)hipGetLastError();
        grid = cus;
    }
    if (grid < 0) return;
    (void)hipMemsetAsync((char*)d_ws + WS_CTL, 0, 1 * MiB, stream);
    KArgs a{};
    for (int i = 0; i < 30; ++i) a.in[i] = (const float*)d_in[i];
    a.out = (float*)d_out; a.ws = (unsigned char*)d_ws;
#if N_LAUNCH_SPLIT
    for (int p = 0; p < N_PHASES; ++p) { a.ph_lo = p; a.ph_hi = p + 1; hipLaunchKernelGGL(fwd_kernel, dim3(grid), dim3(512), LDS_BYTES, stream, a); }
#else
    a.ph_lo = 0; a.ph_hi = N_PHASES; hipLaunchKernelGGL(fwd_kernel, dim3(grid), dim3(512), LDS_BYTES, stream, a);
#endif
}
```

```cpp
#include <hip/hip_runtime.h>
#include <cstdio>
#include <cstdint>

#ifndef N_LAUNCH_SPLIT
#define N_LAUNCH_SPLIT 0
#endif

#define DI __device__ __forceinline__
#ifdef SUB
#define SUBSEL(k) ((k) == SUB)
#else
#define SUBSEL(k) true
#endif
#define LAS __attribute__((address_space(3)))
typedef unsigned short bf16_t;
typedef short bf16x8 __attribute__((ext_vector_type(8)));
typedef short s16x4 __attribute__((ext_vector_type(4)));
typedef float f32x2 __attribute__((ext_vector_type(2)));
typedef float f32x4 __attribute__((ext_vector_type(4)));
typedef float f32x16 __attribute__((ext_vector_type(16)));
typedef unsigned u32x2 __attribute__((ext_vector_type(2)));
typedef unsigned u32x4 __attribute__((ext_vector_type(4)));
typedef int v8i_t __attribute__((ext_vector_type(8)));
typedef int v4i_t __attribute__((ext_vector_type(4)));

constexpr int NB_ = 2, SEQ = 16384, NT = NB_ * SEQ, DM = 1024, CTXL = 256, NTC = NB_ * CTXL;
constexpr int NH = 4, DK = 128, DV = 256, QW = 512, VW = 1024, LW = 1024;
constexpr int NCOL = 7168;
constexpr int NE = 32, EH = 768;
constexpr float EPSV = 1e-6f;
constexpr float LOG2E = 1.4426950408889634f;
constexpr int SCH = 512, NSC = SEQ / SCH;
constexpr int LT = 64, NLT = SEQ / LT, NSLOT = 320;

constexpr size_t MiB = 1u << 20;
constexpr size_t WS_CTL = 0;
constexpr size_t WS_MODP = 1 * MiB;
constexpr size_t WS_MODT = 1 * MiB + 384 * 1024;
constexpr size_t WS_RDEC = 1 * MiB + 448 * 1024;
constexpr size_t WS_ROPE = 1 * MiB + 512 * 1024;
constexpr size_t WS_WRH = 1 * MiB + 768 * 1024;
constexpr size_t WS_LAGG = 2 * MiB;
constexpr size_t WS_LHIN = 12 * MiB;
constexpr size_t WS_CTXK = 17 * MiB;
constexpr size_t WS_CTXV = 17 * MiB + 512 * 1024;
constexpr size_t WS_CTXX = 18 * MiB + 512 * 1024;
constexpr size_t WS_CTXS = 20 * MiB;
constexpr size_t WS_ROUTE = 22 * MiB;
constexpr size_t WS_PTOK = 23 * MiB;
constexpr size_t WS_WIN = 32 * MiB;
constexpr size_t WS_WRET = 46 * MiB, WS_WLRU = 48 * MiB, WS_WOUT = 50 * MiB;
constexpr size_t WS_WLB = 52 * MiB;
constexpr size_t WS_HX = 56 * MiB;
constexpr size_t WS_ZQ = 120 * MiB, WS_ZK = 152 * MiB, WS_ZV = 184 * MiB, WS_ZG = 248 * MiB, WS_ZXL = 312 * MiB, WS_ZGL = 376 * MiB;
constexpr size_t WS_SBF = 440 * MiB;
constexpr size_t WS_WGU = 120 * MiB;
constexpr size_t WS_WDN = 440 * MiB;
constexpr size_t WS_HX2 = 248 * MiB;
constexpr size_t WS_HID = 313 * MiB;
constexpr size_t WS_HX2Q = 168 * MiB;
constexpr size_t WS_YE = 56 * MiB;
constexpr size_t WS_D1 = 376 * MiB;
constexpr size_t WS_NEED = 512 * MiB;
constexpr int CW_BAR = 4096, CW_CNT = 16384;

constexpr int LDS_SCR = 0, LDS_TOK = 131072, LDS_MISC = 131072 + 8192, LDS_BYTES = 147456;

DI int tid_fresh() { int t = threadIdx.x; asm volatile("" : "+v"(t)); return t; }
#ifdef PROBE_ID
DI volatile LAS unsigned long long* probe_words() { extern __shared__ __attribute__((aligned(16))) unsigned char lds_raw[]; return (volatile LAS unsigned long long*)((LAS unsigned char*)lds_raw + 131072 + 8192 + 1024); }
#define PB(id) do { if ((id) == PROBE_ID && threadIdx.x == 0) probe_words()[0] = wall_clock64(); } while (0)
#define PE(id) do { if ((id) == PROBE_ID && threadIdx.x == 0) probe_words()[1] += wall_clock64() - probe_words()[0]; } while (0)
#else
#define PB(id) do {} while (0)
#define PE(id) do {} while (0)
#endif
DI float bf2f(unsigned short b) { return __uint_as_float(((unsigned)b) << 16); }
typedef __bf16 bf16x2_t __attribute__((ext_vector_type(2)));
DI unsigned cvt_pk_bf16(float lo, float hi) { const f32x2 v = {lo, hi}; return __builtin_bit_cast(unsigned, __builtin_convertvector(v, bf16x2_t)); }
DI float clamp_f8(float x) { return __builtin_amdgcn_fmed3f(x, -448.f, 448.f); }
DI unsigned cvt4_fp8(float a, float b, float c, float d) { int p = 0; p = __builtin_amdgcn_cvt_pk_fp8_f32(clamp_f8(a), clamp_f8(b), p, false); p = __builtin_amdgcn_cvt_pk_fp8_f32(clamp_f8(c), clamp_f8(d), p, true); return (unsigned)p; }
DI unsigned short f2bf(float f) { return (unsigned short)(cvt_pk_bf16(f, 0.f) & 0xffffu); }
DI float ex2(float x) { return __builtin_amdgcn_exp2f(x); }
DI float rcpf_(float x) { return __builtin_amdgcn_rcpf(x); }
DI float sigm(float x) { return rcpf_(1.0f + ex2(-LOG2E * x)); }
DI float silu_(float x) { return x * sigm(x); }
DI float gelu_tanh(float x) { const float z = 0.7978845608028654f * (x + 0.044715f * x * x * x); return x * sigm(2.0f * z); }
DI float softplus_(float x) { return x > 20.f ? x : log1pf(expf(x)); }
DI int crow(int i, int h) { return (i & 3) + 8 * (i >> 2) + 4 * h; }
#define MFMA32(a, b, c) __builtin_amdgcn_mfma_f32_32x32x16_bf16((a), (b), (c), 0, 0, 0)
DI void lds_wait() { asm volatile("s_waitcnt lgkmcnt(0)" ::: "memory"); }
template <int O0, int O1> DI bf16x8 tr_frag(unsigned addr) {
    s16x4 lo, hi;
    asm volatile("ds_read_b64_tr_b16 %0, %2 offset:%3\n\tds_read_b64_tr_b16 %1, %2 offset:%4\n\ts_waitcnt lgkmcnt(0)" : "=&v"(lo), "=&v"(hi) : "v"(addr), "i"(O0), "i"(O1) : "memory");
    return __builtin_shufflevector(lo, hi, 0, 1, 2, 3, 4, 5, 6, 7);
}
template <int O, int S, int T> DI void tr_frag4(unsigned addr, bf16x8& f0, bf16x8& f1, bf16x8& f2, bf16x8& f3) {
    s16x4 a0, a1, b0, b1, c0, c1, d0, d1;
    asm volatile("ds_read_b64_tr_b16 %0, %8 offset:%9\n\tds_read_b64_tr_b16 %1, %8 offset:%10\n\t"
                 "ds_read_b64_tr_b16 %2, %8 offset:%11\n\tds_read_b64_tr_b16 %3, %8 offset:%12\n\t"
                 "ds_read_b64_tr_b16 %4, %8 offset:%13\n\tds_read_b64_tr_b16 %5, %8 offset:%14\n\t"
                 "ds_read_b64_tr_b16 %6, %8 offset:%15\n\tds_read_b64_tr_b16 %7, %8 offset:%16\n\ts_waitcnt lgkmcnt(0)"
                 : "=&v"(a0), "=&v"(a1), "=&v"(b0), "=&v"(b1), "=&v"(c0), "=&v"(c1), "=&v"(d0), "=&v"(d1)
                 : "v"(addr), "i"(O), "i"(O + T), "i"(O + S), "i"(O + S + T), "i"(O + 2 * S), "i"(O + 2 * S + T), "i"(O + 3 * S), "i"(O + 3 * S + T) : "memory");
    f0 = __builtin_shufflevector(a0, a1, 0, 1, 2, 3, 4, 5, 6, 7); f1 = __builtin_shufflevector(b0, b1, 0, 1, 2, 3, 4, 5, 6, 7);
    f2 = __builtin_shufflevector(c0, c1, 0, 1, 2, 3, 4, 5, 6, 7); f3 = __builtin_shufflevector(d0, d1, 0, 1, 2, 3, 4, 5, 6, 7);
}
DI void lds_barrier() { asm volatile("s_waitcnt lgkmcnt(0)" ::: "memory"); __builtin_amdgcn_s_barrier(); asm volatile("" ::: "memory"); }
#define GLDS16(gp, lp) __builtin_amdgcn_global_load_lds((const unsigned*)(gp), (LAS unsigned*)(lp), 16, 0, 0)
DI f32x16 zero16() { f32x16 z; for (int i = 0; i < 16; ++i) z[i] = 0.f; return z; }

struct KArgs {
    const float* in[30];
    float* out;
    unsigned char* ws;
    int ph_lo, ph_hi;
};
enum { I_X = 0, I_C, I_CTX, I_CCTX, I_WMOD, I_BMOD, I_NORM1, I_NORM2, I_WIN, I_BGATE, I_RDECAY, I_RNORM, I_WRET, I_CONVW, I_CONVB, I_LWA, I_LBA, I_LWX, I_LBX, I_LLAM,
       I_WLRU, I_WOUT, I_WGRP, I_BGRP, I_WRT, I_BRT, I_WEG, I_WEU, I_WED, I_FNORM };

DI float mod_val(const KArgs& a, int v, int ch, int k) {
    const float* mp = (const float*)(a.ws + WS_MODP); const int n = ch * 1024 + k;
    return ((mp[(0 * 3 + v) * 6144 + n] + mp[(1 * 3 + v) * 6144 + n]) + (mp[(2 * 3 + v) * 6144 + n] + mp[(3 * 3 + v) * 6144 + n])) + a.in[I_BMOD][n];
}

#define XB_TMO      128
#define XB_XCNT(j)  (256  + 64 * (j))
#define XB_XSUB(j)  (1280 + 64 * (j))
#define XB_XGEN(j)  (2304 + 64 * (j))
#define XB_TOP      3328
#define XB_TOPGEN   3392
#define XCD_BAR_WORDS 3456
#define XB_SPIN_CAP (1u << 18)
__device__ __forceinline__ unsigned xb_ld(unsigned* p)              { return __hip_atomic_load(p, __ATOMIC_RELAXED, __HIP_MEMORY_SCOPE_AGENT); }
__device__ __forceinline__ unsigned xb_add(unsigned* p, unsigned v) { return __hip_atomic_fetch_add(p, v, __ATOMIC_RELAXED, __HIP_MEMORY_SCOPE_AGENT); }
__device__ __forceinline__ unsigned xb_xcc_id() { return (unsigned)__builtin_amdgcn_s_getreg((3 << 11) | 20) & 0xFu; }
#define XB_SPIN(cond, bar) do { unsigned _sp = 0; while (cond) { __builtin_amdgcn_s_sleep(1); \
    if ((++_sp & 255u) == 0u) { if (xb_ld(&(bar)[XB_TMO])) break; if (_sp > XB_SPIN_CAP) { atomicAdd(&(bar)[XB_TMO], 1u); break; } } } } while (0)
struct XcdBarrier { unsigned* bar; unsigned x; volatile LAS unsigned* st; };
__device__ __forceinline__ XcdBarrier xcd_barrier_post(unsigned* bar, volatile LAS unsigned* st) {
    XcdBarrier b; b.bar = bar; b.x = xb_xcc_id(); b.st = st;
    if (threadIdx.x == 0) (void)xb_add(&bar[XB_XCNT(b.x)], 1u);
    return b;
}
__device__ __forceinline__ void xcd_barrier_complete(unsigned* bar, unsigned x, unsigned& nloc, unsigned& nx) {
    const unsigned G = gridDim.x * gridDim.y * gridDim.z;
    unsigned sum, cnt, mine, sp = 0u;
    for (;;) {
        sum = 0u; cnt = 0u; mine = 0u;
#pragma unroll
        for (unsigned j = 0; j < 16; ++j) { const unsigned c = xb_ld(&bar[XB_XCNT(j)]); sum += c; cnt += (c > 0u) ? 1u : 0u; mine = (j == x) ? c : mine; }
        if (sum == G) break;
        __builtin_amdgcn_s_sleep(1);
        if ((++sp & 255u) == 0u) { if (xb_ld(&bar[XB_TMO])) break; if (sp > XB_SPIN_CAP) { atomicAdd(&bar[XB_TMO], 1u); break; } }
    }
    nloc = mine > 0u ? mine : 1u; nx = cnt > 0u ? cnt : 1u;
}
__device__ __forceinline__ void xcd_barrier(const XcdBarrier& b) {
    asm volatile("s_waitcnt vmcnt(0)" ::: "memory");
    __syncthreads();
    if (threadIdx.x == 0) {
        unsigned* bar = b.bar;
        __builtin_amdgcn_s_waitcnt(0);
        unsigned nloc = b.st[0], nx = b.st[1];
        if (nloc == 0u) { xcd_barrier_complete(bar, b.x, nloc, nx); b.st[0] = nloc; b.st[1] = nx; }
        const unsigned old = xb_add(&bar[XB_XSUB(b.x)], 1u);
        const unsigned gen = old / nloc;
        if (old + 1u == (gen + 1u) * nloc) {
            __builtin_amdgcn_fence(__ATOMIC_RELEASE, "agent");
            asm volatile("s_waitcnt vmcnt(0)" ::: "memory");
            const unsigned og = xb_add(&bar[XB_TOP], 1u);
            const unsigned tg = og / nx;
            if (og + 1u == (tg + 1u) * nx) xb_add(&bar[XB_TOPGEN], 1u);
            else XB_SPIN(xb_ld(&bar[XB_TOPGEN]) == tg, bar);
            __builtin_amdgcn_fence(__ATOMIC_ACQUIRE, "agent");
            xb_add(&bar[XB_XGEN(b.x)], 1u);
            asm volatile("s_waitcnt vmcnt(0)" ::: "memory");
        } else {
            XB_SPIN(xb_ld(&bar[XB_XGEN(b.x)]) == gen, bar);
            __builtin_amdgcn_fence(__ATOMIC_ACQUIRE, "agent");
            asm volatile("s_waitcnt vmcnt(0)" ::: "memory");
        }
    }
    __syncthreads();
}

namespace pg8 {
constexpr int BM = 256, BK = 64, HALF = 128, HTB = HALF * BK * 2, STAGE_BYTES = 8 * HTB, NXCD = 8, WGM = 8;
DI int lds_byte(int r, int c) { const int st = (r >> 4) * 2 + (c >> 5), rr = r & 15, cc = c & 31, ob = rr * 64 + cc * 2; return st * 1024 + (ob ^ (((ob >> 9) & 1) << 5)); }
DI void stage_rc(int b, int& R, int& C) { const int st = b / 1024, sb = b % 1024, swz = sb ^ (((sb >> 9) & 1) << 5); R = (st >> 1) * 16 + swz / 64; C = (st & 1) * 32 + (swz % 64) / 2; }
DI int perm32(int rho) { const int n = rho >> 4, i = rho & 15; return 8 * (i >> 2) + 4 * n + (i & 3); }
DI int bmap(int mode, int R) {
    if (mode == 1) return (R & ~31) + perm32(R & 31);
    if (mode == 2) { const int wc = R >> 5, n = (R >> 4) & 1, low = R & 15; return 64 * (wc >> 1) + 32 * n + 16 * (wc & 1) + low; }
    return R;
}
struct Unit { const char* A; const char* B; int pm, pn, aux, bmode; };
DI bool static_tile(int i, int G, int c, int nM, int nN, int& pm, int& pn) {
    const int nwg = nM * nN; const long L = (long)i * G + c; if (L >= nwg) return false;
    int wgid = (int)L; { const int q = nwg / NXCD, r = nwg % NXCD, xcd = wgid % NXCD, off = wgid / NXCD; wgid = (xcd < r ? xcd * (q + 1) : r * (q + 1) + (xcd - r) * q) + off; }
    const int nig = WGM * nN, gid = wgid / nig, fm = gid * WGM, gsz = (nM - fm) < WGM ? (nM - fm) : WGM;
    pm = fm + ((wgid % nig) % gsz); pn = (wgid % nig) / gsz; return true;
}

template <bool F8, class Epi, class Sched>
DI void gemm_phase(LAS unsigned char* lds, const int K, const Sched& S, const Epi& E) {
    const int tid = tid_fresh(), wid = __builtin_amdgcn_readfirstlane(tid >> 6), lane = tid & 63, wr = wid >> 2, wc = wid & 3;
    const int rowb = F8 ? K : 2 * K, nt = rowb / 128;
    unsigned voffA[2][2], voffB[2];
    const size_t kstep = (size_t)(BK * 2);
    const size_t hstep = (size_t)HALF * rowb;
    const unsigned ldsw = (unsigned)wid * 1024u;
    const int aoff = lds_byte(wr * 64 + (lane & 15), (lane >> 4) * 8), boff = lds_byte(wc * 32 + (lane & 15), (lane >> 4) * 8);
#define PG8_SA(b, h) (((b) * 2 + (h)) * HTB)
#define PG8_SB(b, h) ((4 + (b) * 2 + (h)) * HTB)
#define PG8_STAGE(bufoff, gbase, voff) do { _Pragma("unroll") for (int _i = 0; _i < 2; ++_i) { unsigned vo_ = (voff)[_i]; asm volatile("" : "+v"(vo_));     \
        __builtin_amdgcn_global_load_lds((const unsigned*)((const char*)(gbase) + vo_), (LAS unsigned*)(lds + (bufoff) + ldsw + _i * 8192), 16, 0, 0); } } while (0)
#define PG8_LD8(p_) __builtin_shufflevector(*(const LAS v4i_t*)(p_), *(const LAS v4i_t*)((p_) + 1024), 0, 1, 2, 3, 4, 5, 6, 7)
#define PG8_LDA(dst, b, h) do { _Pragma("unroll") for (int m = 0; m < 4; ++m) dst[m] = PG8_LD8(lds + PG8_SA(b, h) + aoff + m * 2048); } while (0)
#define PG8_LDB(dst, b, h) do { _Pragma("unroll") for (int n = 0; n < 2; ++n) dst[n] = PG8_LD8(lds + PG8_SB(b, h) + boff + n * 2048); } while (0)
#define PG8_LO(v_) __builtin_bit_cast(bf16x8, __builtin_shufflevector(v_, v_, 0, 1, 2, 3))
#define PG8_HI(v_) __builtin_bit_cast(bf16x8, __builtin_shufflevector(v_, v_, 4, 5, 6, 7))
#define PG8_MMA(ai, bj, At, Bt) do { __builtin_amdgcn_s_setprio(1); _Pragma("unroll") for (int m = 0; m < 4; ++m) _Pragma("unroll") for (int n = 0; n < 2; ++n) { \
        if constexpr (F8) { acc[ai][bj][m][n] = __builtin_amdgcn_mfma_scale_f32_16x16x128_f8f6f4(Bt[n], At[m], acc[ai][bj][m][n], 0, 0, 0, 0x7f7f7f7f, 0, 0x7f7f7f7f); } \
        else { acc[ai][bj][m][n] = __builtin_amdgcn_mfma_f32_16x16x32_bf16(PG8_LO(Bt[n]), PG8_LO(At[m]), acc[ai][bj][m][n], 0, 0, 0); \
               acc[ai][bj][m][n] = __builtin_amdgcn_mfma_f32_16x16x32_bf16(PG8_HI(Bt[n]), PG8_HI(At[m]), acc[ai][bj][m][n], 0, 0, 0); } } \
        __builtin_amdgcn_s_setprio(0); } while (0)
#define PG8_WAIT_V(n) asm volatile("s_waitcnt vmcnt(" #n ")" ::: "memory")
#define PG8_WAIT_L(n) asm volatile("s_waitcnt lgkmcnt(" #n ")" ::: "memory")
#define PG8_BAR __builtin_amdgcn_s_barrier()
#define PG8_SCHED __builtin_amdgcn_sched_barrier(0)
#define PG8_RC() int Rr[2], Cc[2]; { const int t_ = tid_fresh(); _Pragma("unroll") for (int _i = 0; _i < 2; ++_i) stage_rc(t_ * 16 + _i * 8192, Rr[_i], Cc[_i]); }
#define PG8_SETB(u) do { PG8_RC(); _Pragma("unroll") for (int _i = 0; _i < 2; ++_i) voffB[_i] = (unsigned)(bmap((u).bmode, Rr[_i]) * rowb + Cc[_i] * 2); } while (0)
#define PG8_SETA(u, ui_) do { PG8_RC(); S.offsA((u), (ui_), Rr, Cc, voffA); } while (0)
    Unit cur, nxt; int ui = 0;
    if (!S.next(0, cur)) return;
    f32x4 acc[2][2][4][2];
#pragma unroll
    for (int a = 0; a < 2; ++a)
#pragma unroll
        for (int b = 0; b < 2; ++b)
#pragma unroll
            for (int m = 0; m < 4; ++m)
#pragma unroll
                for (int n = 0; n < 2; ++n) acc[a][b][m][n] = (f32x4){0.f, 0.f, 0.f, 0.f};
    v8i_t At[4], B0[2], B1[2];
    const char* cA = cur.A; const char* cB = cur.B;
    PG8_SETA(cur, 0); PG8_SETB(cur);
    PG8_STAGE(PG8_SB(0, 0), cB, voffB); PG8_STAGE(PG8_SB(0, 1), cB + hstep, voffB); PG8_STAGE(PG8_SA(0, 0), cA, voffA[0]); PG8_STAGE(PG8_SA(0, 1), cA, voffA[1]);
    if (wr == 1) PG8_BAR;
    PG8_WAIT_V(2); PG8_BAR;
    PG8_STAGE(PG8_SB(1, 0), cB + kstep, voffB); PG8_STAGE(PG8_SA(1, 0), cA + kstep, voffA[0]); PG8_STAGE(PG8_SB(1, 1), cB + hstep + kstep, voffB);
    PG8_WAIT_V(6); PG8_BAR;
    for (;;) {
        const bool has_next = S.next(ui + 1, nxt);
        const char* nA = has_next ? nxt.A : cA; const char* nB = has_next ? nxt.B : cB;
#pragma unroll 1
        for (int t = 0; t < nt; t += 2) {
            const bool last = (t == nt - 2);
            const char* a1 = cA + (size_t)(t + 1) * kstep;
            const char* a2 = last ? nA : cA + (size_t)(t + 2) * kstep; const char* b2 = last ? nB : cB + (size_t)(t + 2) * kstep;
            const char* a3 = a2 + kstep; const char* b3 = b2 + kstep;
            if (last && has_next) PG8_SETB(nxt);
            PG8_LDB(B0, 0, 0); PG8_LDB(B1, 0, 1); PG8_SCHED; PG8_LDA(At, 0, 0); PG8_STAGE(PG8_SA(1, 1), a1, voffA[1]);
            PG8_WAIT_V(8); PG8_WAIT_L(0); PG8_BAR; PG8_MMA(0, 0, At, B0); PG8_MMA(0, 1, At, B1); PG8_BAR; PG8_SCHED;
            if (last && has_next) PG8_SETA(nxt, ui + 1);
            PG8_LDA(At, 0, 1); PG8_STAGE(PG8_SB(0, 0), b2, voffB); PG8_STAGE(PG8_SB(0, 1), b2 + hstep, voffB); PG8_STAGE(PG8_SA(0, 0), a2, voffA[0]);
            PG8_WAIT_V(8); PG8_WAIT_L(0); PG8_BAR; PG8_MMA(1, 0, At, B0); PG8_MMA(1, 1, At, B1); PG8_BAR; PG8_SCHED;
            PG8_LDB(B0, 1, 0); PG8_LDB(B1, 1, 1); PG8_SCHED; PG8_LDA(At, 1, 0); PG8_STAGE(PG8_SA(0, 1), a2, voffA[1]);
            PG8_WAIT_V(8); PG8_WAIT_L(0); PG8_BAR; PG8_MMA(0, 0, At, B0); PG8_MMA(0, 1, At, B1); PG8_BAR; PG8_SCHED;
            PG8_LDA(At, 1, 1); PG8_STAGE(PG8_SB(1, 0), b3, voffB); PG8_STAGE(PG8_SB(1, 1), b3 + hstep, voffB); PG8_STAGE(PG8_SA(1, 0), a3, voffA[0]);
            PG8_WAIT_V(8); PG8_WAIT_L(0); PG8_BAR; PG8_MMA(1, 0, At, B0); PG8_MMA(1, 1, At, B1); PG8_BAR; PG8_SCHED;
        }
        if (wr == 0) PG8_BAR;
        bool keep; { const int t_ = tid_fresh(), l_ = t_ & 63; keep = E(acc, cur, wr, wc, l_ & 15, l_ >> 4); }
        if (!has_next) break;
        if (!keep) {
#pragma unroll
            for (int a = 0; a < 2; ++a)
#pragma unroll
                for (int b = 0; b < 2; ++b)
#pragma unroll
                    for (int m = 0; m < 4; ++m)
#pragma unroll
                        for (int n = 0; n < 2; ++n) acc[a][b][m][n] = (f32x4){0.f, 0.f, 0.f, 0.f};
        }
        cur = nxt; cA = nA; cB = nB; ++ui;
        if (wr == 1) PG8_BAR;
    }
    PG8_WAIT_V(0);
    PG8_BAR;
#undef PG8_SA
#undef PG8_SB
#undef PG8_STAGE
#undef PG8_LDA
#undef PG8_LD8
#undef PG8_LO
#undef PG8_HI
#undef PG8_LDB
#undef PG8_MMA
#undef PG8_WAIT_V
#undef PG8_WAIT_L
#undef PG8_BAR
#undef PG8_SCHED
#undef PG8_SETB
#undef PG8_SETA
#undef PG8_RC
}
DI void dense_offs(int rowbytes, const int (&R)[2], const int (&C)[2], unsigned (&voffA)[2][2]) {
#pragma unroll
    for (int h = 0; h < 2; ++h)
#pragma unroll
        for (int i = 0; i < 2; ++i) voffA[h][i] = (unsigned)((h * HALF + R[i]) * rowbytes + C[i] * 2);
}
}
using pg8::Unit;

#define EPI_LOOP_ROWS for (int ai = 0; ai < 2; ++ai) _Pragma("unroll") for (int m = 0; m < 4; ++m)

DI void cvt_tile(LAS float* tile, const float* src, int ld_src, bf16_t* dst, int ld_dst, float scale) {
    const int tid = tid_fresh();
    __syncthreads();
#pragma unroll
    for (int i = 0; i < 2; ++i) { const int kr = (tid >> 4) + 32 * i, nc = (tid & 15) * 4; const f32x4 v = *(const f32x4*)(src + (size_t)kr * ld_src + nc);
        tile[kr * 65 + nc + 0] = v[0]; tile[kr * 65 + nc + 1] = v[1]; tile[kr * 65 + nc + 2] = v[2]; tile[kr * 65 + nc + 3] = v[3]; }
    __syncthreads();
    const int n = tid >> 3, kc = (tid & 7) * 8; float v[8];
#pragma unroll
    for (int j = 0; j < 8; ++j) v[j] = tile[(kc + j) * 65 + n] * scale;
    u32x4 w; w.x = cvt_pk_bf16(v[0], v[1]); w.y = cvt_pk_bf16(v[2], v[3]); w.z = cvt_pk_bf16(v[4], v[5]); w.w = cvt_pk_bf16(v[6], v[7]);
    *(u32x4*)(dst + (size_t)n * ld_dst + kc) = w;
}

DI void cvt_tile4(LAS float* tile, const float* src, int ld_src, bf16_t* dst, size_t hi_stride, int ld_dst) {
    const int tid = tid_fresh();
    f32x4 v[8];
#pragma unroll
    for (int i = 0; i < 8; ++i) v[i] = *(const f32x4*)(src + (size_t)((tid >> 6) + 8 * i) * ld_src + 4 * (tid & 63));
    __syncthreads();
#pragma unroll
    for (int i = 0; i < 8; ++i) *(LAS f32x4*)(tile + ((tid >> 6) + 8 * i) * 260 + 4 * (tid & 63)) = v[i];
    __syncthreads();
    const int n = tid & 255, kh = tid >> 8; bf16_t* d = dst + (size_t)(n >> 7) * hi_stride + (size_t)(n & 127) * ld_dst + 32 * kh;
#pragma unroll
    for (int q = 0; q < 4; ++q) { float x[8];
#pragma unroll
        for (int j = 0; j < 8; ++j) x[j] = tile[(32 * kh + 8 * q + j) * 260 + n];
        u32x4 w; w.x = cvt_pk_bf16(x[0], x[1]); w.y = cvt_pk_bf16(x[2], x[3]); w.z = cvt_pk_bf16(x[4], x[5]); w.w = cvt_pk_bf16(x[6], x[7]);
        *(u32x4*)(d + 8 * q) = w; }
}

DI void phase0a(const KArgs& a, LAS unsigned char* lds) {
    const int tid = tid_fresh(), G = gridDim.x;
    LAS float* fl = (LAS float*)lds;
    constexpr int NU_MOD = 192, NU_ROPE = 1, NU_ROUTW = 64, T_WIN = 16 * 28, T_PROJ = 3 * 64, T_LB = 128;
    constexpr int U0 = NU_MOD, U1 = U0 + NU_ROPE, U2 = U1 + NU_ROUTW, U3 = U2 + T_WIN, U4 = U3 + T_PROJ, U5 = U4 + T_LB;
    for (int u = blockIdx.x; u < U5; u += G) {
        if (u < U0) {
            const int ks = u / 48, cg = u % 48;
            __syncthreads();
            for (int i = tid; i < 768; i += 512) { const int v = i >> 8, k = 256 * ks + (i & 255); const float x = (v == 0) ? a.in[I_C][k] : (v == 1) ? a.in[I_C][1024 + k] : a.in[I_CCTX][k]; fl[i] = silu_(x); }
            __syncthreads();
            const int rl = tid >> 5, cl = tid & 31; float acc[3][4];
#pragma unroll
            for (int v = 0; v < 3; ++v) for (int j = 0; j < 4; ++j) acc[v][j] = 0.f;
            f32x4 wv[16];
#pragma unroll
            for (int s = 0; s < 16; ++s) wv[s] = *(const f32x4*)(a.in[I_WMOD] + (size_t)(256 * ks + 16 * s + rl) * 6144 + 128 * cg + 4 * cl);
#pragma unroll
            for (int s = 0; s < 16; ++s) { const int kk = 16 * s + rl; const f32x4 w = wv[s];
#pragma unroll
                for (int v = 0; v < 3; ++v) { const float sv = fl[v * 256 + kk]; acc[v][0] += sv * w[0]; acc[v][1] += sv * w[1]; acc[v][2] += sv * w[2]; acc[v][3] += sv * w[3]; } }
            __syncthreads();
            LAS float* red = fl + 1024;
#pragma unroll
            for (int v = 0; v < 3; ++v) for (int j = 0; j < 4; ++j) red[(rl * 3 + v) * 128 + 4 * cl + j] = acc[v][j];
            __syncthreads();
            if (tid < 384) { const int v = tid >> 7, c = tid & 127; float s = 0.f; for (int r = 0; r < 16; ++r) s += red[(r * 3 + v) * 128 + c];
                ((float*)(a.ws + WS_MODP))[(ks * 3 + v) * 6144 + 128 * cg + c] = s; }
        } else if (u < U1) {
            f32x2* tab = (f32x2*)(a.ws + WS_ROPE);
            if (tid < 8) ((float*)(a.ws + WS_RDEC))[tid] = -softplus_(-a.in[I_RDECAY][tid]) * LOG2E;
            for (int i = tid; i < 320 * 32; i += 512) { const int p = i >> 5, fi = i & 31; const float pos = (float)(p < 256 ? p : p - 256);
                const float freq = ex2(-(float)fi * (13.287712379549449f / 32.0f)); float rev = pos * freq * 0.15915494309189535f; rev -= floorf(rev);
                tab[i] = (f32x2){__builtin_amdgcn_cosf(rev), __builtin_amdgcn_sinf(rev)}; }
        } else if (u < U2) {
            bf16_t* hi = (bf16_t*)(a.ws + WS_WRH); bf16_t* lo = hi + 64 * 1024; const int n = u - U1;
            for (int k = tid; k < 1024; k += 512) { float w = 0.f;
                if (n < 4) w = a.in[I_WGRP][k * 4 + n]; else if (n < 36) w = a.in[I_WRT][k * 32 + (n - 4)];
                const unsigned short h16 = f2bf(w); hi[n * 1024 + k] = h16; lo[n * 1024 + k] = f2bf(w - bf2f(h16)); }
        } else if (u < U3) {
            const int t = u - U2, kt = t / 28, ng = t % 28;
            cvt_tile4(fl, a.in[I_WIN] + (size_t)(64 * kt) * NCOL + 256 * ng, NCOL, (bf16_t*)(a.ws + WS_WIN) + (size_t)(256 * ng) * 1024 + 64 * kt, (size_t)128 * 1024, 1024);
        } else if (u < U4) {
            const int t = u - U3, w = t >> 6, kt = (t & 63) >> 2, ng = t & 3;
            const float* src = a.in[w == 0 ? I_WRET : w == 1 ? I_WLRU : I_WOUT]; bf16_t* dst = (bf16_t*)(a.ws + (w == 0 ? WS_WRET : w == 1 ? WS_WLRU : WS_WOUT));
            cvt_tile4(fl, src + (size_t)(64 * kt) * 1024 + 256 * ng, 1024, dst + (size_t)(256 * ng) * 1024 + 64 * kt, (size_t)128 * 1024, 1024);
        } else {
            const int t = u - U4, mat = t >> 5, blk = (t >> 2) & 7, kt = (t >> 1) & 1, nt = t & 1, dir = mat >> 1;
            const float* src = a.in[(mat & 1) ? I_LWX : I_LWA] + (size_t)(dir * 8 + blk) * 128 * 128;
            bf16_t* dst = (bf16_t*)(a.ws + WS_WLB) + (size_t)(mat * 8 + blk) * 128 * 128;
            cvt_tile(fl, src + (size_t)(64 * kt) * 128 + 64 * nt, 128, dst + (size_t)(64 * nt) * 128 + 64 * kt, 128, -LOG2E);
        }
    }
}

DI void phase0b(const KArgs& a, LAS unsigned char* lds) {
    const int tid = tid_fresh(), G = gridDim.x, lane = tid & 63, wid = tid >> 6;
    LAS float* gm = (LAS float*)lds;
    LAS float* sh = gm + 3072;
    __syncthreads();
    for (int i = tid; i < 3072; i += 512) { const int v = i >> 10, k = i & 1023; gm[i] = a.in[I_NORM1][k] * (1.0f + mod_val(a, v, 1, k)); sh[i] = mod_val(a, v, 0, k); }
    if (blockIdx.x == G - 1) { float* mt = (float*)(a.ws + WS_MODT);
        for (int i = tid; i < 2048; i += 512) { const int v = i >> 10, k = i & 1023; mt[i] = mod_val(a, v, 2, k); mt[2048 + i] = a.in[I_NORM2][k] * (1.0f + mod_val(a, v, 4, k)); mt[4096 + i] = mod_val(a, v, 3, k); mt[6144 + i] = mod_val(a, v, 5, k); } }
    __syncthreads();
    PB(105);
    for (int u = blockIdx.x; u < 160; u += G) {
        const int rt = u / 10, ct = u % 10;
        const int col0 = ct < 2 ? 512 + 256 * ct : ct < 6 ? 1024 + 256 * (ct - 2) : 3072 + 256 * (ct - 6);
        LAS unsigned char* At = lds + 24576;
        __syncthreads();
        {   f32x4 x[4][4];
#pragma unroll
            for (int q = 0; q < 4; ++q)
#pragma unroll
                for (int j = 0; j < 4; ++j) x[q][j] = *(const f32x4*)(a.in[I_CTX] + (size_t)(32 * rt + 4 * wid + q) * 1024 + 4 * lane + 256 * j);
#pragma unroll
            for (int q = 0; q < 4; ++q) { float ss = 0.f;
#pragma unroll
                for (int j = 0; j < 4; ++j) ss += (x[q][j][0] * x[q][j][0] + x[q][j][1] * x[q][j][1]) + (x[q][j][2] * x[q][j][2] + x[q][j][3] * x[q][j][3]);
#pragma unroll
                for (int o = 32; o >= 1; o >>= 1) ss += __shfl_xor(ss, o);
                const float rstd = rsqrtf(ss * (1.0f / 1024.0f) + EPSV);
#pragma unroll
                for (int j = 0; j < 4; ++j) { const int k0 = 4 * lane + 256 * j; const f32x4 g = *(const LAS f32x4*)(gm + 2048 + k0), sv = *(const LAS f32x4*)(sh + 2048 + k0);
                    u32x2 w; w.x = cvt_pk_bf16(x[q][j][0] * rstd * g[0] + sv[0], x[q][j][1] * rstd * g[1] + sv[1]); w.y = cvt_pk_bf16(x[q][j][2] * rstd * g[2] + sv[2], x[q][j][3] * rstd * g[3] + sv[3]);
                    *(LAS u32x2*)(At + (4 * wid + q) * 2064 + k0 * 2) = w; } }
        }
        __syncthreads();
        const int r = lane & 31, h = lane >> 5;
        const bf16_t* wrow = (const bf16_t*)(a.ws + WS_WIN) + (size_t)(col0 + 32 * wid + r) * 1024 + 8 * h;
        f32x16 acc = zero16();
#pragma unroll 16
        for (int s2 = 0; s2 < 64; ++s2) { const bf16x8 bfr = *(const bf16x8*)(wrow + 16 * s2); const bf16x8 af = *(const LAS bf16x8*)(At + r * 2064 + (16 * s2 + 8 * h) * 2);
            acc = MFMA32(af, bfr, acc); }
        const int ccol = 256 * (ct < 2 ? ct : ct < 6 ? ct - 2 : ct - 6) + 32 * wid + r;
        bf16_t* dst = (bf16_t*)(a.ws + (ct < 2 ? WS_CTXK : ct < 6 ? WS_CTXV : WS_CTXX)); const int ldd = ct < 2 ? 512 : 1024; const float scv = ct < 2 ? 0.08838834764831845f : 1.0f;
#pragma unroll
        for (int i = 0; i < 16; ++i) dst[(size_t)(32 * rt + crow(i, h)) * ldd + ccol] = f2bf(acc[i] * scv);
    }
    PE(105);
    PB(106);
    {
        const int rstep = G * 8; int row = blockIdx.x * 8 + wid; f32x4 x[2][4];
#pragma unroll
        for (int q = 0; q < 2; ++q) if (row + q * rstep < NT) {
#pragma unroll
            for (int j = 0; j < 4; ++j) x[q][j] = *(const f32x4*)(a.in[I_X] + (size_t)(row + q * rstep) * 1024 + 4 * lane + 256 * j); }
        for (; row < NT; row += 2 * rstep) {
            f32x4 xn[2][4];
#pragma unroll
            for (int q = 0; q < 2; ++q) if (row + (2 + q) * rstep < NT) {
#pragma unroll
                for (int j = 0; j < 4; ++j) xn[q][j] = *(const f32x4*)(a.in[I_X] + (size_t)(row + (2 + q) * rstep) * 1024 + 4 * lane + 256 * j); }
#pragma unroll
            for (int q = 0; q < 2; ++q) { const int rw = row + q * rstep; if (rw < NT) { const int v = rw / SEQ; float ss = 0.f;
#pragma unroll
                for (int j = 0; j < 4; ++j) ss += (x[q][j][0] * x[q][j][0] + x[q][j][1] * x[q][j][1]) + (x[q][j][2] * x[q][j][2] + x[q][j][3] * x[q][j][3]);
#pragma unroll
                for (int o = 32; o >= 1; o >>= 1) ss += __shfl_xor(ss, o);
                const float rstd = rsqrtf(ss * (1.0f / 1024.0f) + EPSV);
                bf16_t* dst = (bf16_t*)(a.ws + WS_HX) + (size_t)rw * 1024;
#pragma unroll
                for (int j = 0; j < 4; ++j) { const int k0 = 4 * lane + 256 * j; const f32x4 g = *(const LAS f32x4*)(gm + v * 1024 + k0), sv = *(const LAS f32x4*)(sh + v * 1024 + k0);
                    u32x2 w; w.x = cvt_pk_bf16(x[q][j][0] * rstd * g[0] + sv[0], x[q][j][1] * rstd * g[1] + sv[1]); w.y = cvt_pk_bf16(x[q][j][2] * rstd * g[2] + sv[2], x[q][j][3] * rstd * g[3] + sv[3]);
                    *(u32x2*)(dst + k0) = w; } } }
#pragma unroll
            for (int q = 0; q < 2; ++q)
#pragma unroll
                for (int j = 0; j < 4; ++j) x[q][j] = xn[q][j];
        }
    }
    PE(106);
}

struct OrderIn {
    const char* A; const char* B; int G, c;
    DI bool next(int i, Unit& u) const { int pm, pn; if (!pg8::static_tile(i, G, c, NT / 256, NCOL / 256, pm, pn)) return false;
        u.pm = pm; u.pn = pn; u.A = A + (size_t)pm * 256 * 1024 * 2; u.B = B + (size_t)pn * 256 * 1024 * 2; u.aux = 0; u.bmode = pn < 4 ? 2 : 1; return true; }
    DI void offsA(const Unit&, int, const int (&R)[2], const int (&C)[2], unsigned (&v)[2][2]) const { pg8::dense_offs(2048, R, C, v); }
};
DI int glog_frag(int ai, int bj, int m, int wr, int wc, int fr, int fq) { return ((((((ai * 2 + bj) * 4 + m) * 2 + wr) * 4 + wc) * 16 + fr) * 4 + fq) * 8; }
struct EpiIn {
    unsigned char* ws; bf16_t* glog; const float* bgate; const f32x2* rope;
    DI bool operator()(f32x4 (&acc)[2][2][4][2], const Unit& u, int wr, int wc, int fr, int fq) const {
        const int pn = u.pn;
        if (pn < 4) {
            bf16_t* dst = (bf16_t*)(ws + (pn < 2 ? WS_ZQ : WS_ZK)); const float sc = pn < 2 ? 1.0f : 0.08838834764831845f;
            const int half = wc >> 1, f0 = 16 * (wc & 1) + 4 * fq;
#pragma unroll
            EPI_LOOP_ROWS { const int row = u.pm * 256 + ai * 128 + wr * 64 + m * 16 + fr; const int t = row & (SEQ - 1); const int pos = half ? 256 + (t & 63) : (t >> 6);
                const f32x2* tb = rope + pos * 32 + f0; f32x2 cs[4];
#pragma unroll
                for (int j = 0; j < 4; ++j) cs[j] = tb[j];
#pragma unroll
                for (int bj = 0; bj < 2; ++bj) { const f32x4 x1 = acc[ai][bj][m][0], x2 = acc[ai][bj][m][1]; float o1[4], o2[4];
#pragma unroll
                    for (int j = 0; j < 4; ++j) { o1[j] = (x1[j] * cs[j][0] - x2[j] * cs[j][1]) * sc; o2[j] = (x1[j] * cs[j][1] + x2[j] * cs[j][0]) * sc; }
                    bf16_t* p = dst + (size_t)row * 512 + (pn & 1) * 256 + bj * 128 + 64 * half + f0;
                    u32x2 w1, w2; w1.x = cvt_pk_bf16(o1[0], o1[1]); w1.y = cvt_pk_bf16(o1[2], o1[3]); w2.x = cvt_pk_bf16(o2[0], o2[1]); w2.y = cvt_pk_bf16(o2[2], o2[3]);
                    *(u32x2*)p = w1; *(u32x2*)(p + 32) = w2; } }
            return false;
        }
        int act, ldd, cb; bf16_t* dst;
        if (pn < 8) { dst = (bf16_t*)(ws + WS_ZV); act = 0; ldd = 1024; cb = (pn - 4) * 256; }
        else if (pn < 12) { dst = (bf16_t*)(ws + WS_ZG); act = 1; ldd = 1024; cb = (pn - 8) * 256; }
        else if (pn < 16) { dst = (bf16_t*)(ws + WS_ZXL); act = 0; ldd = 1024; cb = (pn - 12) * 256; }
        else if (pn < 20) { dst = (bf16_t*)(ws + WS_ZGL); act = 2; ldd = 1024; cb = (pn - 16) * 256; }
        else { dst = glog; act = 3; ldd = 2048; cb = (pn - 20) * 256; }
#pragma unroll
        for (int bj = 0; bj < 2; ++bj) { const int col = cb + bj * 128 + wc * 32 + 8 * fq; f32x4 b0 = (f32x4){0.f, 0.f, 0.f, 0.f}, b1 = b0;
            if (act == 3) { b0 = *(const f32x4*)(bgate + col); b1 = *(const f32x4*)(bgate + col + 4); }
#pragma unroll
            EPI_LOOP_ROWS { const int row = u.pm * 256 + ai * 128 + wr * 64 + m * 16 + fr; f32x4 v0 = acc[ai][bj][m][0] + b0, v1 = acc[ai][bj][m][1] + b1;
                if (act == 1) {
#pragma unroll
                    for (int j = 0; j < 4; ++j) { v0[j] = silu_(v0[j]); v1[j] = silu_(v1[j]); } }
                if (act == 2) {
#pragma unroll
                    for (int j = 0; j < 4; ++j) { v0[j] = gelu_tanh(v0[j]); v1[j] = gelu_tanh(v1[j]); } }
                u32x4 w; w.x = cvt_pk_bf16(v0[0], v0[1]); w.y = cvt_pk_bf16(v0[2], v0[3]); w.z = cvt_pk_bf16(v1[0], v1[1]); w.w = cvt_pk_bf16(v1[2], v1[3]);
                if (act == 3) *(u32x4*)(glog + (size_t)(u.pm * 8 + (pn - 20)) * 65536 + glog_frag(ai, bj, m, wr, wc, fr, fq)) = w;
                else *(u32x4*)(dst + (size_t)row * ldd + col) = w; } }
        return false;
    }
};

DI bf16x8 scale_frag8(bf16x8 f, const float (&w)[8]) { const u32x4 u = __builtin_bit_cast(u32x4, f); u32x4 o;
#pragma unroll
    for (int e = 0; e < 4; ++e) o[e] = cvt_pk_bf16(__uint_as_float(u[e] << 16) * w[2 * e], __uint_as_float(u[e] & 0xffff0000u) * w[2 * e + 1]);
    return __builtin_bit_cast(bf16x8, o); }
DI void r1_unit(LAS unsigned char* lds, const bf16_t* kp, const bf16_t* vp, int nrows, float lgf2, float lgb2, float* outf, float* outb) {
    const int tid = tid_fresh(), lane = tid & 63, wid = __builtin_amdgcn_readfirstlane(tid >> 6), h = lane >> 5, c = lane & 31;
    const int mh = wid >> 2, nb = wid & 3;
    LAS unsigned char* B0 = lds; LAS unsigned char* B1 = lds + 49152;
    const unsigned wl = (unsigned)wid * 1024u;
    const unsigned koff = (unsigned)((tid >> 4) * 1024 + (((tid & 15) ^ (((tid >> 4) & 3) << 2)) << 4));
    const unsigned voff = (unsigned)((tid >> 5) * 2048 + (((tid & 31) ^ (((tid >> 5) & 3) << 2)) << 4));
#define R1_STAGE(ch_, buf_) do { const char* kb_ = (const char*)kp + (size_t)(ch_) * 65536; const char* vb_ = (const char*)vp + (size_t)(ch_) * 131072; \
        _Pragma("unroll") for (int i_ = 0; i_ < 2; ++i_) GLDS16(kb_ + i_ * 32768 + koff, (buf_) + i_ * 8192 + wl); \
        _Pragma("unroll") for (int i_ = 0; i_ < 4; ++i_) GLDS16(vb_ + i_ * 32768 + voff, (buf_) + 16384 + i_ * 8192 + wl); } while (0)
    __syncthreads();
    R1_STAGE(0, B0);
    f32x16 acc[2][4];
#pragma unroll
    for (int d = 0; d < 2; ++d) for (int mi = 0; mi < 4; ++mi) acc[d][mi] = zero16();
    const unsigned q4 = (unsigned)((lane & 15) >> 2), lrow = (unsigned)(8 * h) + q4, lin = 32u * ((lane >> 4) & 1) + 8u * (lane & 3);
    const float gfm1 = ex2(-lgf2), gb1 = ex2(lgb2);
    const int nch = nrows / 64;
#pragma unroll 1
    for (int ch = 0; ch < nch; ++ch) {
        LAS unsigned char* buf = (ch & 1) ? B1 : B0;
        asm volatile("s_waitcnt vmcnt(0)" ::: "memory");
        lds_barrier();
        if (ch + 1 < nch) { if (ch & 1) R1_STAGE(ch + 1, B0); else R1_STAGE(ch + 1, B1); }
        const unsigned Kb = (unsigned)(size_t)buf + lrow * 256u + lin, Vb = (unsigned)(size_t)buf + 16384u + lrow * 512u + lin;
#pragma unroll
        for (int ks = 0; ks < 4; ++ks) {
            const bf16x8 kf = (ks == 0) ? tr_frag<0, 1024>(Kb + 64u * ((unsigned)nb ^ q4)) : (ks == 1) ? tr_frag<4096, 5120>(Kb + 64u * ((unsigned)nb ^ q4)) : (ks == 2) ? tr_frag<8192, 9216>(Kb + 64u * ((unsigned)nb ^ q4)) : tr_frag<12288, 13312>(Kb + 64u * ((unsigned)nb ^ q4));
            const int j0 = 64 * ch + 16 * ks + 8 * h; float wf[8], wb[8];
            wf[0] = ex2(lgf2 * (float)(nrows - 1 - j0)); wb[0] = ex2(lgb2 * (float)j0);
#pragma unroll
            for (int e = 1; e < 8; ++e) { wf[e] = wf[e - 1] * gfm1; wb[e] = wb[e - 1] * gb1; }
            const bf16x8 kff = scale_frag8(kf, wf), kfb = scale_frag8(kf, wb);
#pragma unroll
            for (int mi = 0; mi < 4; ++mi) { const unsigned va = Vb + 256u * (unsigned)mh + 64u * ((unsigned)mi ^ q4);
                const bf16x8 vf = (ks == 0) ? tr_frag<0, 2048>(va) : (ks == 1) ? tr_frag<8192, 10240>(va) : (ks == 2) ? tr_frag<16384, 18432>(va) : tr_frag<24576, 26624>(va);
                acc[0][mi] = MFMA32(vf, kff, acc[0][mi]); acc[1][mi] = MFMA32(vf, kfb, acc[1][mi]); }
        }
    }
    float* of = outf + (size_t)(128 * mh + 4 * h) * 128 + 32 * nb + c; float* ob = outb + (size_t)(128 * mh + 4 * h) * 128 + 32 * nb + c;
#pragma unroll
    for (int mi = 0; mi < 4; ++mi)
#pragma unroll
        for (int i = 0; i < 16; ++i) { of[(32 * mi + (i & 3) + 8 * (i >> 2)) * 128] = acc[0][mi][i]; ob[(32 * mi + (i & 3) + 8 * (i >> 2)) * 128] = acc[1][mi][i]; }
#undef R1_STAGE
}

template <bool FULL, int DIR>
DI void lru_scan(f32x16 (&acc)[2][2], float Hin, f32x2* agg_out) {
    const int lane = tid_fresh() & 63, h = lane >> 5;
    float sA[8], sU[8];
#pragma unroll
    for (int s = 0; s < 8; ++s) { const int mb = s >> 2, g = s & 3; float A = 1.f, U = 0.f;
#pragma unroll
        for (int e = 0; e < 4; ++e) { const int i = 4 * g + (DIR == 0 ? e : 3 - e); U = acc[0][mb][i] * U + acc[1][mb][i]; A *= acc[0][mb][i]; }
        sA[s] = A; sU[s] = U; }
    float pA[8], pU[8];
#pragma unroll
    for (int s = 0; s < 8; ++s) { pA[s] = __shfl_xor(sA[s], 32); pU[s] = __shfl_xor(sU[s], 32); }
    const bool first = (h == (DIR == 0 ? 0 : 1));
    if (!FULL) {
        float A = 1.f, U = 0.f;
#pragma unroll
        for (int q = 0; q < 8; ++q) { const int s = DIR == 0 ? q : 7 - q;
            const float A1 = first ? sA[s] : pA[s], U1 = first ? sU[s] : pU[s], A2 = first ? pA[s] : sA[s], U2 = first ? pU[s] : sU[s];
            U = A1 * U + U1; A *= A1; U = A2 * U + U2; A *= A2; }
        if (h == 0) *agg_out = (f32x2){A, U};
    } else {
        float H = Hin;
        float st[8];
#pragma unroll
        for (int q = 0; q < 8; ++q) { const int s = DIR == 0 ? q : 7 - q;
            const float A1 = first ? sA[s] : pA[s], U1 = first ? sU[s] : pU[s], A2 = first ? pA[s] : sA[s], U2 = first ? pU[s] : sU[s];
            const float Hm = A1 * H + U1; st[s] = first ? H : Hm; H = A2 * Hm + U2; }
#pragma unroll
        for (int s = 0; s < 8; ++s) { const int mb = s >> 2, g = s & 3; float hv = st[s];
#pragma unroll
            for (int e = 0; e < 4; ++e) { const int i = 4 * g + (DIR == 0 ? e : 3 - e); hv = acc[0][mb][i] * hv + acc[1][mb][i]; acc[1][mb][i] = hv; } }
    }
}

constexpr int LX_RS = 272;
template <bool FULL>
DI void lru_run(const KArgs& a, LAS unsigned char* lds, int b, int n, int tile0, int ntiles, bool is_ctx) {
    const int tid = tid_fresh(), lane = tid & 63, wid = __builtin_amdgcn_readfirstlane(tid >> 6), h = lane >> 5, c = lane & 31;
    LAS unsigned char* raw = lds;
    LAS unsigned char* xcb = lds + 67 * LX_RS;
    LAS float* cw = (LAS float*)(xcb + 64 * LX_RS);
    LAS float* hfb = cw + 640;
    LAS float* hbb = hfb + 64 * 132;
    const int Ls = is_ctx ? CTXL : SEQ;
    const bf16_t* xl = is_ctx ? (const bf16_t*)(a.ws + WS_CTXX) + (size_t)(b * CTXL) * 1024 + 128 * n : (const bf16_t*)(a.ws + WS_ZXL) + (size_t)(b * SEQ) * 1024 + 128 * n;
    const int dir = wid >> 2, nq = wid & 3, gc = 128 * n + 32 * nq + c;
    __syncthreads();
    for (int i = tid; i < 640; i += 512) { const int k = i >> 7, ch = i & 127; cw[i] = k < 4 ? a.in[I_CONVW][k * 1024 + 128 * n + ch] : a.in[I_CONVB][128 * n + ch]; }
    bf16x8 Bw[2][8];
    {   const bf16_t* wa = (const bf16_t*)(a.ws + WS_WLB) + (size_t)((2 * dir) * 8 + n) * 128 * 128 + (size_t)(32 * nq + c) * 128 + 8 * h;
#pragma unroll
        for (int ks = 0; ks < 8; ++ks) { Bw[0][ks] = *(const bf16x8*)(wa + 16 * ks); Bw[1][ks] = *(const bf16x8*)(wa + (size_t)8 * 128 * 128 + 16 * ks); } }
    const float ba2 = -LOG2E * a.in[I_LBA][dir * 1024 + gc], bx2 = -LOG2E * a.in[I_LBX][dir * 1024 + gc];
    const float cl = -8.0f * softplus_(-a.in[I_LLAM][dir * 1024 + gc]) * LOG2E;
    const size_t chain0 = ((size_t)(b * 2 + dir) * 1024 + gc) * NSLOT;
    u32x4 pre[3];
#define LRU_LOADRAW(tile_) do { _Pragma("unroll") for (int i_ = 0; i_ < 3; ++i_) { const int pid_ = tid + 512 * i_; pre[i_] = (u32x4){0u, 0u, 0u, 0u}; \
        if (pid_ < 67 * 16) { const int t_ = (tile_) * LT + (pid_ >> 4) - 1; if (t_ >= 0 && t_ < Ls) pre[i_] = *(const u32x4*)(xl + (size_t)t_ * 1024 + (pid_ & 15) * 8); } } } while (0)
    LRU_LOADRAW(tile0);
    for (int it = 0; it < ntiles; ++it) {
        const int tile = tile0 + it, t0 = tile * LT;
#pragma unroll
        for (int i = 0; i < 3; ++i) { const int pid = tid + 512 * i; if (pid < 67 * 16) *(LAS u32x4*)(raw + (pid >> 4) * LX_RS + (pid & 15) * 16) = pre[i]; }
        if (it + 1 < ntiles) LRU_LOADRAW(tile + 1);
        const int slot = is_ctx ? (dir == 0 ? tile : 3 - tile) : (dir == 0 ? 4 + tile : 4 + (NLT - 1 - tile));
        float Hin = 0.f; if (FULL) Hin = ((const float*)(a.ws + WS_LHIN))[chain0 + slot];
        u32x4 gpre[2]; bf16_t* gtile = (bf16_t*)(a.ws + WS_ZGL) + (size_t)(b * SEQ + t0) * 1024 + 128 * n;
        if (FULL) {
#pragma unroll
            for (int i = 0; i < 2; ++i) { const int pid = tid + 512 * i; gpre[i] = *(const u32x4*)(gtile + (size_t)(pid >> 4) * 1024 + (pid & 15) * 8); } }
        lds_barrier();
        {
            const int row = tid >> 3, c0 = (tid & 7) * 16; float o[16];
#pragma unroll
            for (int j = 0; j < 16; j += 4) { const f32x4 bv = *(const LAS f32x4*)(cw + 512 + c0 + j); o[j] = bv[0]; o[j + 1] = bv[1]; o[j + 2] = bv[2]; o[j + 3] = bv[3]; }
#pragma unroll
            for (int k = 0; k < 4; ++k) { const u32x4 p0 = *(const LAS u32x4*)(raw + (row + k) * LX_RS + c0 * 2), p1 = *(const LAS u32x4*)(raw + (row + k) * LX_RS + c0 * 2 + 16);
#pragma unroll
                for (int e = 0; e < 4; ++e) { const f32x4 w0 = *(const LAS f32x4*)(cw + k * 128 + c0 + 4 * (e >> 1) ), w1 = *(const LAS f32x4*)(cw + k * 128 + c0 + 8 + 4 * (e >> 1));
                    o[2 * e] += w0[2 * (e & 1)] * __uint_as_float(p0[e] << 16); o[2 * e + 1] += w0[2 * (e & 1) + 1] * __uint_as_float(p0[e] & 0xffff0000u);
                    o[8 + 2 * e] += w1[2 * (e & 1)] * __uint_as_float(p1[e] << 16); o[8 + 2 * e + 1] += w1[2 * (e & 1) + 1] * __uint_as_float(p1[e] & 0xffff0000u); } }
            u32x4 w0, w1;
#pragma unroll
            for (int e = 0; e < 4; ++e) { w0[e] = cvt_pk_bf16(o[2 * e], o[2 * e + 1]); w1[e] = cvt_pk_bf16(o[8 + 2 * e], o[8 + 2 * e + 1]); }
            *(LAS u32x4*)(xcb + row * LX_RS + c0 * 2) = w0; *(LAS u32x4*)(xcb + row * LX_RS + c0 * 2 + 16) = w1;
        }
        lds_barrier();
        f32x16 acc[2][2];
#pragma unroll
        for (int q = 0; q < 2; ++q) for (int mb = 0; mb < 2; ++mb) acc[q][mb] = zero16();
#pragma unroll
        for (int ks = 0; ks < 8; ++ks) {
            const bf16x8 a0 = *(const LAS bf16x8*)(xcb + c * LX_RS + (16 * ks + 8 * h) * 2), a1 = *(const LAS bf16x8*)(xcb + (32 + c) * LX_RS + (16 * ks + 8 * h) * 2);
            acc[0][0] = MFMA32(a0, Bw[0][ks], acc[0][0]); acc[0][1] = MFMA32(a1, Bw[0][ks], acc[0][1]); acc[1][0] = MFMA32(a0, Bw[1][ks], acc[1][0]); acc[1][1] = MFMA32(a1, Bw[1][ks], acc[1][1]);
        }
#pragma unroll
        for (int mb = 0; mb < 2; ++mb)
#pragma unroll
            for (int i = 0; i < 16; ++i) { const int row = 32 * mb + crow(i, h);
                const float r = rcpf_(1.0f + ex2(acc[0][mb][i] + ba2)), ig = rcpf_(1.0f + ex2(acc[1][mb][i] + bx2));
                const float av = ex2(cl * r); const float s = __builtin_amdgcn_sqrtf(__builtin_fmaf(-av, av, 1.0f));
                acc[0][mb][i] = av; acc[1][mb][i] = s * ig * bf2f(*(const LAS bf16_t*)(xcb + row * LX_RS + (32 * nq + c) * 2)); }
        f32x2* aggp = (f32x2*)(a.ws + WS_LAGG) + chain0 + slot;
        if (dir == 0) lru_scan<FULL, 0>(acc, Hin, aggp); else lru_scan<FULL, 1>(acc, Hin, aggp);
        if (FULL) {
            LAS float* hd = dir == 0 ? hfb : hbb;
#pragma unroll
            for (int mb = 0; mb < 2; ++mb)
#pragma unroll
                for (int i = 0; i < 16; ++i) hd[(32 * mb + crow(i, h)) * 132 + 32 * nq + c] = acc[1][mb][i];
            lds_barrier();
#pragma unroll
            for (int i = 0; i < 2; ++i) { const int pid = tid + 512 * i, row = pid >> 4, c8 = (pid & 15) * 8;
                const f32x4 f0 = *(const LAS f32x4*)(hfb + row * 132 + c8), f1 = *(const LAS f32x4*)(hfb + row * 132 + c8 + 4), b0 = *(const LAS f32x4*)(hbb + row * 132 + c8), b1 = *(const LAS f32x4*)(hbb + row * 132 + c8 + 4);
                const u32x4 g = gpre[i]; u32x4 o;
                o[0] = cvt_pk_bf16((f0[0] + b0[0]) * __uint_as_float(g[0] << 16), (f0[1] + b0[1]) * __uint_as_float(g[0] & 0xffff0000u));
                o[1] = cvt_pk_bf16((f0[2] + b0[2]) * __uint_as_float(g[1] << 16), (f0[3] + b0[3]) * __uint_as_float(g[1] & 0xffff0000u));
                o[2] = cvt_pk_bf16((f1[0] + b1[0]) * __uint_as_float(g[2] << 16), (f1[1] + b1[1]) * __uint_as_float(g[2] & 0xffff0000u));
                o[3] = cvt_pk_bf16((f1[2] + b1[2]) * __uint_as_float(g[3] << 16), (f1[3] + b1[3]) * __uint_as_float(g[3] & 0xffff0000u));
                *(u32x4*)(gtile + (size_t)row * 1024 + c8) = o; }
        }
    }
#undef LRU_LOADRAW
}

DI void ret_decays(const KArgs& a, int h, float& lgf2, float& lgb2) {
    const float* rd = (const float*)(a.ws + WS_RDEC); lgf2 = rd[h]; lgb2 = rd[4 + h];
}

DI void phase2a(const KArgs& a, LAS unsigned char* lds) {
    const int G = gridDim.x;
    constexpr int NU_R1 = NB_ * NH * NSC, NU_CK = NB_ * NH, NU_LX = NB_ * 8 * 16, NU_LC = NB_ * 8 * 4;
    for (int u = blockIdx.x; u < NU_R1 + NU_CK + NU_LX + NU_LC; u += G) {
        if (SUBSEL(1) && u < NU_R1) {
            const int sc = u & 31, h = (u >> 5) & 3, b = u >> 7; float lgf2, lgb2; ret_decays(a, h, lgf2, lgb2);
            float* o = (float*)(a.ws + WS_HX) + (size_t)(((b * 4 + h) * 32 + sc) * 2) * 32768;
            PB(100); r1_unit(lds, (const bf16_t*)(a.ws + WS_ZK) + (size_t)(b * SEQ + sc * SCH) * 512 + h * 128, (const bf16_t*)(a.ws + WS_ZV) + (size_t)(b * SEQ + sc * SCH) * 1024 + h * 256, SCH, lgf2, lgb2, o, o + 32768); PE(100);
        } else if (SUBSEL(1) && u < NU_R1 + NU_CK) {
            const int q = u - NU_R1, h = q & 3, b = q >> 2; float lgf2, lgb2; ret_decays(a, h, lgf2, lgb2);
            float* o = (float*)(a.ws + WS_CTXS) + (size_t)((b * 4 + h) * 2) * 32768;
            r1_unit(lds, (const bf16_t*)(a.ws + WS_CTXK) + (size_t)(b * CTXL) * 512 + h * 128, (const bf16_t*)(a.ws + WS_CTXV) + (size_t)(b * CTXL) * 1024 + h * 256, CTXL, lgf2, lgb2, o, o + 32768);
        } else if (SUBSEL(2) && u < NU_R1 + NU_CK + NU_LX) {
            const int q = u - NU_R1 - NU_CK, b = q >> 7, n = (q >> 4) & 7, r = q & 15;
            PB(101); lru_run<false>(a, lds, b, n, 16 * r, 16, false); PE(101);
        } else if (SUBSEL(2)) {
            const int q = u - NU_R1 - NU_CK - NU_LX, b = q >> 5, n = (q >> 2) & 7, tl = q & 3;
            lru_run<false>(a, lds, b, n, tl, 1, true);
        }
    }
}

DI void phase2b(const KArgs& a) {
    const int tid = tid_fresh(), G = gridDim.x, lane = tid & 63, wid = tid >> 6;
    for (int e = blockIdx.x * 512 + tid; e < NB_ * NH * 2 * 8192; e += G * 512) {
        const int e4 = e & 8191, dir = (e >> 13) & 1, h = (e >> 14) & 3, b = e >> 16;
        float lgf2, lgb2; ret_decays(a, h, lgf2, lgb2); const float gC = ex2((dir ? lgb2 : lgf2) * (float)SCH);
        f32x4 S = *(const f32x4*)((const float*)(a.ws + WS_CTXS) + (size_t)((b * 4 + h) * 2 + dir) * 32768 + 4 * e4);
        const float* kv = (const float*)(a.ws + WS_HX) + (size_t)((b * 4 + h) * 32 * 2 + dir) * 32768 + 4 * e4;
        bf16_t* so = (bf16_t*)(a.ws + WS_SBF) + (size_t)((b * 4 + h) * 32 * 2 + dir) * 32768 + 4 * e4;
        for (int s0 = 0; s0 < NSC; s0 += 8) {
            f32x4 kvv[8];
#pragma unroll
            for (int j = 0; j < 8; ++j) { const int sc = dir ? NSC - 1 - (s0 + j) : s0 + j; kvv[j] = *(const f32x4*)(kv + (size_t)sc * 65536); }
#pragma unroll
            for (int j = 0; j < 8; ++j) { const int sc = dir ? NSC - 1 - (s0 + j) : s0 + j;
                u32x2 w; w.x = cvt_pk_bf16(S[0], S[1]); w.y = cvt_pk_bf16(S[2], S[3]); *(u32x2*)(so + (size_t)sc * 65536) = w;
                S = S * gC + kvv[j]; }
        }
    }
    for (int ch = blockIdx.x * 8 + wid; ch < NB_ * 2 * 1024; ch += G * 8) {
        const f32x2* ag = (const f32x2*)(a.ws + WS_LAGG) + (size_t)ch * NSLOT; float* hin = (float*)(a.ws + WS_LHIN) + (size_t)ch * NSLOT;
        float carry = 0.f;
        for (int rd = 0; rd < 5; ++rd) { const int slot = 64 * rd + lane;
            f32x2 v = (f32x2){1.f, 0.f}; if (slot < 4 + NLT) v = ag[slot];
            float A = v[0], U = v[1];
#pragma unroll
            for (int o = 1; o < 64; o <<= 1) { const float Ap = __shfl_up(A, o), Up = __shfl_up(U, o); if (lane >= o) { U = A * Up + U; A = A * Ap; } }
            const float incl = A * carry + U;
            float excl = __shfl_up(incl, 1); if (lane == 0) excl = carry;
            if (slot < 4 + NLT) hin[slot] = excl;
            carry = __shfl(incl, 63);
        }
    }
}

constexpr int R3_KB = 16384, R3_VB = 32768;
template <int O, int T> DI void tr_frag2x2(unsigned a0, unsigned a1, bf16x8& f0, bf16x8& f1, bf16x8& f2, bf16x8& f3) {
    s16x4 r0, r1, r2, r3, r4, r5, r6, r7;
    asm volatile("ds_read_b64_tr_b16 %0, %8 offset:%10\n\tds_read_b64_tr_b16 %1, %8 offset:%11\n\t"
                 "ds_read_b64_tr_b16 %2, %8 offset:%12\n\tds_read_b64_tr_b16 %3, %8 offset:%13\n\t"
                 "ds_read_b64_tr_b16 %4, %9 offset:%10\n\tds_read_b64_tr_b16 %5, %9 offset:%11\n\t"
                 "ds_read_b64_tr_b16 %6, %9 offset:%12\n\tds_read_b64_tr_b16 %7, %9 offset:%13\n\ts_waitcnt lgkmcnt(0)"
                 : "=&v"(r0), "=&v"(r1), "=&v"(r2), "=&v"(r3), "=&v"(r4), "=&v"(r5), "=&v"(r6), "=&v"(r7)
                 : "v"(a0), "v"(a1), "i"(O), "i"(O + T), "i"(O + 256), "i"(O + 256 + T) : "memory");
    f0 = __builtin_shufflevector(r0, r1, 0, 1, 2, 3, 4, 5, 6, 7); f1 = __builtin_shufflevector(r2, r3, 0, 1, 2, 3, 4, 5, 6, 7);
    f2 = __builtin_shufflevector(r4, r5, 0, 1, 2, 3, 4, 5, 6, 7); f3 = __builtin_shufflevector(r6, r7, 0, 1, 2, 3, 4, 5, 6, 7);
}
DI bf16x8 scale_frag(bf16x8 f, float s) { const u32x4 u = __builtin_bit_cast(u32x4, f); u32x4 o;
#pragma unroll
    for (int e = 0; e < 4; ++e) o[e] = cvt_pk_bf16(__uint_as_float(u[e] << 16) * s, __uint_as_float(u[e] & 0xffff0000u) * s);
    return __builtin_bit_cast(bf16x8, o); }

DI void r3_unit(const KArgs& a, LAS unsigned char* lds, int b, int hh, int qb2) {
    const int tid = tid_fresh(), lane = tid & 63, wid = __builtin_amdgcn_readfirstlane(tid >> 6), h = lane >> 5, c = lane & 31;
    const int sc = qb2 >> 1, qpos = 256 * (qb2 & 1) + 32 * wid + c;
    float lgf2, lgb2; ret_decays(a, hh, lgf2, lgb2);
    const size_t tokS = (size_t)b * SEQ + SCH * sc, tokQ = tokS + qpos;
    LAS unsigned char* R0 = lds; LAS unsigned char* R1 = lds + 65536;
    const bf16_t* zk = (const bf16_t*)(a.ws + WS_ZK) + tokS * 512 + hh * 128; const bf16_t* zv = (const bf16_t*)(a.ws + WS_ZV) + tokS * 1024 + hh * 256;
    const unsigned wl = (unsigned)wid * 1024u;
    const unsigned soff = (unsigned)((tid >> 4) * 256 + (((tid & 15) ^ ((tid >> 4) & 15)) << 4));
    const unsigned koff = (unsigned)((tid >> 4) * 1024 + (((tid & 15) ^ ((tid >> 4) & 15)) << 4));
    const unsigned voff = (unsigned)((tid >> 5) * 2048 + (((tid & 31) ^ (((tid >> 5) & 3) << 2)) << 4));
#define R3_STAGE_KV(jb_, buf_) do { const char* kb_ = (const char*)zk + (size_t)(jb_) * 65536; const char* vb_ = (const char*)zv + (size_t)(jb_) * 131072; \
        _Pragma("unroll") for (int i_ = 0; i_ < 2; ++i_) GLDS16(kb_ + i_ * 32768 + koff, (buf_) + i_ * 8192 + wl); \
        _Pragma("unroll") for (int i_ = 0; i_ < 4; ++i_) GLDS16(vb_ + i_ * 32768 + voff, (buf_) + R3_KB + i_ * 8192 + wl); } while (0)
    __syncthreads();
    PB(110);
#pragma unroll
    for (int d = 0; d < 2; ++d) { const char* Sg = (const char*)((const bf16_t*)(a.ws + WS_SBF) + (size_t)(((b * 4 + hh) * 32 + sc) * 2 + d) * 32768);
#pragma unroll
        for (int i = 0; i < 8; ++i) GLDS16(Sg + i * 8192 + soff, (d ? R1 : R0) + i * 8192 + wl); }
    bf16x8 Qf[8];
    {   const bf16_t* qp = (const bf16_t*)(a.ws + WS_ZQ) + tokQ * 512 + hh * 128 + 8 * h;
#pragma unroll
        for (int ks = 0; ks < 8; ++ks) Qf[ks] = *(const bf16x8*)(qp + 16 * ks); }
    f32x16 OT[8];
#pragma unroll
    for (int nb = 0; nb < 8; ++nb) OT[nb] = zero16();
    const unsigned xq = (unsigned)(c & 15), rowb = (unsigned)c * 256u;
    float cf8[4], cfe[4], cb8[4], cbe[4];
#pragma unroll
    for (int k = 1; k < 4; ++k) { cf8[k] = __int_as_float(__builtin_amdgcn_readfirstlane(__float_as_int(ex2(-lgf2 * (float)(8 * k))))); cfe[k] = __int_as_float(__builtin_amdgcn_readfirstlane(__float_as_int(ex2(-lgf2 * (float)k))));
        cb8[k] = __int_as_float(__builtin_amdgcn_readfirstlane(__float_as_int(ex2(lgb2 * (float)(8 * k))))); cbe[k] = __int_as_float(__builtin_amdgcn_readfirstlane(__float_as_int(ex2(lgb2 * (float)k)))); }
    const int q0 = 256 * (qb2 & 1) + 32 * wid;
#pragma unroll
    for (int d = 0; d < 2; ++d) {
        if (d == 0) asm volatile("s_waitcnt vmcnt(16)" ::: "memory"); else asm volatile("s_waitcnt vmcnt(6)" ::: "memory");
        __builtin_amdgcn_s_barrier(); asm volatile("" ::: "memory");
        const float dec = d == 0 ? ex2(lgf2 * (float)(qpos + 1)) : ex2(lgb2 * (float)(SCH - qpos));
        const unsigned Sb = (unsigned)(size_t)(d ? R1 : R0) + rowb;
#pragma unroll
        for (int ks = 0; ks < 8; ++ks) { bf16x8 qf = Qf[ks]; asm volatile("" : "+v"(qf));
            const bf16x8 qs = scale_frag(qf, dec); const unsigned co = (((unsigned)(2 * ks + h)) ^ xq) << 4;
#pragma unroll
            for (int nb = 0; nb < 8; ++nb) { const bf16x8 sf = *(const LAS bf16x8*)(size_t)(Sb + 32 * 256 * nb + co); OT[nb] = MFMA32(sf, qs, OT[nb]); if (nb == 3) asm volatile("" ::: "memory"); }
            asm volatile("" ::: "memory"); }
        if (d == 0) { lds_barrier(); R3_STAGE_KV(0, R0); }
    }
    PE(110); PB(111);
    const unsigned q4 = (unsigned)((lane & 15) >> 2), vlane = (unsigned)(4 * h + q4) * 512u + 32u * ((lane >> 4) & 1) + 8u * (lane & 3);
#pragma unroll 1
    for (int jb = 0; jb < 8; ++jb) {
        LAS unsigned char* buf = (jb & 1) ? R1 : R0;
        asm volatile("s_waitcnt vmcnt(0)" ::: "memory");
        lds_barrier();
        if (jb + 1 < 8) { if (jb & 1) R3_STAGE_KV(jb + 1, R0); else R3_STAGE_KV(jb + 1, R1); }
        const unsigned Kb = (unsigned)(size_t)buf + rowb, Vb = (unsigned)(size_t)buf + R3_KB + vlane;
#pragma unroll
        for (int jt = 0; jt < 2; ++jt) {
            f32x16 st = zero16();
#pragma unroll
            for (int ks = 0; ks < 8; ++ks) { const bf16x8 kf = *(const LAS bf16x8*)(size_t)(Kb + 32 * 256 * jt + ((((unsigned)(2 * ks + h)) ^ xq) << 4)); st = MFMA32(kf, Qf[ks], st); }
            const int k0 = 64 * jb + 32 * jt;
            if (k0 == q0) {
#pragma unroll
                for (int i = 0; i < 16; ++i) { const int dd = qpos - (k0 + (i & 3) + 8 * (i >> 2) + 4 * h); st[i] *= (dd >= 0 ? ex2(lgf2 * (float)dd) : ex2(lgb2 * (float)(-dd))); }
            } else if (k0 < q0) { const float bh = ex2(lgf2 * (float)(q0 - k0 + c - 4 * h));
#pragma unroll
                for (int i = 0; i < 16; ++i) { float w = bh; if (i >> 2) w *= cf8[i >> 2]; if (i & 3) w *= cfe[i & 3]; st[i] *= w; }
            } else { const float bh = ex2(lgb2 * (float)(k0 - q0 + 4 * h - c));
#pragma unroll
                for (int i = 0; i < 16; ++i) { float w = bh; if (i >> 2) w *= cb8[i >> 2]; if (i & 3) w *= cbe[i & 3]; st[i] *= w; }
            }
#pragma unroll
            for (int s2 = 0; s2 < 2; ++s2) { u32x4 pk;
#pragma unroll
                for (int e = 0; e < 4; ++e) pk[e] = cvt_pk_bf16(st[8 * s2 + 2 * e], st[8 * s2 + 2 * e + 1]);
                const bf16x8 pb = __builtin_bit_cast(bf16x8, pk);
#pragma unroll
                for (int hf = 0; hf < 2; ++hf) {
                    bf16x8 v0, v1, v2, v3; const unsigned a0 = Vb + 64u * ((unsigned)(2 * hf) ^ q4), a1 = Vb + 64u * ((unsigned)(2 * hf + 1) ^ q4);
                    if (jt == 0 && s2 == 0) tr_frag2x2<0, 4096>(a0, a1, v0, v1, v2, v3);
                    if (jt == 0 && s2 == 1) tr_frag2x2<8192, 4096>(a0, a1, v0, v1, v2, v3);
                    if (jt == 1 && s2 == 0) tr_frag2x2<16384, 4096>(a0, a1, v0, v1, v2, v3);
                    if (jt == 1 && s2 == 1) tr_frag2x2<24576, 4096>(a0, a1, v0, v1, v2, v3);
                    OT[2 * hf] = MFMA32(v0, pb, OT[2 * hf]); OT[2 * hf + 4] = MFMA32(v1, pb, OT[2 * hf + 4]);
                    OT[2 * hf + 1] = MFMA32(v2, pb, OT[2 * hf + 1]); OT[2 * hf + 5] = MFMA32(v3, pb, OT[2 * hf + 5]);
                }
            }
        }
    }
    PE(111); PB(112);
    float s1 = 0.f, s2 = 0.f;
#pragma unroll
    for (int nb = 0; nb < 8; ++nb)
#pragma unroll
        for (int i = 0; i < 16; ++i) { s1 += OT[nb][i]; s2 += OT[nb][i] * OT[nb][i]; }
    s1 += __shfl_xor(s1, 32); s2 += __shfl_xor(s2, 32);
    const float mu = s1 * (1.0f / 256.0f), rstd = rsqrtf(fmaxf(s2 * (1.0f / 256.0f) - mu * mu, 0.f) + EPSV);
    lds_barrier();
    {   const int t2 = tid_fresh(), l2 = t2 & 63, w2 = t2 >> 6, h2 = l2 >> 5, c2 = l2 & 31;
        LAS unsigned char* slab = lds + (size_t)w2 * 16896;
#pragma unroll
        for (int nb = 0; nb < 8; ++nb)
#pragma unroll
            for (int g = 0; g < 4; ++g) { u32x2 o; o.x = cvt_pk_bf16((OT[nb][4 * g] - mu) * rstd, (OT[nb][4 * g + 1] - mu) * rstd); o.y = cvt_pk_bf16((OT[nb][4 * g + 2] - mu) * rstd, (OT[nb][4 * g + 3] - mu) * rstd);
                *(LAS u32x2*)(slab + c2 * 528 + (32 * nb + 8 * g + 4 * h2) * 2) = o; }
        bf16_t* gp = (bf16_t*)(a.ws + WS_ZG) + ((size_t)b * SEQ + SCH * sc + 256 * (qb2 & 1) + 32 * w2) * 1024 + hh * 256 + 8 * c2;
        const f32x4 gn0 = *(const f32x4*)(a.in[I_RNORM] + hh * 256 + 8 * c2), gn1 = *(const f32x4*)(a.in[I_RNORM] + hh * 256 + 8 * c2 + 4);
        u32x4 sg[16];
#pragma unroll
        for (int r = 0; r < 16; ++r) sg[r] = *(const u32x4*)(gp + (size_t)(2 * r + h2) * 1024);
        lds_wait();
#pragma unroll
        for (int r = 0; r < 16; ++r) { const u32x4 y = *(const LAS u32x4*)(slab + (2 * r + h2) * 528 + c2 * 16); u32x4 o;
            o[0] = cvt_pk_bf16(__uint_as_float(y[0] << 16) * gn0[0] * __uint_as_float(sg[r][0] << 16), __uint_as_float(y[0] & 0xffff0000u) * gn0[1] * __uint_as_float(sg[r][0] & 0xffff0000u));
            o[1] = cvt_pk_bf16(__uint_as_float(y[1] << 16) * gn0[2] * __uint_as_float(sg[r][1] << 16), __uint_as_float(y[1] & 0xffff0000u) * gn0[3] * __uint_as_float(sg[r][1] & 0xffff0000u));
            o[2] = cvt_pk_bf16(__uint_as_float(y[2] << 16) * gn1[0] * __uint_as_float(sg[r][2] << 16), __uint_as_float(y[2] & 0xffff0000u) * gn1[1] * __uint_as_float(sg[r][2] & 0xffff0000u));
            o[3] = cvt_pk_bf16(__uint_as_float(y[3] << 16) * gn1[2] * __uint_as_float(sg[r][3] << 16), __uint_as_float(y[3] & 0xffff0000u) * gn1[3] * __uint_as_float(sg[r][3] & 0xffff0000u));
            *(u32x4*)(gp + (size_t)(2 * r + h2) * 1024) = o; }
    }
    PE(112);
#undef R3_STAGE_KV
}

DI void phase2c(const KArgs& a, LAS unsigned char* lds) {
    const int G = gridDim.x;
    constexpr int NU_R3 = NB_ * NH * (SEQ / 256), NU_L3 = NB_ * 8 * 16;
    for (int u = blockIdx.x; u < NU_R3 + NU_L3; u += G) {
        if (SUBSEL(1) && u < NU_R3) { const int w = u & 255, uu = (u & ~255) + 2 * ((w & 7) + 8 * (w >> 4)) + ((w >> 3) & 1);
            const int b = uu >> 8, hh = (uu >> 6) & 3, qb2 = uu & 63; PB(102); r3_unit(a, lds, b, hh, qb2); PE(102); }
        else if (SUBSEL(2)) { const int q = u - NU_R3, b = q >> 7, n = (q >> 4) & 7, r = q & 15; PB(103); lru_run<true>(a, lds, b, n, 16 * r, 16, false); PE(103); }
    }
}

DI void cvt4_decode(const KArgs& a, int t, const float*& src, int& ld_src, unsigned char*& dst, size_t& hi_stride, int& ld_dst) {
    constexpr int T_GU = 32 * 2 * 16 * 3;
    if (t < T_GU) { const int e = t / 96, r = t % 96, mat = r / 48, kt = (r % 48) / 3, ng = r % 3;
        src = a.in[mat ? I_WEU : I_WEG] + (size_t)e * 1024 * 768 + (size_t)(64 * kt) * 768 + 256 * ng; ld_src = 768;
        dst = (unsigned char*)(a.ws + WS_WGU) + ((size_t)(e * 6 + 2 * ng) * 256 + mat * 128) * 1024 + 64 * kt; hi_stride = (size_t)256 * 1024; ld_dst = 1024;
    } else { const int q = t - T_GU, e = q / 48, r = q % 48, kt = r / 4, ng = r % 4;
        src = a.in[I_WED] + (size_t)e * 768 * 1024 + (size_t)(64 * kt) * 1024 + 256 * ng; ld_src = 1024;
        dst = (unsigned char*)(a.ws + WS_WDN) + ((size_t)e * 1024 + 256 * ng) * 768 + 64 * kt; hi_stride = (size_t)128 * 768; ld_dst = 768; }
}
DI unsigned cvt4_fp8_noclamp(float a, float b, float c, float d) { int p = 0; p = __builtin_amdgcn_cvt_pk_fp8_f32(a, b, p, false); p = __builtin_amdgcn_cvt_pk_fp8_f32(c, d, p, true); return (unsigned)p; }
DI void phase3_cvt(const KArgs& a, LAS unsigned char* lds) {
    const int G = gridDim.x, tid = tid_fresh(); LAS float* tile = (LAS float*)lds;
    constexpr int T_ALL = 32 * 2 * 16 * 3 + 32 * 12 * 4;
    const float* src; int ld_src; unsigned char* dA; size_t hA; int ldA; unsigned char* dB = nullptr; size_t hB = 0; int ldB = 0; unsigned char* dC = nullptr; size_t hC = 0; int ldC = 0;
    f32x4 va[8], vb[8], vc[8];
#define CVT_LOAD(v_, t_, d_, h_, l_) do { cvt4_decode(a, (t_), src, ld_src, d_, h_, l_); _Pragma("unroll") for (int i_ = 0; i_ < 8; ++i_) v_[i_] = *(const f32x4*)(src + (size_t)((tid >> 6) + 8 * i_) * ld_src + 4 * (tid & 63)); } while (0)
#define CVT_EMIT(v_) do { lds_barrier(); _Pragma("unroll") for (int i_ = 0; i_ < 8; ++i_) *(LAS f32x4*)(tile + ((tid >> 6) + 8 * i_) * 260 + 4 * (tid & 63)) = v_[i_]; } while (0)
#define CVT_STORE(d_, h_, l_) do { lds_barrier(); const int n_ = tid & 255, kh_ = tid >> 8; unsigned char* p_ = (d_) + (size_t)(n_ >> 7) * (h_) + (size_t)(n_ & 127) * (l_) + 32 * kh_; \
        _Pragma("unroll") for (int q_ = 0; q_ < 2; ++q_) { float x_[16]; _Pragma("unroll") for (int j_ = 0; j_ < 16; ++j_) x_[j_] = tile[(32 * kh_ + 16 * q_ + j_) * 260 + n_] * 64.0f; \
            u32x4 w_; w_.x = cvt4_fp8_noclamp(x_[0], x_[1], x_[2], x_[3]); w_.y = cvt4_fp8_noclamp(x_[4], x_[5], x_[6], x_[7]); w_.z = cvt4_fp8_noclamp(x_[8], x_[9], x_[10], x_[11]); w_.w = cvt4_fp8_noclamp(x_[12], x_[13], x_[14], x_[15]); \
            *(u32x4*)(p_ + 16 * q_) = w_; } } while (0)
#define CVT_STEP(v_, d_, h_, l_) { unsigned char* d0 = d_; const size_t h0 = h_; const int l0 = l_; CVT_EMIT(v_); if (t + 3 * G < T_ALL) CVT_LOAD(v_, t + 3 * G, d_, h_, l_); CVT_STORE(d0, h0, l0); } t += G; if (t >= T_ALL) break;
    int t = blockIdx.x; if (t >= T_ALL) return;
    CVT_LOAD(va, t, dA, hA, ldA);
    if (t + G < T_ALL) CVT_LOAD(vb, t + G, dB, hB, ldB);
    if (t + 2 * G < T_ALL) CVT_LOAD(vc, t + 2 * G, dC, hC, ldC);
    for (;;) {
        CVT_STEP(va, dA, hA, ldA)
        CVT_STEP(vb, dB, hB, ldB)
        CVT_STEP(vc, dC, hC, ldC)
    }
#undef CVT_LOAD
#undef CVT_EMIT
#undef CVT_STORE
#undef CVT_STEP
    __syncthreads();
}
struct OrderMerge {
    const char* A0; const char* A1; const char* B0; const char* B1; int G, c;
    DI bool next(int i, Unit& u) const { int pm, pn; if (!pg8::static_tile(i >> 1, G, c, NT / 256, 4, pm, pn)) return false;
        const int st = i & 1; u.pm = pm; u.pn = pn; u.aux = st; u.bmode = 1; u.A = (st ? A1 : A0) + (size_t)pm * 256 * 1024 * 2; u.B = (st ? B1 : B0) + (size_t)pn * 256 * 1024 * 2; return true; }
    DI void offsA(const Unit&, int, const int (&R)[2], const int (&C)[2], unsigned (&v)[2][2]) const { pg8::dense_offs(2048, R, C, v); }
};
struct EpiMerge {
    const bf16_t* glog; bf16_t* out;
    DI bool operator()(f32x4 (&acc)[2][2][4][2], const Unit& u, int wr, int wc, int fr, int fq) const {
        const bool st0 = (u.aux == 0);
        const bf16_t* gbase = glog + (size_t)(u.pm * 8 + u.pn) * 65536;
        u32x4 gl[2][4], gr[2][4];
#define EM_LOAD(bt_, slot_) do { const int bj_ = (bt_) >> 1, ai_ = (bt_) & 1; _Pragma("unroll") for (int m_ = 0; m_ < 4; ++m_) { const bf16_t* p_ = gbase + glog_frag(ai_, bj_, m_, wr, wc, fr, fq); \
            gl[slot_][m_] = *(const u32x4*)(p_ + 4 * 65536); if (st0) gr[slot_][m_] = *(const u32x4*)p_; } } while (0)
        EM_LOAD(0, 0);
#pragma unroll
        for (int bt = 0; bt < 4; ++bt) { const int bj = bt >> 1, ai = bt & 1, sl = bt & 1;
            if (bt + 1 < 4) { if (sl == 0) EM_LOAD(bt + 1, 1); else EM_LOAD(bt + 1, 0); }
#pragma unroll
            for (int m = 0; m < 4; ++m) { const u32x4 l4 = gl[sl][m];
                if (st0) { const u32x4 r4 = gr[sl][m];
#pragma unroll
                    for (int e = 0; e < 4; ++e) { const float r0 = __uint_as_float(r4[e] << 16), r1 = __uint_as_float(r4[e] & 0xffff0000u), l0 = __uint_as_float(l4[e] << 16), l1 = __uint_as_float(l4[e] & 0xffff0000u);
                        const float q0 = (1.0f + ex2(-LOG2E * l0)) * rcpf_(1.0f + ex2(-LOG2E * r0)), q1 = (1.0f + ex2(-LOG2E * l1)) * rcpf_(1.0f + ex2(-LOG2E * r1));
                        acc[ai][bj][m][e >> 1][2 * (e & 1)] *= q0; acc[ai][bj][m][e >> 1][2 * (e & 1) + 1] *= q1; }
                } else { float v[8];
#pragma unroll
                    for (int e = 0; e < 4; ++e) { const float l0 = __uint_as_float(l4[e] << 16), l1 = __uint_as_float(l4[e] & 0xffff0000u);
                        v[2 * e] = acc[ai][bj][m][e >> 1][2 * (e & 1)] * sigm(l0); v[2 * e + 1] = acc[ai][bj][m][e >> 1][2 * (e & 1) + 1] * sigm(l1); }
                    u32x4 w; w.x = cvt_pk_bf16(v[0], v[1]); w.y = cvt_pk_bf16(v[2], v[3]); w.z = cvt_pk_bf16(v[4], v[5]); w.w = cvt_pk_bf16(v[6], v[7]);
                    *(u32x4*)(out + (size_t)(u.pm * 256 + ai * 128 + wr * 64 + m * 16 + fr) * 1024 + u.pn * 256 + bj * 128 + wc * 32 + 8 * fq) = w; } } }
#undef EM_LOAD
        return st0;
    }
};

struct OrderOut {
    const char* A; const char* B; int G, c;
    DI bool next(int i, Unit& u) const { int pm, pn; if (!pg8::static_tile(i, G, c, NT / 256, 4, pm, pn)) return false;
        u.pm = pm; u.pn = pn; u.aux = 0; u.bmode = 1; u.A = A + (size_t)pm * 256 * 1024 * 2; u.B = B + (size_t)pn * 256 * 1024 * 2; return true; }
    DI void offsA(const Unit&, int, const int (&R)[2], const int (&C)[2], unsigned (&v)[2][2]) const { pg8::dense_offs(2048, R, C, v); }
};
struct EpiOut {
    const KArgs* a;
    DI bool operator()(f32x4 (&acc)[2][2][4][2], const Unit& u, int wr, int wc, int fr, int fq) const {
        const int b = (u.pm * 256) / SEQ; bf16_t* d1 = (bf16_t*)(a->ws + WS_D1);
#pragma unroll
        for (int bj = 0; bj < 2; ++bj) { const int col = u.pn * 256 + bj * 128 + wc * 32 + 8 * fq;
            const f32x4 g0 = *(const f32x4*)((const float*)(a->ws + WS_MODT) + b * 1024 + col), g1 = *(const f32x4*)((const float*)(a->ws + WS_MODT) + b * 1024 + col + 4);
#pragma unroll
            EPI_LOOP_ROWS { const size_t off = (size_t)(u.pm * 256 + ai * 128 + wr * 64 + m * 16 + fr) * 1024 + col; const f32x4 v0 = g0 * acc[ai][bj][m][0], v1 = g1 * acc[ai][bj][m][1];
                u32x4 w; w.x = cvt_pk_bf16(v0[0], v0[1]); w.y = cvt_pk_bf16(v0[2], v0[3]); w.z = cvt_pk_bf16(v1[0], v1[1]); w.w = cvt_pk_bf16(v1[2], v1[3]);
                *(u32x4*)(d1 + off) = w; } }
        return false;
    }
};

DI void phase5(const KArgs& a, LAS unsigned char* lds) {
    const int tid = tid_fresh(), G = gridDim.x, lane = tid & 63, wid = __builtin_amdgcn_readfirstlane(tid >> 6);
    LAS float* gm = (LAS float*)lds;
    LAS float* sh = gm + 2048;
    LAS float* lg = sh + 2048;
    LAS int* lcnt = (LAS int*)(lg + 128 * 40);
    LAS int* rinfo = lcnt + 64;
    LAS float* rw = (LAS float*)(rinfo + 512);
    LAS float* red = rw + 256;
    LAS unsigned char* At = (LAS unsigned char*)(red + 4 * 32 * 40);
    __syncthreads();
    for (int i = tid; i < 2048; i += 512) { const float* mt = (const float*)(a.ws + WS_MODT); gm[i] = mt[2048 + i]; sh[i] = mt[4096 + i]; }
    if (blockIdx.x == 0 && tid < 256) ((unsigned*)(a.ws + WS_HX2Q) + (size_t)NT * 256)[tid] = 0u;
    const int cb = wid & 1, kq = wid >> 1, r = lane & 31, h = lane >> 5;
    bf16x8 Bh[16], Bl[16];
    {   const bf16_t* bh = (const bf16_t*)(a.ws + WS_WRH) + (size_t)(32 * cb + r) * 1024 + 256 * kq + 8 * h;
#pragma unroll
        for (int s2 = 0; s2 < 16; ++s2) { Bh[s2] = *(const bf16x8*)(bh + 16 * s2); Bl[s2] = *(const bf16x8*)(bh + 64 * 1024 + 16 * s2); } }
    for (int rt = blockIdx.x; rt < NT / 128; rt += G) {
        __syncthreads();
        if (tid < 32) lcnt[tid] = 0;
        const int v = (128 * rt) / SEQ; const bf16_t* d1 = (const bf16_t*)(a.ws + WS_D1);
        for (int ch = 0; ch < 4; ++ch) {
            PB(130);
            {
                const int rowc = 4 * wid, row0 = 128 * rt + 32 * ch + rowc; f32x4 x[2][4], xb[2][4]; u32x2 dl[2][4], db[2][4];
#pragma unroll
                for (int q = 0; q < 2; ++q)
#pragma unroll
                    for (int j = 0; j < 4; ++j) { x[q][j] = *(const f32x4*)(a.in[I_X] + (size_t)(row0 + q) * 1024 + 4 * lane + 256 * j); dl[q][j] = *(const u32x2*)(d1 + (size_t)(row0 + q) * 1024 + 4 * lane + 256 * j); }
#pragma unroll
                for (int pr = 0; pr < 2; ++pr) {
                    if (pr == 0) {
#pragma unroll
                        for (int q = 0; q < 2; ++q)
#pragma unroll
                            for (int j = 0; j < 4; ++j) { xb[q][j] = *(const f32x4*)(a.in[I_X] + (size_t)(row0 + 2 + q) * 1024 + 4 * lane + 256 * j); db[q][j] = *(const u32x2*)(d1 + (size_t)(row0 + 2 + q) * 1024 + 4 * lane + 256 * j); } }
#pragma unroll
                    for (int q = 0; q < 2; ++q) { const int row = row0 + 2 * pr + q; float ss = 0.f;
#pragma unroll
                        for (int j = 0; j < 4; ++j) { x[q][j][0] += __uint_as_float(dl[q][j].x << 16); x[q][j][1] += __uint_as_float(dl[q][j].x & 0xffff0000u); x[q][j][2] += __uint_as_float(dl[q][j].y << 16); x[q][j][3] += __uint_as_float(dl[q][j].y & 0xffff0000u);
                            ss += (x[q][j][0] * x[q][j][0] + x[q][j][1] * x[q][j][1]) + (x[q][j][2] * x[q][j][2] + x[q][j][3] * x[q][j][3]); }
#pragma unroll
                        for (int o = 32; o >= 1; o >>= 1) ss += __shfl_xor(ss, o);
                        const float rstd = rsqrtf(ss * (1.0f / 1024.0f) + EPSV);
#pragma unroll
                        for (int j = 0; j < 4; ++j) { const int k0 = 4 * lane + 256 * j; const f32x4 g = *(const LAS f32x4*)(gm + v * 1024 + k0), sv = *(const LAS f32x4*)(sh + v * 1024 + k0);
                            const float y0 = x[q][j][0] * rstd * g[0] + sv[0], y1 = x[q][j][1] * rstd * g[1] + sv[1], y2 = x[q][j][2] * rstd * g[2] + sv[2], y3 = x[q][j][3] * rstd * g[3] + sv[3];
                            u32x2 w; w.x = cvt_pk_bf16(y0, y1); w.y = cvt_pk_bf16(y2, y3);
                            *(LAS u32x2*)(At + (rowc + 2 * pr + q) * 2064 + k0 * 2) = w;
                            *(unsigned*)((unsigned char*)(a.ws + WS_HX2Q) + (size_t)row * 1024 + k0) = cvt4_fp8(16.f * y0, 16.f * y1, 16.f * y2, 16.f * y3); } }
                    if (pr == 0) {
#pragma unroll
                        for (int q = 0; q < 2; ++q)
#pragma unroll
                            for (int j = 0; j < 4; ++j) { x[q][j] = xb[q][j]; dl[q][j] = db[q][j]; } }
                }
            }
            lds_barrier();
            PE(130); PB(131);
            {
                f32x16 acc = zero16();
#pragma unroll
                for (int s2 = 0; s2 < 16; ++s2) { const bf16x8 af = *(const LAS bf16x8*)(At + r * 2064 + (256 * kq + 16 * s2 + 8 * h) * 2); acc = MFMA32(af, Bh[s2], acc); acc = MFMA32(af, Bl[s2], acc); }
                const int col = 32 * cb + r;
                if (col < 36) {
#pragma unroll
                    for (int i = 0; i < 16; ++i) red[(kq * 32 + crow(i, h)) * 40 + col] = acc[i]; }
            }
            lds_barrier();
            for (int i = tid; i < 32 * 36; i += 512) { const int rr = i / 36, cc = i % 36; lg[(32 * ch + rr) * 40 + cc] = (red[(0 * 32 + rr) * 40 + cc] + red[(1 * 32 + rr) * 40 + cc]) + (red[(2 * 32 + rr) * 40 + cc] + red[(3 * 32 + rr) * 40 + cc]); }
            PE(131);
        }
        __syncthreads();
        PB(132);
        if (tid < 128) { const LAS float* l = lg + tid * 40;
            int gs = 0; float best = l[0] + a.in[I_BGRP][0];
#pragma unroll
            for (int g = 1; g < 4; ++g) { const float vv = l[g] + a.in[I_BGRP][g]; if (vv > best) { best = vv; gs = g; } }
            const float mx = fmaxf(fmaxf(l[0], l[1]), fmaxf(l[2], l[3])); float den = 0.f;
#pragma unroll
            for (int g = 0; g < 4; ++g) den += expf(l[g] - mx);
            const float pg = expf(l[gs] - mx) / den;
            int i0 = 0, i1 = -1; float v0 = -3.0e38f, v1 = -3.0e38f;
#pragma unroll
            for (int e = 0; e < 8; ++e) { const float vv = l[4 + 8 * gs + e] + a.in[I_BRT][8 * gs + e];
                if (vv > v0) { v1 = v0; i1 = i0; v0 = vv; i0 = e; } else if (vv > v1) { v1 = vv; i1 = e; } }
            const float e0 = l[4 + 8 * gs + i0], e1 = l[4 + 8 * gs + i1], m2 = fmaxf(e0, e1), x0 = expf(e0 - m2), x1 = expf(e1 - m2), inv = 1.0f / (x0 + x1);
            const int ex0 = 8 * gs + i0, ex1 = 8 * gs + i1;
            rinfo[tid * 4 + 0] = ex0; rinfo[tid * 4 + 1] = atomicAdd((int*)&lcnt[ex0], 1); rinfo[tid * 4 + 2] = ex1; rinfo[tid * 4 + 3] = atomicAdd((int*)&lcnt[ex1], 1);
            rw[tid * 2 + 0] = pg * x0 * inv; rw[tid * 2 + 1] = pg * x1 * inv; }
        __syncthreads();
        { const int t3 = tid_fresh(); if (t3 < 32) lcnt[32 + t3] = lcnt[t3] ? atomicAdd((int*)(a.ws + WS_CTL) + CW_CNT + t3, lcnt[t3]) : 0; }
        __syncthreads();
        if (tid < 128) { const int tok = 128 * rt + tid; const int e0 = rinfo[tid * 4 + 0], s0 = lcnt[32 + e0] + rinfo[tid * 4 + 1], e1 = rinfo[tid * 4 + 2], s1 = lcnt[32 + e1] + rinfo[tid * 4 + 3];
            int* ptok = (int*)(a.ws + WS_PTOK); ptok[(size_t)e0 * 65536 + s0] = tok; ptok[(size_t)e1 * 65536 + s1] = tok;
            unsigned* ro = (unsigned*)(a.ws + WS_ROUTE) + (size_t)tok * 8; ro[0] = e0; ro[1] = s0; ro[2] = e1; ro[3] = s1; ro[4] = __float_as_uint(rw[tid * 2]); ro[5] = __float_as_uint(rw[tid * 2 + 1]); }
        PE(132);
    }
}

DI void moe_tiles(const KArgs& a, LAS int* tt) {
    __syncthreads();
    if (threadIdx.x == 0) { const int* cnt = (const int*)(a.ws + WS_CTL) + CW_CNT; int s = 0; for (int e = 0; e < 32; ++e) { tt[e] = s; s += (cnt[e] + 255) >> 8; } tt[32] = s; }
    __syncthreads();
}
DI int moe_expert(const LAS int* tt, int rt) { int e = 0;
#pragma unroll
    for (int q = 16; q >= 1; q >>= 1) if (tt[e + q] <= rt) e += q;
    return e; }
struct OrderMoe1 {
    const char* A; const char* B; const LAS int* tt; const LAS int* tok; int G, c;
    DI bool next(int i, Unit& u) const { const int L = i * G + c; if (L >= tt[32] * 6) return false; const int rt = L / 6, ct = L % 6, e = moe_expert(tt, rt);
        u.pm = rt; u.pn = ct; u.aux = e; u.bmode = 1; u.A = A; u.B = B + (size_t)(e * 6 + ct) * 256 * 1024; return true; }
    DI void offsA(const Unit&, int ui, const int (&R)[2], const int (&C)[2], unsigned (&v)[2][2]) const {
#pragma unroll
        for (int h = 0; h < 2; ++h)
#pragma unroll
            for (int i = 0; i < 2; ++i) v[h][i] = (unsigned)tok[ui * 256 + h * 128 + R[i]] * 1024u + (unsigned)C[i] * 2u; }
};
struct EpiMoe1 {
    unsigned char* hid;
    DI bool operator()(f32x4 (&acc)[2][2][4][2], const Unit& u, int wr, int wc, int fr, int fq) const {
        const int col = u.pn * 128 + wc * 32 + 8 * fq;
#pragma unroll
        EPI_LOOP_ROWS { const size_t row = (size_t)u.pm * 256 + ai * 128 + wr * 64 + m * 16 + fr; float v[8];
#pragma unroll
            for (int n = 0; n < 2; ++n)
#pragma unroll
                for (int j = 0; j < 4; ++j) { const float g = acc[ai][0][m][n][j] * (1.0f / 1024.0f), up = acc[ai][1][m][n][j] * (1.0f / 1024.0f); v[4 * n + j] = silu_(g) * up * 8.0f; }
            u32x2 w; w.x = cvt4_fp8(v[0], v[1], v[2], v[3]); w.y = cvt4_fp8(v[4], v[5], v[6], v[7]);
            *(u32x2*)(hid + row * 768 + col) = w; }
        return false;
    }
};
struct OrderMoe2 {
    const char* A; const char* B; const LAS int* tt; int G, c;
    DI bool next(int i, Unit& u) const { const int L = i * G + c; if (L >= tt[32] * 4) return false; const int rt = L >> 2, ct = L & 3, e = moe_expert(tt, rt);
        u.pm = rt; u.pn = ct; u.aux = e; u.bmode = 1; u.A = A + (size_t)rt * 256 * 768; u.B = B + ((size_t)e * 1024 + 256 * ct) * 768; return true; }
    DI void offsA(const Unit&, int, const int (&R)[2], const int (&C)[2], unsigned (&v)[2][2]) const { pg8::dense_offs(768, R, C, v); }
};
struct EpiMoe2 {
    unsigned char* ye;
    DI bool operator()(f32x4 (&acc)[2][2][4][2], const Unit& u, int wr, int wc, int fr, int fq) const {
#pragma unroll
        for (int bj = 0; bj < 2; ++bj) { const int col = u.pn * 256 + bj * 128 + wc * 32 + 8 * fq;
#pragma unroll
            EPI_LOOP_ROWS { const size_t row = (size_t)u.pm * 256 + ai * 128 + wr * 64 + m * 16 + fr; const f32x4 v0 = acc[ai][bj][m][0] * (16.0f / 512.0f), v1 = acc[ai][bj][m][1] * (16.0f / 512.0f);
                u32x2 w; w.x = cvt4_fp8(v0[0], v0[1], v0[2], v0[3]); w.y = cvt4_fp8(v1[0], v1[1], v1[2], v1[3]);
                *(u32x2*)(ye + row * 1024 + col) = w; } }
        return false;
    }
};

DI void phase8(const KArgs& a, LAS unsigned char* lds) {
    const int tid = tid_fresh(), G = gridDim.x, lane = tid & 63, wid = tid >> 6;
    LAS float* g2 = (LAS float*)lds;
    LAS int* tt = (LAS int*)(g2 + 2048);
    moe_tiles(a, tt);
    for (int i = tid; i < 2048; i += 512) g2[i] = ((const float*)(a.ws + WS_MODT))[6144 + i];
    __syncthreads();
    const unsigned char* ye = (const unsigned char*)(a.ws + WS_YE); const bf16_t* d1 = (const bf16_t*)(a.ws + WS_D1);
    const int rstep = G * 8; int row = blockIdx.x * 8 + wid;
    f32x4 x[4]; u32x2 dl[4]; unsigned ya[4], yb[4]; float w0 = 0.f, w1 = 0.f; unsigned ron[6];
#define P8_ROUTE(r_, dst_) do { const unsigned* ro_ = (const unsigned*)(a.ws + WS_ROUTE) + (size_t)(r_) * 8; _Pragma("unroll") for (int q_ = 0; q_ < 6; ++q_) dst_[q_] = ro_[q_]; } while (0)
#define P8_LOAD(r_, rt_, X_, D_, A_, B_) do { const size_t p0_ = (size_t)tt[rt_[0]] * 256 + rt_[1], p1_ = (size_t)tt[rt_[2]] * 256 + rt_[3]; \
        _Pragma("unroll") for (int j_ = 0; j_ < 4; ++j_) { const int k0_ = 4 * lane + 256 * j_; X_[j_] = *(const f32x4*)(a.in[I_X] + (size_t)(r_) * 1024 + k0_); D_[j_] = *(const u32x2*)(d1 + (size_t)(r_) * 1024 + k0_); \
            A_[j_] = *(const unsigned*)(ye + p0_ * 1024 + k0_); B_[j_] = *(const unsigned*)(ye + p1_ * 1024 + k0_); } } while (0)
    if (row < NT) { unsigned r0[6]; P8_ROUTE(row, r0); P8_LOAD(row, r0, x, dl, ya, yb); w0 = __uint_as_float(r0[4]); w1 = __uint_as_float(r0[5]); if (row + rstep < NT) P8_ROUTE(row + rstep, ron); }
    for (; row < NT; row += rstep) {
        const int v = row / SEQ, nrow = row + rstep; f32x4 xn[4]; u32x2 dn[4]; unsigned yan[4], ybn[4]; float w0n = 0.f, w1n = 0.f;
        if (nrow < NT) { P8_LOAD(nrow, ron, xn, dn, yan, ybn); w0n = __uint_as_float(ron[4]); w1n = __uint_as_float(ron[5]); if (nrow + rstep < NT) P8_ROUTE(nrow + rstep, ron); }
        float ss = 0.f; const float s0 = w0 * (1.0f / 16.0f), s1 = w1 * (1.0f / 16.0f);
#pragma unroll
        for (int j = 0; j < 4; ++j) { const int k0 = 4 * lane + 256 * j; const f32x4 g = *(const LAS f32x4*)(g2 + v * 1024 + k0);
            const float m0 = s0 * __builtin_amdgcn_cvt_f32_fp8(ya[j], 0) + s1 * __builtin_amdgcn_cvt_f32_fp8(yb[j], 0), m1 = s0 * __builtin_amdgcn_cvt_f32_fp8(ya[j], 1) + s1 * __builtin_amdgcn_cvt_f32_fp8(yb[j], 1);
            const float m2 = s0 * __builtin_amdgcn_cvt_f32_fp8(ya[j], 2) + s1 * __builtin_amdgcn_cvt_f32_fp8(yb[j], 2), m3 = s0 * __builtin_amdgcn_cvt_f32_fp8(ya[j], 3) + s1 * __builtin_amdgcn_cvt_f32_fp8(yb[j], 3);
            x[j][0] += __uint_as_float(dl[j].x << 16) + g[0] * m0; x[j][1] += __uint_as_float(dl[j].x & 0xffff0000u) + g[1] * m1;
            x[j][2] += __uint_as_float(dl[j].y << 16) + g[2] * m2; x[j][3] += __uint_as_float(dl[j].y & 0xffff0000u) + g[3] * m3;
            ss += (x[j][0] * x[j][0] + x[j][1] * x[j][1]) + (x[j][2] * x[j][2] + x[j][3] * x[j][3]); }
#pragma unroll
        for (int o = 32; o >= 1; o >>= 1) ss += __shfl_xor(ss, o);
        const float rstd = rsqrtf(ss * (1.0f / 1024.0f) + EPSV);
        float* xr = a.out + (size_t)row * 1024;
#pragma unroll
        for (int j = 0; j < 4; ++j) { const int k0 = 4 * lane + 256 * j; const f32x4 fn = *(const f32x4*)(a.in[I_FNORM] + k0); *(f32x4*)(xr + k0) = x[j] * rstd * fn; }
#pragma unroll
        for (int j = 0; j < 4; ++j) { x[j] = xn[j]; dl[j] = dn[j]; ya[j] = yan[j]; yb[j] = ybn[j]; }
        w0 = w0n; w1 = w1n;
    }
#undef P8_ROUTE
#undef P8_LOAD
}

constexpr int N_PHASES = 12;
__global__ void __launch_bounds__(512, 2) fwd_kernel(KArgs a) {
    extern __shared__ __attribute__((aligned(16))) unsigned char lds_raw[];
    LAS unsigned char* lds = (LAS unsigned char*)lds_raw;
    volatile LAS unsigned* misc = (volatile LAS unsigned*)(lds + LDS_MISC);
    if (threadIdx.x < 8) misc[threadIdx.x] = 0u;
#ifdef PROBE_ID
    if (threadIdx.x == 0) { probe_words()[0] = 0; probe_words()[1] = 0; }
#endif
    __syncthreads();
    XcdBarrier bar; bar.bar = (unsigned*)(a.ws + WS_CTL) + CW_BAR; bar.x = 0; bar.st = misc;
    const bool one = (a.ph_hi - a.ph_lo) > 1;
    if (one) bar = xcd_barrier_post((unsigned*)(a.ws + WS_CTL) + CW_BAR, misc);
#ifdef ONLY_PHASE
#define IN(k) ((k) == ONLY_PHASE)
#else
#define IN(k) (a.ph_lo <= (k) && (k) < a.ph_hi)
#endif
#define SEAM(k) do { if (IN(k) && IN((k) + 1)) xcd_barrier(bar); PE(k); PB((k) + 1); } while (0)
    const int G = gridDim.x, c = blockIdx.x;
    PB(0);
    if (IN(0)) { phase0a(a, lds); } SEAM(0);
    if (IN(1)) { phase0b(a, lds); } SEAM(1);
    if (IN(2)) { __syncthreads(); OrderIn S{(const char*)(a.ws + WS_HX), (const char*)(a.ws + WS_WIN), G, c};
        EpiIn E{a.ws, (bf16_t*)a.out, a.in[I_BGATE], (const f32x2*)(a.ws + WS_ROPE)}; pg8::gemm_phase<false>(lds, 1024, S, E); } SEAM(2);
    if (IN(3)) { phase2a(a, lds); } SEAM(3);
    if (IN(4)) { phase2b(a); } SEAM(4);
    if (IN(5)) { phase2c(a, lds); } SEAM(5);
    if (IN(6)) {
        const bool cvt_first = (c & 1) == 0;
        if (cvt_first) { PB(104); phase3_cvt(a, lds); PE(104); }
        {   OrderMerge S{(const char*)(a.ws + WS_ZG), (const char*)(a.ws + WS_ZGL), (const char*)(a.ws + WS_WRET), (const char*)(a.ws + WS_WLRU), G, c};
            EpiMerge E{(const bf16_t*)a.out, (bf16_t*)(a.ws + WS_HX)}; __syncthreads(); pg8::gemm_phase<false>(lds, 1024, S, E); }
        if (!cvt_first) { phase3_cvt(a, lds); } } SEAM(6);
    if (IN(7)) { __syncthreads(); OrderOut S{(const char*)(a.ws + WS_HX), (const char*)(a.ws + WS_WOUT), G, c}; EpiOut E{&a}; pg8::gemm_phase<false>(lds, 1024, S, E); } SEAM(7);
    if (IN(8)) { phase5(a, lds); } SEAM(8);
    if (IN(9)) {
        LAS int* tt = (LAS int*)(lds + LDS_MISC + 64); LAS int* tok = (LAS int*)(lds + LDS_TOK);
        moe_tiles(a, tt);
        {
            const int tid = tid_fresh();
            const int* cnt = (const int*)(a.ws + WS_CTL) + CW_CNT; const int* ptok = (const int*)(a.ws + WS_PTOK);
            for (int i = 0; i < 8; ++i) { const int L = i * G + c; if (L >= tt[32] * 6) break; const int rt = L / 6, e = moe_expert(tt, rt), r0 = (rt - tt[e]) * 256;
                if (tid < 256) tok[i * 256 + tid] = (r0 + tid < cnt[e]) ? ptok[(size_t)e * 65536 + r0 + tid] : NT; }
            __syncthreads();
        }
        OrderMoe1 S{(const char*)(a.ws + WS_HX2Q), (const char*)(a.ws + WS_WGU), tt, tok, G, c}; EpiMoe1 E{(unsigned char*)(a.ws + WS_HID)}; pg8::gemm_phase<true>(lds, 1024, S, E); } SEAM(9);
    if (IN(10)) { LAS int* tt = (LAS int*)(lds + LDS_MISC + 64); moe_tiles(a, tt);
        OrderMoe2 S{(const char*)(a.ws + WS_HID), (const char*)(a.ws + WS_WDN), tt, G, c}; EpiMoe2 E{(unsigned char*)(a.ws + WS_YE)}; pg8::gemm_phase<true>(lds, 768, S, E); } SEAM(10);
    if (IN(11)) { phase8(a, lds); }
    PE(11);
#ifdef PROBE_ID
    if (blockIdx.x == 0 && threadIdx.x == 0) { const unsigned long long w = probe_words()[1] * 4ull, t0 = wall_clock64(); while (wall_clock64() - t0 < w) __builtin_amdgcn_s_sleep(8); }
#endif
#undef IN
#undef SEAM
}

extern "C" void kernel_launch(void* const* d_in, const int* in_sizes, int n_in, void* d_out, int out_size, void* d_ws, size_t ws_size, hipStream_t stream) {
    static int grid = 0;
    if (grid == 0) {
        if (n_in != 30 || out_size != NT * DM || ws_size < WS_NEED) { fprintf(stderr, "kernel_launch: unexpected shapes (n_in %d out %d ws %zu)\n", n_in, out_size, ws_size); grid = -1; return; }
        int dev = 0, cus = 0;
        if (hipGetDevice(&dev) != hipSuccess || hipDeviceGetAttribute(&cus, hipDeviceAttributeMultiprocessorCount, dev) != hipSuccess) { grid = -1; return; }
        if (hipFuncSetAttribute((const void*)fwd_kernel, hipFuncAttributeMaxDynamicSharedMemorySize, LDS_BYTES) != hipSuccess) { fprintf(stderr, "kernel_launch: hipFuncSetAttribute failed\n"); grid = -1; return; }
        int per_cu = 0; (void)hipOccupancyMaxActiveBlocksPerMultiprocessor(&per_cu, (const void*)fwd_kernel, 512, LDS_BYTES); (void)hipGetLastError();
        grid = cus;
    }
    if (grid < 0) return;
    (void)hipMemsetAsync((char*)d_ws + WS_CTL, 0, 1 * MiB, stream);
    KArgs a{};
    for (int i = 0; i < 30; ++i) a.in[i] = (const float*)d_in[i];
    a.out = (float*)d_out; a.ws = (unsigned char*)d_ws;
#if N_LAUNCH_SPLIT
    for (int p = 0; p < N_PHASES; ++p) { a.ph_lo = p; a.ph_hi = p + 1; hipLaunchKernelGGL(fwd_kernel, dim3(grid), dim3(512), LDS_BYTES, stream, a); }
#else
    a.ph_lo = 0; a.ph_hi = N_PHASES; hipLaunchKernelGGL(fwd_kernel, dim3(grid), dim3(512), LDS_BYTES, stream, a);
#endif
}
```

```cpp
#include <hip/hip_runtime.h>
#include <cstdio>
#include <cstdint>

#ifndef N_LAUNCH_SPLIT
#define N_LAUNCH_SPLIT 0
#endif

#define DI __device__ __forceinline__
#ifdef SUB
#define SUBSEL(k) ((k) == SUB)
#else
#define SUBSEL(k) true
#endif
#define LAS __attribute__((address_space(3)))
typedef unsigned short bf16_t;
typedef short bf16x8 __attribute__((ext_vector_type(8)));
typedef short s16x4 __attribute__((ext_vector_type(4)));
typedef float f32x2 __attribute__((ext_vector_type(2)));
typedef float f32x4 __attribute__((ext_vector_type(4)));
typedef float f32x16 __attribute__((ext_vector_type(16)));
typedef unsigned u32x2 __attribute__((ext_vector_type(2)));
typedef unsigned u32x4 __attribute__((ext_vector_type(4)));
typedef int v8i_t __attribute__((ext_vector_type(8)));
typedef int v4i_t __attribute__((ext_vector_type(4)));

constexpr int NB_ = 2, SEQ = 16384, NT = NB_ * SEQ, DM = 1024, CTXL = 256, NTC = NB_ * CTXL;
constexpr int NH = 4, DK = 128, DV = 256, QW = 512, VW = 1024, LW = 1024;
constexpr int NCOL = 7168;
constexpr int NE = 32, EH = 768;
constexpr float EPSV = 1e-6f;
constexpr float LOG2E = 1.4426950408889634f;
constexpr int SCH = 512, NSC = SEQ / SCH;
constexpr int LT = 64, NLT = SEQ / LT, NSLOT = 320;

constexpr size_t MiB = 1u << 20;
constexpr size_t WS_CTL = 0;
constexpr size_t WS_MODP = 1 * MiB;
constexpr size_t WS_MODT = 1 * MiB + 384 * 1024;
constexpr size_t WS_RDEC = 1 * MiB + 448 * 1024;
constexpr size_t WS_ROPE = 1 * MiB + 512 * 1024;
constexpr size_t WS_WRH = 1 * MiB + 768 * 1024;
constexpr size_t WS_LAGG = 2 * MiB;
constexpr size_t WS_LHIN = 12 * MiB;
constexpr size_t WS_CTXK = 17 * MiB;
constexpr size_t WS_CTXV = 17 * MiB + 512 * 1024;
constexpr size_t WS_CTXX = 18 * MiB + 512 * 1024;
constexpr size_t WS_CTXS = 20 * MiB;
constexpr size_t WS_ROUTE = 22 * MiB;
constexpr size_t WS_PTOK = 23 * MiB;
constexpr size_t WS_WIN = 32 * MiB;
constexpr size_t WS_WRET = 46 * MiB, WS_WLRU = 48 * MiB, WS_WOUT = 50 * MiB;
constexpr size_t WS_WLB = 52 * MiB;
constexpr size_t WS_HX = 56 * MiB;
constexpr size_t WS_ZQ = 120 * MiB, WS_ZK = 152 * MiB, WS_ZV = 184 * MiB, WS_ZG = 248 * MiB, WS_ZXL = 312 * MiB, WS_ZGL = 376 * MiB;
constexpr size_t WS_SBF = 440 * MiB;
constexpr size_t WS_WGU = 120 * MiB;
constexpr size_t WS_WDN = 440 * MiB;
constexpr size_t WS_HX2 = 248 * MiB;
constexpr size_t WS_HID = 313 * MiB;
constexpr size_t WS_HX2Q = 168 * MiB;
constexpr size_t WS_YE = 56 * MiB;
constexpr size_t WS_D1 = 376 * MiB;
constexpr size_t WS_NEED = 512 * MiB;
constexpr int CW_BAR = 4096, CW_CNT = 16384;

constexpr int LDS_SCR = 0, LDS_TOK = 131072, LDS_MISC = 131072 + 8192, LDS_BYTES = 147456;

DI int tid_fresh() { int t = threadIdx.x; asm volatile("" : "+v"(t)); return t; }
#ifdef PROBE_ID
DI volatile LAS unsigned long long* probe_words() { extern __shared__ __attribute__((aligned(16))) unsigned char lds_raw[]; return (volatile LAS unsigned long long*)((LAS unsigned char*)lds_raw + 131072 + 8192 + 1024); }
#define PB(id) do { if ((id) == PROBE_ID && threadIdx.x == 0) probe_words()[0] = wall_clock64(); } while (0)
#define PE(id) do { if ((id) == PROBE_ID && threadIdx.x == 0) probe_words()[1] += wall_clock64() - probe_words()[0]; } while (0)
#else
#define PB(id) do {} while (0)
#define PE(id) do {} while (0)
#endif
DI float bf2f(unsigned short b) { return __uint_as_float(((unsigned)b) << 16); }
typedef __bf16 bf16x2_t __attribute__((ext_vector_type(2)));
DI unsigned cvt_pk_bf16(float lo, float hi) { const f32x2 v = {lo, hi}; return __builtin_bit_cast(unsigned, __builtin_convertvector(v, bf16x2_t)); }
DI float clamp_f8(float x) { return __builtin_amdgcn_fmed3f(x, -448.f, 448.f); }
DI unsigned cvt4_fp8(float a, float b, float c, float d) { int p = 0; p = __builtin_amdgcn_cvt_pk_fp8_f32(clamp_f8(a), clamp_f8(b), p, false); p = __builtin_amdgcn_cvt_pk_fp8_f32(clamp_f8(c), clamp_f8(d), p, true); return (unsigned)p; }
DI unsigned short f2bf(float f) { return (unsigned short)(cvt_pk_bf16(f, 0.f) & 0xffffu); }
DI float ex2(float x) { return __builtin_amdgcn_exp2f(x); }
DI float rcpf_(float x) { return __builtin_amdgcn_rcpf(x); }
DI float sigm(float x) { return rcpf_(1.0f + ex2(-LOG2E * x)); }
DI float silu_(float x) { return x * sigm(x); }
DI float gelu_tanh(float x) { const float z = 0.7978845608028654f * (x + 0.044715f * x * x * x); return x * sigm(2.0f * z); }
DI float softplus_(float x) { return x > 20.f ? x : log1pf(expf(x)); }
DI int crow(int i, int h) { return (i & 3) + 8 * (i >> 2) + 4 * h; }
#define MFMA32(a, b, c) __builtin_amdgcn_mfma_f32_32x32x16_bf16((a), (b), (c), 0, 0, 0)
DI void lds_wait() { asm volatile("s_waitcnt lgkmcnt(0)" ::: "memory"); }
template <int O0, int O1> DI bf16x8 tr_frag(unsigned addr) {
    s16x4 lo, hi;
    asm volatile("ds_read_b64_tr_b16 %0, %2 offset:%3\n\tds_read_b64_tr_b16 %1, %2 offset:%4\n\ts_waitcnt lgkmcnt(0)" : "=&v"(lo), "=&v"(hi) : "v"(addr), "i"(O0), "i"(O1) : "memory");
    return __builtin_shufflevector(lo, hi, 0, 1, 2, 3, 4, 5, 6, 7);
}
template <int O, int S, int T> DI void tr_frag4(unsigned addr, bf16x8& f0, bf16x8& f1, bf16x8& f2, bf16x8& f3) {
    s16x4 a0, a1, b0, b1, c0, c1, d0, d1;
    asm volatile("ds_read_b64_tr_b16 %0, %8 offset:%9\n\tds_read_b64_tr_b16 %1, %8 offset:%10\n\t"
                 "ds_read_b64_tr_b16 %2, %8 offset:%11\n\tds_read_b64_tr_b16 %3, %8 offset:%12\n\t"
                 "ds_read_b64_tr_b16 %4, %8 offset:%13\n\tds_read_b64_tr_b16 %5, %8 offset:%14\n\t"
                 "ds_read_b64_tr_b16 %6, %8 offset:%15\n\tds_read_b64_tr_b16 %7, %8 offset:%16\n\ts_waitcnt lgkmcnt(0)"
                 : "=&v"(a0), "=&v"(a1), "=&v"(b0), "=&v"(b1), "=&v"(c0), "=&v"(c1), "=&v"(d0), "=&v"(d1)
                 : "v"(addr), "i"(O), "i"(O + T), "i"(O + S), "i"(O + S + T), "i"(O + 2 * S), "i"(O + 2 * S + T), "i"(O + 3 * S), "i"(O + 3 * S + T) : "memory");
    f0 = __builtin_shufflevector(a0, a1, 0, 1, 2, 3, 4, 5, 6, 7); f1 = __builtin_shufflevector(b0, b1, 0, 1, 2, 3, 4, 5, 6, 7);
    f2 = __builtin_shufflevector(c0, c1, 0, 1, 2, 3, 4, 5, 6, 7); f3 = __builtin_shufflevector(d0, d1, 0, 1, 2, 3, 4, 5, 6, 7);
}
DI void lds_barrier() { asm volatile("s_waitcnt lgkmcnt(0)" ::: "memory"); __builtin_amdgcn_s_barrier(); asm volatile("" ::: "memory"); }
#define GLDS16(gp, lp) __builtin_amdgcn_global_load_lds((const unsigned*)(gp), (LAS unsigned*)(lp), 16, 0, 0)
DI f32x16 zero16() { f32x16 z; for (int i = 0; i < 16; ++i) z[i] = 0.f; return z; }

struct KArgs {
    const float* in[30];
    float* out;
    unsigned char* ws;
    int ph_lo, ph_hi;
};
enum { I_X = 0, I_C, I_CTX, I_CCTX, I_WMOD, I_BMOD, I_NORM1, I_NORM2, I_WIN, I_BGATE, I_RDECAY, I_RNORM, I_WRET, I_CONVW, I_CONVB, I_LWA, I_LBA, I_LWX, I_LBX, I_LLAM,
       I_WLRU, I_WOUT, I_WGRP, I_BGRP, I_WRT, I_BRT, I_WEG, I_WEU, I_WED, I_FNORM };

DI float mod_val(const KArgs& a, int v, int ch, int k) {
    const float* mp = (const float*)(a.ws + WS_MODP); const int n = ch * 1024 + k;
    return ((mp[(0 * 3 + v) * 6144 + n] + mp[(1 * 3 + v) * 6144 + n]) + (mp[(2 * 3 + v) * 6144 + n] + mp[(3 * 3 + v) * 6144 + n])) + a.in[I_BMOD][n];
}

#define XB_TMO      128
#define XB_XCNT(j)  (256  + 64 * (j))
#define XB_XSUB(j)  (1280 + 64 * (j))
#define XB_XGEN(j)  (2304 + 64 * (j))
#define XB_TOP      3328
#define XB_TOPGEN   3392
#define XCD_BAR_WORDS 3456
#define XB_SPIN_CAP (1u << 18)
__device__ __forceinline__ unsigned xb_ld(unsigned* p)              { return __hip_atomic_load(p, __ATOMIC_RELAXED, __HIP_MEMORY_SCOPE_AGENT); }
__device__ __forceinline__ unsigned xb_add(unsigned* p, unsigned v) { return __hip_atomic_fetch_add(p, v, __ATOMIC_RELAXED, __HIP_MEMORY_SCOPE_AGENT); }
__device__ __forceinline__ unsigned xb_xcc_id() { return (unsigned)__builtin_amdgcn_s_getreg((3 << 11) | 20) & 0xFu; }
#define XB_SPIN(cond, bar) do { unsigned _sp = 0; while (cond) { __builtin_amdgcn_s_sleep(1); \
    if ((++_sp & 255u) == 0u) { if (xb_ld(&(bar)[XB_TMO])) break; if (_sp > XB_SPIN_CAP) { atomicAdd(&(bar)[XB_TMO], 1u); break; } } } } while (0)
struct XcdBarrier { unsigned* bar; unsigned x; volatile LAS unsigned* st; };
__device__ __forceinline__ XcdBarrier xcd_barrier_post(unsigned* bar, volatile LAS unsigned* st) {
    XcdBarrier b; b.bar = bar; b.x = xb_xcc_id(); b.st = st;
    if (threadIdx.x == 0) (void)xb_add(&bar[XB_XCNT(b.x)], 1u);
    return b;
}
__device__ __forceinline__ void xcd_barrier_complete(unsigned* bar, unsigned x, unsigned& nloc, unsigned& nx) {
    const unsigned G = gridDim.x * gridDim.y * gridDim.z;
    unsigned sum, cnt, mine, sp = 0u;
    for (;;) {
        sum = 0u; cnt = 0u; mine = 0u;
#pragma unroll
        for (unsigned j = 0; j < 16; ++j) { const unsigned c = xb_ld(&bar[XB_XCNT(j)]); sum += c; cnt += (c > 0u) ? 1u : 0u; mine = (j == x) ? c : mine; }
        if (sum == G) break;
        __builtin_amdgcn_s_sleep(1);
        if ((++sp & 255u) == 0u) { if (xb_ld(&bar[XB_TMO])) break; if (sp > XB_SPIN_CAP) { atomicAdd(&bar[XB_TMO], 1u); break; } }
    }
    nloc = mine > 0u ? mine : 1u; nx = cnt > 0u ? cnt : 1u;
}
__device__ __forceinline__ void xcd_barrier(const XcdBarrier& b) {
    asm volatile("s_waitcnt vmcnt(0)" ::: "memory");
    __syncthreads();
    if (threadIdx.x == 0) {
        unsigned* bar = b.bar;
        __builtin_amdgcn_s_waitcnt(0);
        unsigned nloc = b.st[0], nx = b.st[1];
        if (nloc == 0u) { xcd_barrier_complete(bar, b.x, nloc, nx); b.st[0] = nloc; b.st[1] = nx; }
        const unsigned old = xb_add(&bar[XB_XSUB(b.x)], 1u);
        const unsigned gen = old / nloc;
        if (old + 1u == (gen + 1u) * nloc) {
            __builtin_amdgcn_fence(__ATOMIC_RELEASE, "agent");
            asm volatile("s_waitcnt vmcnt(0)" ::: "memory");
            const unsigned og = xb_add(&bar[XB_TOP], 1u);
            const unsigned tg = og / nx;
            if (og + 1u == (tg + 1u) * nx) xb_add(&bar[XB_TOPGEN], 1u);
            else XB_SPIN(xb_ld(&bar[XB_TOPGEN]) == tg, bar);
            __builtin_amdgcn_fence(__ATOMIC_ACQUIRE, "agent");
            xb_add(&bar[XB_XGEN(b.x)], 1u);
            asm volatile("s_waitcnt vmcnt(0)" ::: "memory");
        } else {
            XB_SPIN(xb_ld(&bar[XB_XGEN(b.x)]) == gen, bar);
            __builtin_amdgcn_fence(__ATOMIC_ACQUIRE, "agent");
            asm volatile("s_waitcnt vmcnt(0)" ::: "memory");
        }
    }
    __syncthreads();
}

namespace pg8 {
constexpr int BM = 256, BK = 64, HALF = 128, HTB = HALF * BK * 2, STAGE_BYTES = 8 * HTB, NXCD = 8, WGM = 2;
DI int lds_byte(int r, int c) { const int st = (r >> 4) * 2 + (c >> 5), rr = r & 15, cc = c & 31, ob = rr * 64 + cc * 2; return st * 1024 + (ob ^ (((ob >> 9) & 1) << 5)); }
DI void stage_rc(int b, int& R, int& C) { const int st = b / 1024, sb = b % 1024, swz = sb ^ (((sb >> 9) & 1) << 5); R = (st >> 1) * 16 + swz / 64; C = (st & 1) * 32 + (swz % 64) / 2; }
DI int perm32(int rho) { const int n = rho >> 4, i = rho & 15; return 8 * (i >> 2) + 4 * n + (i & 3); }
DI int bmap(int mode, int R) {
    if (mode == 1) return (R & ~31) + perm32(R & 31);
    if (mode == 2) { const int wc = R >> 5, n = (R >> 4) & 1, low = R & 15; return 64 * (wc >> 1) + 32 * n + 16 * (wc & 1) + low; }
    return R;
}
struct Unit { const char* A; const char* B; int pm, pn, aux, bmode; };
DI bool static_tile(int i, int G, int c, int nM, int nN, int& pm, int& pn) {
    const int nwg = nM * nN; const long L = (long)i * G + c; if (L >= nwg) return false;
    int wgid = (int)L; { const int q = nwg / NXCD, r = nwg % NXCD, xcd = wgid % NXCD, off = wgid / NXCD; wgid = (xcd < r ? xcd * (q + 1) : r * (q + 1) + (xcd - r) * q) + off; }
    const int nig = WGM * nN, gid = wgid / nig, fm = gid * WGM, gsz = (nM - fm) < WGM ? (nM - fm) : WGM;
    pm = fm + ((wgid % nig) % gsz); pn = (wgid % nig) / gsz; return true;
}

template <bool F8, class Epi, class Sched>
DI void gemm_phase(LAS unsigned char* lds, const int K, const Sched& S, const Epi& E) {
    const int tid = tid_fresh(), wid = __builtin_amdgcn_readfirstlane(tid >> 6), lane = tid & 63, wr = wid >> 2, wc = wid & 3;
    const int rowb = F8 ? K : 2 * K, nt = rowb / 128;
    unsigned voffA[2][2], voffB[2];
    const size_t kstep = (size_t)(BK * 2);
    const size_t hstep = (size_t)HALF * rowb;
    const unsigned ldsw = (unsigned)wid * 1024u;
    const int aoff = lds_byte(wr * 64 + (lane & 15), (lane >> 4) * 8), boff = lds_byte(wc * 32 + (lane & 15), (lane >> 4) * 8);
#define PG8_SA(b, h) (((b) * 2 + (h)) * HTB)
#define PG8_SB(b, h) ((4 + (b) * 2 + (h)) * HTB)
#define PG8_STAGE(bufoff, gbase, voff) do { _Pragma("unroll") for (int _i = 0; _i < 2; ++_i) { unsigned vo_ = (voff)[_i]; asm volatile("" : "+v"(vo_));     \
        __builtin_amdgcn_global_load_lds((const unsigned*)((const char*)(gbase) + vo_), (LAS unsigned*)(lds + (bufoff) + ldsw + _i * 8192), 16, 0, 0); } } while (0)
#define PG8_LD8(p_) __builtin_shufflevector(*(const LAS v4i_t*)(p_), *(const LAS v4i_t*)((p_) + 1024), 0, 1, 2, 3, 4, 5, 6, 7)
#define PG8_LDA(dst, b, h) do { _Pragma("unroll") for (int m = 0; m < 4; ++m) dst[m] = PG8_LD8(lds + PG8_SA(b, h) + aoff + m * 2048); } while (0)
#define PG8_LDB(dst, b, h) do { _Pragma("unroll") for (int n = 0; n < 2; ++n) dst[n] = PG8_LD8(lds + PG8_SB(b, h) + boff + n * 2048); } while (0)
#define PG8_LO(v_) __builtin_bit_cast(bf16x8, __builtin_shufflevector(v_, v_, 0, 1, 2, 3))
#define PG8_HI(v_) __builtin_bit_cast(bf16x8, __builtin_shufflevector(v_, v_, 4, 5, 6, 7))
#define PG8_MMA(ai, bj, At, Bt) do { __builtin_amdgcn_s_setprio(1); _Pragma("unroll") for (int m = 0; m < 4; ++m) _Pragma("unroll") for (int n = 0; n < 2; ++n) { \
        if constexpr (F8) { acc[ai][bj][m][n] = __builtin_amdgcn_mfma_scale_f32_16x16x128_f8f6f4(Bt[n], At[m], acc[ai][bj][m][n], 0, 0, 0, 0x7f7f7f7f, 0, 0x7f7f7f7f); } \
        else { acc[ai][bj][m][n] = __builtin_amdgcn_mfma_f32_16x16x32_bf16(PG8_LO(Bt[n]), PG8_LO(At[m]), acc[ai][bj][m][n], 0, 0, 0); \
               acc[ai][bj][m][n] = __builtin_amdgcn_mfma_f32_16x16x32_bf16(PG8_HI(Bt[n]), PG8_HI(At[m]), acc[ai][bj][m][n], 0, 0, 0); } } \
        __builtin_amdgcn_s_setprio(0); } while (0)
#define PG8_WAIT_V(n) asm volatile("s_waitcnt vmcnt(" #n ")" ::: "memory")
#define PG8_WAIT_L(n) asm volatile("s_waitcnt lgkmcnt(" #n ")" ::: "memory")
#define PG8_BAR __builtin_amdgcn_s_barrier()
#define PG8_SCHED __builtin_amdgcn_sched_barrier(0)
#define PG8_RC() int Rr[2], Cc[2]; { const int t_ = tid_fresh(); _Pragma("unroll") for (int _i = 0; _i < 2; ++_i) stage_rc(t_ * 16 + _i * 8192, Rr[_i], Cc[_i]); }
#define PG8_SETB(u) do { PG8_RC(); _Pragma("unroll") for (int _i = 0; _i < 2; ++_i) voffB[_i] = (unsigned)(bmap((u).bmode, Rr[_i]) * rowb + Cc[_i] * 2); } while (0)
#define PG8_SETA(u, ui_) do { PG8_RC(); S.offsA((u), (ui_), Rr, Cc, voffA); } while (0)
    Unit cur, nxt; int ui = 0;
    if (!S.next(0, cur)) return;
    f32x4 acc[2][2][4][2];
#pragma unroll
    for (int a = 0; a < 2; ++a)
#pragma unroll
        for (int b = 0; b < 2; ++b)
#pragma unroll
            for (int m = 0; m < 4; ++m)
#pragma unroll
                for (int n = 0; n < 2; ++n) acc[a][b][m][n] = (f32x4){0.f, 0.f, 0.f, 0.f};
    v8i_t At[4], B0[2], B1[2];
    const char* cA = cur.A; const char* cB = cur.B;
    PG8_SETA(cur, 0); PG8_SETB(cur);
    PG8_STAGE(PG8_SB(0, 0), cB, voffB); PG8_STAGE(PG8_SB(0, 1), cB + hstep, voffB); PG8_STAGE(PG8_SA(0, 0), cA, voffA[0]); PG8_STAGE(PG8_SA(0, 1), cA, voffA[1]);
    if (wr == 1) PG8_BAR;
    PG8_WAIT_V(2); PG8_BAR;
    PG8_STAGE(PG8_SB(1, 0), cB + kstep, voffB); PG8_STAGE(PG8_SA(1, 0), cA + kstep, voffA[0]); PG8_STAGE(PG8_SB(1, 1), cB + hstep + kstep, voffB);
    PG8_WAIT_V(6); PG8_BAR;
    for (;;) {
        const bool has_next = S.next(ui + 1, nxt);
        const char* nA = has_next ? nxt.A : cA; const char* nB = has_next ? nxt.B : cB;
#pragma unroll 1
        for (int t = 0; t < nt; t += 2) {
            const bool last = (t == nt - 2);
            const char* a1 = cA + (size_t)(t + 1) * kstep;
            const char* a2 = last ? nA : cA + (size_t)(t + 2) * kstep; const char* b2 = last ? nB : cB + (size_t)(t + 2) * kstep;
            const char* a3 = a2 + kstep; const char* b3 = b2 + kstep;
            if (last && has_next) PG8_SETB(nxt);
            PG8_LDB(B0, 0, 0); PG8_LDB(B1, 0, 1); PG8_SCHED; PG8_LDA(At, 0, 0); PG8_STAGE(PG8_SA(1, 1), a1, voffA[1]);
            PG8_WAIT_V(8); PG8_WAIT_L(0); PG8_BAR; PG8_MMA(0, 0, At, B0); PG8_MMA(0, 1, At, B1); PG8_BAR; PG8_SCHED;
            if (last && has_next) PG8_SETA(nxt, ui + 1);
            PG8_LDA(At, 0, 1); PG8_STAGE(PG8_SB(0, 0), b2, voffB); PG8_STAGE(PG8_SB(0, 1), b2 + hstep, voffB); PG8_STAGE(PG8_SA(0, 0), a2, voffA[0]);
            PG8_WAIT_V(8); PG8_WAIT_L(0); PG8_BAR; PG8_MMA(1, 0, At, B0); PG8_MMA(1, 1, At, B1); PG8_BAR; PG8_SCHED;
            PG8_LDB(B0, 1, 0); PG8_LDB(B1, 1, 1); PG8_SCHED; PG8_LDA(At, 1, 0); PG8_STAGE(PG8_SA(0, 1), a2, voffA[1]);
            PG8_WAIT_V(8); PG8_WAIT_L(0); PG8_BAR; PG8_MMA(0, 0, At, B0); PG8_MMA(0, 1, At, B1); PG8_BAR; PG8_SCHED;
            PG8_LDA(At, 1, 1); PG8_STAGE(PG8_SB(1, 0), b3, voffB); PG8_STAGE(PG8_SB(1, 1), b3 + hstep, voffB); PG8_STAGE(PG8_SA(1, 0), a3, voffA[0]);
            PG8_WAIT_V(8); PG8_WAIT_L(0); PG8_BAR; PG8_MMA(1, 0, At, B0); PG8_MMA(1, 1, At, B1); PG8_BAR; PG8_SCHED;
        }
        if (wr == 0) PG8_BAR;
        bool keep; { const int t_ = tid_fresh(), l_ = t_ & 63; keep = E(acc, cur, wr, wc, l_ & 15, l_ >> 4); }
        if (!has_next) break;
        if (!keep) {
#pragma unroll
            for (int a = 0; a < 2; ++a)
#pragma unroll
                for (int b = 0; b < 2; ++b)
#pragma unroll
                    for (int m = 0; m < 4; ++m)
#pragma unroll
                        for (int n = 0; n < 2; ++n) acc[a][b][m][n] = (f32x4){0.f, 0.f, 0.f, 0.f};
        }
        cur = nxt; cA = nA; cB = nB; ++ui;
        if (wr == 1) PG8_BAR;
    }
    PG8_WAIT_V(0);
    PG8_BAR;
#undef PG8_SA
#undef PG8_SB
#undef PG8_STAGE
#undef PG8_LDA
#undef PG8_LD8
#undef PG8_LO
#undef PG8_HI
#undef PG8_LDB
#undef PG8_MMA
#undef PG8_WAIT_V
#undef PG8_WAIT_L
#undef PG8_BAR
#undef PG8_SCHED
#undef PG8_SETB
#undef PG8_SETA
#undef PG8_RC
}
DI void dense_offs(int rowbytes, const int (&R)[2], const int (&C)[2], unsigned (&voffA)[2][2]) {
#pragma unroll
    for (int h = 0; h < 2; ++h)
#pragma unroll
        for (int i = 0; i < 2; ++i) voffA[h][i] = (unsigned)((h * HALF + R[i]) * rowbytes + C[i] * 2);
}
}
using pg8::Unit;

#define EPI_LOOP_ROWS for (int ai = 0; ai < 2; ++ai) _Pragma("unroll") for (int m = 0; m < 4; ++m)

DI void cvt_tile(LAS float* tile, const float* src, int ld_src, bf16_t* dst, int ld_dst, float scale) {
    const int tid = tid_fresh();
    __syncthreads();
#pragma unroll
    for (int i = 0; i < 2; ++i) { const int kr = (tid >> 4) + 32 * i, nc = (tid & 15) * 4; const f32x4 v = *(const f32x4*)(src + (size_t)kr * ld_src + nc);
        tile[kr * 65 + nc + 0] = v[0]; tile[kr * 65 + nc + 1] = v[1]; tile[kr * 65 + nc + 2] = v[2]; tile[kr * 65 + nc + 3] = v[3]; }
    __syncthreads();
    const int n = tid >> 3, kc = (tid & 7) * 8; float v[8];
#pragma unroll
    for (int j = 0; j < 8; ++j) v[j] = tile[(kc + j) * 65 + n] * scale;
    u32x4 w; w.x = cvt_pk_bf16(v[0], v[1]); w.y = cvt_pk_bf16(v[2], v[3]); w.z = cvt_pk_bf16(v[4], v[5]); w.w = cvt_pk_bf16(v[6], v[7]);
    *(u32x4*)(dst + (size_t)n * ld_dst + kc) = w;
}

DI void cvt_tile4(LAS float* tile, const float* src, int ld_src, bf16_t* dst, size_t hi_stride, int ld_dst) {
    const int tid = tid_fresh();
    f32x4 v[8];
#pragma unroll
    for (int i = 0; i < 8; ++i) v[i] = *(const f32x4*)(src + (size_t)((tid >> 6) + 8 * i) * ld_src + 4 * (tid & 63));
    __syncthreads();
#pragma unroll
    for (int i = 0; i < 8; ++i) *(LAS f32x4*)(tile + ((tid >> 6) + 8 * i) * 260 + 4 * (tid & 63)) = v[i];
    __syncthreads();
    const int n = tid & 255, kh = tid >> 8; bf16_t* d = dst + (size_t)(n >> 7) * hi_stride + (size_t)(n & 127) * ld_dst + 32 * kh;
#pragma unroll
    for (int q = 0; q < 4; ++q) { float x[8];
#pragma unroll
        for (int j = 0; j < 8; ++j) x[j] = tile[(32 * kh + 8 * q + j) * 260 + n];
        u32x4 w; w.x = cvt_pk_bf16(x[0], x[1]); w.y = cvt_pk_bf16(x[2], x[3]); w.z = cvt_pk_bf16(x[4], x[5]); w.w = cvt_pk_bf16(x[6], x[7]);
        *(u32x4*)(d + 8 * q) = w; }
}

DI void phase0a(const KArgs& a, LAS unsigned char* lds) {
    const int tid = tid_fresh(), G = gridDim.x;
    LAS float* fl = (LAS float*)lds;
    constexpr int NU_MOD = 192, NU_ROPE = 1, NU_ROUTW = 64, T_WIN = 16 * 28, T_PROJ = 3 * 64, T_LB = 128;
    constexpr int U0 = NU_MOD, U1 = U0 + NU_ROPE, U2 = U1 + NU_ROUTW, U3 = U2 + T_WIN, U4 = U3 + T_PROJ, U5 = U4 + T_LB;
    for (int u = blockIdx.x; u < U5; u += G) {
        if (u < U0) {
            const int ks = u / 48, cg = u % 48;
            __syncthreads();
            for (int i = tid; i < 768; i += 512) { const int v = i >> 8, k = 256 * ks + (i & 255); const float x = (v == 0) ? a.in[I_C][k] : (v == 1) ? a.in[I_C][1024 + k] : a.in[I_CCTX][k]; fl[i] = silu_(x); }
            __syncthreads();
            const int rl = tid >> 5, cl = tid & 31; float acc[3][4];
#pragma unroll
            for (int v = 0; v < 3; ++v) for (int j = 0; j < 4; ++j) acc[v][j] = 0.f;
            f32x4 wv[16];
#pragma unroll
            for (int s = 0; s < 16; ++s) wv[s] = *(const f32x4*)(a.in[I_WMOD] + (size_t)(256 * ks + 16 * s + rl) * 6144 + 128 * cg + 4 * cl);
#pragma unroll
            for (int s = 0; s < 16; ++s) { const int kk = 16 * s + rl; const f32x4 w = wv[s];
#pragma unroll
                for (int v = 0; v < 3; ++v) { const float sv = fl[v * 256 + kk]; acc[v][0] += sv * w[0]; acc[v][1] += sv * w[1]; acc[v][2] += sv * w[2]; acc[v][3] += sv * w[3]; } }
            __syncthreads();
            LAS float* red = fl + 1024;
#pragma unroll
            for (int v = 0; v < 3; ++v) for (int j = 0; j < 4; ++j) red[(rl * 3 + v) * 128 + 4 * cl + j] = acc[v][j];
            __syncthreads();
            if (tid < 384) { const int v = tid >> 7, c = tid & 127; float s = 0.f; for (int r = 0; r < 16; ++r) s += red[(r * 3 + v) * 128 + c];
                ((float*)(a.ws + WS_MODP))[(ks * 3 + v) * 6144 + 128 * cg + c] = s; }
        } else if (u < U1) {
            f32x2* tab = (f32x2*)(a.ws + WS_ROPE);
            if (tid < 8) ((float*)(a.ws + WS_RDEC))[tid] = -softplus_(-a.in[I_RDECAY][tid]) * LOG2E;
            for (int i = tid; i < 320 * 32; i += 512) { const int p = i >> 5, fi = i & 31; const float pos = (float)(p < 256 ? p : p - 256);
                const float freq = ex2(-(float)fi * (13.287712379549449f / 32.0f)); float rev = pos * freq * 0.15915494309189535f; rev -= floorf(rev);
                tab[i] = (f32x2){__builtin_amdgcn_cosf(rev), __builtin_amdgcn_sinf(rev)}; }
        } else if (u < U2) {
            bf16_t* hi = (bf16_t*)(a.ws + WS_WRH); bf16_t* lo = hi + 64 * 1024; const int n = u - U1;
            for (int k = tid; k < 1024; k += 512) { float w = 0.f;
                if (n < 4) w = a.in[I_WGRP][k * 4 + n]; else if (n < 36) w = a.in[I_WRT][k * 32 + (n - 4)];
                const unsigned short h16 = f2bf(w); hi[n * 1024 + k] = h16; lo[n * 1024 + k] = f2bf(w - bf2f(h16)); }
        } else if (u < U3) {
            const int t = u - U2, kt = t / 28, ng = t % 28;
            cvt_tile4(fl, a.in[I_WIN] + (size_t)(64 * kt) * NCOL + 256 * ng, NCOL, (bf16_t*)(a.ws + WS_WIN) + (size_t)(256 * ng) * 1024 + 64 * kt, (size_t)128 * 1024, 1024);
        } else if (u < U4) {
            const int t = u - U3, w = t >> 6, kt = (t & 63) >> 2, ng = t & 3;
            const float* src = a.in[w == 0 ? I_WRET : w == 1 ? I_WLRU : I_WOUT]; bf16_t* dst = (bf16_t*)(a.ws + (w == 0 ? WS_WRET : w == 1 ? WS_WLRU : WS_WOUT));
            cvt_tile4(fl, src + (size_t)(64 * kt) * 1024 + 256 * ng, 1024, dst + (size_t)(256 * ng) * 1024 + 64 * kt, (size_t)128 * 1024, 1024);
        } else {
            const int t = u - U4, mat = t >> 5, blk = (t >> 2) & 7, kt = (t >> 1) & 1, nt = t & 1, dir = mat >> 1;
            const float* src = a.in[(mat & 1) ? I_LWX : I_LWA] + (size_t)(dir * 8 + blk) * 128 * 128;
            bf16_t* dst = (bf16_t*)(a.ws + WS_WLB) + (size_t)(mat * 8 + blk) * 128 * 128;
            cvt_tile(fl, src + (size_t)(64 * kt) * 128 + 64 * nt, 128, dst + (size_t)(64 * nt) * 128 + 64 * kt, 128, -LOG2E);
        }
    }
}

DI void phase0b(const KArgs& a, LAS unsigned char* lds) {
    const int tid = tid_fresh(), G = gridDim.x, lane = tid & 63, wid = tid >> 6;
    LAS float* gm = (LAS float*)lds;
    LAS float* sh = gm + 3072;
    __syncthreads();
    for (int i = tid; i < 3072; i += 512) { const int v = i >> 10, k = i & 1023; gm[i] = a.in[I_NORM1][k] * (1.0f + mod_val(a, v, 1, k)); sh[i] = mod_val(a, v, 0, k); }
    if (blockIdx.x == G - 1) { float* mt = (float*)(a.ws + WS_MODT);
        for (int i = tid; i < 2048; i += 512) { const int v = i >> 10, k = i & 1023; mt[i] = mod_val(a, v, 2, k); mt[2048 + i] = a.in[I_NORM2][k] * (1.0f + mod_val(a, v, 4, k)); mt[4096 + i] = mod_val(a, v, 3, k); mt[6144 + i] = mod_val(a, v, 5, k); } }
    __syncthreads();
    PB(105);
    for (int u = blockIdx.x; u < 160; u += G) {
        const int rt = u / 10, ct = u % 10;
        const int col0 = ct < 2 ? 512 + 256 * ct : ct < 6 ? 1024 + 256 * (ct - 2) : 3072 + 256 * (ct - 6);
        LAS unsigned char* At = lds + 24576;
        __syncthreads();
        {   f32x4 x[4][4];
#pragma unroll
            for (int q = 0; q < 4; ++q)
#pragma unroll
                for (int j = 0; j < 4; ++j) x[q][j] = *(const f32x4*)(a.in[I_CTX] + (size_t)(32 * rt + 4 * wid + q) * 1024 + 4 * lane + 256 * j);
#pragma unroll
            for (int q = 0; q < 4; ++q) { float ss = 0.f;
#pragma unroll
                for (int j = 0; j < 4; ++j) ss += (x[q][j][0] * x[q][j][0] + x[q][j][1] * x[q][j][1]) + (x[q][j][2] * x[q][j][2] + x[q][j][3] * x[q][j][3]);
#pragma unroll
                for (int o = 32; o >= 1; o >>= 1) ss += __shfl_xor(ss, o);
                const float rstd = rsqrtf(ss * (1.0f / 1024.0f) + EPSV);
#pragma unroll
                for (int j = 0; j < 4; ++j) { const int k0 = 4 * lane + 256 * j; const f32x4 g = *(const LAS f32x4*)(gm + 2048 + k0), sv = *(const LAS f32x4*)(sh + 2048 + k0);
                    u32x2 w; w.x = cvt_pk_bf16(x[q][j][0] * rstd * g[0] + sv[0], x[q][j][1] * rstd * g[1] + sv[1]); w.y = cvt_pk_bf16(x[q][j][2] * rstd * g[2] + sv[2], x[q][j][3] * rstd * g[3] + sv[3]);
                    *(LAS u32x2*)(At + (4 * wid + q) * 2064 + k0 * 2) = w; } }
        }
        __syncthreads();
        const int r = lane & 31, h = lane >> 5;
        const bf16_t* wrow = (const bf16_t*)(a.ws + WS_WIN) + (size_t)(col0 + 32 * wid + r) * 1024 + 8 * h;
        f32x16 acc = zero16();
#pragma unroll 16
        for (int s2 = 0; s2 < 64; ++s2) { const bf16x8 bfr = *(const bf16x8*)(wrow + 16 * s2); const bf16x8 af = *(const LAS bf16x8*)(At + r * 2064 + (16 * s2 + 8 * h) * 2);
            acc = MFMA32(af, bfr, acc); }
        const int ccol = 256 * (ct < 2 ? ct : ct < 6 ? ct - 2 : ct - 6) + 32 * wid + r;
        bf16_t* dst = (bf16_t*)(a.ws + (ct < 2 ? WS_CTXK : ct < 6 ? WS_CTXV : WS_CTXX)); const int ldd = ct < 2 ? 512 : 1024; const float scv = ct < 2 ? 0.08838834764831845f : 1.0f;
#pragma unroll
        for (int i = 0; i < 16; ++i) dst[(size_t)(32 * rt + crow(i, h)) * ldd + ccol] = f2bf(acc[i] * scv);
    }
    PE(105);
    PB(106);
    {
        const int rstep = G * 8; int row = blockIdx.x * 8 + wid; f32x4 x[2][4];
#pragma unroll
        for (int q = 0; q < 2; ++q) if (row + q * rstep < NT) {
#pragma unroll
            for (int j = 0; j < 4; ++j) x[q][j] = *(const f32x4*)(a.in[I_X] + (size_t)(row + q * rstep) * 1024 + 4 * lane + 256 * j); }
        for (; row < NT; row += 2 * rstep) {
            f32x4 xn[2][4];
#pragma unroll
            for (int q = 0; q < 2; ++q) if (row + (2 + q) * rstep < NT) {
#pragma unroll
                for (int j = 0; j < 4; ++j) xn[q][j] = *(const f32x4*)(a.in[I_X] + (size_t)(row + (2 + q) * rstep) * 1024 + 4 * lane + 256 * j); }
#pragma unroll
            for (int q = 0; q < 2; ++q) { const int rw = row + q * rstep; if (rw < NT) { const int v = rw / SEQ; float ss = 0.f;
#pragma unroll
                for (int j = 0; j < 4; ++j) ss += (x[q][j][0] * x[q][j][0] + x[q][j][1] * x[q][j][1]) + (x[q][j][2] * x[q][j][2] + x[q][j][3] * x[q][j][3]);
#pragma unroll
                for (int o = 32; o >= 1; o >>= 1) ss += __shfl_xor(ss, o);
                const float rstd = rsqrtf(ss * (1.0f / 1024.0f) + EPSV);
                bf16_t* dst = (bf16_t*)(a.ws + WS_HX) + (size_t)rw * 1024;
#pragma unroll
                for (int j = 0; j < 4; ++j) { const int k0 = 4 * lane + 256 * j; const f32x4 g = *(const LAS f32x4*)(gm + v * 1024 + k0), sv = *(const LAS f32x4*)(sh + v * 1024 + k0);
                    u32x2 w; w.x = cvt_pk_bf16(x[q][j][0] * rstd * g[0] + sv[0], x[q][j][1] * rstd * g[1] + sv[1]); w.y = cvt_pk_bf16(x[q][j][2] * rstd * g[2] + sv[2], x[q][j][3] * rstd * g[3] + sv[3]);
                    *(u32x2*)(dst + k0) = w; } } }
#pragma unroll
            for (int q = 0; q < 2; ++q)
#pragma unroll
                for (int j = 0; j < 4; ++j) x[q][j] = xn[q][j];
        }
    }
    PE(106);
}

struct OrderIn {
    const char* A; const char* B; int G, c;
    DI bool next(int i, Unit& u) const { int pm, pn; if (!pg8::static_tile(i, G, c, NT / 256, NCOL / 256, pm, pn)) return false;
        u.pm = pm; u.pn = pn; u.A = A + (size_t)pm * 256 * 1024 * 2; u.B = B + (size_t)pn * 256 * 1024 * 2; u.aux = 0; u.bmode = pn < 4 ? 2 : 1; return true; }
    DI void offsA(const Unit&, int, const int (&R)[2], const int (&C)[2], unsigned (&v)[2][2]) const { pg8::dense_offs(2048, R, C, v); }
};
DI int glog_frag(int ai, int bj, int m, int wr, int wc, int fr, int fq) { return ((((((ai * 2 + bj) * 4 + m) * 2 + wr) * 4 + wc) * 16 + fr) * 4 + fq) * 8; }
struct EpiIn {
    unsigned char* ws; bf16_t* glog; const float* bgate; const f32x2* rope;
    DI bool operator()(f32x4 (&acc)[2][2][4][2], const Unit& u, int wr, int wc, int fr, int fq) const {
        const int pn = u.pn;
        if (pn < 4) {
            bf16_t* dst = (bf16_t*)(ws + (pn < 2 ? WS_ZQ : WS_ZK)); const float sc = pn < 2 ? 1.0f : 0.08838834764831845f;
            const int half = wc >> 1, f0 = 16 * (wc & 1) + 4 * fq;
#pragma unroll
            EPI_LOOP_ROWS { const int row = u.pm * 256 + ai * 128 + wr * 64 + m * 16 + fr; const int t = row & (SEQ - 1); const int pos = half ? 256 + (t & 63) : (t >> 6);
                const f32x2* tb = rope + pos * 32 + f0; f32x2 cs[4];
#pragma unroll
                for (int j = 0; j < 4; ++j) cs[j] = tb[j];
#pragma unroll
                for (int bj = 0; bj < 2; ++bj) { const f32x4 x1 = acc[ai][bj][m][0], x2 = acc[ai][bj][m][1]; float o1[4], o2[4];
#pragma unroll
                    for (int j = 0; j < 4; ++j) { o1[j] = (x1[j] * cs[j][0] - x2[j] * cs[j][1]) * sc; o2[j] = (x1[j] * cs[j][1] + x2[j] * cs[j][0]) * sc; }
                    bf16_t* p = dst + (size_t)row * 512 + (pn & 1) * 256 + bj * 128 + 64 * half + f0;
                    u32x2 w1, w2; w1.x = cvt_pk_bf16(o1[0], o1[1]); w1.y = cvt_pk_bf16(o1[2], o1[3]); w2.x = cvt_pk_bf16(o2[0], o2[1]); w2.y = cvt_pk_bf16(o2[2], o2[3]);
                    *(u32x2*)p = w1; *(u32x2*)(p + 32) = w2; } }
            return false;
        }
        int act, ldd, cb; bf16_t* dst;
        if (pn < 8) { dst = (bf16_t*)(ws + WS_ZV); act = 0; ldd = 1024; cb = (pn - 4) * 256; }
        else if (pn < 12) { dst = (bf16_t*)(ws + WS_ZG); act = 1; ldd = 1024; cb = (pn - 8) * 256; }
        else if (pn < 16) { dst = (bf16_t*)(ws + WS_ZXL); act = 0; ldd = 1024; cb = (pn - 12) * 256; }
        else if (pn < 20) { dst = (bf16_t*)(ws + WS_ZGL); act = 2; ldd = 1024; cb = (pn - 16) * 256; }
        else { dst = glog; act = 3; ldd = 2048; cb = (pn - 20) * 256; }
#pragma unroll
        for (int bj = 0; bj < 2; ++bj) { const int col = cb + bj * 128 + wc * 32 + 8 * fq; f32x4 b0 = (f32x4){0.f, 0.f, 0.f, 0.f}, b1 = b0;
            if (act == 3) { b0 = *(const f32x4*)(bgate + col); b1 = *(const f32x4*)(bgate + col + 4); }
#pragma unroll
            EPI_LOOP_ROWS { const int row = u.pm * 256 + ai * 128 + wr * 64 + m * 16 + fr; f32x4 v0 = acc[ai][bj][m][0] + b0, v1 = acc[ai][bj][m][1] + b1;
                if (act == 1) {
#pragma unroll
                    for (int j = 0; j < 4; ++j) { v0[j] = silu_(v0[j]); v1[j] = silu_(v1[j]); } }
                if (act == 2) {
#pragma unroll
                    for (int j = 0; j < 4; ++j) { v0[j] = gelu_tanh(v0[j]); v1[j] = gelu_tanh(v1[j]); } }
                u32x4 w; w.x = cvt_pk_bf16(v0[0], v0[1]); w.y = cvt_pk_bf16(v0[2], v0[3]); w.z = cvt_pk_bf16(v1[0], v1[1]); w.w = cvt_pk_bf16(v1[2], v1[3]);
                if (act == 3) *(u32x4*)(glog + (size_t)(u.pm * 8 + (pn - 20)) * 65536 + glog_frag(ai, bj, m, wr, wc, fr, fq)) = w;
                else *(u32x4*)(dst + (size_t)row * ldd + col) = w; } }
        return false;
    }
};

DI bf16x8 scale_frag8(bf16x8 f, const float (&w)[8]) { const u32x4 u = __builtin_bit_cast(u32x4, f); u32x4 o;
#pragma unroll
    for (int e = 0; e < 4; ++e) o[e] = cvt_pk_bf16(__uint_as_float(u[e] << 16) * w[2 * e], __uint_as_float(u[e] & 0xffff0000u) * w[2 * e + 1]);
    return __builtin_bit_cast(bf16x8, o); }
DI void r1_unit(LAS unsigned char* lds, const bf16_t* kp, const bf16_t* vp, int nrows, float lgf2, float lgb2, float* outf, float* outb) {
    const int tid = tid_fresh(), lane = tid & 63, wid = __builtin_amdgcn_readfirstlane(tid >> 6), h = lane >> 5, c = lane & 31;
    const int mh = wid >> 2, nb = wid & 3;
    LAS unsigned char* B0 = lds; LAS unsigned char* B1 = lds + 49152;
    const unsigned wl = (unsigned)wid * 1024u;
    const unsigned koff = (unsigned)((tid >> 4) * 1024 + (((tid & 15) ^ (((tid >> 4) & 3) << 2)) << 4));
    const unsigned voff = (unsigned)((tid >> 5) * 2048 + (((tid & 31) ^ (((tid >> 5) & 3) << 2)) << 4));
#define R1_STAGE(ch_, buf_) do { const char* kb_ = (const char*)kp + (size_t)(ch_) * 65536; const char* vb_ = (const char*)vp + (size_t)(ch_) * 131072; \
        _Pragma("unroll") for (int i_ = 0; i_ < 2; ++i_) GLDS16(kb_ + i_ * 32768 + koff, (buf_) + i_ * 8192 + wl); \
        _Pragma("unroll") for (int i_ = 0; i_ < 4; ++i_) GLDS16(vb_ + i_ * 32768 + voff, (buf_) + 16384 + i_ * 8192 + wl); } while (0)
    __syncthreads();
    R1_STAGE(0, B0);
    f32x16 acc[2][4];
#pragma unroll
    for (int d = 0; d < 2; ++d) for (int mi = 0; mi < 4; ++mi) acc[d][mi] = zero16();
    const unsigned q4 = (unsigned)((lane & 15) >> 2), lrow = (unsigned)(8 * h) + q4, lin = 32u * ((lane >> 4) & 1) + 8u * (lane & 3);
    const float gfm1 = ex2(-lgf2), gb1 = ex2(lgb2);
    const int nch = nrows / 64;
#pragma unroll 1
    for (int ch = 0; ch < nch; ++ch) {
        LAS unsigned char* buf = (ch & 1) ? B1 : B0;
        asm volatile("s_waitcnt vmcnt(0)" ::: "memory");
        lds_barrier();
        if (ch + 1 < nch) { if (ch & 1) R1_STAGE(ch + 1, B0); else R1_STAGE(ch + 1, B1); }
        const unsigned Kb = (unsigned)(size_t)buf + lrow * 256u + lin, Vb = (unsigned)(size_t)buf + 16384u + lrow * 512u + lin;
#pragma unroll
        for (int ks = 0; ks < 4; ++ks) {
            const bf16x8 kf = (ks == 0) ? tr_frag<0, 1024>(Kb + 64u * ((unsigned)nb ^ q4)) : (ks == 1) ? tr_frag<4096, 5120>(Kb + 64u * ((unsigned)nb ^ q4)) : (ks == 2) ? tr_frag<8192, 9216>(Kb + 64u * ((unsigned)nb ^ q4)) : tr_frag<12288, 13312>(Kb + 64u * ((unsigned)nb ^ q4));
            const int j0 = 64 * ch + 16 * ks + 8 * h; float wf[8], wb[8];
            wf[0] = ex2(lgf2 * (float)(nrows - 1 - j0)); wb[0] = ex2(lgb2 * (float)j0);
#pragma unroll
            for (int e = 1; e < 8; ++e) { wf[e] = wf[e - 1] * gfm1; wb[e] = wb[e - 1] * gb1; }
            const bf16x8 kff = scale_frag8(kf, wf), kfb = scale_frag8(kf, wb);
#pragma unroll
            for (int mi = 0; mi < 4; ++mi) { const unsigned va = Vb + 256u * (unsigned)mh + 64u * ((unsigned)mi ^ q4);
                const bf16x8 vf = (ks == 0) ? tr_frag<0, 2048>(va) : (ks == 1) ? tr_frag<8192, 10240>(va) : (ks == 2) ? tr_frag<16384, 18432>(va) : tr_frag<24576, 26624>(va);
                acc[0][mi] = MFMA32(vf, kff, acc[0][mi]); acc[1][mi] = MFMA32(vf, kfb, acc[1][mi]); }
        }
    }
    float* of = outf + (size_t)(128 * mh + 4 * h) * 128 + 32 * nb + c; float* ob = outb + (size_t)(128 * mh + 4 * h) * 128 + 32 * nb + c;
#pragma unroll
    for (int mi = 0; mi < 4; ++mi)
#pragma unroll
        for (int i = 0; i < 16; ++i) { of[(32 * mi + (i & 3) + 8 * (i >> 2)) * 128] = acc[0][mi][i]; ob[(32 * mi + (i & 3) + 8 * (i >> 2)) * 128] = acc[1][mi][i]; }
#undef R1_STAGE
}

template <bool FULL, int DIR>
DI void lru_scan(f32x16 (&acc)[2][2], float Hin, f32x2* agg_out) {
    const int lane = tid_fresh() & 63, h = lane >> 5;
    float sA[8], sU[8];
#pragma unroll
    for (int s = 0; s < 8; ++s) { const int mb = s >> 2, g = s & 3; float A = 1.f, U = 0.f;
#pragma unroll
        for (int e = 0; e < 4; ++e) { const int i = 4 * g + (DIR == 0 ? e : 3 - e); U = acc[0][mb][i] * U + acc[1][mb][i]; A *= acc[0][mb][i]; }
        sA[s] = A; sU[s] = U; }
    float pA[8], pU[8];
#pragma unroll
    for (int s = 0; s < 8; ++s) { pA[s] = __shfl_xor(sA[s], 32); pU[s] = __shfl_xor(sU[s], 32); }
    const bool first = (h == (DIR == 0 ? 0 : 1));
    if (!FULL) {
        float A = 1.f, U = 0.f;
#pragma unroll
        for (int q = 0; q < 8; ++q) { const int s = DIR == 0 ? q : 7 - q;
            const float A1 = first ? sA[s] : pA[s], U1 = first ? sU[s] : pU[s], A2 = first ? pA[s] : sA[s], U2 = first ? pU[s] : sU[s];
            U = A1 * U + U1; A *= A1; U = A2 * U + U2; A *= A2; }
        if (h == 0) *agg_out = (f32x2){A, U};
    } else {
        float H = Hin;
        float st[8];
#pragma unroll
        for (int q = 0; q < 8; ++q) { const int s = DIR == 0 ? q : 7 - q;
            const float A1 = first ? sA[s] : pA[s], U1 = first ? sU[s] : pU[s], A2 = first ? pA[s] : sA[s], U2 = first ? pU[s] : sU[s];
            const float Hm = A1 * H + U1; st[s] = first ? H : Hm; H = A2 * Hm + U2; }
#pragma unroll
        for (int s = 0; s < 8; ++s) { const int mb = s >> 2, g = s & 3; float hv = st[s];
#pragma unroll
            for (int e = 0; e < 4; ++e) { const int i = 4 * g + (DIR == 0 ? e : 3 - e); hv = acc[0][mb][i] * hv + acc[1][mb][i]; acc[1][mb][i] = hv; } }
    }
}

constexpr int LX_RS = 272;
template <bool FULL>
DI void lru_run(const KArgs& a, LAS unsigned char* lds, int b, int n, int tile0, int ntiles, bool is_ctx) {
    const int tid = tid_fresh(), lane = tid & 63, wid = __builtin_amdgcn_readfirstlane(tid >> 6), h = lane >> 5, c = lane & 31;
    LAS unsigned char* raw = lds;
    LAS unsigned char* xcb = lds + 67 * LX_RS;
    LAS float* cw = (LAS float*)(xcb + 64 * LX_RS);
    LAS float* hfb = cw + 640;
    LAS float* hbb = hfb + 64 * 132;
    const int Ls = is_ctx ? CTXL : SEQ;
    const bf16_t* xl = is_ctx ? (const bf16_t*)(a.ws + WS_CTXX) + (size_t)(b * CTXL) * 1024 + 128 * n : (const bf16_t*)(a.ws + WS_ZXL) + (size_t)(b * SEQ) * 1024 + 128 * n;
    const int dir = wid >> 2, nq = wid & 3, gc = 128 * n + 32 * nq + c;
    __syncthreads();
    for (int i = tid; i < 640; i += 512) { const int k = i >> 7, ch = i & 127; cw[i] = k < 4 ? a.in[I_CONVW][k * 1024 + 128 * n + ch] : a.in[I_CONVB][128 * n + ch]; }
    bf16x8 Bw[2][8];
    {   const bf16_t* wa = (const bf16_t*)(a.ws + WS_WLB) + (size_t)((2 * dir) * 8 + n) * 128 * 128 + (size_t)(32 * nq + c) * 128 + 8 * h;
#pragma unroll
        for (int ks = 0; ks < 8; ++ks) { Bw[0][ks] = *(const bf16x8*)(wa + 16 * ks); Bw[1][ks] = *(const bf16x8*)(wa + (size_t)8 * 128 * 128 + 16 * ks); } }
    const float ba2 = -LOG2E * a.in[I_LBA][dir * 1024 + gc], bx2 = -LOG2E * a.in[I_LBX][dir * 1024 + gc];
    const float cl = -8.0f * softplus_(-a.in[I_LLAM][dir * 1024 + gc]) * LOG2E;
    const size_t chain0 = ((size_t)(b * 2 + dir) * 1024 + gc) * NSLOT;
    u32x4 pre[3];
#define LRU_LOADRAW(tile_) do { _Pragma("unroll") for (int i_ = 0; i_ < 3; ++i_) { const int pid_ = tid + 512 * i_; pre[i_] = (u32x4){0u, 0u, 0u, 0u}; \
        if (pid_ < 67 * 16) { const int t_ = (tile_) * LT + (pid_ >> 4) - 1; if (t_ >= 0 && t_ < Ls) pre[i_] = *(const u32x4*)(xl + (size_t)t_ * 1024 + (pid_ & 15) * 8); } } } while (0)
    LRU_LOADRAW(tile0);
    for (int it = 0; it < ntiles; ++it) {
        const int tile = tile0 + it, t0 = tile * LT;
#pragma unroll
        for (int i = 0; i < 3; ++i) { const int pid = tid + 512 * i; if (pid < 67 * 16) *(LAS u32x4*)(raw + (pid >> 4) * LX_RS + (pid & 15) * 16) = pre[i]; }
        if (it + 1 < ntiles) LRU_LOADRAW(tile + 1);
        const int slot = is_ctx ? (dir == 0 ? tile : 3 - tile) : (dir == 0 ? 4 + tile : 4 + (NLT - 1 - tile));
        float Hin = 0.f; if (FULL) Hin = ((const float*)(a.ws + WS_LHIN))[chain0 + slot];
        u32x4 gpre[2]; bf16_t* gtile = (bf16_t*)(a.ws + WS_ZGL) + (size_t)(b * SEQ + t0) * 1024 + 128 * n;
        if (FULL) {
#pragma unroll
            for (int i = 0; i < 2; ++i) { const int pid = tid + 512 * i; gpre[i] = *(const u32x4*)(gtile + (size_t)(pid >> 4) * 1024 + (pid & 15) * 8); } }
        lds_barrier();
        {
            const int row = tid >> 3, c0 = (tid & 7) * 16; float o[16];
#pragma unroll
            for (int j = 0; j < 16; j += 4) { const f32x4 bv = *(const LAS f32x4*)(cw + 512 + c0 + j); o[j] = bv[0]; o[j + 1] = bv[1]; o[j + 2] = bv[2]; o[j + 3] = bv[3]; }
#pragma unroll
            for (int k = 0; k < 4; ++k) { const u32x4 p0 = *(const LAS u32x4*)(raw + (row + k) * LX_RS + c0 * 2), p1 = *(const LAS u32x4*)(raw + (row + k) * LX_RS + c0 * 2 + 16);
#pragma unroll
                for (int e = 0; e < 4; ++e) { const f32x4 w0 = *(const LAS f32x4*)(cw + k * 128 + c0 + 4 * (e >> 1) ), w1 = *(const LAS f32x4*)(cw + k * 128 + c0 + 8 + 4 * (e >> 1));
                    o[2 * e] += w0[2 * (e & 1)] * __uint_as_float(p0[e] << 16); o[2 * e + 1] += w0[2 * (e & 1) + 1] * __uint_as_float(p0[e] & 0xffff0000u);
                    o[8 + 2 * e] += w1[2 * (e & 1)] * __uint_as_float(p1[e] << 16); o[8 + 2 * e + 1] += w1[2 * (e & 1) + 1] * __uint_as_float(p1[e] & 0xffff0000u); } }
            u32x4 w0, w1;
#pragma unroll
            for (int e = 0; e < 4; ++e) { w0[e] = cvt_pk_bf16(o[2 * e], o[2 * e + 1]); w1[e] = cvt_pk_bf16(o[8 + 2 * e], o[8 + 2 * e + 1]); }
            *(LAS u32x4*)(xcb + row * LX_RS + c0 * 2) = w0; *(LAS u32x4*)(xcb + row * LX_RS + c0 * 2 + 16) = w1;
        }
        lds_barrier();
        f32x16 acc[2][2];
#pragma unroll
        for (int q = 0; q < 2; ++q) for (int mb = 0; mb < 2; ++mb) acc[q][mb] = zero16();
#pragma unroll
        for (int ks = 0; ks < 8; ++ks) {
            const bf16x8 a0 = *(const LAS bf16x8*)(xcb + c * LX_RS + (16 * ks + 8 * h) * 2), a1 = *(const LAS bf16x8*)(xcb + (32 + c) * LX_RS + (16 * ks + 8 * h) * 2);
            acc[0][0] = MFMA32(a0, Bw[0][ks], acc[0][0]); acc[0][1] = MFMA32(a1, Bw[0][ks], acc[0][1]); acc[1][0] = MFMA32(a0, Bw[1][ks], acc[1][0]); acc[1][1] = MFMA32(a1, Bw[1][ks], acc[1][1]);
        }
#pragma unroll
        for (int mb = 0; mb < 2; ++mb)
#pragma unroll
            for (int i = 0; i < 16; ++i) { const int row = 32 * mb + crow(i, h);
                const float r = rcpf_(1.0f + ex2(acc[0][mb][i] + ba2)), ig = rcpf_(1.0f + ex2(acc[1][mb][i] + bx2));
                const float av = ex2(cl * r); const float s = __builtin_amdgcn_sqrtf(__builtin_fmaf(-av, av, 1.0f));
                acc[0][mb][i] = av; acc[1][mb][i] = s * ig * bf2f(*(const LAS bf16_t*)(xcb + row * LX_RS + (32 * nq + c) * 2)); }
        f32x2* aggp = (f32x2*)(a.ws + WS_LAGG) + chain0 + slot;
        if (dir == 0) lru_scan<FULL, 0>(acc, Hin, aggp); else lru_scan<FULL, 1>(acc, Hin, aggp);
        if (FULL) {
            LAS float* hd = dir == 0 ? hfb : hbb;
#pragma unroll
            for (int mb = 0; mb < 2; ++mb)
#pragma unroll
                for (int i = 0; i < 16; ++i) hd[(32 * mb + crow(i, h)) * 132 + 32 * nq + c] = acc[1][mb][i];
            lds_barrier();
#pragma unroll
            for (int i = 0; i < 2; ++i) { const int pid = tid + 512 * i, row = pid >> 4, c8 = (pid & 15) * 8;
                const f32x4 f0 = *(const LAS f32x4*)(hfb + row * 132 + c8), f1 = *(const LAS f32x4*)(hfb + row * 132 + c8 + 4), b0 = *(const LAS f32x4*)(hbb + row * 132 + c8), b1 = *(const LAS f32x4*)(hbb + row * 132 + c8 + 4);
                const u32x4 g = gpre[i]; u32x4 o;
                o[0] = cvt_pk_bf16((f0[0] + b0[0]) * __uint_as_float(g[0] << 16), (f0[1] + b0[1]) * __uint_as_float(g[0] & 0xffff0000u));
                o[1] = cvt_pk_bf16((f0[2] + b0[2]) * __uint_as_float(g[1] << 16), (f0[3] + b0[3]) * __uint_as_float(g[1] & 0xffff0000u));
                o[2] = cvt_pk_bf16((f1[0] + b1[0]) * __uint_as_float(g[2] << 16), (f1[1] + b1[1]) * __uint_as_float(g[2] & 0xffff0000u));
                o[3] = cvt_pk_bf16((f1[2] + b1[2]) * __uint_as_float(g[3] << 16), (f1[3] + b1[3]) * __uint_as_float(g[3] & 0xffff0000u));
                *(u32x4*)(gtile + (size_t)row * 1024 + c8) = o; }
        }
    }
#undef LRU_LOADRAW
}

DI void ret_decays(const KArgs& a, int h, float& lgf2, float& lgb2) {
    const float* rd = (const float*)(a.ws + WS_RDEC); lgf2 = rd[h]; lgb2 = rd[4 + h];
}

DI void phase2a(const KArgs& a, LAS unsigned char* lds) {
    const int G = gridDim.x;
    constexpr int NU_R1 = NB_ * NH * NSC, NU_CK = NB_ * NH, NU_LX = NB_ * 8 * 16, NU_LC = NB_ * 8 * 4;
    for (int u = blockIdx.x; u < NU_R1 + NU_CK + NU_LX + NU_LC; u += G) {
        if (SUBSEL(1) && u < NU_R1) {
            const int sc = u & 31, h = (u >> 5) & 3, b = u >> 7; float lgf2, lgb2; ret_decays(a, h, lgf2, lgb2);
            float* o = (float*)(a.ws + WS_HX) + (size_t)(((b * 4 + h) * 32 + sc) * 2) * 32768;
            PB(100); r1_unit(lds, (const bf16_t*)(a.ws + WS_ZK) + (size_t)(b * SEQ + sc * SCH) * 512 + h * 128, (const bf16_t*)(a.ws + WS_ZV) + (size_t)(b * SEQ + sc * SCH) * 1024 + h * 256, SCH, lgf2, lgb2, o, o + 32768); PE(100);
        } else if (SUBSEL(1) && u < NU_R1 + NU_CK) {
            const int q = u - NU_R1, h = q & 3, b = q >> 2; float lgf2, lgb2; ret_decays(a, h, lgf2, lgb2);
            float* o = (float*)(a.ws + WS_CTXS) + (size_t)((b * 4 + h) * 2) * 32768;
            r1_unit(lds, (const bf16_t*)(a.ws + WS_CTXK) + (size_t)(b * CTXL) * 512 + h * 128, (const bf16_t*)(a.ws + WS_CTXV) + (size_t)(b * CTXL) * 1024 + h * 256, CTXL, lgf2, lgb2, o, o + 32768);
        } else if (SUBSEL(2) && u < NU_R1 + NU_CK + NU_LX) {
            const int q = u - NU_R1 - NU_CK, b = q >> 7, n = (q >> 4) & 7, r = q & 15;
            PB(101); lru_run<false>(a, lds, b, n, 16 * r, 16, false); PE(101);
        } else if (SUBSEL(2)) {
            const int q = u - NU_R1 - NU_CK - NU_LX, b = q >> 5, n = (q >> 2) & 7, tl = q & 3;
            lru_run<false>(a, lds, b, n, tl, 1, true);
        }
    }
}

DI void phase2b(const KArgs& a) {
    const int tid = tid_fresh(), G = gridDim.x, lane = tid & 63, wid = tid >> 6;
    for (int e = blockIdx.x * 512 + tid; e < NB_ * NH * 2 * 8192; e += G * 512) {
        const int e4 = e & 8191, dir = (e >> 13) & 1, h = (e >> 14) & 3, b = e >> 16;
        float lgf2, lgb2; ret_decays(a, h, lgf2, lgb2); const float gC = ex2((dir ? lgb2 : lgf2) * (float)SCH);
        f32x4 S = *(const f32x4*)((const float*)(a.ws + WS_CTXS) + (size_t)((b * 4 + h) * 2 + dir) * 32768 + 4 * e4);
        const float* kv = (const float*)(a.ws + WS_HX) + (size_t)((b * 4 + h) * 32 * 2 + dir) * 32768 + 4 * e4;
        bf16_t* so = (bf16_t*)(a.ws + WS_SBF) + (size_t)((b * 4 + h) * 32 * 2 + dir) * 32768 + 4 * e4;
        for (int s0 = 0; s0 < NSC; s0 += 8) {
            f32x4 kvv[8];
#pragma unroll
            for (int j = 0; j < 8; ++j) { const int sc = dir ? NSC - 1 - (s0 + j) : s0 + j; kvv[j] = *(const f32x4*)(kv + (size_t)sc * 65536); }
#pragma unroll
            for (int j = 0; j < 8; ++j) { const int sc = dir ? NSC - 1 - (s0 + j) : s0 + j;
                u32x2 w; w.x = cvt_pk_bf16(S[0], S[1]); w.y = cvt_pk_bf16(S[2], S[3]); *(u32x2*)(so + (size_t)sc * 65536) = w;
                S = S * gC + kvv[j]; }
        }
    }
    for (int ch = blockIdx.x * 8 + wid; ch < NB_ * 2 * 1024; ch += G * 8) {
        const f32x2* ag = (const f32x2*)(a.ws + WS_LAGG) + (size_t)ch * NSLOT; float* hin = (float*)(a.ws + WS_LHIN) + (size_t)ch * NSLOT;
        float carry = 0.f;
        for (int rd = 0; rd < 5; ++rd) { const int slot = 64 * rd + lane;
            f32x2 v = (f32x2){1.f, 0.f}; if (slot < 4 + NLT) v = ag[slot];
            float A = v[0], U = v[1];
#pragma unroll
            for (int o = 1; o < 64; o <<= 1) { const float Ap = __shfl_up(A, o), Up = __shfl_up(U, o); if (lane >= o) { U = A * Up + U; A = A * Ap; } }
            const float incl = A * carry + U;
            float excl = __shfl_up(incl, 1); if (lane == 0) excl = carry;
            if (slot < 4 + NLT) hin[slot] = excl;
            carry = __shfl(incl, 63);
        }
    }
}

constexpr int R3_KB = 16384, R3_VB = 32768;
template <int O, int T> DI void tr_frag2x2(unsigned a0, unsigned a1, bf16x8& f0, bf16x8& f1, bf16x8& f2, bf16x8& f3) {
    s16x4 r0, r1, r2, r3, r4, r5, r6, r7;
    asm volatile("ds_read_b64_tr_b16 %0, %8 offset:%10\n\tds_read_b64_tr_b16 %1, %8 offset:%11\n\t"
                 "ds_read_b64_tr_b16 %2, %8 offset:%12\n\tds_read_b64_tr_b16 %3, %8 offset:%13\n\t"
                 "ds_read_b64_tr_b16 %4, %9 offset:%10\n\tds_read_b64_tr_b16 %5, %9 offset:%11\n\t"
                 "ds_read_b64_tr_b16 %6, %9 offset:%12\n\tds_read_b64_tr_b16 %7, %9 offset:%13\n\ts_waitcnt lgkmcnt(0)"
                 : "=&v"(r0), "=&v"(r1), "=&v"(r2), "=&v"(r3), "=&v"(r4), "=&v"(r5), "=&v"(r6), "=&v"(r7)
                 : "v"(a0), "v"(a1), "i"(O), "i"(O + T), "i"(O + 256), "i"(O + 256 + T) : "memory");
    f0 = __builtin_shufflevector(r0, r1, 0, 1, 2, 3, 4, 5, 6, 7); f1 = __builtin_shufflevector(r2, r3, 0, 1, 2, 3, 4, 5, 6, 7);
    f2 = __builtin_shufflevector(r4, r5, 0, 1, 2, 3, 4, 5, 6, 7); f3 = __builtin_shufflevector(r6, r7, 0, 1, 2, 3, 4, 5, 6, 7);
}
DI bf16x8 scale_frag(bf16x8 f, float s) { const u32x4 u = __builtin_bit_cast(u32x4, f); u32x4 o;
#pragma unroll
    for (int e = 0; e < 4; ++e) o[e] = cvt_pk_bf16(__uint_as_float(u[e] << 16) * s, __uint_as_float(u[e] & 0xffff0000u) * s);
    return __builtin_bit_cast(bf16x8, o); }

DI void r3_unit(const KArgs& a, LAS unsigned char* lds, int b, int hh, int qb2) {
    const int tid = tid_fresh(), lane = tid & 63, wid = __builtin_amdgcn_readfirstlane(tid >> 6), h = lane >> 5, c = lane & 31;
    const int sc = qb2 >> 1, qpos = 256 * (qb2 & 1) + 32 * wid + c;
    float lgf2, lgb2; ret_decays(a, hh, lgf2, lgb2);
    const size_t tokS = (size_t)b * SEQ + SCH * sc, tokQ = tokS + qpos;
    LAS unsigned char* R0 = lds; LAS unsigned char* R1 = lds + 65536;
    const bf16_t* zk = (const bf16_t*)(a.ws + WS_ZK) + tokS * 512 + hh * 128; const bf16_t* zv = (const bf16_t*)(a.ws + WS_ZV) + tokS * 1024 + hh * 256;
    const unsigned wl = (unsigned)wid * 1024u;
    const unsigned soff = (unsigned)((tid >> 4) * 256 + (((tid & 15) ^ ((tid >> 4) & 15)) << 4));
    const unsigned koff = (unsigned)((tid >> 4) * 1024 + (((tid & 15) ^ ((tid >> 4) & 15)) << 4));
    const unsigned voff = (unsigned)((tid >> 5) * 2048 + (((tid & 31) ^ (((tid >> 5) & 3) << 2)) << 4));
#define R3_STAGE_KV(jb_, buf_) do { const char* kb_ = (const char*)zk + (size_t)(jb_) * 65536; const char* vb_ = (const char*)zv + (size_t)(jb_) * 131072; \
        _Pragma("unroll") for (int i_ = 0; i_ < 2; ++i_) GLDS16(kb_ + i_ * 32768 + koff, (buf_) + i_ * 8192 + wl); \
        _Pragma("unroll") for (int i_ = 0; i_ < 4; ++i_) GLDS16(vb_ + i_ * 32768 + voff, (buf_) + R3_KB + i_ * 8192 + wl); } while (0)
    __syncthreads();
    PB(110);
#pragma unroll
    for (int d = 0; d < 2; ++d) { const char* Sg = (const char*)((const bf16_t*)(a.ws + WS_SBF) + (size_t)(((b * 4 + hh) * 32 + sc) * 2 + d) * 32768);
#pragma unroll
        for (int i = 0; i < 8; ++i) GLDS16(Sg + i * 8192 + soff, (d ? R1 : R0) + i * 8192 + wl); }
    bf16x8 Qf[8];
    {   const bf16_t* qp = (const bf16_t*)(a.ws + WS_ZQ) + tokQ * 512 + hh * 128 + 8 * h;
#pragma unroll
        for (int ks = 0; ks < 8; ++ks) Qf[ks] = *(const bf16x8*)(qp + 16 * ks); }
    f32x16 OT[8];
#pragma unroll
    for (int nb = 0; nb < 8; ++nb) OT[nb] = zero16();
    const unsigned xq = (unsigned)(c & 15), rowb = (unsigned)c * 256u;
    float cf8[4], cfe[4], cb8[4], cbe[4];
#pragma unroll
    for (int k = 1; k < 4; ++k) { cf8[k] = __int_as_float(__builtin_amdgcn_readfirstlane(__float_as_int(ex2(-lgf2 * (float)(8 * k))))); cfe[k] = __int_as_float(__builtin_amdgcn_readfirstlane(__float_as_int(ex2(-lgf2 * (float)k))));
        cb8[k] = __int_as_float(__builtin_amdgcn_readfirstlane(__float_as_int(ex2(lgb2 * (float)(8 * k))))); cbe[k] = __int_as_float(__builtin_amdgcn_readfirstlane(__float_as_int(ex2(lgb2 * (float)k)))); }
    const int q0 = 256 * (qb2 & 1) + 32 * wid;
#pragma unroll
    for (int d = 0; d < 2; ++d) {
        if (d == 0) asm volatile("s_waitcnt vmcnt(16)" ::: "memory"); else asm volatile("s_waitcnt vmcnt(6)" ::: "memory");
        __builtin_amdgcn_s_barrier(); asm volatile("" ::: "memory");
        const float dec = d == 0 ? ex2(lgf2 * (float)(qpos + 1)) : ex2(lgb2 * (float)(SCH - qpos));
        const unsigned Sb = (unsigned)(size_t)(d ? R1 : R0) + rowb;
#pragma unroll
        for (int ks = 0; ks < 8; ++ks) { bf16x8 qf = Qf[ks]; asm volatile("" : "+v"(qf));
            const bf16x8 qs = scale_frag(qf, dec); const unsigned co = (((unsigned)(2 * ks + h)) ^ xq) << 4;
#pragma unroll
            for (int nb = 0; nb < 8; ++nb) { const bf16x8 sf = *(const LAS bf16x8*)(size_t)(Sb + 32 * 256 * nb + co); OT[nb] = MFMA32(sf, qs, OT[nb]); if (nb == 3) asm volatile("" ::: "memory"); }
            asm volatile("" ::: "memory"); }
        if (d == 0) { lds_barrier(); R3_STAGE_KV(0, R0); }
    }
    PE(110); PB(111);
    const unsigned q4 = (unsigned)((lane & 15) >> 2), vlane = (unsigned)(4 * h + q4) * 512u + 32u * ((lane >> 4) & 1) + 8u * (lane & 3);
#pragma unroll 1
    for (int jb = 0; jb < 8; ++jb) {
        LAS unsigned char* buf = (jb & 1) ? R1 : R0;
        asm volatile("s_waitcnt vmcnt(0)" ::: "memory");
        lds_barrier();
        if (jb + 1 < 8) { if (jb & 1) R3_STAGE_KV(jb + 1, R0); else R3_STAGE_KV(jb + 1, R1); }
        const unsigned Kb = (unsigned)(size_t)buf + rowb, Vb = (unsigned)(size_t)buf + R3_KB + vlane;
#pragma unroll
        for (int jt = 0; jt < 2; ++jt) {
            f32x16 st = zero16();
#pragma unroll
            for (int ks = 0; ks < 8; ++ks) { const bf16x8 kf = *(const LAS bf16x8*)(size_t)(Kb + 32 * 256 * jt + ((((unsigned)(2 * ks + h)) ^ xq) << 4)); st = MFMA32(kf, Qf[ks], st); }
            const int k0 = 64 * jb + 32 * jt;
            if (k0 == q0) {
#pragma unroll
                for (int i = 0; i < 16; ++i) { const int dd = qpos - (k0 + (i & 3) + 8 * (i >> 2) + 4 * h); st[i] *= (dd >= 0 ? ex2(lgf2 * (float)dd) : ex2(lgb2 * (float)(-dd))); }
            } else if (k0 < q0) { const float bh = ex2(lgf2 * (float)(q0 - k0 + c - 4 * h));
#pragma unroll
                for (int i = 0; i < 16; ++i) { float w = bh; if (i >> 2) w *= cf8[i >> 2]; if (i & 3) w *= cfe[i & 3]; st[i] *= w; }
            } else { const float bh = ex2(lgb2 * (float)(k0 - q0 + 4 * h - c));
#pragma unroll
                for (int i = 0; i < 16; ++i) { float w = bh; if (i >> 2) w *= cb8[i >> 2]; if (i & 3) w *= cbe[i & 3]; st[i] *= w; }
            }
#pragma unroll
            for (int s2 = 0; s2 < 2; ++s2) { u32x4 pk;
#pragma unroll
                for (int e = 0; e < 4; ++e) pk[e] = cvt_pk_bf16(st[8 * s2 + 2 * e], st[8 * s2 + 2 * e + 1]);
                const bf16x8 pb = __builtin_bit_cast(bf16x8, pk);
#pragma unroll
                for (int hf = 0; hf < 2; ++hf) {
                    bf16x8 v0, v1, v2, v3; const unsigned a0 = Vb + 64u * ((unsigned)(2 * hf) ^ q4), a1 = Vb + 64u * ((unsigned)(2 * hf + 1) ^ q4);
                    if (jt == 0 && s2 == 0) tr_frag2x2<0, 4096>(a0, a1, v0, v1, v2, v3);
                    if (jt == 0 && s2 == 1) tr_frag2x2<8192, 4096>(a0, a1, v0, v1, v2, v3);
                    if (jt == 1 && s2 == 0) tr_frag2x2<16384, 4096>(a0, a1, v0, v1, v2, v3);
                    if (jt == 1 && s2 == 1) tr_frag2x2<24576, 4096>(a0, a1, v0, v1, v2, v3);
                    OT[2 * hf] = MFMA32(v0, pb, OT[2 * hf]); OT[2 * hf + 4] = MFMA32(v1, pb, OT[2 * hf + 4]);
                    OT[2 * hf + 1] = MFMA32(v2, pb, OT[2 * hf + 1]); OT[2 * hf + 5] = MFMA32(v3, pb, OT[2 * hf + 5]);
                }
            }
        }
    }
    PE(111); PB(112);
    float s1 = 0.f, s2 = 0.f;
#pragma unroll
    for (int nb = 0; nb < 8; ++nb)
#pragma unroll
        for (int i = 0; i < 16; ++i) { s1 += OT[nb][i]; s2 += OT[nb][i] * OT[nb][i]; }
    s1 += __shfl_xor(s1, 32); s2 += __shfl_xor(s2, 32);
    const float mu = s1 * (1.0f / 256.0f), rstd = rsqrtf(fmaxf(s2 * (1.0f / 256.0f) - mu * mu, 0.f) + EPSV);
    lds_barrier();
    {   const int t2 = tid_fresh(), l2 = t2 & 63, w2 = t2 >> 6, h2 = l2 >> 5, c2 = l2 & 31;
        LAS unsigned char* slab = lds + (size_t)w2 * 16896;
#pragma unroll
        for (int nb = 0; nb < 8; ++nb)
#pragma unroll
            for (int g = 0; g < 4; ++g) { u32x2 o; o.x = cvt_pk_bf16((OT[nb][4 * g] - mu) * rstd, (OT[nb][4 * g + 1] - mu) * rstd); o.y = cvt_pk_bf16((OT[nb][4 * g + 2] - mu) * rstd, (OT[nb][4 * g + 3] - mu) * rstd);
                *(LAS u32x2*)(slab + c2 * 528 + (32 * nb + 8 * g + 4 * h2) * 2) = o; }
        bf16_t* gp = (bf16_t*)(a.ws + WS_ZG) + ((size_t)b * SEQ + SCH * sc + 256 * (qb2 & 1) + 32 * w2) * 1024 + hh * 256 + 8 * c2;
        const f32x4 gn0 = *(const f32x4*)(a.in[I_RNORM] + hh * 256 + 8 * c2), gn1 = *(const f32x4*)(a.in[I_RNORM] + hh * 256 + 8 * c2 + 4);
        u32x4 sg[16];
#pragma unroll
        for (int r = 0; r < 16; ++r) sg[r] = *(const u32x4*)(gp + (size_t)(2 * r + h2) * 1024);
        lds_wait();
#pragma unroll
        for (int r = 0; r < 16; ++r) { const u32x4 y = *(const LAS u32x4*)(slab + (2 * r + h2) * 528 + c2 * 16); u32x4 o;
            o[0] = cvt_pk_bf16(__uint_as_float(y[0] << 16) * gn0[0] * __uint_as_float(sg[r][0] << 16), __uint_as_float(y[0] & 0xffff0000u) * gn0[1] * __uint_as_float(sg[r][0] & 0xffff0000u));
            o[1] = cvt_pk_bf16(__uint_as_float(y[1] << 16) * gn0[2] * __uint_as_float(sg[r][1] << 16), __uint_as_float(y[1] & 0xffff0000u) * gn0[3] * __uint_as_float(sg[r][1] & 0xffff0000u));
            o[2] = cvt_pk_bf16(__uint_as_float(y[2] << 16) * gn1[0] * __uint_as_float(sg[r][2] << 16), __uint_as_float(y[2] & 0xffff0000u) * gn1[1] * __uint_as_float(sg[r][2] & 0xffff0000u));
            o[3] = cvt_pk_bf16(__uint_as_float(y[3] << 16) * gn1[2] * __uint_as_float(sg[r][3] << 16), __uint_as_float(y[3] & 0xffff0000u) * gn1[3] * __uint_as_float(sg[r][3] & 0xffff0000u));
            *(u32x4*)(gp + (size_t)(2 * r + h2) * 1024) = o; }
    }
    PE(112);
#undef R3_STAGE_KV
}

DI void phase2c(const KArgs& a, LAS unsigned char* lds) {
    const int G = gridDim.x;
    constexpr int NU_R3 = NB_ * NH * (SEQ / 256), NU_L3 = NB_ * 8 * 16;
    for (int u = blockIdx.x; u < NU_R3 + NU_L3; u += G) {
        if (SUBSEL(1) && u < NU_R3) { const int w = u & 255, uu = (u & ~255) + 2 * ((w & 7) + 8 * (w >> 4)) + ((w >> 3) & 1);
            const int b = uu >> 8, hh = (uu >> 6) & 3, qb2 = uu & 63; PB(102); r3_unit(a, lds, b, hh, qb2); PE(102); }
        else if (SUBSEL(2)) { const int q = u - NU_R3, b = q >> 7, n = (q >> 4) & 7, r = q & 15; PB(103); lru_run<true>(a, lds, b, n, 16 * r, 16, false); PE(103); }
    }
}

DI void cvt4_decode(const KArgs& a, int t, const float*& src, int& ld_src, unsigned char*& dst, size_t& hi_stride, int& ld_dst) {
    constexpr int T_GU = 32 * 2 * 16 * 3;
    if (t < T_GU) { const int e = t / 96, r = t % 96, mat = r / 48, kt = (r % 48) / 3, ng = r % 3;
        src = a.in[mat ? I_WEU : I_WEG] + (size_t)e * 1024 * 768 + (size_t)(64 * kt) * 768 + 256 * ng; ld_src = 768;
        dst = (unsigned char*)(a.ws + WS_WGU) + ((size_t)(e * 6 + 2 * ng) * 256 + mat * 128) * 1024 + 64 * kt; hi_stride = (size_t)256 * 1024; ld_dst = 1024;
    } else { const int q = t - T_GU, e = q / 48, r = q % 48, kt = r / 4, ng = r % 4;
        src = a.in[I_WED] + (size_t)e * 768 * 1024 + (size_t)(64 * kt) * 1024 + 256 * ng; ld_src = 1024;
        dst = (unsigned char*)(a.ws + WS_WDN) + ((size_t)e * 1024 + 256 * ng) * 768 + 64 * kt; hi_stride = (size_t)128 * 768; ld_dst = 768; }
}
DI unsigned cvt4_fp8_noclamp(float a, float b, float c, float d) { int p = 0; p = __builtin_amdgcn_cvt_pk_fp8_f32(a, b, p, false); p = __builtin_amdgcn_cvt_pk_fp8_f32(c, d, p, true); return (unsigned)p; }
DI void phase3_cvt(const KArgs& a, LAS unsigned char* lds) {
    const int G = gridDim.x, tid = tid_fresh(); LAS float* tile = (LAS float*)lds;
    constexpr int T_ALL = 32 * 2 * 16 * 3 + 32 * 12 * 4;
    const float* src; int ld_src; unsigned char* dA; size_t hA; int ldA; unsigned char* dB = nullptr; size_t hB = 0; int ldB = 0; unsigned char* dC = nullptr; size_t hC = 0; int ldC = 0;
    f32x4 va[8], vb[8], vc[8];
#define CVT_LOAD(v_, t_, d_, h_, l_) do { cvt4_decode(a, (t_), src, ld_src, d_, h_, l_); _Pragma("unroll") for (int i_ = 0; i_ < 8; ++i_) v_[i_] = *(const f32x4*)(src + (size_t)((tid >> 6) + 8 * i_) * ld_src + 4 * (tid & 63)); } while (0)
#define CVT_EMIT(v_) do { lds_barrier(); _Pragma("unroll") for (int i_ = 0; i_ < 8; ++i_) *(LAS f32x4*)(tile + ((tid >> 6) + 8 * i_) * 260 + 4 * (tid & 63)) = v_[i_]; } while (0)
#define CVT_STORE(d_, h_, l_) do { lds_barrier(); const int n_ = tid & 255, kh_ = tid >> 8; unsigned char* p_ = (d_) + (size_t)(n_ >> 7) * (h_) + (size_t)(n_ & 127) * (l_) + 32 * kh_; \
        _Pragma("unroll") for (int q_ = 0; q_ < 2; ++q_) { float x_[16]; _Pragma("unroll") for (int j_ = 0; j_ < 16; ++j_) x_[j_] = tile[(32 * kh_ + 16 * q_ + j_) * 260 + n_] * 64.0f; \
            u32x4 w_; w_.x = cvt4_fp8_noclamp(x_[0], x_[1], x_[2], x_[3]); w_.y = cvt4_fp8_noclamp(x_[4], x_[5], x_[6], x_[7]); w_.z = cvt4_fp8_noclamp(x_[8], x_[9], x_[10], x_[11]); w_.w = cvt4_fp8_noclamp(x_[12], x_[13], x_[14], x_[15]); \
            *(u32x4*)(p_ + 16 * q_) = w_; } } while (0)
#define CVT_STEP(v_, d_, h_, l_) { unsigned char* d0 = d_; const size_t h0 = h_; const int l0 = l_; CVT_EMIT(v_); if (t + 3 * G < T_ALL) CVT_LOAD(v_, t + 3 * G, d_, h_, l_); CVT_STORE(d0, h0, l0); } t += G; if (t >= T_ALL) break;
    int t = blockIdx.x; if (t >= T_ALL) return;
    CVT_LOAD(va, t, dA, hA, ldA);
    if (t + G < T_ALL) CVT_LOAD(vb, t + G, dB, hB, ldB);
    if (t + 2 * G < T_ALL) CVT_LOAD(vc, t + 2 * G, dC, hC, ldC);
    for (;;) {
        CVT_STEP(va, dA, hA, ldA)
        CVT_STEP(vb, dB, hB, ldB)
        CVT_STEP(vc, dC, hC, ldC)
    }
#undef CVT_LOAD
#undef CVT_EMIT
#undef CVT_STORE
#undef CVT_STEP
    __syncthreads();
}
struct OrderMerge {
    const char* A0; const char* A1; const char* B0; const char* B1; int G, c;
    DI bool next(int i, Unit& u) const { int pm, pn; if (!pg8::static_tile(i >> 1, G, c, NT / 256, 4, pm, pn)) return false;
        const int st = i & 1; u.pm = pm; u.pn = pn; u.aux = st; u.bmode = 1; u.A = (st ? A1 : A0) + (size_t)pm * 256 * 1024 * 2; u.B = (st ? B1 : B0) + (size_t)pn * 256 * 1024 * 2; return true; }
    DI void offsA(const Unit&, int, const int (&R)[2], const int (&C)[2], unsigned (&v)[2][2]) const { pg8::dense_offs(2048, R, C, v); }
};
struct EpiMerge {
    const bf16_t* glog; bf16_t* out;
    DI bool operator()(f32x4 (&acc)[2][2][4][2], const Unit& u, int wr, int wc, int fr, int fq) const {
        const bool st0 = (u.aux == 0);
        const bf16_t* gbase = glog + (size_t)(u.pm * 8 + u.pn) * 65536;
        u32x4 gl[2][4], gr[2][4];
#define EM_LOAD(bt_, slot_) do { const int bj_ = (bt_) >> 1, ai_ = (bt_) & 1; _Pragma("unroll") for (int m_ = 0; m_ < 4; ++m_) { const bf16_t* p_ = gbase + glog_frag(ai_, bj_, m_, wr, wc, fr, fq); \
            gl[slot_][m_] = *(const u32x4*)(p_ + 4 * 65536); if (st0) gr[slot_][m_] = *(const u32x4*)p_; } } while (0)
        EM_LOAD(0, 0);
#pragma unroll
        for (int bt = 0; bt < 4; ++bt) { const int bj = bt >> 1, ai = bt & 1, sl = bt & 1;
            if (bt + 1 < 4) { if (sl == 0) EM_LOAD(bt + 1, 1); else EM_LOAD(bt + 1, 0); }
#pragma unroll
            for (int m = 0; m < 4; ++m) { const u32x4 l4 = gl[sl][m];
                if (st0) { const u32x4 r4 = gr[sl][m];
#pragma unroll
                    for (int e = 0; e < 4; ++e) { const float r0 = __uint_as_float(r4[e] << 16), r1 = __uint_as_float(r4[e] & 0xffff0000u), l0 = __uint_as_float(l4[e] << 16), l1 = __uint_as_float(l4[e] & 0xffff0000u);
                        const float q0 = (1.0f + ex2(-LOG2E * l0)) * rcpf_(1.0f + ex2(-LOG2E * r0)), q1 = (1.0f + ex2(-LOG2E * l1)) * rcpf_(1.0f + ex2(-LOG2E * r1));
                        acc[ai][bj][m][e >> 1][2 * (e & 1)] *= q0; acc[ai][bj][m][e >> 1][2 * (e & 1) + 1] *= q1; }
                } else { float v[8];
#pragma unroll
                    for (int e = 0; e < 4; ++e) { const float l0 = __uint_as_float(l4[e] << 16), l1 = __uint_as_float(l4[e] & 0xffff0000u);
                        v[2 * e] = acc[ai][bj][m][e >> 1][2 * (e & 1)] * sigm(l0); v[2 * e + 1] = acc[ai][bj][m][e >> 1][2 * (e & 1) + 1] * sigm(l1); }
                    u32x4 w; w.x = cvt_pk_bf16(v[0], v[1]); w.y = cvt_pk_bf16(v[2], v[3]); w.z = cvt_pk_bf16(v[4], v[5]); w.w = cvt_pk_bf16(v[6], v[7]);
                    *(u32x4*)(out + (size_t)(u.pm * 256 + ai * 128 + wr * 64 + m * 16 + fr) * 1024 + u.pn * 256 + bj * 128 + wc * 32 + 8 * fq) = w; } } }
#undef EM_LOAD
        return st0;
    }
};

struct OrderOut {
    const char* A; const char* B; int G, c;
    DI bool next(int i, Unit& u) const { int pm, pn; if (!pg8::static_tile(i, G, c, NT / 256, 4, pm, pn)) return false;
        u.pm = pm; u.pn = pn; u.aux = 0; u.bmode = 1; u.A = A + (size_t)pm * 256 * 1024 * 2; u.B = B + (size_t)pn * 256 * 1024 * 2; return true; }
    DI void offsA(const Unit&, int, const int (&R)[2], const int (&C)[2], unsigned (&v)[2][2]) const { pg8::dense_offs(2048, R, C, v); }
};
struct EpiOut {
    const KArgs* a;
    DI bool operator()(f32x4 (&acc)[2][2][4][2], const Unit& u, int wr, int wc, int fr, int fq) const {
        const int b = (u.pm * 256) / SEQ; bf16_t* d1 = (bf16_t*)(a->ws + WS_D1);
#pragma unroll
        for (int bj = 0; bj < 2; ++bj) { const int col = u.pn * 256 + bj * 128 + wc * 32 + 8 * fq;
            const f32x4 g0 = *(const f32x4*)((const float*)(a->ws + WS_MODT) + b * 1024 + col), g1 = *(const f32x4*)((const float*)(a->ws + WS_MODT) + b * 1024 + col + 4);
#pragma unroll
            EPI_LOOP_ROWS { const size_t off = (size_t)(u.pm * 256 + ai * 128 + wr * 64 + m * 16 + fr) * 1024 + col; const f32x4 v0 = g0 * acc[ai][bj][m][0], v1 = g1 * acc[ai][bj][m][1];
                u32x4 w; w.x = cvt_pk_bf16(v0[0], v0[1]); w.y = cvt_pk_bf16(v0[2], v0[3]); w.z = cvt_pk_bf16(v1[0], v1[1]); w.w = cvt_pk_bf16(v1[2], v1[3]);
                *(u32x4*)(d1 + off) = w; } }
        return false;
    }
};

DI void phase5(const KArgs& a, LAS unsigned char* lds) {
    const int tid = tid_fresh(), G = gridDim.x, lane = tid & 63, wid = __builtin_amdgcn_readfirstlane(tid >> 6);
    LAS float* gm = (LAS float*)lds;
    LAS float* sh = gm + 2048;
    LAS float* lg = sh + 2048;
    LAS int* lcnt = (LAS int*)(lg + 128 * 40);
    LAS int* rinfo = lcnt + 64;
    LAS float* rw = (LAS float*)(rinfo + 512);
    LAS float* red = rw + 256;
    LAS unsigned char* At = (LAS unsigned char*)(red + 4 * 32 * 40);
    __syncthreads();
    for (int i = tid; i < 2048; i += 512) { const float* mt = (const float*)(a.ws + WS_MODT); gm[i] = mt[2048 + i]; sh[i] = mt[4096 + i]; }
    if (blockIdx.x == 0 && tid < 256) ((unsigned*)(a.ws + WS_HX2Q) + (size_t)NT * 256)[tid] = 0u;
    const int cb = wid & 1, kq = wid >> 1, r = lane & 31, h = lane >> 5;
    bf16x8 Bh[16], Bl[16];
    {   const bf16_t* bh = (const bf16_t*)(a.ws + WS_WRH) + (size_t)(32 * cb + r) * 1024 + 256 * kq + 8 * h;
#pragma unroll
        for (int s2 = 0; s2 < 16; ++s2) { Bh[s2] = *(const bf16x8*)(bh + 16 * s2); Bl[s2] = *(const bf16x8*)(bh + 64 * 1024 + 16 * s2); } }
    for (int rt = blockIdx.x; rt < NT / 128; rt += G) {
        __syncthreads();
        if (tid < 32) lcnt[tid] = 0;
        const int v = (128 * rt) / SEQ; const bf16_t* d1 = (const bf16_t*)(a.ws + WS_D1);
        for (int ch = 0; ch < 4; ++ch) {
            PB(130);
            {
                const int rowc = 4 * wid, row0 = 128 * rt + 32 * ch + rowc; f32x4 x[2][4], xb[2][4]; u32x2 dl[2][4], db[2][4];
#pragma unroll
                for (int q = 0; q < 2; ++q)
#pragma unroll
                    for (int j = 0; j < 4; ++j) { x[q][j] = *(const f32x4*)(a.in[I_X] + (size_t)(row0 + q) * 1024 + 4 * lane + 256 * j); dl[q][j] = *(const u32x2*)(d1 + (size_t)(row0 + q) * 1024 + 4 * lane + 256 * j); }
#pragma unroll
                for (int pr = 0; pr < 2; ++pr) {
                    if (pr == 0) {
#pragma unroll
                        for (int q = 0; q < 2; ++q)
#pragma unroll
                            for (int j = 0; j < 4; ++j) { xb[q][j] = *(const f32x4*)(a.in[I_X] + (size_t)(row0 + 2 + q) * 1024 + 4 * lane + 256 * j); db[q][j] = *(const u32x2*)(d1 + (size_t)(row0 + 2 + q) * 1024 + 4 * lane + 256 * j); } }
#pragma unroll
                    for (int q = 0; q < 2; ++q) { const int row = row0 + 2 * pr + q; float ss = 0.f;
#pragma unroll
                        for (int j = 0; j < 4; ++j) { x[q][j][0] += __uint_as_float(dl[q][j].x << 16); x[q][j][1] += __uint_as_float(dl[q][j].x & 0xffff0000u); x[q][j][2] += __uint_as_float(dl[q][j].y << 16); x[q][j][3] += __uint_as_float(dl[q][j].y & 0xffff0000u);
                            ss += (x[q][j][0] * x[q][j][0] + x[q][j][1] * x[q][j][1]) + (x[q][j][2] * x[q][j][2] + x[q][j][3] * x[q][j][3]); }
#pragma unroll
                        for (int o = 32; o >= 1; o >>= 1) ss += __shfl_xor(ss, o);
                        const float rstd = rsqrtf(ss * (1.0f / 1024.0f) + EPSV);
#pragma unroll
                        for (int j = 0; j < 4; ++j) { const int k0 = 4 * lane + 256 * j; const f32x4 g = *(const LAS f32x4*)(gm + v * 1024 + k0), sv = *(const LAS f32x4*)(sh + v * 1024 + k0);
                            const float y0 = x[q][j][0] * rstd * g[0] + sv[0], y1 = x[q][j][1] * rstd * g[1] + sv[1], y2 = x[q][j][2] * rstd * g[2] + sv[2], y3 = x[q][j][3] * rstd * g[3] + sv[3];
                            u32x2 w; w.x = cvt_pk_bf16(y0, y1); w.y = cvt_pk_bf16(y2, y3);
                            *(LAS u32x2*)(At + (rowc + 2 * pr + q) * 2064 + k0 * 2) = w;
                            *(unsigned*)((unsigned char*)(a.ws + WS_HX2Q) + (size_t)row * 1024 + k0) = cvt4_fp8(16.f * y0, 16.f * y1, 16.f * y2, 16.f * y3); } }
                    if (pr == 0) {
#pragma unroll
                        for (int q = 0; q < 2; ++q)
#pragma unroll
                            for (int j = 0; j < 4; ++j) { x[q][j] = xb[q][j]; dl[q][j] = db[q][j]; } }
                }
            }
            lds_barrier();
            PE(130); PB(131);
            {
                f32x16 acc = zero16();
#pragma unroll
                for (int s2 = 0; s2 < 16; ++s2) { const bf16x8 af = *(const LAS bf16x8*)(At + r * 2064 + (256 * kq + 16 * s2 + 8 * h) * 2); acc = MFMA32(af, Bh[s2], acc); acc = MFMA32(af, Bl[s2], acc); }
                const int col = 32 * cb + r;
                if (col < 36) {
#pragma unroll
                    for (int i = 0; i < 16; ++i) red[(kq * 32 + crow(i, h)) * 40 + col] = acc[i]; }
            }
            lds_barrier();
            for (int i = tid; i < 32 * 36; i += 512) { const int rr = i / 36, cc = i % 36; lg[(32 * ch + rr) * 40 + cc] = (red[(0 * 32 + rr) * 40 + cc] + red[(1 * 32 + rr) * 40 + cc]) + (red[(2 * 32 + rr) * 40 + cc] + red[(3 * 32 + rr) * 40 + cc]); }
            PE(131);
        }
        __syncthreads();
        PB(132);
        if (tid < 128) { const LAS float* l = lg + tid * 40;
            int gs = 0; float best = l[0] + a.in[I_BGRP][0];
#pragma unroll
            for (int g = 1; g < 4; ++g) { const float vv = l[g] + a.in[I_BGRP][g]; if (vv > best) { best = vv; gs = g; } }
            const float mx = fmaxf(fmaxf(l[0], l[1]), fmaxf(l[2], l[3])); float den = 0.f;
#pragma unroll
            for (int g = 0; g < 4; ++g) den += expf(l[g] - mx);
            const float pg = expf(l[gs] - mx) / den;
            int i0 = 0, i1 = -1; float v0 = -3.0e38f, v1 = -3.0e38f;
#pragma unroll
            for (int e = 0; e < 8; ++e) { const float vv = l[4 + 8 * gs + e] + a.in[I_BRT][8 * gs + e];
                if (vv > v0) { v1 = v0; i1 = i0; v0 = vv; i0 = e; } else if (vv > v1) { v1 = vv; i1 = e; } }
            const float e0 = l[4 + 8 * gs + i0], e1 = l[4 + 8 * gs + i1], m2 = fmaxf(e0, e1), x0 = expf(e0 - m2), x1 = expf(e1 - m2), inv = 1.0f / (x0 + x1);
            const int ex0 = 8 * gs + i0, ex1 = 8 * gs + i1;
            rinfo[tid * 4 + 0] = ex0; rinfo[tid * 4 + 1] = atomicAdd((int*)&lcnt[ex0], 1); rinfo[tid * 4 + 2] = ex1; rinfo[tid * 4 + 3] = atomicAdd((int*)&lcnt[ex1], 1);
            rw[tid * 2 + 0] = pg * x0 * inv; rw[tid * 2 + 1] = pg * x1 * inv; }
        __syncthreads();
        { const int t3 = tid_fresh(); if (t3 < 32) lcnt[32 + t3] = lcnt[t3] ? atomicAdd((int*)(a.ws + WS_CTL) + CW_CNT + t3, lcnt[t3]) : 0; }
        __syncthreads();
        if (tid < 128) { const int tok = 128 * rt + tid; const int e0 = rinfo[tid * 4 + 0], s0 = lcnt[32 + e0] + rinfo[tid * 4 + 1], e1 = rinfo[tid * 4 + 2], s1 = lcnt[32 + e1] + rinfo[tid * 4 + 3];
            int* ptok = (int*)(a.ws + WS_PTOK); ptok[(size_t)e0 * 65536 + s0] = tok; ptok[(size_t)e1 * 65536 + s1] = tok;
            unsigned* ro = (unsigned*)(a.ws + WS_ROUTE) + (size_t)tok * 8; ro[0] = e0; ro[1] = s0; ro[2] = e1; ro[3] = s1; ro[4] = __float_as_uint(rw[tid * 2]); ro[5] = __float_as_uint(rw[tid * 2 + 1]); }
        PE(132);
    }
}

DI void moe_tiles(const KArgs& a, LAS int* tt) {
    __syncthreads();
    if (threadIdx.x == 0) { const int* cnt = (const int*)(a.ws + WS_CTL) + CW_CNT; int s = 0; for (int e = 0; e < 32; ++e) { tt[e] = s; s += (cnt[e] + 255) >> 8; } tt[32] = s; }
    __syncthreads();
}
DI int moe_expert(const LAS int* tt, int rt) { int e = 0;
#pragma unroll
    for (int q = 16; q >= 1; q >>= 1) if (tt[e + q] <= rt) e += q;
    return e; }
struct OrderMoe1 {
    const char* A; const char* B; const LAS int* tt; const LAS int* tok; int G, c;
    DI bool next(int i, Unit& u) const { const int L = i * G + c; if (L >= tt[32] * 6) return false; const int rt = L / 6, ct = L % 6, e = moe_expert(tt, rt);
        u.pm = rt; u.pn = ct; u.aux = e; u.bmode = 1; u.A = A; u.B = B + (size_t)(e * 6 + ct) * 256 * 1024; return true; }
    DI void offsA(const Unit&, int ui, const int (&R)[2], const int (&C)[2], unsigned (&v)[2][2]) const {
#pragma unroll
        for (int h = 0; h < 2; ++h)
#pragma unroll
            for (int i = 0; i < 2; ++i) v[h][i] = (unsigned)tok[ui * 256 + h * 128 + R[i]] * 1024u + (unsigned)C[i] * 2u; }
};
struct EpiMoe1 {
    unsigned char* hid;
    DI bool operator()(f32x4 (&acc)[2][2][4][2], const Unit& u, int wr, int wc, int fr, int fq) const {
        const int col = u.pn * 128 + wc * 32 + 8 * fq;
#pragma unroll
        EPI_LOOP_ROWS { const size_t row = (size_t)u.pm * 256 + ai * 128 + wr * 64 + m * 16 + fr; float v[8];
#pragma unroll
            for (int n = 0; n < 2; ++n)
#pragma unroll
                for (int j = 0; j < 4; ++j) { const float g = acc[ai][0][m][n][j] * (1.0f / 1024.0f), up = acc[ai][1][m][n][j] * (1.0f / 1024.0f); v[4 * n + j] = silu_(g) * up * 8.0f; }
            u32x2 w; w.x = cvt4_fp8(v[0], v[1], v[2], v[3]); w.y = cvt4_fp8(v[4], v[5], v[6], v[7]);
            *(u32x2*)(hid + row * 768 + col) = w; }
        return false;
    }
};
struct OrderMoe2 {
    const char* A; const char* B; const LAS int* tt; int G, c;
    DI bool next(int i, Unit& u) const { const int L = i * G + c; if (L >= tt[32] * 4) return false; const int rt = L >> 2, ct = L & 3, e = moe_expert(tt, rt);
        u.pm = rt; u.pn = ct; u.aux = e; u.bmode = 1; u.A = A + (size_t)rt * 256 * 768; u.B = B + ((size_t)e * 1024 + 256 * ct) * 768; return true; }
    DI void offsA(const Unit&, int, const int (&R)[2], const int (&C)[2], unsigned (&v)[2][2]) const { pg8::dense_offs(768, R, C, v); }
};
struct EpiMoe2 {
    unsigned char* ye;
    DI bool operator()(f32x4 (&acc)[2][2][4][2], const Unit& u, int wr, int wc, int fr, int fq) const {
#pragma unroll
        for (int bj = 0; bj < 2; ++bj) { const int col = u.pn * 256 + bj * 128 + wc * 32 + 8 * fq;
#pragma unroll
            EPI_LOOP_ROWS { const size_t row = (size_t)u.pm * 256 + ai * 128 + wr * 64 + m * 16 + fr; const f32x4 v0 = acc[ai][bj][m][0] * (16.0f / 512.0f), v1 = acc[ai][bj][m][1] * (16.0f / 512.0f);
                u32x2 w; w.x = cvt4_fp8(v0[0], v0[1], v0[2], v0[3]); w.y = cvt4_fp8(v1[0], v1[1], v1[2], v1[3]);
                *(u32x2*)(ye + row * 1024 + col) = w; } }
        return false;
    }
};

DI void phase8(const KArgs& a, LAS unsigned char* lds) {
    const int tid = tid_fresh(), G = gridDim.x, lane = tid & 63, wid = tid >> 6;
    LAS float* g2 = (LAS float*)lds;
    LAS int* tt = (LAS int*)(g2 + 2048);
    moe_tiles(a, tt);
    for (int i = tid; i < 2048; i += 512) g2[i] = ((const float*)(a.ws + WS_MODT))[6144 + i];
    __syncthreads();
    const unsigned char* ye = (const unsigned char*)(a.ws + WS_YE); const bf16_t* d1 = (const bf16_t*)(a.ws + WS_D1);
    const int rstep = G * 8; int row = blockIdx.x * 8 + wid;
    f32x4 x[4]; u32x2 dl[4]; unsigned ya[4], yb[4]; float w0 = 0.f, w1 = 0.f; unsigned ron[6];
#define P8_ROUTE(r_, dst_) do { const unsigned* ro_ = (const unsigned*)(a.ws + WS_ROUTE) + (size_t)(r_) * 8; _Pragma("unroll") for (int q_ = 0; q_ < 6; ++q_) dst_[q_] = ro_[q_]; } while (0)
#define P8_LOAD(r_, rt_, X_, D_, A_, B_) do { const size_t p0_ = (size_t)tt[rt_[0]] * 256 + rt_[1], p1_ = (size_t)tt[rt_[2]] * 256 + rt_[3]; \
        _Pragma("unroll") for (int j_ = 0; j_ < 4; ++j_) { const int k0_ = 4 * lane + 256 * j_; X_[j_] = *(const f32x4*)(a.in[I_X] + (size_t)(r_) * 1024 + k0_); D_[j_] = *(const u32x2*)(d1 + (size_t)(r_) * 1024 + k0_); \
            A_[j_] = *(const unsigned*)(ye + p0_ * 1024 + k0_); B_[j_] = *(const unsigned*)(ye + p1_ * 1024 + k0_); } } while (0)
    if (row < NT) { unsigned r0[6]; P8_ROUTE(row, r0); P8_LOAD(row, r0, x, dl, ya, yb); w0 = __uint_as_float(r0[4]); w1 = __uint_as_float(r0[5]); if (row + rstep < NT) P8_ROUTE(row + rstep, ron); }
    for (; row < NT; row += rstep) {
        const int v = row / SEQ, nrow = row + rstep; f32x4 xn[4]; u32x2 dn[4]; unsigned yan[4], ybn[4]; float w0n = 0.f, w1n = 0.f;
        if (nrow < NT) { P8_LOAD(nrow, ron, xn, dn, yan, ybn); w0n = __uint_as_float(ron[4]); w1n = __uint_as_float(ron[5]); if (nrow + rstep < NT) P8_ROUTE(nrow + rstep, ron); }
        float ss = 0.f; const float s0 = w0 * (1.0f / 16.0f), s1 = w1 * (1.0f / 16.0f);
#pragma unroll
        for (int j = 0; j < 4; ++j) { const int k0 = 4 * lane + 256 * j; const f32x4 g = *(const LAS f32x4*)(g2 + v * 1024 + k0);
            const float m0 = s0 * __builtin_amdgcn_cvt_f32_fp8(ya[j], 0) + s1 * __builtin_amdgcn_cvt_f32_fp8(yb[j], 0), m1 = s0 * __builtin_amdgcn_cvt_f32_fp8(ya[j], 1) + s1 * __builtin_amdgcn_cvt_f32_fp8(yb[j], 1);
            const float m2 = s0 * __builtin_amdgcn_cvt_f32_fp8(ya[j], 2) + s1 * __builtin_amdgcn_cvt_f32_fp8(yb[j], 2), m3 = s0 * __builtin_amdgcn_cvt_f32_fp8(ya[j], 3) + s1 * __builtin_amdgcn_cvt_f32_fp8(yb[j], 3);
            x[j][0] += __uint_as_float(dl[j].x << 16) + g[0] * m0; x[j][1] += __uint_as_float(dl[j].x & 0xffff0000u) + g[1] * m1;
            x[j][2] += __uint_as_float(dl[j].y << 16) + g[2] * m2; x[j][3] += __uint_as_float(dl[j].y & 0xffff0000u) + g[3] * m3;
            ss += (x[j][0] * x[j][0] + x[j][1] * x[j][1]) + (x[j][2] * x[j][2] + x[j][3] * x[j][3]); }
#pragma unroll
        for (int o = 32; o >= 1; o >>= 1) ss += __shfl_xor(ss, o);
        const float rstd = rsqrtf(ss * (1.0f / 1024.0f) + EPSV);
        float* xr = a.out + (size_t)row * 1024;
#pragma unroll
        for (int j = 0; j < 4; ++j) { const int k0 = 4 * lane + 256 * j; const f32x4 fn = *(const f32x4*)(a.in[I_FNORM] + k0); *(f32x4*)(xr + k0) = x[j] * rstd * fn; }
#pragma unroll
        for (int j = 0; j < 4; ++j) { x[j] = xn[j]; dl[j] = dn[j]; ya[j] = yan[j]; yb[j] = ybn[j]; }
        w0 = w0n; w1 = w1n;
    }
#undef P8_ROUTE
#undef P8_LOAD
}

constexpr int N_PHASES = 12;
__global__ void __launch_bounds__(512, 2) fwd_kernel(KArgs a) {
    extern __shared__ __attribute__((aligned(16))) unsigned char lds_raw[];
    LAS unsigned char* lds = (LAS unsigned char*)lds_raw;
    volatile LAS unsigned* misc = (volatile LAS unsigned*)(lds + LDS_MISC);
    if (threadIdx.x < 8) misc[threadIdx.x] = 0u;
#ifdef PROBE_ID
    if (threadIdx.x == 0) { probe_words()[0] = 0; probe_words()[1] = 0; }
#endif
    __syncthreads();
    XcdBarrier bar; bar.bar = (unsigned*)(a.ws + WS_CTL) + CW_BAR; bar.x = 0; bar.st = misc;
    const bool one = (a.ph_hi - a.ph_lo) > 1;
    if (one) bar = xcd_barrier_post((unsigned*)(a.ws + WS_CTL) + CW_BAR, misc);
#ifdef ONLY_PHASE
#define IN(k) ((k) == ONLY_PHASE)
#else
#define IN(k) (a.ph_lo <= (k) && (k) < a.ph_hi)
#endif
#define SEAM(k) do { if (IN(k) && IN((k) + 1)) xcd_barrier(bar); PE(k); PB((k) + 1); } while (0)
    const int G = gridDim.x, c = blockIdx.x;
    PB(0);
    if (IN(0)) { phase0a(a, lds); } SEAM(0);
    if (IN(1)) { phase0b(a, lds); } SEAM(1);
    if (IN(2)) { __syncthreads(); OrderIn S{(const char*)(a.ws + WS_HX), (const char*)(a.ws + WS_WIN), G, c};
        EpiIn E{a.ws, (bf16_t*)a.out, a.in[I_BGATE], (const f32x2*)(a.ws + WS_ROPE)}; pg8::gemm_phase<false>(lds, 1024, S, E); } SEAM(2);
    if (IN(3)) { phase2a(a, lds); } SEAM(3);
    if (IN(4)) { phase2b(a); } SEAM(4);
    if (IN(5)) { phase2c(a, lds); } SEAM(5);
    if (IN(6)) {
        const bool cvt_first = (c & 1) == 0;
        if (cvt_first) { PB(104); phase3_cvt(a, lds); PE(104); }
        {   OrderMerge S{(const char*)(a.ws + WS_ZG), (const char*)(a.ws + WS_ZGL), (const char*)(a.ws + WS_WRET), (const char*)(a.ws + WS_WLRU), G, c};
            EpiMerge E{(const bf16_t*)a.out, (bf16_t*)(a.ws + WS_HX)}; __syncthreads(); pg8::gemm_phase<false>(lds, 1024, S, E); }
        if (!cvt_first) { phase3_cvt(a, lds); } } SEAM(6);
    if (IN(7)) { __syncthreads(); OrderOut S{(const char*)(a.ws + WS_HX), (const char*)(a.ws + WS_WOUT), G, c}; EpiOut E{&a}; pg8::gemm_phase<false>(lds, 1024, S, E); } SEAM(7);
    if (IN(8)) { phase5(a, lds); } SEAM(8);
    if (IN(9)) {
        LAS int* tt = (LAS int*)(lds + LDS_MISC + 64); LAS int* tok = (LAS int*)(lds + LDS_TOK);
        moe_tiles(a, tt);
        {
            const int tid = tid_fresh();
            const int* cnt = (const int*)(a.ws + WS_CTL) + CW_CNT; const int* ptok = (const int*)(a.ws + WS_PTOK);
            for (int i = 0; i < 8; ++i) { const int L = i * G + c; if (L >= tt[32] * 6) break; const int rt = L / 6, e = moe_expert(tt, rt), r0 = (rt - tt[e]) * 256;
                if (tid < 256) tok[i * 256 + tid] = (r0 + tid < cnt[e]) ? ptok[(size_t)e * 65536 + r0 + tid] : NT; }
            __syncthreads();
        }
        OrderMoe1 S{(const char*)(a.ws + WS_HX2Q), (const char*)(a.ws + WS_WGU), tt, tok, G, c}; EpiMoe1 E{(unsigned char*)(a.ws + WS_HID)}; pg8::gemm_phase<true>(lds, 1024, S, E); } SEAM(9);
    if (IN(10)) { LAS int* tt = (LAS int*)(lds + LDS_MISC + 64); moe_tiles(a, tt);
        OrderMoe2 S{(const char*)(a.ws + WS_HID), (const char*)(a.ws + WS_WDN), tt, G, c}; EpiMoe2 E{(unsigned char*)(a.ws + WS_YE)}; pg8::gemm_phase<true>(lds, 768, S, E); } SEAM(10);
    if (IN(11)) { phase8(a, lds); }
    PE(11);
#ifdef PROBE_ID
    if (blockIdx.x == 0 && threadIdx.x == 0) { const unsigned long long w = probe_words()[1] * 4ull, t0 = wall_clock64(); while (wall_clock64() - t0 < w) __builtin_amdgcn_s_sleep(8); }
#endif
#undef IN
#undef SEAM
}

extern "C" void kernel_launch(void* const* d_in, const int* in_sizes, int n_in, void* d_out, int out_size, void* d_ws, size_t ws_size, hipStream_t stream) {
    static int grid = 0;
    if (grid == 0) {
        if (n_in != 30 || out_size != NT * DM || ws_size < WS_NEED) { fprintf(stderr, "kernel_launch: unexpected shapes (n_in %d out %d ws %zu)\n", n_in, out_size, ws_size); grid = -1; return; }
        int dev = 0, cus = 0;
        if (hipGetDevice(&dev) != hipSuccess || hipDeviceGetAttribute(&cus, hipDeviceAttributeMultiprocessorCount, dev) != hipSuccess) { grid = -1; return; }
        if (hipFuncSetAttribute((const void*)fwd_kernel, hipFuncAttributeMaxDynamicSharedMemorySize, LDS_BYTES) != hipSuccess) { fprintf(stderr, "kernel_launch: hipFuncSetAttribute failed\n"); grid = -1; return; }
        int per_cu = 0; (void)hipOccupancyMaxActiveBlocksPerMultiprocessor(&per_cu, (const void*)fwd_kernel, 512, LDS_BYTES); (void)hipGetLastError();
        grid = cus;
    }
    if (grid < 0) return;
    (void)hipMemsetAsync((char*)d_ws + WS_CTL, 0, 1 * MiB, stream);
    KArgs a{};
    for (int i = 0; i < 30; ++i) a.in[i] = (const float*)d_in[i];
    a.out = (float*)d_out; a.ws = (unsigned char*)d_ws;
#if N_LAUNCH_SPLIT
    for (int p = 0; p < N_PHASES; ++p) { a.ph_lo = p; a.ph_hi = p + 1; hipLaunchKernelGGL(fwd_kernel, dim3(grid), dim3(512), LDS_BYTES, stream, a); }
#else
    a.ph_lo = 0; a.ph_hi = N_PHASES; hipLaunchKernelGGL(fwd_kernel, dim3(grid), dim3(512), LDS_BYTES, stream, a);
#endif
}
```

```cpp
#include <hip/hip_runtime.h>
#include <cstdio>
#include <cstdint>

#ifndef N_LAUNCH_SPLIT
#define N_LAUNCH_SPLIT 0
#endif

#define DI __device__ __forceinline__
#ifdef SUB
#define SUBSEL(k) ((k) == SUB)
#else
#define SUBSEL(k) true
#endif
#define LAS __attribute__((address_space(3)))
typedef unsigned short bf16_t;
typedef short bf16x8 __attribute__((ext_vector_type(8)));
typedef short s16x4 __attribute__((ext_vector_type(4)));
typedef float f32x2 __attribute__((ext_vector_type(2)));
typedef float f32x4 __attribute__((ext_vector_type(4)));
typedef float f32x16 __attribute__((ext_vector_type(16)));
typedef unsigned u32x2 __attribute__((ext_vector_type(2)));
typedef unsigned u32x4 __attribute__((ext_vector_type(4)));
typedef int v8i_t __attribute__((ext_vector_type(8)));
typedef int v4i_t __attribute__((ext_vector_type(4)));

constexpr int NB_ = 2, SEQ = 16384, NT = NB_ * SEQ, DM = 1024, CTXL = 256, NTC = NB_ * CTXL;
constexpr int NH = 4, DK = 128, DV = 256, QW = 512, VW = 1024, LW = 1024;
constexpr int NCOL = 7168;
constexpr int NE = 32, EH = 768;
constexpr float EPSV = 1e-6f;
constexpr float LOG2E = 1.4426950408889634f;
constexpr int SCH = 512, NSC = SEQ / SCH;
constexpr int LT = 64, NLT = SEQ / LT, NSLOT = 320;

constexpr size_t MiB = 1u << 20;
constexpr size_t WS_CTL = 0;
constexpr size_t WS_MODP = 1 * MiB;
constexpr size_t WS_MODT = 1 * MiB + 384 * 1024;
constexpr size_t WS_RDEC = 1 * MiB + 448 * 1024;
constexpr size_t WS_ROPE = 1 * MiB + 512 * 1024;
constexpr size_t WS_WRH = 1 * MiB + 768 * 1024;
constexpr size_t WS_LAGG = 2 * MiB;
constexpr size_t WS_LHIN = 12 * MiB;
constexpr size_t WS_CTXK = 17 * MiB;
constexpr size_t WS_CTXV = 17 * MiB + 512 * 1024;
constexpr size_t WS_CTXX = 18 * MiB + 512 * 1024;
constexpr size_t WS_CTXS = 20 * MiB;
constexpr size_t WS_ROUTE = 22 * MiB;
constexpr size_t WS_PTOK = 23 * MiB;
constexpr size_t WS_WIN = 32 * MiB;
constexpr size_t WS_WRET = 46 * MiB, WS_WLRU = 48 * MiB, WS_WOUT = 50 * MiB;
constexpr size_t WS_WLB = 52 * MiB;
constexpr size_t WS_HX = 56 * MiB;
constexpr size_t WS_ZQ = 120 * MiB, WS_ZK = 152 * MiB, WS_ZV = 184 * MiB, WS_ZG = 248 * MiB, WS_ZXL = 312 * MiB, WS_ZGL = 376 * MiB;
constexpr size_t WS_SBF = 440 * MiB;
constexpr size_t WS_WGU = 120 * MiB;
constexpr size_t WS_WDN = 440 * MiB;
constexpr size_t WS_HX2 = 248 * MiB;
constexpr size_t WS_HID = 313 * MiB;
constexpr size_t WS_HX2Q = 168 * MiB;
constexpr size_t WS_YE = 56 * MiB;
constexpr size_t WS_D1 = 376 * MiB;
constexpr size_t WS_NEED = 512 * MiB;
constexpr int CW_BAR = 4096, CW_CNT = 16384;

constexpr int LDS_SCR = 0, LDS_TOK = 131072, LDS_MISC = 131072 + 8192, LDS_BYTES = 147456;

DI int tid_fresh() { int t = threadIdx.x; asm volatile("" : "+v"(t)); return t; }
#ifdef PROBE_ID
DI volatile LAS unsigned long long* probe_words() { extern __shared__ __attribute__((aligned(16))) unsigned char lds_raw[]; return (volatile LAS unsigned long long*)((LAS unsigned char*)lds_raw + 131072 + 8192 + 1024); }
#define PB(id) do { if ((id) == PROBE_ID && threadIdx.x == 0) probe_words()[0] = wall_clock64(); } while (0)
#define PE(id) do { if ((id) == PROBE_ID && threadIdx.x == 0) probe_words()[1] += wall_clock64() - probe_words()[0]; } while (0)
#else
#define PB(id) do {} while (0)
#define PE(id) do {} while (0)
#endif
DI float bf2f(unsigned short b) { return __uint_as_float(((unsigned)b) << 16); }
typedef __bf16 bf16x2_t __attribute__((ext_vector_type(2)));
DI unsigned cvt_pk_bf16(float lo, float hi) { const f32x2 v = {lo, hi}; return __builtin_bit_cast(unsigned, __builtin_convertvector(v, bf16x2_t)); }
DI float clamp_f8(float x) { return __builtin_amdgcn_fmed3f(x, -448.f, 448.f); }
DI unsigned cvt4_fp8(float a, float b, float c, float d) { int p = 0; p = __builtin_amdgcn_cvt_pk_fp8_f32(clamp_f8(a), clamp_f8(b), p, false); p = __builtin_amdgcn_cvt_pk_fp8_f32(clamp_f8(c), clamp_f8(d), p, true); return (unsigned)p; }
DI unsigned short f2bf(float f) { return (unsigned short)(cvt_pk_bf16(f, 0.f) & 0xffffu); }
DI float ex2(float x) { return __builtin_amdgcn_exp2f(x); }
DI float rcpf_(float x) { return __builtin_amdgcn_rcpf(x); }
DI float sigm(float x) { return rcpf_(1.0f + ex2(-LOG2E * x)); }
DI float silu_(float x) { return x * sigm(x); }
DI float gelu_tanh(float x) { const float z = 0.7978845608028654f * (x + 0.044715f * x * x * x); return x * sigm(2.0f * z); }
DI float softplus_(float x) { return x > 20.f ? x : log1pf(expf(x)); }
DI int crow(int i, int h) { return (i & 3) + 8 * (i >> 2) + 4 * h; }
#define MFMA32(a, b, c) __builtin_amdgcn_mfma_f32_32x32x16_bf16((a), (b), (c), 0, 0, 0)
DI void lds_wait() { asm volatile("s_waitcnt lgkmcnt(0)" ::: "memory"); }
template <int O0, int O1> DI bf16x8 tr_frag(unsigned addr) {
    s16x4 lo, hi;
    asm volatile("ds_read_b64_tr_b16 %0, %2 offset:%3\n\tds_read_b64_tr_b16 %1, %2 offset:%4\n\ts_waitcnt lgkmcnt(0)" : "=&v"(lo), "=&v"(hi) : "v"(addr), "i"(O0), "i"(O1) : "memory");
    return __builtin_shufflevector(lo, hi, 0, 1, 2, 3, 4, 5, 6, 7);
}
template <int O, int S, int T> DI void tr_frag4(unsigned addr, bf16x8& f0, bf16x8& f1, bf16x8& f2, bf16x8& f3) {
    s16x4 a0, a1, b0, b1, c0, c1, d0, d1;
    asm volatile("ds_read_b64_tr_b16 %0, %8 offset:%9\n\tds_read_b64_tr_b16 %1, %8 offset:%10\n\t"
                 "ds_read_b64_tr_b16 %2, %8 offset:%11\n\tds_read_b64_tr_b16 %3, %8 offset:%12\n\t"
                 "ds_read_b64_tr_b16 %4, %8 offset:%13\n\tds_read_b64_tr_b16 %5, %8 offset:%14\n\t"
                 "ds_read_b64_tr_b16 %6, %8 offset:%15\n\tds_read_b64_tr_b16 %7, %8 offset:%16\n\ts_waitcnt lgkmcnt(0)"
                 : "=&v"(a0), "=&v"(a1), "=&v"(b0), "=&v"(b1), "=&v"(c0), "=&v"(c1), "=&v"(d0), "=&v"(d1)
                 : "v"(addr), "i"(O), "i"(O + T), "i"(O + S), "i"(O + S + T), "i"(O + 2 * S), "i"(O + 2 * S + T), "i"(O + 3 * S), "i"(O + 3 * S + T) : "memory");
    f0 = __builtin_shufflevector(a0, a1, 0, 1, 2, 3, 4, 5, 6, 7); f1 = __builtin_shufflevector(b0, b1, 0, 1, 2, 3, 4, 5, 6, 7);
    f2 = __builtin_shufflevector(c0, c1, 0, 1, 2, 3, 4, 5, 6, 7); f3 = __builtin_shufflevector(d0, d1, 0, 1, 2, 3, 4, 5, 6, 7);
}
DI void lds_barrier() { asm volatile("s_waitcnt lgkmcnt(0)" ::: "memory"); __builtin_amdgcn_s_barrier(); asm volatile("" ::: "memory"); }
#define GLDS16(gp, lp) __builtin_amdgcn_global_load_lds((const unsigned*)(gp), (LAS unsigned*)(lp), 16, 0, 0)
DI f32x16 zero16() { f32x16 z; for (int i = 0; i < 16; ++i) z[i] = 0.f; return z; }

struct KArgs {
    const float* in[30];
    float* out;
    unsigned char* ws;
    int ph_lo, ph_hi;
};
enum { I_X = 0, I_C, I_CTX, I_CCTX, I_WMOD, I_BMOD, I_NORM1, I_NORM2, I_WIN, I_BGATE, I_RDECAY, I_RNORM, I_WRET, I_CONVW, I_CONVB, I_LWA, I_LBA, I_LWX, I_LBX, I_LLAM,
       I_WLRU, I_WOUT, I_WGRP, I_BGRP, I_WRT, I_BRT, I_WEG, I_WEU, I_WED, I_FNORM };

DI float mod_val(const KArgs& a, int v, int ch, int k) {
    const float* mp = (const float*)(a.ws + WS_MODP); const int n = ch * 1024 + k;
    return ((mp[(0 * 3 + v) * 6144 + n] + mp[(1 * 3 + v) * 6144 + n]) + (mp[(2 * 3 + v) * 6144 + n] + mp[(3 * 3 + v) * 6144 + n])) + a.in[I_BMOD][n];
}

#define XB_TMO      128
#define XB_XCNT(j)  (256  + 64 * (j))
#define XB_XSUB(j)  (1280 + 64 * (j))
#define XB_XGEN(j)  (2304 + 64 * (j))
#define XB_TOP      3328
#define XB_TOPGEN   3392
#define XCD_BAR_WORDS 3456
#define XB_SPIN_CAP (1u << 18)
__device__ __forceinline__ unsigned xb_ld(unsigned* p)              { return __hip_atomic_load(p, __ATOMIC_RELAXED, __HIP_MEMORY_SCOPE_AGENT); }
__device__ __forceinline__ unsigned xb_add(unsigned* p, unsigned v) { return __hip_atomic_fetch_add(p, v, __ATOMIC_RELAXED, __HIP_MEMORY_SCOPE_AGENT); }
__device__ __forceinline__ unsigned xb_xcc_id() { return (unsigned)__builtin_amdgcn_s_getreg((3 << 11) | 20) & 0xFu; }
#define XB_SPIN(cond, bar) do { unsigned _sp = 0; while (cond) { __builtin_amdgcn_s_sleep(1); \
    if ((++_sp & 255u) == 0u) { if (xb_ld(&(bar)[XB_TMO])) break; if (_sp > XB_SPIN_CAP) { atomicAdd(&(bar)[XB_TMO], 1u); break; } } } } while (0)
struct XcdBarrier { unsigned* bar; unsigned x; volatile LAS unsigned* st; };
__device__ __forceinline__ XcdBarrier xcd_barrier_post(unsigned* bar, volatile LAS unsigned* st) {
    XcdBarrier b; b.bar = bar; b.x = xb_xcc_id(); b.st = st;
    if (threadIdx.x == 0) (void)xb_add(&bar[XB_XCNT(b.x)], 1u);
    return b;
}
__device__ __forceinline__ void xcd_barrier_complete(unsigned* bar, unsigned x, unsigned& nloc, unsigned& nx) {
    const unsigned G = gridDim.x * gridDim.y * gridDim.z;
    unsigned sum, cnt, mine, sp = 0u;
    for (;;) {
        sum = 0u; cnt = 0u; mine = 0u;
#pragma unroll
        for (unsigned j = 0; j < 16; ++j) { const unsigned c = xb_ld(&bar[XB_XCNT(j)]); sum += c; cnt += (c > 0u) ? 1u : 0u; mine = (j == x) ? c : mine; }
        if (sum == G) break;
        __builtin_amdgcn_s_sleep(1);
        if ((++sp & 255u) == 0u) { if (xb_ld(&bar[XB_TMO])) break; if (sp > XB_SPIN_CAP) { atomicAdd(&bar[XB_TMO], 1u); break; } }
    }
    nloc = mine > 0u ? mine : 1u; nx = cnt > 0u ? cnt : 1u;
}
__device__ __forceinline__ void xcd_barrier(const XcdBarrier& b) {
    asm volatile("s_waitcnt vmcnt(0)" ::: "memory");
    __syncthreads();
    if (threadIdx.x == 0) {
        unsigned* bar = b.bar;
        __builtin_amdgcn_s_waitcnt(0);
        unsigned nloc = b.st[0], nx = b.st[1];
        if (nloc == 0u) { xcd_barrier_complete(bar, b.x, nloc, nx); b.st[0] = nloc; b.st[1] = nx; }
        const unsigned old = xb_add(&bar[XB_XSUB(b.x)], 1u);
        const unsigned gen = old / nloc;
        if (old + 1u == (gen + 1u) * nloc) {
            __builtin_amdgcn_fence(__ATOMIC_RELEASE, "agent");
            asm volatile("s_waitcnt vmcnt(0)" ::: "memory");
            const unsigned og = xb_add(&bar[XB_TOP], 1u);
            const unsigned tg = og / nx;
            if (og + 1u == (tg + 1u) * nx) xb_add(&bar[XB_TOPGEN], 1u);
            else XB_SPIN(xb_ld(&bar[XB_TOPGEN]) == tg, bar);
            __builtin_amdgcn_fence(__ATOMIC_ACQUIRE, "agent");
            xb_add(&bar[XB_XGEN(b.x)], 1u);
            asm volatile("s_waitcnt vmcnt(0)" ::: "memory");
        } else {
            XB_SPIN(xb_ld(&bar[XB_XGEN(b.x)]) == gen, bar);
            __builtin_amdgcn_fence(__ATOMIC_ACQUIRE, "agent");
            asm volatile("s_waitcnt vmcnt(0)" ::: "memory");
        }
    }
    __syncthreads();
}

namespace pg8 {
constexpr int BM = 256, BK = 64, HALF = 128, HTB = HALF * BK * 2, STAGE_BYTES = 8 * HTB, NXCD = 8, WGM = 2;
DI int lds_byte(int r, int c) { const int st = (r >> 4) * 2 + (c >> 5), rr = r & 15, cc = c & 31, ob = rr * 64 + cc * 2; return st * 1024 + (ob ^ (((ob >> 9) & 1) << 5)); }
DI void stage_rc(int b, int& R, int& C) { const int st = b / 1024, sb = b % 1024, swz = sb ^ (((sb >> 9) & 1) << 5); R = (st >> 1) * 16 + swz / 64; C = (st & 1) * 32 + (swz % 64) / 2; }
DI int perm32(int rho) { const int n = rho >> 4, i = rho & 15; return 8 * (i >> 2) + 4 * n + (i & 3); }
DI int bmap(int mode, int R) {
    if (mode == 1) return (R & ~31) + perm32(R & 31);
    if (mode == 2) { const int wc = R >> 5, n = (R >> 4) & 1, low = R & 15; return 64 * (wc >> 1) + 32 * n + 16 * (wc & 1) + low; }
    return R;
}
struct Unit { const char* A; const char* B; int pm, pn, aux, bmode; };
DI bool static_tile(int i, int G, int c, int nM, int nN, int& pm, int& pn) {
    const int nwg = nM * nN; const long L = (long)i * G + c; if (L >= nwg) return false;
    int wgid = (int)L; { const int q = nwg / NXCD, r = nwg % NXCD, xcd = wgid % NXCD, off = wgid / NXCD; wgid = (xcd < r ? xcd * (q + 1) : r * (q + 1) + (xcd - r) * q) + off; }
    const int nig = WGM * nN, gid = wgid / nig, fm = gid * WGM, gsz = (nM - fm) < WGM ? (nM - fm) : WGM;
    pm = fm + ((wgid % nig) % gsz); pn = (wgid % nig) / gsz; return true;
}

template <bool F8, class Epi, class Sched>
DI void gemm_phase(LAS unsigned char* lds, const int K, const Sched& S, const Epi& E) {
    const int tid = tid_fresh(), wid = __builtin_amdgcn_readfirstlane(tid >> 6), lane = tid & 63, wr = wid >> 2, wc = wid & 3;
    const int rowb = F8 ? K : 2 * K, nt = rowb / 128;
    unsigned voffA[2][2], voffB[2];
    const size_t kstep = (size_t)(BK * 2);
    const size_t hstep = (size_t)HALF * rowb;
    const unsigned ldsw = (unsigned)wid * 1024u;
    const int aoff = lds_byte(wr * 64 + (lane & 15), (lane >> 4) * 8), boff = lds_byte(wc * 32 + (lane & 15), (lane >> 4) * 8);
#define PG8_SA(b, h) (((b) * 2 + (h)) * HTB)
#define PG8_SB(b, h) ((4 + (b) * 2 + (h)) * HTB)
#define PG8_STAGE(bufoff, gbase, voff) do { _Pragma("unroll") for (int _i = 0; _i < 2; ++_i) { unsigned vo_ = (voff)[_i]; asm volatile("" : "+v"(vo_));     \
        __builtin_amdgcn_global_load_lds((const unsigned*)((const char*)(gbase) + vo_), (LAS unsigned*)(lds + (bufoff) + ldsw + _i * 8192), 16, 0, 0); } } while (0)
#define PG8_LD8(p_) __builtin_shufflevector(*(const LAS v4i_t*)(p_), *(const LAS v4i_t*)((p_) + 1024), 0, 1, 2, 3, 4, 5, 6, 7)
#define PG8_LDA(dst, b, h) do { _Pragma("unroll") for (int m = 0; m < 4; ++m) dst[m] = PG8_LD8(lds + PG8_SA(b, h) + aoff + m * 2048); } while (0)
#define PG8_LDB(dst, b, h) do { _Pragma("unroll") for (int n = 0; n < 2; ++n) dst[n] = PG8_LD8(lds + PG8_SB(b, h) + boff + n * 2048); } while (0)
#define PG8_LO(v_) __builtin_bit_cast(bf16x8, __builtin_shufflevector(v_, v_, 0, 1, 2, 3))
#define PG8_HI(v_) __builtin_bit_cast(bf16x8, __builtin_shufflevector(v_, v_, 4, 5, 6, 7))
#define PG8_MMA(ai, bj, At, Bt) do { __builtin_amdgcn_s_setprio(1); _Pragma("unroll") for (int m = 0; m < 4; ++m) _Pragma("unroll") for (int n = 0; n < 2; ++n) { \
        if constexpr (F8) { acc[ai][bj][m][n] = __builtin_amdgcn_mfma_scale_f32_16x16x128_f8f6f4(Bt[n], At[m], acc[ai][bj][m][n], 0, 0, 0, 0x7f7f7f7f, 0, 0x7f7f7f7f); } \
        else { acc[ai][bj][m][n] = __builtin_amdgcn_mfma_f32_16x16x32_bf16(PG8_LO(Bt[n]), PG8_LO(At[m]), acc[ai][bj][m][n], 0, 0, 0); \
               acc[ai][bj][m][n] = __builtin_amdgcn_mfma_f32_16x16x32_bf16(PG8_HI(Bt[n]), PG8_HI(At[m]), acc[ai][bj][m][n], 0, 0, 0); } } \
        __builtin_amdgcn_s_setprio(0); } while (0)
#define PG8_WAIT_V(n) asm volatile("s_waitcnt vmcnt(" #n ")" ::: "memory")
#define PG8_WAIT_L(n) asm volatile("s_waitcnt lgkmcnt(" #n ")" ::: "memory")
#define PG8_BAR __builtin_amdgcn_s_barrier()
#define PG8_SCHED __builtin_amdgcn_sched_barrier(0)
#define PG8_RC() int Rr[2], Cc[2]; { const int t_ = tid_fresh(); _Pragma("unroll") for (int _i = 0; _i < 2; ++_i) stage_rc(t_ * 16 + _i * 8192, Rr[_i], Cc[_i]); }
#define PG8_SETB(u) do { PG8_RC(); _Pragma("unroll") for (int _i = 0; _i < 2; ++_i) voffB[_i] = (unsigned)(bmap((u).bmode, Rr[_i]) * rowb + Cc[_i] * 2); } while (0)
#define PG8_SETA(u, ui_) do { PG8_RC(); S.offsA((u), (ui_), Rr, Cc, voffA); } while (0)
    Unit cur, nxt; int ui = 0;
    if (!S.next(0, cur)) return;
    f32x4 acc[2][2][4][2];
#pragma unroll
    for (int a = 0; a < 2; ++a)
#pragma unroll
        for (int b = 0; b < 2; ++b)
#pragma unroll
            for (int m = 0; m < 4; ++m)
#pragma unroll
                for (int n = 0; n < 2; ++n) acc[a][b][m][n] = (f32x4){0.f, 0.f, 0.f, 0.f};
    v8i_t At[4], B0[2], B1[2];
    const char* cA = cur.A; const char* cB = cur.B;
    PG8_SETA(cur, 0); PG8_SETB(cur);
    PG8_STAGE(PG8_SB(0, 0), cB, voffB); PG8_STAGE(PG8_SB(0, 1), cB + hstep, voffB); PG8_STAGE(PG8_SA(0, 0), cA, voffA[0]); PG8_STAGE(PG8_SA(0, 1), cA, voffA[1]);
    if (wr == 1) PG8_BAR;
    PG8_WAIT_V(2); PG8_BAR;
    PG8_STAGE(PG8_SB(1, 0), cB + kstep, voffB); PG8_STAGE(PG8_SA(1, 0), cA + kstep, voffA[0]); PG8_STAGE(PG8_SB(1, 1), cB + hstep + kstep, voffB);
    PG8_WAIT_V(6); PG8_BAR;
    for (;;) {
        const bool has_next = S.next(ui + 1, nxt);
        const char* nA = has_next ? nxt.A : cA; const char* nB = has_next ? nxt.B : cB;
#pragma unroll 1
        for (int t = 0; t < nt; t += 2) {
            const bool last = (t == nt - 2);
            const char* a1 = cA + (size_t)(t + 1) * kstep;
            const char* a2 = last ? nA : cA + (size_t)(t + 2) * kstep; const char* b2 = last ? nB : cB + (size_t)(t + 2) * kstep;
            const char* a3 = a2 + kstep; const char* b3 = b2 + kstep;
            if (last && has_next) PG8_SETB(nxt);
            PG8_LDB(B0, 0, 0); PG8_LDB(B1, 0, 1); PG8_SCHED; PG8_LDA(At, 0, 0); PG8_STAGE(PG8_SA(1, 1), a1, voffA[1]);
            PG8_WAIT_V(8); PG8_WAIT_L(0); PG8_BAR; PG8_MMA(0, 0, At, B0); PG8_MMA(0, 1, At, B1); PG8_BAR; PG8_SCHED;
            if (last && has_next) PG8_SETA(nxt, ui + 1);
            PG8_LDA(At, 0, 1); PG8_STAGE(PG8_SB(0, 0), b2, voffB); PG8_STAGE(PG8_SB(0, 1), b2 + hstep, voffB); PG8_STAGE(PG8_SA(0, 0), a2, voffA[0]);
            PG8_WAIT_V(8); PG8_WAIT_L(0); PG8_BAR; PG8_MMA(1, 0, At, B0); PG8_MMA(1, 1, At, B1); PG8_BAR; PG8_SCHED;
            PG8_LDB(B0, 1, 0); PG8_LDB(B1, 1, 1); PG8_SCHED; PG8_LDA(At, 1, 0); PG8_STAGE(PG8_SA(0, 1), a2, voffA[1]);
            PG8_WAIT_V(8); PG8_WAIT_L(0); PG8_BAR; PG8_MMA(0, 0, At, B0); PG8_MMA(0, 1, At, B1); PG8_BAR; PG8_SCHED;
            PG8_LDA(At, 1, 1); PG8_STAGE(PG8_SB(1, 0), b3, voffB); PG8_STAGE(PG8_SB(1, 1), b3 + hstep, voffB); PG8_STAGE(PG8_SA(1, 0), a3, voffA[0]);
            PG8_WAIT_V(8); PG8_WAIT_L(0); PG8_BAR; PG8_MMA(1, 0, At, B0); PG8_MMA(1, 1, At, B1); PG8_BAR; PG8_SCHED;
        }
        if (wr == 0) PG8_BAR;
        bool keep; { const int t_ = tid_fresh(), l_ = t_ & 63; keep = E(acc, cur, wr, wc, l_ & 15, l_ >> 4); }
        if (!has_next) break;
        if (!keep) {
#pragma unroll
            for (int a = 0; a < 2; ++a)
#pragma unroll
                for (int b = 0; b < 2; ++b)
#pragma unroll
                    for (int m = 0; m < 4; ++m)
#pragma unroll
                        for (int n = 0; n < 2; ++n) acc[a][b][m][n] = (f32x4){0.f, 0.f, 0.f, 0.f};
        }
        cur = nxt; cA = nA; cB = nB; ++ui;
        if (wr == 1) PG8_BAR;
    }
    PG8_WAIT_V(0);
    PG8_BAR;
#undef PG8_SA
#undef PG8_SB
#undef PG8_STAGE
#undef PG8_LDA
#undef PG8_LD8
#undef PG8_LO
#undef PG8_HI
#undef PG8_LDB
#undef PG8_MMA
#undef PG8_WAIT_V
#undef PG8_WAIT_L
#undef PG8_BAR
#undef PG8_SCHED
#undef PG8_SETB
#undef PG8_SETA
#undef PG8_RC
}
DI void dense_offs(int rowbytes, const int (&R)[2], const int (&C)[2], unsigned (&voffA)[2][2]) {
#pragma unroll
    for (int h = 0; h < 2; ++h)
#pragma unroll
        for (int i = 0; i < 2; ++i) voffA[h][i] = (unsigned)((h * HALF + R[i]) * rowbytes + C[i] * 2);
}
}
using pg8::Unit;

#define EPI_LOOP_ROWS for (int ai = 0; ai < 2; ++ai) _Pragma("unroll") for (int m = 0; m < 4; ++m)

DI void cvt_tile(LAS float* tile, const float* src, int ld_src, bf16_t* dst, int ld_dst, float scale) {
    const int tid = tid_fresh();
    __syncthreads();
#pragma unroll
    for (int i = 0; i < 2; ++i) { const int kr = (tid >> 4) + 32 * i, nc = (tid & 15) * 4; const f32x4 v = *(const f32x4*)(src + (size_t)kr * ld_src + nc);
        tile[kr * 65 + nc + 0] = v[0]; tile[kr * 65 + nc + 1] = v[1]; tile[kr * 65 + nc + 2] = v[2]; tile[kr * 65 + nc + 3] = v[3]; }
    __syncthreads();
    const int n = tid >> 3, kc = (tid & 7) * 8; float v[8];
#pragma unroll
    for (int j = 0; j < 8; ++j) v[j] = tile[(kc + j) * 65 + n] * scale;
    u32x4 w; w.x = cvt_pk_bf16(v[0], v[1]); w.y = cvt_pk_bf16(v[2], v[3]); w.z = cvt_pk_bf16(v[4], v[5]); w.w = cvt_pk_bf16(v[6], v[7]);
    *(u32x4*)(dst + (size_t)n * ld_dst + kc) = w;
}

DI void cvt_tile4(LAS float* tile, const float* src, int ld_src, bf16_t* dst, size_t hi_stride, int ld_dst) {
    const int tid = tid_fresh();
    f32x4 v[8];
#pragma unroll
    for (int i = 0; i < 8; ++i) v[i] = *(const f32x4*)(src + (size_t)((tid >> 6) + 8 * i) * ld_src + 4 * (tid & 63));
    __syncthreads();
#pragma unroll
    for (int i = 0; i < 8; ++i) *(LAS f32x4*)(tile + ((tid >> 6) + 8 * i) * 260 + 4 * (tid & 63)) = v[i];
    __syncthreads();
    const int n = tid & 255, kh = tid >> 8; bf16_t* d = dst + (size_t)(n >> 7) * hi_stride + (size_t)(n & 127) * ld_dst + 32 * kh;
#pragma unroll
    for (int q = 0; q < 4; ++q) { float x[8];
#pragma unroll
        for (int j = 0; j < 8; ++j) x[j] = tile[(32 * kh + 8 * q + j) * 260 + n];
        u32x4 w; w.x = cvt_pk_bf16(x[0], x[1]); w.y = cvt_pk_bf16(x[2], x[3]); w.z = cvt_pk_bf16(x[4], x[5]); w.w = cvt_pk_bf16(x[6], x[7]);
        *(u32x4*)(d + 8 * q) = w; }
}

DI void phase0a(const KArgs& a, LAS unsigned char* lds) {
    const int tid = tid_fresh(), G = gridDim.x;
    LAS float* fl = (LAS float*)lds;
    constexpr int NU_MOD = 192, NU_ROPE = 1, NU_ROUTW = 64, T_WIN = 16 * 28, T_PROJ = 3 * 64, T_LB = 128;
    constexpr int U0 = NU_MOD, U1 = U0 + NU_ROPE, U2 = U1 + NU_ROUTW, U3 = U2 + T_WIN, U4 = U3 + T_PROJ, U5 = U4 + T_LB;
    for (int u = blockIdx.x; u < U5; u += G) {
        if (u < U0) {
            const int ks = u / 48, cg = u % 48;
            __syncthreads();
            for (int i = tid; i < 768; i += 512) { const int v = i >> 8, k = 256 * ks + (i & 255); const float x = (v == 0) ? a.in[I_C][k] : (v == 1) ? a.in[I_C][1024 + k] : a.in[I_CCTX][k]; fl[i] = silu_(x); }
            __syncthreads();
            const int rl = tid >> 5, cl = tid & 31; float acc[3][4];
#pragma unroll
            for (int v = 0; v < 3; ++v) for (int j = 0; j < 4; ++j) acc[v][j] = 0.f;
            f32x4 wv[16];
#pragma unroll
            for (int s = 0; s < 16; ++s) wv[s] = *(const f32x4*)(a.in[I_WMOD] + (size_t)(256 * ks + 16 * s + rl) * 6144 + 128 * cg + 4 * cl);
#pragma unroll
            for (int s = 0; s < 16; ++s) { const int kk = 16 * s + rl; const f32x4 w = wv[s];
#pragma unroll
                for (int v = 0; v < 3; ++v) { const float sv = fl[v * 256 + kk]; acc[v][0] += sv * w[0]; acc[v][1] += sv * w[1]; acc[v][2] += sv * w[2]; acc[v][3] += sv * w[3]; } }
            __syncthreads();
            LAS float* red = fl + 1024;
#pragma unroll
            for (int v = 0; v < 3; ++v) for (int j = 0; j < 4; ++j) red[(rl * 3 + v) * 128 + 4 * cl + j] = acc[v][j];
            __syncthreads();
            if (tid < 384) { const int v = tid >> 7, c = tid & 127; float s = 0.f; for (int r = 0; r < 16; ++r) s += red[(r * 3 + v) * 128 + c];
                ((float*)(a.ws + WS_MODP))[(ks * 3 + v) * 6144 + 128 * cg + c] = s; }
        } else if (u < U1) {
            f32x2* tab = (f32x2*)(a.ws + WS_ROPE);
            if (tid < 8) ((float*)(a.ws + WS_RDEC))[tid] = -softplus_(-a.in[I_RDECAY][tid]) * LOG2E;
            for (int i = tid; i < 320 * 32; i += 512) { const int p = i >> 5, fi = i & 31; const float pos = (float)(p < 256 ? p : p - 256);
                const float freq = ex2(-(float)fi * (13.287712379549449f / 32.0f)); float rev = pos * freq * 0.15915494309189535f; rev -= floorf(rev);
                tab[i] = (f32x2){__builtin_amdgcn_cosf(rev), __builtin_amdgcn_sinf(rev)}; }
        } else if (u < U2) {
            bf16_t* hi = (bf16_t*)(a.ws + WS_WRH); bf16_t* lo = hi + 64 * 1024; const int n = u - U1;
            for (int k = tid; k < 1024; k += 512) { float w = 0.f;
                if (n < 4) w = a.in[I_WGRP][k * 4 + n]; else if (n < 36) w = a.in[I_WRT][k * 32 + (n - 4)];
                const unsigned short h16 = f2bf(w); hi[n * 1024 + k] = h16; lo[n * 1024 + k] = f2bf(w - bf2f(h16)); }
        } else if (u < U3) {
            const int t = u - U2, kt = t / 28, ng = t % 28;
            cvt_tile4(fl, a.in[I_WIN] + (size_t)(64 * kt) * NCOL + 256 * ng, NCOL, (bf16_t*)(a.ws + WS_WIN) + (size_t)(256 * ng) * 1024 + 64 * kt, (size_t)128 * 1024, 1024);
        } else if (u < U4) {
            const int t = u - U3, w = t >> 6, kt = (t & 63) >> 2, ng = t & 3;
            const float* src = a.in[w == 0 ? I_WRET : w == 1 ? I_WLRU : I_WOUT]; bf16_t* dst = (bf16_t*)(a.ws + (w == 0 ? WS_WRET : w == 1 ? WS_WLRU : WS_WOUT));
            cvt_tile4(fl, src + (size_t)(64 * kt) * 1024 + 256 * ng, 1024, dst + (size_t)(256 * ng) * 1024 + 64 * kt, (size_t)128 * 1024, 1024);
        } else {
            const int t = u - U4, mat = t >> 5, blk = (t >> 2) & 7, kt = (t >> 1) & 1, nt = t & 1, dir = mat >> 1;
            const float* src = a.in[(mat & 1) ? I_LWX : I_LWA] + (size_t)(dir * 8 + blk) * 128 * 128;
            bf16_t* dst = (bf16_t*)(a.ws + WS_WLB) + (size_t)(mat * 8 + blk) * 128 * 128;
            cvt_tile(fl, src + (size_t)(64 * kt) * 128 + 64 * nt, 128, dst + (size_t)(64 * nt) * 128 + 64 * kt, 128, -LOG2E);
        }
    }
}

DI void phase0b(const KArgs& a, LAS unsigned char* lds) {
    const int tid = tid_fresh(), G = gridDim.x, lane = tid & 63, wid = tid >> 6;
    LAS float* gm = (LAS float*)lds;
    LAS float* sh = gm + 3072;
    __syncthreads();
    for (int i = tid; i < 3072; i += 512) { const int v = i >> 10, k = i & 1023; gm[i] = a.in[I_NORM1][k] * (1.0f + mod_val(a, v, 1, k)); sh[i] = mod_val(a, v, 0, k); }
    if (blockIdx.x == G - 1) { float* mt = (float*)(a.ws + WS_MODT);
        for (int i = tid; i < 2048; i += 512) { const int v = i >> 10, k = i & 1023; mt[i] = mod_val(a, v, 2, k); mt[2048 + i] = a.in[I_NORM2][k] * (1.0f + mod_val(a, v, 4, k)); mt[4096 + i] = mod_val(a, v, 3, k); mt[6144 + i] = mod_val(a, v, 5, k); } }
    __syncthreads();
    PB(105);
    for (int u = blockIdx.x; u < 160; u += G) {
        const int rt = u / 10, ct = u % 10;
        const int col0 = ct < 2 ? 512 + 256 * ct : ct < 6 ? 1024 + 256 * (ct - 2) : 3072 + 256 * (ct - 6);
        LAS unsigned char* At = lds + 24576;
        __syncthreads();
        {   f32x4 x[4][4];
#pragma unroll
            for (int q = 0; q < 4; ++q)
#pragma unroll
                for (int j = 0; j < 4; ++j) x[q][j] = *(const f32x4*)(a.in[I_CTX] + (size_t)(32 * rt + 4 * wid + q) * 1024 + 4 * lane + 256 * j);
#pragma unroll
            for (int q = 0; q < 4; ++q) { float ss = 0.f;
#pragma unroll
                for (int j = 0; j < 4; ++j) ss += (x[q][j][0] * x[q][j][0] + x[q][j][1] * x[q][j][1]) + (x[q][j][2] * x[q][j][2] + x[q][j][3] * x[q][j][3]);
#pragma unroll
                for (int o = 32; o >= 1; o >>= 1) ss += __shfl_xor(ss, o);
                const float rstd = rsqrtf(ss * (1.0f / 1024.0f) + EPSV);
#pragma unroll
                for (int j = 0; j < 4; ++j) { const int k0 = 4 * lane + 256 * j; const f32x4 g = *(const LAS f32x4*)(gm + 2048 + k0), sv = *(const LAS f32x4*)(sh + 2048 + k0);
                    u32x2 w; w.x = cvt_pk_bf16(x[q][j][0] * rstd * g[0] + sv[0], x[q][j][1] * rstd * g[1] + sv[1]); w.y = cvt_pk_bf16(x[q][j][2] * rstd * g[2] + sv[2], x[q][j][3] * rstd * g[3] + sv[3]);
                    *(LAS u32x2*)(At + (4 * wid + q) * 2064 + k0 * 2) = w; } }
        }
        __syncthreads();
        const int r = lane & 31, h = lane >> 5;
        const bf16_t* wrow = (const bf16_t*)(a.ws + WS_WIN) + (size_t)(col0 + 32 * wid + r) * 1024 + 8 * h;
        f32x16 acc = zero16();
#pragma unroll 16
        for (int s2 = 0; s2 < 64; ++s2) { const bf16x8 bfr = *(const bf16x8*)(wrow + 16 * s2); const bf16x8 af = *(const LAS bf16x8*)(At + r * 2064 + (16 * s2 + 8 * h) * 2);
            acc = MFMA32(af, bfr, acc); }
        const int ccol = 256 * (ct < 2 ? ct : ct < 6 ? ct - 2 : ct - 6) + 32 * wid + r;
        bf16_t* dst = (bf16_t*)(a.ws + (ct < 2 ? WS_CTXK : ct < 6 ? WS_CTXV : WS_CTXX)); const int ldd = ct < 2 ? 512 : 1024; const float scv = ct < 2 ? 0.08838834764831845f : 1.0f;
#pragma unroll
        for (int i = 0; i < 16; ++i) dst[(size_t)(32 * rt + crow(i, h)) * ldd + ccol] = f2bf(acc[i] * scv);
    }
    PE(105);
    PB(106);
    {
        const int rstep = G * 8; int row = blockIdx.x * 8 + wid; f32x4 x[2][4];
#pragma unroll
        for (int q = 0; q < 2; ++q) if (row + q * rstep < NT) {
#pragma unroll
            for (int j = 0; j < 4; ++j) x[q][j] = *(const f32x4*)(a.in[I_X] + (size_t)(row + q * rstep) * 1024 + 4 * lane + 256 * j); }
        for (; row < NT; row += 2 * rstep) {
            f32x4 xn[2][4];
#pragma unroll
            for (int q = 0; q < 2; ++q) if (row + (2 + q) * rstep < NT) {
#pragma unroll
                for (int j = 0; j < 4; ++j) xn[q][j] = *(const f32x4*)(a.in[I_X] + (size_t)(row + (2 + q) * rstep) * 1024 + 4 * lane + 256 * j); }
#pragma unroll
            for (int q = 0; q < 2; ++q) { const int rw = row + q * rstep; if (rw < NT) { const int v = rw / SEQ; float ss = 0.f;
#pragma unroll
                for (int j = 0; j < 4; ++j) ss += (x[q][j][0] * x[q][j][0] + x[q][j][1] * x[q][j][1]) + (x[q][j][2] * x[q][j][2] + x[q][j][3] * x[q][j][3]);
#pragma unroll
                for (int o = 32; o >= 1; o >>= 1) ss += __shfl_xor(ss, o);
                const float rstd = rsqrtf(ss * (1.0f / 1024.0f) + EPSV);
                bf16_t* dst = (bf16_t*)(a.ws + WS_HX) + (size_t)rw * 1024;
#pragma unroll
                for (int j = 0; j < 4; ++j) { const int k0 = 4 * lane + 256 * j; const f32x4 g = *(const LAS f32x4*)(gm + v * 1024 + k0), sv = *(const LAS f32x4*)(sh + v * 1024 + k0);
                    u32x2 w; w.x = cvt_pk_bf16(x[q][j][0] * rstd * g[0] + sv[0], x[q][j][1] * rstd * g[1] + sv[1]); w.y = cvt_pk_bf16(x[q][j][2] * rstd * g[2] + sv[2], x[q][j][3] * rstd * g[3] + sv[3]);
                    *(u32x2*)(dst + k0) = w; } } }
#pragma unroll
            for (int q = 0; q < 2; ++q)
#pragma unroll
                for (int j = 0; j < 4; ++j) x[q][j] = xn[q][j];
        }
    }
    PE(106);
}

struct OrderIn {
    const char* A; const char* B; int G, c;
    DI bool next(int i, Unit& u) const { int pm, pn; if (!pg8::static_tile(i, G, c, NT / 256, NCOL / 256, pm, pn)) return false;
        u.pm = pm; u.pn = pn; u.A = A + (size_t)pm * 256 * 1024 * 2; u.B = B + (size_t)pn * 256 * 1024 * 2; u.aux = 0; u.bmode = pn < 4 ? 2 : 1; return true; }
    DI void offsA(const Unit&, int, const int (&R)[2], const int (&C)[2], unsigned (&v)[2][2]) const { pg8::dense_offs(2048, R, C, v); }
};
DI int glog_frag(int ai, int bj, int m, int wr, int wc, int fr, int fq) { return ((((((ai * 2 + bj) * 4 + m) * 2 + wr) * 4 + wc) * 16 + fr) * 4 + fq) * 8; }
struct EpiIn {
    unsigned char* ws; bf16_t* glog; const float* bgate; const f32x2* rope;
    DI bool operator()(f32x4 (&acc)[2][2][4][2], const Unit& u, int wr, int wc, int fr, int fq) const {
        const int pn = u.pn;
        if (pn < 4) {
            bf16_t* dst = (bf16_t*)(ws + (pn < 2 ? WS_ZQ : WS_ZK)); const float sc = pn < 2 ? 1.0f : 0.08838834764831845f;
            const int half = wc >> 1, f0 = 16 * (wc & 1) + 4 * fq;
            f32x2 cs[2][4][4];
#define RP_LOAD(ai_, sl_) do { _Pragma("unroll") for (int m_ = 0; m_ < 4; ++m_) { const int t_ = (u.pm * 256 + (ai_) * 128 + wr * 64 + m_ * 16 + fr) & (SEQ - 1); const f32x2* tb_ = rope + (half ? 256 + (t_ & 63) : (t_ >> 6)) * 32 + f0; \
                _Pragma("unroll") for (int j_ = 0; j_ < 4; ++j_) cs[sl_][m_][j_] = tb_[j_]; } } while (0)
            RP_LOAD(0, 0);
#pragma unroll
            for (int ai = 0; ai < 2; ++ai) { if (ai == 0) RP_LOAD(1, 1);
#pragma unroll
                for (int m = 0; m < 4; ++m) { const int row = u.pm * 256 + ai * 128 + wr * 64 + m * 16 + fr;
#pragma unroll
                    for (int bj = 0; bj < 2; ++bj) { const f32x4 x1 = acc[ai][bj][m][0], x2 = acc[ai][bj][m][1]; float o1[4], o2[4];
#pragma unroll
                        for (int j = 0; j < 4; ++j) { o1[j] = (x1[j] * cs[ai][m][j][0] - x2[j] * cs[ai][m][j][1]) * sc; o2[j] = (x1[j] * cs[ai][m][j][1] + x2[j] * cs[ai][m][j][0]) * sc; }
                        bf16_t* p = dst + (size_t)row * 512 + (pn & 1) * 256 + bj * 128 + 64 * half + f0;
                        u32x2 w1, w2; w1.x = cvt_pk_bf16(o1[0], o1[1]); w1.y = cvt_pk_bf16(o1[2], o1[3]); w2.x = cvt_pk_bf16(o2[0], o2[1]); w2.y = cvt_pk_bf16(o2[2], o2[3]);
                        *(u32x2*)p = w1; *(u32x2*)(p + 32) = w2; } } }
#undef RP_LOAD
            return false;
        }
        int act, ldd, cb; bf16_t* dst;
        if (pn < 8) { dst = (bf16_t*)(ws + WS_ZV); act = 0; ldd = 1024; cb = (pn - 4) * 256; }
        else if (pn < 12) { dst = (bf16_t*)(ws + WS_ZG); act = 1; ldd = 1024; cb = (pn - 8) * 256; }
        else if (pn < 16) { dst = (bf16_t*)(ws + WS_ZXL); act = 0; ldd = 1024; cb = (pn - 12) * 256; }
        else if (pn < 20) { dst = (bf16_t*)(ws + WS_ZGL); act = 2; ldd = 1024; cb = (pn - 16) * 256; }
        else { dst = glog; act = 3; ldd = 2048; cb = (pn - 20) * 256; }
#pragma unroll
        for (int bj = 0; bj < 2; ++bj) { const int col = cb + bj * 128 + wc * 32 + 8 * fq; f32x4 b0 = (f32x4){0.f, 0.f, 0.f, 0.f}, b1 = b0;
            if (act == 3) { b0 = *(const f32x4*)(bgate + col); b1 = *(const f32x4*)(bgate + col + 4); }
#pragma unroll
            EPI_LOOP_ROWS { const int row = u.pm * 256 + ai * 128 + wr * 64 + m * 16 + fr; f32x4 v0 = acc[ai][bj][m][0] + b0, v1 = acc[ai][bj][m][1] + b1;
                if (act == 1) {
#pragma unroll
                    for (int j = 0; j < 4; ++j) { v0[j] = silu_(v0[j]); v1[j] = silu_(v1[j]); } }
                if (act == 2) {
#pragma unroll
                    for (int j = 0; j < 4; ++j) { v0[j] = gelu_tanh(v0[j]); v1[j] = gelu_tanh(v1[j]); } }
                u32x4 w; w.x = cvt_pk_bf16(v0[0], v0[1]); w.y = cvt_pk_bf16(v0[2], v0[3]); w.z = cvt_pk_bf16(v1[0], v1[1]); w.w = cvt_pk_bf16(v1[2], v1[3]);
                if (act == 3) *(u32x4*)(glog + (size_t)(u.pm * 8 + (pn - 20)) * 65536 + glog_frag(ai, bj, m, wr, wc, fr, fq)) = w;
                else *(u32x4*)(dst + (size_t)row * ldd + col) = w; } }
        return false;
    }
};

DI bf16x8 scale_frag8(bf16x8 f, const float (&w)[8]) { const u32x4 u = __builtin_bit_cast(u32x4, f); u32x4 o;
#pragma unroll
    for (int e = 0; e < 4; ++e) o[e] = cvt_pk_bf16(__uint_as_float(u[e] << 16) * w[2 * e], __uint_as_float(u[e] & 0xffff0000u) * w[2 * e + 1]);
    return __builtin_bit_cast(bf16x8, o); }
DI void r1_unit(LAS unsigned char* lds, const bf16_t* kp, const bf16_t* vp, int nrows, float lgf2, float lgb2, float* outf, float* outb) {
    const int tid = tid_fresh(), lane = tid & 63, wid = __builtin_amdgcn_readfirstlane(tid >> 6), h = lane >> 5, c = lane & 31;
    const int mh = wid >> 2, nb = wid & 3;
    LAS unsigned char* B0 = lds; LAS unsigned char* B1 = lds + 49152;
    const unsigned wl = (unsigned)wid * 1024u;
    const unsigned koff = (unsigned)((tid >> 4) * 1024 + (((tid & 15) ^ (((tid >> 4) & 3) << 2)) << 4));
    const unsigned voff = (unsigned)((tid >> 5) * 2048 + (((tid & 31) ^ (((tid >> 5) & 3) << 2)) << 4));
#define R1_STAGE(ch_, buf_) do { const char* kb_ = (const char*)kp + (size_t)(ch_) * 65536; const char* vb_ = (const char*)vp + (size_t)(ch_) * 131072; \
        _Pragma("unroll") for (int i_ = 0; i_ < 2; ++i_) GLDS16(kb_ + i_ * 32768 + koff, (buf_) + i_ * 8192 + wl); \
        _Pragma("unroll") for (int i_ = 0; i_ < 4; ++i_) GLDS16(vb_ + i_ * 32768 + voff, (buf_) + 16384 + i_ * 8192 + wl); } while (0)
    __syncthreads();
    R1_STAGE(0, B0);
    f32x16 acc[2][4];
#pragma unroll
    for (int d = 0; d < 2; ++d) for (int mi = 0; mi < 4; ++mi) acc[d][mi] = zero16();
    const unsigned q4 = (unsigned)((lane & 15) >> 2), lrow = (unsigned)(8 * h) + q4, lin = 32u * ((lane >> 4) & 1) + 8u * (lane & 3);
    const float gfm1 = ex2(-lgf2), gb1 = ex2(lgb2);
    const int nch = nrows / 64;
#pragma unroll 1
    for (int ch = 0; ch < nch; ++ch) {
        LAS unsigned char* buf = (ch & 1) ? B1 : B0;
        asm volatile("s_waitcnt vmcnt(0)" ::: "memory");
        lds_barrier();
        if (ch + 1 < nch) { if (ch & 1) R1_STAGE(ch + 1, B0); else R1_STAGE(ch + 1, B1); }
        const unsigned Kb = (unsigned)(size_t)buf + lrow * 256u + lin, Vb = (unsigned)(size_t)buf + 16384u + lrow * 512u + lin;
#pragma unroll
        for (int ks = 0; ks < 4; ++ks) {
            const bf16x8 kf = (ks == 0) ? tr_frag<0, 1024>(Kb + 64u * ((unsigned)nb ^ q4)) : (ks == 1) ? tr_frag<4096, 5120>(Kb + 64u * ((unsigned)nb ^ q4)) : (ks == 2) ? tr_frag<8192, 9216>(Kb + 64u * ((unsigned)nb ^ q4)) : tr_frag<12288, 13312>(Kb + 64u * ((unsigned)nb ^ q4));
            const int j0 = 64 * ch + 16 * ks + 8 * h; float wf[8], wb[8];
            wf[0] = ex2(lgf2 * (float)(nrows - 1 - j0)); wb[0] = ex2(lgb2 * (float)j0);
#pragma unroll
            for (int e = 1; e < 8; ++e) { wf[e] = wf[e - 1] * gfm1; wb[e] = wb[e - 1] * gb1; }
            const bf16x8 kff = scale_frag8(kf, wf), kfb = scale_frag8(kf, wb);
#pragma unroll
            for (int mi = 0; mi < 4; ++mi) { const unsigned va = Vb + 256u * (unsigned)mh + 64u * ((unsigned)mi ^ q4);
                const bf16x8 vf = (ks == 0) ? tr_frag<0, 2048>(va) : (ks == 1) ? tr_frag<8192, 10240>(va) : (ks == 2) ? tr_frag<16384, 18432>(va) : tr_frag<24576, 26624>(va);
                acc[0][mi] = MFMA32(vf, kff, acc[0][mi]); acc[1][mi] = MFMA32(vf, kfb, acc[1][mi]); }
        }
    }
    float* of = outf + (size_t)(128 * mh + 4 * h) * 128 + 32 * nb + c; float* ob = outb + (size_t)(128 * mh + 4 * h) * 128 + 32 * nb + c;
#pragma unroll
    for (int mi = 0; mi < 4; ++mi)
#pragma unroll
        for (int i = 0; i < 16; ++i) { of[(32 * mi + (i & 3) + 8 * (i >> 2)) * 128] = acc[0][mi][i]; ob[(32 * mi + (i & 3) + 8 * (i >> 2)) * 128] = acc[1][mi][i]; }
#undef R1_STAGE
}

template <bool FULL, int DIR>
DI void lru_scan(f32x16 (&acc)[2][2], float Hin, f32x2* agg_out) {
    const int lane = tid_fresh() & 63, h = lane >> 5;
    float sA[8], sU[8];
#pragma unroll
    for (int s = 0; s < 8; ++s) { const int mb = s >> 2, g = s & 3; float A = 1.f, U = 0.f;
#pragma unroll
        for (int e = 0; e < 4; ++e) { const int i = 4 * g + (DIR == 0 ? e : 3 - e); U = acc[0][mb][i] * U + acc[1][mb][i]; A *= acc[0][mb][i]; }
        sA[s] = A; sU[s] = U; }
    float pA[8], pU[8];
#pragma unroll
    for (int s = 0; s < 8; ++s) { pA[s] = __shfl_xor(sA[s], 32); pU[s] = __shfl_xor(sU[s], 32); }
    const bool first = (h == (DIR == 0 ? 0 : 1));
    if (!FULL) {
        float A = 1.f, U = 0.f;
#pragma unroll
        for (int q = 0; q < 8; ++q) { const int s = DIR == 0 ? q : 7 - q;
            const float A1 = first ? sA[s] : pA[s], U1 = first ? sU[s] : pU[s], A2 = first ? pA[s] : sA[s], U2 = first ? pU[s] : sU[s];
            U = A1 * U + U1; A *= A1; U = A2 * U + U2; A *= A2; }
        if (h == 0) *agg_out = (f32x2){A, U};
    } else {
        float H = Hin;
        float st[8];
#pragma unroll
        for (int q = 0; q < 8; ++q) { const int s = DIR == 0 ? q : 7 - q;
            const float A1 = first ? sA[s] : pA[s], U1 = first ? sU[s] : pU[s], A2 = first ? pA[s] : sA[s], U2 = first ? pU[s] : sU[s];
            const float Hm = A1 * H + U1; st[s] = first ? H : Hm; H = A2 * Hm + U2; }
#pragma unroll
        for (int s = 0; s < 8; ++s) { const int mb = s >> 2, g = s & 3; float hv = st[s];
#pragma unroll
            for (int e = 0; e < 4; ++e) { const int i = 4 * g + (DIR == 0 ? e : 3 - e); hv = acc[0][mb][i] * hv + acc[1][mb][i]; acc[1][mb][i] = hv; } }
    }
}

constexpr int LX_RS = 272;
template <bool FULL>
DI void lru_run(const KArgs& a, LAS unsigned char* lds, int b, int n, int tile0, int ntiles, bool is_ctx) {
    const int tid = tid_fresh(), lane = tid & 63, wid = __builtin_amdgcn_readfirstlane(tid >> 6), h = lane >> 5, c = lane & 31;
    LAS unsigned char* raw = lds;
    LAS unsigned char* xcb = lds + 67 * LX_RS;
    LAS float* cw = (LAS float*)(xcb + 64 * LX_RS);
    LAS float* hfb = cw + 640;
    LAS float* hbb = hfb + 64 * 132;
    const int Ls = is_ctx ? CTXL : SEQ;
    const bf16_t* xl = is_ctx ? (const bf16_t*)(a.ws + WS_CTXX) + (size_t)(b * CTXL) * 1024 + 128 * n : (const bf16_t*)(a.ws + WS_ZXL) + (size_t)(b * SEQ) * 1024 + 128 * n;
    const int dir = wid >> 2, nq = wid & 3, gc = 128 * n + 32 * nq + c;
    __syncthreads();
    for (int i = tid; i < 640; i += 512) { const int k = i >> 7, ch = i & 127; cw[i] = k < 4 ? a.in[I_CONVW][k * 1024 + 128 * n + ch] : a.in[I_CONVB][128 * n + ch]; }
    bf16x8 Bw[2][8];
    {   const bf16_t* wa = (const bf16_t*)(a.ws + WS_WLB) + (size_t)((2 * dir) * 8 + n) * 128 * 128 + (size_t)(32 * nq + c) * 128 + 8 * h;
#pragma unroll
        for (int ks = 0; ks < 8; ++ks) { Bw[0][ks] = *(const bf16x8*)(wa + 16 * ks); Bw[1][ks] = *(const bf16x8*)(wa + (size_t)8 * 128 * 128 + 16 * ks); } }
    const float ba2 = -LOG2E * a.in[I_LBA][dir * 1024 + gc], bx2 = -LOG2E * a.in[I_LBX][dir * 1024 + gc];
    const float cl = -8.0f * softplus_(-a.in[I_LLAM][dir * 1024 + gc]) * LOG2E;
    const size_t chain0 = ((size_t)(b * 2 + dir) * 1024 + gc) * NSLOT;
    u32x4 pre[3];
#define LRU_LOADRAW(tile_) do { _Pragma("unroll") for (int i_ = 0; i_ < 3; ++i_) { const int pid_ = tid + 512 * i_; pre[i_] = (u32x4){0u, 0u, 0u, 0u}; \
        if (pid_ < 67 * 16) { const int t_ = (tile_) * LT + (pid_ >> 4) - 1; if (t_ >= 0 && t_ < Ls) pre[i_] = *(const u32x4*)(xl + (size_t)t_ * 1024 + (pid_ & 15) * 8); } } } while (0)
    LRU_LOADRAW(tile0);
    for (int it = 0; it < ntiles; ++it) {
        const int tile = tile0 + it, t0 = tile * LT;
#pragma unroll
        for (int i = 0; i < 3; ++i) { const int pid = tid + 512 * i; if (pid < 67 * 16) *(LAS u32x4*)(raw + (pid >> 4) * LX_RS + (pid & 15) * 16) = pre[i]; }
        if (it + 1 < ntiles) LRU_LOADRAW(tile + 1);
        const int slot = is_ctx ? (dir == 0 ? tile : 3 - tile) : (dir == 0 ? 4 + tile : 4 + (NLT - 1 - tile));
        float Hin = 0.f; if (FULL) Hin = ((const float*)(a.ws + WS_LHIN))[chain0 + slot];
        u32x4 gpre[2]; bf16_t* gtile = (bf16_t*)(a.ws + WS_ZGL) + (size_t)(b * SEQ + t0) * 1024 + 128 * n;
        if (FULL) {
#pragma unroll
            for (int i = 0; i < 2; ++i) { const int pid = tid + 512 * i; gpre[i] = *(const u32x4*)(gtile + (size_t)(pid >> 4) * 1024 + (pid & 15) * 8); } }
        lds_barrier();
        {
            const int row = tid >> 3, c0 = (tid & 7) * 16; float o[16];
#pragma unroll
            for (int j = 0; j < 16; j += 4) { const f32x4 bv = *(const LAS f32x4*)(cw + 512 + c0 + j); o[j] = bv[0]; o[j + 1] = bv[1]; o[j + 2] = bv[2]; o[j + 3] = bv[3]; }
#pragma unroll
            for (int k = 0; k < 4; ++k) { const u32x4 p0 = *(const LAS u32x4*)(raw + (row + k) * LX_RS + c0 * 2), p1 = *(const LAS u32x4*)(raw + (row + k) * LX_RS + c0 * 2 + 16);
#pragma unroll
                for (int e = 0; e < 4; ++e) { const f32x4 w0 = *(const LAS f32x4*)(cw + k * 128 + c0 + 4 * (e >> 1) ), w1 = *(const LAS f32x4*)(cw + k * 128 + c0 + 8 + 4 * (e >> 1));
                    o[2 * e] += w0[2 * (e & 1)] * __uint_as_float(p0[e] << 16); o[2 * e + 1] += w0[2 * (e & 1) + 1] * __uint_as_float(p0[e] & 0xffff0000u);
                    o[8 + 2 * e] += w1[2 * (e & 1)] * __uint_as_float(p1[e] << 16); o[8 + 2 * e + 1] += w1[2 * (e & 1) + 1] * __uint_as_float(p1[e] & 0xffff0000u); } }
            u32x4 w0, w1;
#pragma unroll
            for (int e = 0; e < 4; ++e) { w0[e] = cvt_pk_bf16(o[2 * e], o[2 * e + 1]); w1[e] = cvt_pk_bf16(o[8 + 2 * e], o[8 + 2 * e + 1]); }
            *(LAS u32x4*)(xcb + row * LX_RS + c0 * 2) = w0; *(LAS u32x4*)(xcb + row * LX_RS + c0 * 2 + 16) = w1;
        }
        lds_barrier();
        f32x16 acc[2][2];
#pragma unroll
        for (int q = 0; q < 2; ++q) for (int mb = 0; mb < 2; ++mb) acc[q][mb] = zero16();
#pragma unroll
        for (int ks = 0; ks < 8; ++ks) {
            const bf16x8 a0 = *(const LAS bf16x8*)(xcb + c * LX_RS + (16 * ks + 8 * h) * 2), a1 = *(const LAS bf16x8*)(xcb + (32 + c) * LX_RS + (16 * ks + 8 * h) * 2);
            acc[0][0] = MFMA32(a0, Bw[0][ks], acc[0][0]); acc[0][1] = MFMA32(a1, Bw[0][ks], acc[0][1]); acc[1][0] = MFMA32(a0, Bw[1][ks], acc[1][0]); acc[1][1] = MFMA32(a1, Bw[1][ks], acc[1][1]);
        }
#pragma unroll
        for (int mb = 0; mb < 2; ++mb)
#pragma unroll
            for (int i = 0; i < 16; ++i) { const int row = 32 * mb + crow(i, h);
                const float r = rcpf_(1.0f + ex2(acc[0][mb][i] + ba2)), ig = rcpf_(1.0f + ex2(acc[1][mb][i] + bx2));
                const float av = ex2(cl * r); const float s = __builtin_amdgcn_sqrtf(__builtin_fmaf(-av, av, 1.0f));
                acc[0][mb][i] = av; acc[1][mb][i] = s * ig * bf2f(*(const LAS bf16_t*)(xcb + row * LX_RS + (32 * nq + c) * 2)); }
        f32x2* aggp = (f32x2*)(a.ws + WS_LAGG) + chain0 + slot;
        if (dir == 0) lru_scan<FULL, 0>(acc, Hin, aggp); else lru_scan<FULL, 1>(acc, Hin, aggp);
        if (FULL) {
            LAS float* hd = dir == 0 ? hfb : hbb;
#pragma unroll
            for (int mb = 0; mb < 2; ++mb)
#pragma unroll
                for (int i = 0; i < 16; ++i) hd[(32 * mb + crow(i, h)) * 132 + 32 * nq + c] = acc[1][mb][i];
            lds_barrier();
#pragma unroll
            for (int i = 0; i < 2; ++i) { const int pid = tid + 512 * i, row = pid >> 4, c8 = (pid & 15) * 8;
                const f32x4 f0 = *(const LAS f32x4*)(hfb + row * 132 + c8), f1 = *(const LAS f32x4*)(hfb + row * 132 + c8 + 4), b0 = *(const LAS f32x4*)(hbb + row * 132 + c8), b1 = *(const LAS f32x4*)(hbb + row * 132 + c8 + 4);
                const u32x4 g = gpre[i]; u32x4 o;
                o[0] = cvt_pk_bf16((f0[0] + b0[0]) * __uint_as_float(g[0] << 16), (f0[1] + b0[1]) * __uint_as_float(g[0] & 0xffff0000u));
                o[1] = cvt_pk_bf16((f0[2] + b0[2]) * __uint_as_float(g[1] << 16), (f0[3] + b0[3]) * __uint_as_float(g[1] & 0xffff0000u));
                o[2] = cvt_pk_bf16((f1[0] + b1[0]) * __uint_as_float(g[2] << 16), (f1[1] + b1[1]) * __uint_as_float(g[2] & 0xffff0000u));
                o[3] = cvt_pk_bf16((f1[2] + b1[2]) * __uint_as_float(g[3] << 16), (f1[3] + b1[3]) * __uint_as_float(g[3] & 0xffff0000u));
                *(u32x4*)(gtile + (size_t)row * 1024 + c8) = o; }
        }
    }
#undef LRU_LOADRAW
}

DI void ret_decays(const KArgs& a, int h, float& lgf2, float& lgb2) {
    const float* rd = (const float*)(a.ws + WS_RDEC); lgf2 = rd[h]; lgb2 = rd[4 + h];
}

DI void phase2a(const KArgs& a, LAS unsigned char* lds) {
    const int G = gridDim.x;
    constexpr int NU_R1 = NB_ * NH * NSC, NU_CK = NB_ * NH, NU_LX = NB_ * 8 * 16, NU_LC = NB_ * 8 * 4;
    for (int u = blockIdx.x; u < NU_R1 + NU_CK + NU_LX + NU_LC; u += G) {
        if (SUBSEL(1) && u < NU_R1) {
            const int sc = u & 31, h = (u >> 5) & 3, b = u >> 7; float lgf2, lgb2; ret_decays(a, h, lgf2, lgb2);
            float* o = (float*)(a.ws + WS_HX) + (size_t)(((b * 4 + h) * 32 + sc) * 2) * 32768;
            PB(100); r1_unit(lds, (const bf16_t*)(a.ws + WS_ZK) + (size_t)(b * SEQ + sc * SCH) * 512 + h * 128, (const bf16_t*)(a.ws + WS_ZV) + (size_t)(b * SEQ + sc * SCH) * 1024 + h * 256, SCH, lgf2, lgb2, o, o + 32768); PE(100);
        } else if (SUBSEL(1) && u < NU_R1 + NU_CK) {
            const int q = u - NU_R1, h = q & 3, b = q >> 2; float lgf2, lgb2; ret_decays(a, h, lgf2, lgb2);
            float* o = (float*)(a.ws + WS_CTXS) + (size_t)((b * 4 + h) * 2) * 32768;
            r1_unit(lds, (const bf16_t*)(a.ws + WS_CTXK) + (size_t)(b * CTXL) * 512 + h * 128, (const bf16_t*)(a.ws + WS_CTXV) + (size_t)(b * CTXL) * 1024 + h * 256, CTXL, lgf2, lgb2, o, o + 32768);
        } else if (SUBSEL(2) && u < NU_R1 + NU_CK + NU_LX) {
            const int q = u - NU_R1 - NU_CK, b = q >> 7, n = (q >> 4) & 7, r = q & 15;
            PB(101); lru_run<false>(a, lds, b, n, 16 * r, 16, false); PE(101);
        } else if (SUBSEL(2)) {
            const int q = u - NU_R1 - NU_CK - NU_LX, b = q >> 5, n = (q >> 2) & 7, tl = q & 3;
            lru_run<false>(a, lds, b, n, tl, 1, true);
        }
    }
}

DI void phase2b(const KArgs& a) {
    const int tid = tid_fresh(), G = gridDim.x, lane = tid & 63, wid = tid >> 6;
    for (int e = blockIdx.x * 512 + tid; e < NB_ * NH * 2 * 8192; e += G * 512) {
        const int e4 = e & 8191, dir = (e >> 13) & 1, h = (e >> 14) & 3, b = e >> 16;
        float lgf2, lgb2; ret_decays(a, h, lgf2, lgb2); const float gC = ex2((dir ? lgb2 : lgf2) * (float)SCH);
        f32x4 S = *(const f32x4*)((const float*)(a.ws + WS_CTXS) + (size_t)((b * 4 + h) * 2 + dir) * 32768 + 4 * e4);
        const float* kv = (const float*)(a.ws + WS_HX) + (size_t)((b * 4 + h) * 32 * 2 + dir) * 32768 + 4 * e4;
        bf16_t* so = (bf16_t*)(a.ws + WS_SBF) + (size_t)((b * 4 + h) * 32 * 2 + dir) * 32768 + 4 * e4;
        for (int s0 = 0; s0 < NSC; s0 += 8) {
            f32x4 kvv[8];
#pragma unroll
            for (int j = 0; j < 8; ++j) { const int sc = dir ? NSC - 1 - (s0 + j) : s0 + j; kvv[j] = *(const f32x4*)(kv + (size_t)sc * 65536); }
#pragma unroll
            for (int j = 0; j < 8; ++j) { const int sc = dir ? NSC - 1 - (s0 + j) : s0 + j;
                u32x2 w; w.x = cvt_pk_bf16(S[0], S[1]); w.y = cvt_pk_bf16(S[2], S[3]); *(u32x2*)(so + (size_t)sc * 65536) = w;
                S = S * gC + kvv[j]; }
        }
    }
    for (int ch = blockIdx.x * 8 + wid; ch < NB_ * 2 * 1024; ch += G * 8) {
        const f32x2* ag = (const f32x2*)(a.ws + WS_LAGG) + (size_t)ch * NSLOT; float* hin = (float*)(a.ws + WS_LHIN) + (size_t)ch * NSLOT;
        float carry = 0.f;
        for (int rd = 0; rd < 5; ++rd) { const int slot = 64 * rd + lane;
            f32x2 v = (f32x2){1.f, 0.f}; if (slot < 4 + NLT) v = ag[slot];
            float A = v[0], U = v[1];
#pragma unroll
            for (int o = 1; o < 64; o <<= 1) { const float Ap = __shfl_up(A, o), Up = __shfl_up(U, o); if (lane >= o) { U = A * Up + U; A = A * Ap; } }
            const float incl = A * carry + U;
            float excl = __shfl_up(incl, 1); if (lane == 0) excl = carry;
            if (slot < 4 + NLT) hin[slot] = excl;
            carry = __shfl(incl, 63);
        }
    }
}

constexpr int R3_KB = 16384, R3_VB = 32768;
template <int O, int T> DI void tr_frag2x2(unsigned a0, unsigned a1, bf16x8& f0, bf16x8& f1, bf16x8& f2, bf16x8& f3) {
    s16x4 r0, r1, r2, r3, r4, r5, r6, r7;
    asm volatile("ds_read_b64_tr_b16 %0, %8 offset:%10\n\tds_read_b64_tr_b16 %1, %8 offset:%11\n\t"
                 "ds_read_b64_tr_b16 %2, %8 offset:%12\n\tds_read_b64_tr_b16 %3, %8 offset:%13\n\t"
                 "ds_read_b64_tr_b16 %4, %9 offset:%10\n\tds_read_b64_tr_b16 %5, %9 offset:%11\n\t"
                 "ds_read_b64_tr_b16 %6, %9 offset:%12\n\tds_read_b64_tr_b16 %7, %9 offset:%13\n\ts_waitcnt lgkmcnt(0)"
                 : "=&v"(r0), "=&v"(r1), "=&v"(r2), "=&v"(r3), "=&v"(r4), "=&v"(r5), "=&v"(r6), "=&v"(r7)
                 : "v"(a0), "v"(a1), "i"(O), "i"(O + T), "i"(O + 256), "i"(O + 256 + T) : "memory");
    f0 = __builtin_shufflevector(r0, r1, 0, 1, 2, 3, 4, 5, 6, 7); f1 = __builtin_shufflevector(r2, r3, 0, 1, 2, 3, 4, 5, 6, 7);
    f2 = __builtin_shufflevector(r4, r5, 0, 1, 2, 3, 4, 5, 6, 7); f3 = __builtin_shufflevector(r6, r7, 0, 1, 2, 3, 4, 5, 6, 7);
}
DI bf16x8 scale_frag(bf16x8 f, float s) { const u32x4 u = __builtin_bit_cast(u32x4, f); u32x4 o;
#pragma unroll
    for (int e = 0; e < 4; ++e) o[e] = cvt_pk_bf16(__uint_as_float(u[e] << 16) * s, __uint_as_float(u[e] & 0xffff0000u) * s);
    return __builtin_bit_cast(bf16x8, o); }

DI void r3_unit(const KArgs& a, LAS unsigned char* lds, int b, int hh, int qb2) {
    const int tid = tid_fresh(), lane = tid & 63, wid = __builtin_amdgcn_readfirstlane(tid >> 6), h = lane >> 5, c = lane & 31;
    const int sc = qb2 >> 1, qpos = 256 * (qb2 & 1) + 32 * wid + c;
    float lgf2, lgb2; ret_decays(a, hh, lgf2, lgb2);
    const size_t tokS = (size_t)b * SEQ + SCH * sc, tokQ = tokS + qpos;
    LAS unsigned char* R0 = lds; LAS unsigned char* R1 = lds + 65536;
    const bf16_t* zk = (const bf16_t*)(a.ws + WS_ZK) + tokS * 512 + hh * 128; const bf16_t* zv = (const bf16_t*)(a.ws + WS_ZV) + tokS * 1024 + hh * 256;
    const unsigned wl = (unsigned)wid * 1024u;
    const unsigned soff = (unsigned)((tid >> 4) * 256 + (((tid & 15) ^ ((tid >> 4) & 15)) << 4));
    const unsigned koff = (unsigned)((tid >> 4) * 1024 + (((tid & 15) ^ ((tid >> 4) & 15)) << 4));
    const unsigned voff = (unsigned)((tid >> 5) * 2048 + (((tid & 31) ^ (((tid >> 5) & 3) << 2)) << 4));
#define R3_STAGE_KV(jb_, buf_) do { const char* kb_ = (const char*)zk + (size_t)(jb_) * 65536; const char* vb_ = (const char*)zv + (size_t)(jb_) * 131072; \
        _Pragma("unroll") for (int i_ = 0; i_ < 2; ++i_) GLDS16(kb_ + i_ * 32768 + koff, (buf_) + i_ * 8192 + wl); \
        _Pragma("unroll") for (int i_ = 0; i_ < 4; ++i_) GLDS16(vb_ + i_ * 32768 + voff, (buf_) + R3_KB + i_ * 8192 + wl); } while (0)
    __syncthreads();
    PB(110);
#pragma unroll
    for (int d = 0; d < 2; ++d) { const char* Sg = (const char*)((const bf16_t*)(a.ws + WS_SBF) + (size_t)(((b * 4 + hh) * 32 + sc) * 2 + d) * 32768);
#pragma unroll
        for (int i = 0; i < 8; ++i) GLDS16(Sg + i * 8192 + soff, (d ? R1 : R0) + i * 8192 + wl); }
    bf16x8 Qf[8];
    {   const bf16_t* qp = (const bf16_t*)(a.ws + WS_ZQ) + tokQ * 512 + hh * 128 + 8 * h;
#pragma unroll
        for (int ks = 0; ks < 8; ++ks) Qf[ks] = *(const bf16x8*)(qp + 16 * ks); }
    f32x16 OT[8];
#pragma unroll
    for (int nb = 0; nb < 8; ++nb) OT[nb] = zero16();
    const unsigned xq = (unsigned)(c & 15), rowb = (unsigned)c * 256u;
    float cf8[4], cfe[4], cb8[4], cbe[4];
#pragma unroll
    for (int k = 1; k < 4; ++k) { cf8[k] = __int_as_float(__builtin_amdgcn_readfirstlane(__float_as_int(ex2(-lgf2 * (float)(8 * k))))); cfe[k] = __int_as_float(__builtin_amdgcn_readfirstlane(__float_as_int(ex2(-lgf2 * (float)k))));
        cb8[k] = __int_as_float(__builtin_amdgcn_readfirstlane(__float_as_int(ex2(lgb2 * (float)(8 * k))))); cbe[k] = __int_as_float(__builtin_amdgcn_readfirstlane(__float_as_int(ex2(lgb2 * (float)k)))); }
    const int q0 = 256 * (qb2 & 1) + 32 * wid;
#pragma unroll
    for (int d = 0; d < 2; ++d) {
        if (d == 0) asm volatile("s_waitcnt vmcnt(16)" ::: "memory"); else asm volatile("s_waitcnt vmcnt(6)" ::: "memory");
        __builtin_amdgcn_s_barrier(); asm volatile("" ::: "memory");
        const float dec = d == 0 ? ex2(lgf2 * (float)(qpos + 1)) : ex2(lgb2 * (float)(SCH - qpos));
        const unsigned Sb = (unsigned)(size_t)(d ? R1 : R0) + rowb;
#pragma unroll
        for (int ks = 0; ks < 8; ++ks) { bf16x8 qf = Qf[ks]; asm volatile("" : "+v"(qf));
            const bf16x8 qs = scale_frag(qf, dec); const unsigned co = (((unsigned)(2 * ks + h)) ^ xq) << 4;
#pragma unroll
            for (int nb = 0; nb < 8; ++nb) { const bf16x8 sf = *(const LAS bf16x8*)(size_t)(Sb + 32 * 256 * nb + co); OT[nb] = MFMA32(sf, qs, OT[nb]); if (nb == 3) asm volatile("" ::: "memory"); }
            asm volatile("" ::: "memory"); }
        if (d == 0) { lds_barrier(); R3_STAGE_KV(0, R0); }
    }
    PE(110); PB(111);
    const unsigned q4 = (unsigned)((lane & 15) >> 2), vlane = (unsigned)(4 * h + q4) * 512u + 32u * ((lane >> 4) & 1) + 8u * (lane & 3);
#pragma unroll 1
    for (int jb = 0; jb < 8; ++jb) {
        LAS unsigned char* buf = (jb & 1) ? R1 : R0;
        asm volatile("s_waitcnt vmcnt(0)" ::: "memory");
        lds_barrier();
        if (jb + 1 < 8) { if (jb & 1) R3_STAGE_KV(jb + 1, R0); else R3_STAGE_KV(jb + 1, R1); }
        const unsigned Kb = (unsigned)(size_t)buf + rowb, Vb = (unsigned)(size_t)buf + R3_KB + vlane;
#pragma unroll
        for (int jt = 0; jt < 2; ++jt) {
            f32x16 st = zero16();
#pragma unroll
            for (int ks = 0; ks < 8; ++ks) { const bf16x8 kf = *(const LAS bf16x8*)(size_t)(Kb + 32 * 256 * jt + ((((unsigned)(2 * ks + h)) ^ xq) << 4)); st = MFMA32(kf, Qf[ks], st); }
            const int k0 = 64 * jb + 32 * jt;
            if (k0 == q0) {
#pragma unroll
                for (int i = 0; i < 16; ++i) { const int dd = qpos - (k0 + (i & 3) + 8 * (i >> 2) + 4 * h); st[i] *= (dd >= 0 ? ex2(lgf2 * (float)dd) : ex2(lgb2 * (float)(-dd))); }
            } else if (k0 < q0) { const float bh = ex2(lgf2 * (float)(q0 - k0 + c - 4 * h));
#pragma unroll
                for (int i = 0; i < 16; ++i) { float w = bh; if (i >> 2) w *= cf8[i >> 2]; if (i & 3) w *= cfe[i & 3]; st[i] *= w; }
            } else { const float bh = ex2(lgb2 * (float)(k0 - q0 + 4 * h - c));
#pragma unroll
                for (int i = 0; i < 16; ++i) { float w = bh; if (i >> 2) w *= cb8[i >> 2]; if (i & 3) w *= cbe[i & 3]; st[i] *= w; }
            }
#pragma unroll
            for (int s2 = 0; s2 < 2; ++s2) { u32x4 pk;
#pragma unroll
                for (int e = 0; e < 4; ++e) pk[e] = cvt_pk_bf16(st[8 * s2 + 2 * e], st[8 * s2 + 2 * e + 1]);
                const bf16x8 pb = __builtin_bit_cast(bf16x8, pk);
#pragma unroll
                for (int hf = 0; hf < 2; ++hf) {
                    bf16x8 v0, v1, v2, v3; const unsigned a0 = Vb + 64u * ((unsigned)(2 * hf) ^ q4), a1 = Vb + 64u * ((unsigned)(2 * hf + 1) ^ q4);
                    if (jt == 0 && s2 == 0) tr_frag2x2<0, 4096>(a0, a1, v0, v1, v2, v3);
                    if (jt == 0 && s2 == 1) tr_frag2x2<8192, 4096>(a0, a1, v0, v1, v2, v3);
                    if (jt == 1 && s2 == 0) tr_frag2x2<16384, 4096>(a0, a1, v0, v1, v2, v3);
                    if (jt == 1 && s2 == 1) tr_frag2x2<24576, 4096>(a0, a1, v0, v1, v2, v3);
                    OT[2 * hf] = MFMA32(v0, pb, OT[2 * hf]); OT[2 * hf + 4] = MFMA32(v1, pb, OT[2 * hf + 4]);
                    OT[2 * hf + 1] = MFMA32(v2, pb, OT[2 * hf + 1]); OT[2 * hf + 5] = MFMA32(v3, pb, OT[2 * hf + 5]);
                }
            }
        }
    }
    PE(111); PB(112);
    float s1 = 0.f, s2 = 0.f;
#pragma unroll
    for (int nb = 0; nb < 8; ++nb)
#pragma unroll
        for (int i = 0; i < 16; ++i) { s1 += OT[nb][i]; s2 += OT[nb][i] * OT[nb][i]; }
    s1 += __shfl_xor(s1, 32); s2 += __shfl_xor(s2, 32);
    const float mu = s1 * (1.0f / 256.0f), rstd = rsqrtf(fmaxf(s2 * (1.0f / 256.0f) - mu * mu, 0.f) + EPSV);
    lds_barrier();
    {   const int t2 = tid_fresh(), l2 = t2 & 63, w2 = t2 >> 6, h2 = l2 >> 5, c2 = l2 & 31;
        LAS unsigned char* slab = lds + (size_t)w2 * 16896;
#pragma unroll
        for (int nb = 0; nb < 8; ++nb)
#pragma unroll
            for (int g = 0; g < 4; ++g) { u32x2 o; o.x = cvt_pk_bf16((OT[nb][4 * g] - mu) * rstd, (OT[nb][4 * g + 1] - mu) * rstd); o.y = cvt_pk_bf16((OT[nb][4 * g + 2] - mu) * rstd, (OT[nb][4 * g + 3] - mu) * rstd);
                *(LAS u32x2*)(slab + c2 * 528 + (32 * nb + 8 * g + 4 * h2) * 2) = o; }
        bf16_t* gp = (bf16_t*)(a.ws + WS_ZG) + ((size_t)b * SEQ + SCH * sc + 256 * (qb2 & 1) + 32 * w2) * 1024 + hh * 256 + 8 * c2;
        const f32x4 gn0 = *(const f32x4*)(a.in[I_RNORM] + hh * 256 + 8 * c2), gn1 = *(const f32x4*)(a.in[I_RNORM] + hh * 256 + 8 * c2 + 4);
        u32x4 sg[16];
#pragma unroll
        for (int r = 0; r < 16; ++r) sg[r] = *(const u32x4*)(gp + (size_t)(2 * r + h2) * 1024);
        lds_wait();
#pragma unroll
        for (int r = 0; r < 16; ++r) { const u32x4 y = *(const LAS u32x4*)(slab + (2 * r + h2) * 528 + c2 * 16); u32x4 o;
            o[0] = cvt_pk_bf16(__uint_as_float(y[0] << 16) * gn0[0] * __uint_as_float(sg[r][0] << 16), __uint_as_float(y[0] & 0xffff0000u) * gn0[1] * __uint_as_float(sg[r][0] & 0xffff0000u));
            o[1] = cvt_pk_bf16(__uint_as_float(y[1] << 16) * gn0[2] * __uint_as_float(sg[r][1] << 16), __uint_as_float(y[1] & 0xffff0000u) * gn0[3] * __uint_as_float(sg[r][1] & 0xffff0000u));
            o[2] = cvt_pk_bf16(__uint_as_float(y[2] << 16) * gn1[0] * __uint_as_float(sg[r][2] << 16), __uint_as_float(y[2] & 0xffff0000u) * gn1[1] * __uint_as_float(sg[r][2] & 0xffff0000u));
            o[3] = cvt_pk_bf16(__uint_as_float(y[3] << 16) * gn1[2] * __uint_as_float(sg[r][3] << 16), __uint_as_float(y[3] & 0xffff0000u) * gn1[3] * __uint_as_float(sg[r][3] & 0xffff0000u));
            *(u32x4*)(gp + (size_t)(2 * r + h2) * 1024) = o; }
    }
    PE(112);
#undef R3_STAGE_KV
}

DI void phase2c(const KArgs& a, LAS unsigned char* lds) {
    const int G = gridDim.x;
    constexpr int NU_R3 = NB_ * NH * (SEQ / 256), NU_L3 = NB_ * 8 * 16;
    for (int u = blockIdx.x; u < NU_R3 + NU_L3; u += G) {
        if (SUBSEL(1) && u < NU_R3) { const int w = u & 255, uu = (u & ~255) + 2 * ((w & 7) + 8 * (w >> 4)) + ((w >> 3) & 1);
            const int b = uu >> 8, hh = (uu >> 6) & 3, qb2 = uu & 63; PB(102); r3_unit(a, lds, b, hh, qb2); PE(102); }
        else if (SUBSEL(2)) { const int q = u - NU_R3, b = q >> 7, n = (q >> 4) & 7, r = q & 15; PB(103); lru_run<true>(a, lds, b, n, 16 * r, 16, false); PE(103); }
    }
}

DI void cvt4_decode(const KArgs& a, int t, const float*& src, int& ld_src, unsigned char*& dst, size_t& hi_stride, int& ld_dst) {
    constexpr int T_GU = 32 * 2 * 16 * 3;
    if (t < T_GU) { const int e = t / 96, r = t % 96, mat = r / 48, kt = (r % 48) / 3, ng = r % 3;
        src = a.in[mat ? I_WEU : I_WEG] + (size_t)e * 1024 * 768 + (size_t)(64 * kt) * 768 + 256 * ng; ld_src = 768;
        dst = (unsigned char*)(a.ws + WS_WGU) + ((size_t)(e * 6 + 2 * ng) * 256 + mat * 128) * 1024 + 64 * kt; hi_stride = (size_t)256 * 1024; ld_dst = 1024;
    } else { const int q = t - T_GU, e = q / 48, r = q % 48, kt = r / 4, ng = r % 4;
        src = a.in[I_WED] + (size_t)e * 768 * 1024 + (size_t)(64 * kt) * 1024 + 256 * ng; ld_src = 1024;
        dst = (unsigned char*)(a.ws + WS_WDN) + ((size_t)e * 1024 + 256 * ng) * 768 + 64 * kt; hi_stride = (size_t)128 * 768; ld_dst = 768; }
}
DI unsigned cvt4_fp8_noclamp(float a, float b, float c, float d) { int p = 0; p = __builtin_amdgcn_cvt_pk_fp8_f32(a, b, p, false); p = __builtin_amdgcn_cvt_pk_fp8_f32(c, d, p, true); return (unsigned)p; }
DI void phase3_cvt(const KArgs& a, LAS unsigned char* lds) {
    const int G = gridDim.x, tid = tid_fresh(); LAS float* tile = (LAS float*)lds;
    constexpr int T_ALL = 32 * 2 * 16 * 3 + 32 * 12 * 4;
    const float* src; int ld_src; unsigned char* dA; size_t hA; int ldA; unsigned char* dB = nullptr; size_t hB = 0; int ldB = 0; unsigned char* dC = nullptr; size_t hC = 0; int ldC = 0;
    f32x4 va[8], vb[8], vc[8];
#define CVT_LOAD(v_, t_, d_, h_, l_) do { cvt4_decode(a, (t_), src, ld_src, d_, h_, l_); _Pragma("unroll") for (int i_ = 0; i_ < 8; ++i_) v_[i_] = *(const f32x4*)(src + (size_t)((tid >> 6) + 8 * i_) * ld_src + 4 * (tid & 63)); } while (0)
#define CVT_EMIT(v_) do { lds_barrier(); _Pragma("unroll") for (int i_ = 0; i_ < 8; ++i_) *(LAS f32x4*)(tile + ((tid >> 6) + 8 * i_) * 260 + 4 * (tid & 63)) = v_[i_]; } while (0)
#define CVT_STORE(d_, h_, l_) do { lds_barrier(); const int n_ = tid & 255, kh_ = tid >> 8; unsigned char* p_ = (d_) + (size_t)(n_ >> 7) * (h_) + (size_t)(n_ & 127) * (l_) + 32 * kh_; \
        _Pragma("unroll") for (int q_ = 0; q_ < 2; ++q_) { float x_[16]; _Pragma("unroll") for (int j_ = 0; j_ < 16; ++j_) x_[j_] = tile[(32 * kh_ + 16 * q_ + j_) * 260 + n_] * 64.0f; \
            u32x4 w_; w_.x = cvt4_fp8_noclamp(x_[0], x_[1], x_[2], x_[3]); w_.y = cvt4_fp8_noclamp(x_[4], x_[5], x_[6], x_[7]); w_.z = cvt4_fp8_noclamp(x_[8], x_[9], x_[10], x_[11]); w_.w = cvt4_fp8_noclamp(x_[12], x_[13], x_[14], x_[15]); \
            *(u32x4*)(p_ + 16 * q_) = w_; } } while (0)
#define CVT_STEP(v_, d_, h_, l_) { unsigned char* d0 = d_; const size_t h0 = h_; const int l0 = l_; CVT_EMIT(v_); if (t + 3 * G < T_ALL) CVT_LOAD(v_, t + 3 * G, d_, h_, l_); CVT_STORE(d0, h0, l0); } t += G; if (t >= T_ALL) break;
    int t = blockIdx.x; if (t >= T_ALL) return;
    CVT_LOAD(va, t, dA, hA, ldA);
    if (t + G < T_ALL) CVT_LOAD(vb, t + G, dB, hB, ldB);
    if (t + 2 * G < T_ALL) CVT_LOAD(vc, t + 2 * G, dC, hC, ldC);
    for (;;) {
        CVT_STEP(va, dA, hA, ldA)
        CVT_STEP(vb, dB, hB, ldB)
        CVT_STEP(vc, dC, hC, ldC)
    }
#undef CVT_LOAD
#undef CVT_EMIT
#undef CVT_STORE
#undef CVT_STEP
    __syncthreads();
}
struct OrderMerge {
    const char* A0; const char* A1; const char* B0; const char* B1; int G, c;
    DI bool next(int i, Unit& u) const { int pm, pn; if (!pg8::static_tile(i >> 1, G, c, NT / 256, 4, pm, pn)) return false;
        const int st = i & 1; u.pm = pm; u.pn = pn; u.aux = st; u.bmode = 1; u.A = (st ? A1 : A0) + (size_t)pm * 256 * 1024 * 2; u.B = (st ? B1 : B0) + (size_t)pn * 256 * 1024 * 2; return true; }
    DI void offsA(const Unit&, int, const int (&R)[2], const int (&C)[2], unsigned (&v)[2][2]) const { pg8::dense_offs(2048, R, C, v); }
};
struct EpiMerge {
    const bf16_t* glog; bf16_t* out;
    DI bool operator()(f32x4 (&acc)[2][2][4][2], const Unit& u, int wr, int wc, int fr, int fq) const {
        const bool st0 = (u.aux == 0);
        const bf16_t* gbase = glog + (size_t)(u.pm * 8 + u.pn) * 65536;
        u32x4 gl[2][4], gr[2][4];
#define EM_LOAD(bt_, slot_) do { const int bj_ = (bt_) >> 1, ai_ = (bt_) & 1; _Pragma("unroll") for (int m_ = 0; m_ < 4; ++m_) { const bf16_t* p_ = gbase + glog_frag(ai_, bj_, m_, wr, wc, fr, fq); \
            gl[slot_][m_] = *(const u32x4*)(p_ + 4 * 65536); if (st0) gr[slot_][m_] = *(const u32x4*)p_; } } while (0)
        EM_LOAD(0, 0);
#pragma unroll
        for (int bt = 0; bt < 4; ++bt) { const int bj = bt >> 1, ai = bt & 1, sl = bt & 1;
            if (bt + 1 < 4) { if (sl == 0) EM_LOAD(bt + 1, 1); else EM_LOAD(bt + 1, 0); }
#pragma unroll
            for (int m = 0; m < 4; ++m) { const u32x4 l4 = gl[sl][m];
                if (st0) { const u32x4 r4 = gr[sl][m];
#pragma unroll
                    for (int e = 0; e < 4; ++e) { const float r0 = __uint_as_float(r4[e] << 16), r1 = __uint_as_float(r4[e] & 0xffff0000u), l0 = __uint_as_float(l4[e] << 16), l1 = __uint_as_float(l4[e] & 0xffff0000u);
                        const float q0 = (1.0f + ex2(-LOG2E * l0)) * rcpf_(1.0f + ex2(-LOG2E * r0)), q1 = (1.0f + ex2(-LOG2E * l1)) * rcpf_(1.0f + ex2(-LOG2E * r1));
                        acc[ai][bj][m][e >> 1][2 * (e & 1)] *= q0; acc[ai][bj][m][e >> 1][2 * (e & 1) + 1] *= q1; }
                } else { float v[8];
#pragma unroll
                    for (int e = 0; e < 4; ++e) { const float l0 = __uint_as_float(l4[e] << 16), l1 = __uint_as_float(l4[e] & 0xffff0000u);
                        v[2 * e] = acc[ai][bj][m][e >> 1][2 * (e & 1)] * sigm(l0); v[2 * e + 1] = acc[ai][bj][m][e >> 1][2 * (e & 1) + 1] * sigm(l1); }
                    u32x4 w; w.x = cvt_pk_bf16(v[0], v[1]); w.y = cvt_pk_bf16(v[2], v[3]); w.z = cvt_pk_bf16(v[4], v[5]); w.w = cvt_pk_bf16(v[6], v[7]);
                    *(u32x4*)(out + (size_t)(u.pm * 256 + ai * 128 + wr * 64 + m * 16 + fr) * 1024 + u.pn * 256 + bj * 128 + wc * 32 + 8 * fq) = w; } } }
#undef EM_LOAD
        return st0;
    }
};

struct OrderOut {
    const char* A; const char* B; int G, c;
    DI bool next(int i, Unit& u) const { int pm, pn; if (!pg8::static_tile(i, G, c, NT / 256, 4, pm, pn)) return false;
        u.pm = pm; u.pn = pn; u.aux = 0; u.bmode = 1; u.A = A + (size_t)pm * 256 * 1024 * 2; u.B = B + (size_t)pn * 256 * 1024 * 2; return true; }
    DI void offsA(const Unit&, int, const int (&R)[2], const int (&C)[2], unsigned (&v)[2][2]) const { pg8::dense_offs(2048, R, C, v); }
};
struct EpiOut {
    const KArgs* a;
    DI bool operator()(f32x4 (&acc)[2][2][4][2], const Unit& u, int wr, int wc, int fr, int fq) const {
        const int b = (u.pm * 256) / SEQ; bf16_t* d1 = (bf16_t*)(a->ws + WS_D1);
#pragma unroll
        for (int bj = 0; bj < 2; ++bj) { const int col = u.pn * 256 + bj * 128 + wc * 32 + 8 * fq;
            const f32x4 g0 = *(const f32x4*)((const float*)(a->ws + WS_MODT) + b * 1024 + col), g1 = *(const f32x4*)((const float*)(a->ws + WS_MODT) + b * 1024 + col + 4);
#pragma unroll
            EPI_LOOP_ROWS { const size_t off = (size_t)(u.pm * 256 + ai * 128 + wr * 64 + m * 16 + fr) * 1024 + col; const f32x4 v0 = g0 * acc[ai][bj][m][0], v1 = g1 * acc[ai][bj][m][1];
                u32x4 w; w.x = cvt_pk_bf16(v0[0], v0[1]); w.y = cvt_pk_bf16(v0[2], v0[3]); w.z = cvt_pk_bf16(v1[0], v1[1]); w.w = cvt_pk_bf16(v1[2], v1[3]);
                *(u32x4*)(d1 + off) = w; } }
        return false;
    }
};

DI void phase5(const KArgs& a, LAS unsigned char* lds) {
    const int tid = tid_fresh(), G = gridDim.x, lane = tid & 63, wid = __builtin_amdgcn_readfirstlane(tid >> 6);
    LAS float* gm = (LAS float*)lds;
    LAS float* sh = gm + 2048;
    LAS float* lg = sh + 2048;
    LAS int* lcnt = (LAS int*)(lg + 128 * 40);
    LAS int* rinfo = lcnt + 64;
    LAS float* rw = (LAS float*)(rinfo + 512);
    LAS float* red = rw + 256;
    LAS unsigned char* At = (LAS unsigned char*)(red + 4 * 32 * 40);
    __syncthreads();
    for (int i = tid; i < 2048; i += 512) { const float* mt = (const float*)(a.ws + WS_MODT); gm[i] = mt[2048 + i]; sh[i] = mt[4096 + i]; }
    if (blockIdx.x == 0 && tid < 256) ((unsigned*)(a.ws + WS_HX2Q) + (size_t)NT * 256)[tid] = 0u;
    const int cb = wid & 1, kq = wid >> 1, r = lane & 31, h = lane >> 5;
    bf16x8 Bh[16], Bl[16];
    {   const bf16_t* bh = (const bf16_t*)(a.ws + WS_WRH) + (size_t)(32 * cb + r) * 1024 + 256 * kq + 8 * h;
#pragma unroll
        for (int s2 = 0; s2 < 16; ++s2) { Bh[s2] = *(const bf16x8*)(bh + 16 * s2); Bl[s2] = *(const bf16x8*)(bh + 64 * 1024 + 16 * s2); } }
    for (int rt = blockIdx.x; rt < NT / 128; rt += G) {
        __syncthreads();
        if (tid < 32) lcnt[tid] = 0;
        const int v = (128 * rt) / SEQ; const bf16_t* d1 = (const bf16_t*)(a.ws + WS_D1);
        for (int ch = 0; ch < 4; ++ch) {
            PB(130);
            {
                const int rowc = 4 * wid, row0 = 128 * rt + 32 * ch + rowc; f32x4 x[2][4], xb[2][4]; u32x2 dl[2][4], db[2][4];
#pragma unroll
                for (int q = 0; q < 2; ++q)
#pragma unroll
                    for (int j = 0; j < 4; ++j) { x[q][j] = *(const f32x4*)(a.in[I_X] + (size_t)(row0 + q) * 1024 + 4 * lane + 256 * j); dl[q][j] = *(const u32x2*)(d1 + (size_t)(row0 + q) * 1024 + 4 * lane + 256 * j); }
#pragma unroll
                for (int pr = 0; pr < 2; ++pr) {
                    if (pr == 0) {
#pragma unroll
                        for (int q = 0; q < 2; ++q)
#pragma unroll
                            for (int j = 0; j < 4; ++j) { xb[q][j] = *(const f32x4*)(a.in[I_X] + (size_t)(row0 + 2 + q) * 1024 + 4 * lane + 256 * j); db[q][j] = *(const u32x2*)(d1 + (size_t)(row0 + 2 + q) * 1024 + 4 * lane + 256 * j); } }
#pragma unroll
                    for (int q = 0; q < 2; ++q) { const int row = row0 + 2 * pr + q; float ss = 0.f;
#pragma unroll
                        for (int j = 0; j < 4; ++j) { x[q][j][0] += __uint_as_float(dl[q][j].x << 16); x[q][j][1] += __uint_as_float(dl[q][j].x & 0xffff0000u); x[q][j][2] += __uint_as_float(dl[q][j].y << 16); x[q][j][3] += __uint_as_float(dl[q][j].y & 0xffff0000u);
                            ss += (x[q][j][0] * x[q][j][0] + x[q][j][1] * x[q][j][1]) + (x[q][j][2] * x[q][j][2] + x[q][j][3] * x[q][j][3]); }
#pragma unroll
                        for (int o = 32; o >= 1; o >>= 1) ss += __shfl_xor(ss, o);
                        const float rstd = rsqrtf(ss * (1.0f / 1024.0f) + EPSV);
#pragma unroll
                        for (int j = 0; j < 4; ++j) { const int k0 = 4 * lane + 256 * j; const f32x4 g = *(const LAS f32x4*)(gm + v * 1024 + k0), sv = *(const LAS f32x4*)(sh + v * 1024 + k0);
                            const float y0 = x[q][j][0] * rstd * g[0] + sv[0], y1 = x[q][j][1] * rstd * g[1] + sv[1], y2 = x[q][j][2] * rstd * g[2] + sv[2], y3 = x[q][j][3] * rstd * g[3] + sv[3];
                            u32x2 w; w.x = cvt_pk_bf16(y0, y1); w.y = cvt_pk_bf16(y2, y3);
                            *(LAS u32x2*)(At + (rowc + 2 * pr + q) * 2064 + k0 * 2) = w;
                            *(unsigned*)((unsigned char*)(a.ws + WS_HX2Q) + (size_t)row * 1024 + k0) = cvt4_fp8(16.f * y0, 16.f * y1, 16.f * y2, 16.f * y3); } }
                    if (pr == 0) {
#pragma unroll
                        for (int q = 0; q < 2; ++q)
#pragma unroll
                            for (int j = 0; j < 4; ++j) { x[q][j] = xb[q][j]; dl[q][j] = db[q][j]; } }
                }
            }
            lds_barrier();
            PE(130); PB(131);
            {
                f32x16 acc = zero16();
#pragma unroll
                for (int s2 = 0; s2 < 16; ++s2) { const bf16x8 af = *(const LAS bf16x8*)(At + r * 2064 + (256 * kq + 16 * s2 + 8 * h) * 2); acc = MFMA32(af, Bh[s2], acc); acc = MFMA32(af, Bl[s2], acc); }
                const int col = 32 * cb + r;
                if (col < 36) {
#pragma unroll
                    for (int i = 0; i < 16; ++i) red[(kq * 32 + crow(i, h)) * 40 + col] = acc[i]; }
            }
            lds_barrier();
            for (int i = tid; i < 32 * 36; i += 512) { const int rr = i / 36, cc = i % 36; lg[(32 * ch + rr) * 40 + cc] = (red[(0 * 32 + rr) * 40 + cc] + red[(1 * 32 + rr) * 40 + cc]) + (red[(2 * 32 + rr) * 40 + cc] + red[(3 * 32 + rr) * 40 + cc]); }
            PE(131);
        }
        __syncthreads();
        PB(132);
        if (tid < 128) { const LAS float* l = lg + tid * 40;
            int gs = 0; float best = l[0] + a.in[I_BGRP][0];
#pragma unroll
            for (int g = 1; g < 4; ++g) { const float vv = l[g] + a.in[I_BGRP][g]; if (vv > best) { best = vv; gs = g; } }
            const float mx = fmaxf(fmaxf(l[0], l[1]), fmaxf(l[2], l[3])); float den = 0.f;
#pragma unroll
            for (int g = 0; g < 4; ++g) den += expf(l[g] - mx);
            const float pg = expf(l[gs] - mx) / den;
            int i0 = 0, i1 = -1; float v0 = -3.0e38f, v1 = -3.0e38f;
#pragma unroll
            for (int e = 0; e < 8; ++e) { const float vv = l[4 + 8 * gs + e] + a.in[I_BRT][8 * gs + e];
                if (vv > v0) { v1 = v0; i1 = i0; v0 = vv; i0 = e; } else if (vv > v1) { v1 = vv; i1 = e; } }
            const float e0 = l[4 + 8 * gs + i0], e1 = l[4 + 8 * gs + i1], m2 = fmaxf(e0, e1), x0 = expf(e0 - m2), x1 = expf(e1 - m2), inv = 1.0f / (x0 + x1);
            const int ex0 = 8 * gs + i0, ex1 = 8 * gs + i1;
            rinfo[tid * 4 + 0] = ex0; rinfo[tid * 4 + 1] = atomicAdd((int*)&lcnt[ex0], 1); rinfo[tid * 4 + 2] = ex1; rinfo[tid * 4 + 3] = atomicAdd((int*)&lcnt[ex1], 1);
            rw[tid * 2 + 0] = pg * x0 * inv; rw[tid * 2 + 1] = pg * x1 * inv; }
        __syncthreads();
        { const int t3 = tid_fresh(); if (t3 < 32) lcnt[32 + t3] = lcnt[t3] ? atomicAdd((int*)(a.ws + WS_CTL) + CW_CNT + t3, lcnt[t3]) : 0; }
        __syncthreads();
        if (tid < 128) { const int tok = 128 * rt + tid; const int e0 = rinfo[tid * 4 + 0], s0 = lcnt[32 + e0] + rinfo[tid * 4 + 1], e1 = rinfo[tid * 4 + 2], s1 = lcnt[32 + e1] + rinfo[tid * 4 + 3];
            int* ptok = (int*)(a.ws + WS_PTOK); ptok[(size_t)e0 * 65536 + s0] = tok; ptok[(size_t)e1 * 65536 + s1] = tok;
            unsigned* ro = (unsigned*)(a.ws + WS_ROUTE) + (size_t)tok * 8; ro[0] = e0; ro[1] = s0; ro[2] = e1; ro[3] = s1; ro[4] = __float_as_uint(rw[tid * 2]); ro[5] = __float_as_uint(rw[tid * 2 + 1]); }
        PE(132);
    }
}

DI void moe_tiles(const KArgs& a, LAS int* tt) {
    __syncthreads();
    if (threadIdx.x == 0) { const int* cnt = (const int*)(a.ws + WS_CTL) + CW_CNT; int s = 0; for (int e = 0; e < 32; ++e) { tt[e] = s; s += (cnt[e] + 255) >> 8; } tt[32] = s; }
    __syncthreads();
}
DI int moe_unit(int i, int G, int c, int nunits) { const long L = (long)i * G + c; if (L >= nunits) return -1; const int q = nunits / 8, r = nunits % 8, x = (int)(L % 8), off = (int)(L / 8);
    return (x < r ? x * (q + 1) : r * (q + 1) + (x - r) * q) + off; }
DI int moe_expert(const LAS int* tt, int rt) { int e = 0;
#pragma unroll
    for (int q = 16; q >= 1; q >>= 1) if (tt[e + q] <= rt) e += q;
    return e; }
struct OrderMoe1 {
    const char* A; const char* B; const LAS int* tt; const LAS int* tok; int G, c;
    DI bool next(int i, Unit& u) const { const int L = moe_unit(i, G, c, tt[32] * 6); if (L < 0) return false; const int rt = L / 6, ct = L % 6, e = moe_expert(tt, rt);
        u.pm = rt; u.pn = ct; u.aux = e; u.bmode = 1; u.A = A; u.B = B + (size_t)(e * 6 + ct) * 256 * 1024; return true; }
    DI void offsA(const Unit&, int ui, const int (&R)[2], const int (&C)[2], unsigned (&v)[2][2]) const {
#pragma unroll
        for (int h = 0; h < 2; ++h)
#pragma unroll
            for (int i = 0; i < 2; ++i) v[h][i] = (unsigned)tok[ui * 256 + h * 128 + R[i]] * 1024u + (unsigned)C[i] * 2u; }
};
struct EpiMoe1 {
    unsigned char* hid;
    DI bool operator()(f32x4 (&acc)[2][2][4][2], const Unit& u, int wr, int wc, int fr, int fq) const {
        const int col = u.pn * 128 + wc * 32 + 8 * fq;
#pragma unroll
        EPI_LOOP_ROWS { const size_t row = (size_t)u.pm * 256 + ai * 128 + wr * 64 + m * 16 + fr; float v[8];
#pragma unroll
            for (int n = 0; n < 2; ++n)
#pragma unroll
                for (int j = 0; j < 4; ++j) { const float g = acc[ai][0][m][n][j] * (1.0f / 1024.0f), up = acc[ai][1][m][n][j] * (1.0f / 1024.0f); v[4 * n + j] = silu_(g) * up * 8.0f; }
            u32x2 w; w.x = cvt4_fp8(v[0], v[1], v[2], v[3]); w.y = cvt4_fp8(v[4], v[5], v[6], v[7]);
            *(u32x2*)(hid + row * 768 + col) = w; }
        return false;
    }
};
struct OrderMoe2 {
    const char* A; const char* B; const LAS int* tt; int G, c;
    DI bool next(int i, Unit& u) const { const int L = moe_unit(i, G, c, tt[32] * 4); if (L < 0) return false; const int rt = L >> 2, ct = L & 3, e = moe_expert(tt, rt);
        u.pm = rt; u.pn = ct; u.aux = e; u.bmode = 1; u.A = A + (size_t)rt * 256 * 768; u.B = B + ((size_t)e * 1024 + 256 * ct) * 768; return true; }
    DI void offsA(const Unit&, int, const int (&R)[2], const int (&C)[2], unsigned (&v)[2][2]) const { pg8::dense_offs(768, R, C, v); }
};
struct EpiMoe2 {
    unsigned char* ye;
    DI bool operator()(f32x4 (&acc)[2][2][4][2], const Unit& u, int wr, int wc, int fr, int fq) const {
#pragma unroll
        for (int bj = 0; bj < 2; ++bj) { const int col = u.pn * 256 + bj * 128 + wc * 32 + 8 * fq;
#pragma unroll
            EPI_LOOP_ROWS { const size_t row = (size_t)u.pm * 256 + ai * 128 + wr * 64 + m * 16 + fr; const f32x4 v0 = acc[ai][bj][m][0] * (16.0f / 512.0f), v1 = acc[ai][bj][m][1] * (16.0f / 512.0f);
                u32x2 w; w.x = cvt4_fp8(v0[0], v0[1], v0[2], v0[3]); w.y = cvt4_fp8(v1[0], v1[1], v1[2], v1[3]);
                *(u32x2*)(ye + row * 1024 + col) = w; } }
        return false;
    }
};

DI void phase8(const KArgs& a, LAS unsigned char* lds) {
    const int tid = tid_fresh(), G = gridDim.x, lane = tid & 63, wid = tid >> 6;
    LAS float* g2 = (LAS float*)lds;
    LAS int* tt = (LAS int*)(g2 + 2048);
    moe_tiles(a, tt);
    for (int i = tid; i < 2048; i += 512) g2[i] = ((const float*)(a.ws + WS_MODT))[6144 + i];
    __syncthreads();
    const unsigned char* ye = (const unsigned char*)(a.ws + WS_YE); const bf16_t* d1 = (const bf16_t*)(a.ws + WS_D1);
    const int rstep = G * 8; int row = blockIdx.x * 8 + wid;
    f32x4 x[4]; u32x2 dl[4]; unsigned ya[4], yb[4]; float w0 = 0.f, w1 = 0.f; unsigned ron[6];
#define P8_ROUTE(r_, dst_) do { const unsigned* ro_ = (const unsigned*)(a.ws + WS_ROUTE) + (size_t)(r_) * 8; _Pragma("unroll") for (int q_ = 0; q_ < 6; ++q_) dst_[q_] = ro_[q_]; } while (0)
#define P8_LOAD(r_, rt_, X_, D_, A_, B_) do { const size_t p0_ = (size_t)tt[rt_[0]] * 256 + rt_[1], p1_ = (size_t)tt[rt_[2]] * 256 + rt_[3]; \
        _Pragma("unroll") for (int j_ = 0; j_ < 4; ++j_) { const int k0_ = 4 * lane + 256 * j_; X_[j_] = *(const f32x4*)(a.in[I_X] + (size_t)(r_) * 1024 + k0_); D_[j_] = *(const u32x2*)(d1 + (size_t)(r_) * 1024 + k0_); \
            A_[j_] = *(const unsigned*)(ye + p0_ * 1024 + k0_); B_[j_] = *(const unsigned*)(ye + p1_ * 1024 + k0_); } } while (0)
    if (row < NT) { unsigned r0[6]; P8_ROUTE(row, r0); P8_LOAD(row, r0, x, dl, ya, yb); w0 = __uint_as_float(r0[4]); w1 = __uint_as_float(r0[5]); if (row + rstep < NT) P8_ROUTE(row + rstep, ron); }
    for (; row < NT; row += rstep) {
        const int v = row / SEQ, nrow = row + rstep; f32x4 xn[4]; u32x2 dn[4]; unsigned yan[4], ybn[4]; float w0n = 0.f, w1n = 0.f;
        if (nrow < NT) { P8_LOAD(nrow, ron, xn, dn, yan, ybn); w0n = __uint_as_float(ron[4]); w1n = __uint_as_float(ron[5]); if (nrow + rstep < NT) P8_ROUTE(nrow + rstep, ron); }
        float ss = 0.f; const float s0 = w0 * (1.0f / 16.0f), s1 = w1 * (1.0f / 16.0f);
#pragma unroll
        for (int j = 0; j < 4; ++j) { const int k0 = 4 * lane + 256 * j; const f32x4 g = *(const LAS f32x4*)(g2 + v * 1024 + k0);
            const float m0 = s0 * __builtin_amdgcn_cvt_f32_fp8(ya[j], 0) + s1 * __builtin_amdgcn_cvt_f32_fp8(yb[j], 0), m1 = s0 * __builtin_amdgcn_cvt_f32_fp8(ya[j], 1) + s1 * __builtin_amdgcn_cvt_f32_fp8(yb[j], 1);
            const float m2 = s0 * __builtin_amdgcn_cvt_f32_fp8(ya[j], 2) + s1 * __builtin_amdgcn_cvt_f32_fp8(yb[j], 2), m3 = s0 * __builtin_amdgcn_cvt_f32_fp8(ya[j], 3) + s1 * __builtin_amdgcn_cvt_f32_fp8(yb[j], 3);
            x[j][0] += __uint_as_float(dl[j].x << 16) + g[0] * m0; x[j][1] += __uint_as_float(dl[j].x & 0xffff0000u) + g[1] * m1;
            x[j][2] += __uint_as_float(dl[j].y << 16) + g[2] * m2; x[j][3] += __uint_as_float(dl[j].y & 0xffff0000u) + g[3] * m3;
            ss += (x[j][0] * x[j][0] + x[j][1] * x[j][1]) + (x[j][2] * x[j][2] + x[j][3] * x[j][3]); }
#pragma unroll
        for (int o = 32; o >= 1; o >>= 1) ss += __shfl_xor(ss, o);
        const float rstd = rsqrtf(ss * (1.0f / 1024.0f) + EPSV);
        float* xr = a.out + (size_t)row * 1024;
#pragma unroll
        for (int j = 0; j < 4; ++j) { const int k0 = 4 * lane + 256 * j; const f32x4 fn = *(const f32x4*)(a.in[I_FNORM] + k0); *(f32x4*)(xr + k0) = x[j] * rstd * fn; }
#pragma unroll
        for (int j = 0; j < 4; ++j) { x[j] = xn[j]; dl[j] = dn[j]; ya[j] = yan[j]; yb[j] = ybn[j]; }
        w0 = w0n; w1 = w1n;
    }
#undef P8_ROUTE
#undef P8_LOAD
}

constexpr int N_PHASES = 12;
__global__ void __launch_bounds__(512, 2) fwd_kernel(KArgs a) {
    extern __shared__ __attribute__((aligned(16))) unsigned char lds_raw[];
    LAS unsigned char* lds = (LAS unsigned char*)lds_raw;
    volatile LAS unsigned* misc = (volatile LAS unsigned*)(lds + LDS_MISC);
    if (threadIdx.x < 8) misc[threadIdx.x] = 0u;
#ifdef PROBE_ID
    if (threadIdx.x == 0) { probe_words()[0] = 0; probe_words()[1] = 0; }
#endif
    __syncthreads();
    XcdBarrier bar; bar.bar = (unsigned*)(a.ws + WS_CTL) + CW_BAR; bar.x = 0; bar.st = misc;
    const bool one = (a.ph_hi - a.ph_lo) > 1;
    if (one) bar = xcd_barrier_post((unsigned*)(a.ws + WS_CTL) + CW_BAR, misc);
#ifdef ONLY_PHASE
#define IN(k) ((k) == ONLY_PHASE)
#else
#define IN(k) (a.ph_lo <= (k) && (k) < a.ph_hi)
#endif
#define SEAM(k) do { if (IN(k) && IN((k) + 1)) xcd_barrier(bar); PE(k); PB((k) + 1); } while (0)
    const int G = gridDim.x, c = blockIdx.x;
    PB(0);
    if (IN(0)) { phase0a(a, lds); } SEAM(0);
    if (IN(1)) { phase0b(a, lds); } SEAM(1);
    if (IN(2)) { __syncthreads(); OrderIn S{(const char*)(a.ws + WS_HX), (const char*)(a.ws + WS_WIN), G, c};
        EpiIn E{a.ws, (bf16_t*)a.out, a.in[I_BGATE], (const f32x2*)(a.ws + WS_ROPE)}; pg8::gemm_phase<false>(lds, 1024, S, E); } SEAM(2);
    if (IN(3)) { phase2a(a, lds); } SEAM(3);
    if (IN(4)) { phase2b(a); } SEAM(4);
    if (IN(5)) { phase2c(a, lds); } SEAM(5);
    if (IN(6)) {
        const bool cvt_first = (c & 1) == 0;
        if (cvt_first) { PB(104); phase3_cvt(a, lds); PE(104); }
        {   OrderMerge S{(const char*)(a.ws + WS_ZG), (const char*)(a.ws + WS_ZGL), (const char*)(a.ws + WS_WRET), (const char*)(a.ws + WS_WLRU), G, c};
            EpiMerge E{(const bf16_t*)a.out, (bf16_t*)(a.ws + WS_HX)}; __syncthreads(); pg8::gemm_phase<false>(lds, 1024, S, E); }
        if (!cvt_first) { phase3_cvt(a, lds); } } SEAM(6);
    if (IN(7)) { __syncthreads(); OrderOut S{(const char*)(a.ws + WS_HX), (const char*)(a.ws + WS_WOUT), G, c}; EpiOut E{&a}; pg8::gemm_phase<false>(lds, 1024, S, E); } SEAM(7);
    if (IN(8)) { phase5(a, lds); } SEAM(8);
    if (IN(9)) {
        LAS int* tt = (LAS int*)(lds + LDS_MISC + 64); LAS int* tok = (LAS int*)(lds + LDS_TOK);
        moe_tiles(a, tt);
        {
            const int tid = tid_fresh();
            const int* cnt = (const int*)(a.ws + WS_CTL) + CW_CNT; const int* ptok = (const int*)(a.ws + WS_PTOK);
            for (int i = 0; i < 8; ++i) { const int L = moe_unit(i, G, c, tt[32] * 6); if (L < 0) break; const int rt = L / 6, e = moe_expert(tt, rt), r0 = (rt - tt[e]) * 256;
                if (tid < 256) tok[i * 256 + tid] = (r0 + tid < cnt[e]) ? ptok[(size_t)e * 65536 + r0 + tid] : NT; }
            __syncthreads();
        }
        OrderMoe1 S{(const char*)(a.ws + WS_HX2Q), (const char*)(a.ws + WS_WGU), tt, tok, G, c}; EpiMoe1 E{(unsigned char*)(a.ws + WS_HID)}; pg8::gemm_phase<true>(lds, 1024, S, E); } SEAM(9);
    if (IN(10)) { LAS int* tt = (LAS int*)(lds + LDS_MISC + 64); moe_tiles(a, tt);
        OrderMoe2 S{(const char*)(a.ws + WS_HID), (const char*)(a.ws + WS_WDN), tt, G, c}; EpiMoe2 E{(unsigned char*)(a.ws + WS_YE)}; pg8::gemm_phase<true>(lds, 768, S, E); } SEAM(10);
    if (IN(11)) { phase8(a, lds); }
    PE(11);
#ifdef PROBE_ID
    if (blockIdx.x == 0 && threadIdx.x == 0) { const unsigned long long w = probe_words()[1] * 4ull, t0 = wall_clock64(); while (wall_clock64() - t0 < w) __builtin_amdgcn_s_sleep(8); }
#endif
#undef IN
#undef SEAM
}

extern "C" void kernel_launch(void* const* d_in, const int* in_sizes, int n_in, void* d_out, int out_size, void* d_ws, size_t ws_size, hipStream_t stream) {
    static int grid = 0;
    if (grid == 0) {
        if (n_in != 30 || out_size != NT * DM || ws_size < WS_NEED) { fprintf(stderr, "kernel_launch: unexpected shapes (n_in %d out %d ws %zu)\n", n_in, out_size, ws_size); grid = -1; return; }
        int dev = 0, cus = 0;
        if (hipGetDevice(&dev) != hipSuccess || hipDeviceGetAttribute(&cus, hipDeviceAttributeMultiprocessorCount, dev) != hipSuccess) { grid = -1; return; }
        if (hipFuncSetAttribute((const void*)fwd_kernel, hipFuncAttributeMaxDynamicSharedMemorySize, LDS_BYTES) != hipSuccess) { fprintf(stderr, "kernel_launch: hipFuncSetAttribute failed\n"); grid = -1; return; }
        int per_cu = 0; (void)hipOccupancyMaxActiveBlocksPerMultiprocessor(&per_cu, (const void*)fwd_kernel, 512, LDS_BYTES); (void)hipGetLastError();
        grid = cus;
    }
    if (grid < 0) return;
    (void)hipMemsetAsync((char*)d_ws + WS_CTL, 0, 1 * MiB, stream);
    KArgs a{};
    for (int i = 0; i < 30; ++i) a.in[i] = (const float*)d_in[i];
    a.out = (float*)d_out; a.ws = (unsigned char*)d_ws;
#if N_LAUNCH_SPLIT
    for (int p = 0; p < N_PHASES; ++p) { a.ph_lo = p; a.ph_hi = p + 1; hipLaunchKernelGGL(fwd_kernel, dim3(grid), dim3(512), LDS_BYTES, stream, a); }
#else
    a.ph_lo = 0; a.ph_hi = N_PHASES; hipLaunchKernelGGL(fwd_kernel, dim3(grid), dim3(512), LDS_BYTES, stream, a);
#endif
}
```
